# Optimizing an MI355X kernel written in HIP

```python
import math
import jax
import jax.numpy as jnp
from jax import lax
import numpy as np

D_MODEL = 1024
BATCH = 8
SEQ = 2048
DEPTH = 4

ROPE_THETA = 500000.0
EPS = 1e-6
Q_BLOCK = 128
D_FF = 4 * D_MODEL
POS_OFFSET_MAX = 4096
NEG = -1e30
FORCED = 1e9
N_EVEN = (DEPTH + 1) // 2
N_ODD = DEPTH // 2

MLA_HEADS = 8
MLA_NOPE = 64
MLA_ROPE = 32
MLA_V = 64
MLA_Q_RANK = 256
MLA_KV_RANK = 256

NSA_HEADS = 8
NSA_GROUPS = 2
NSA_HPG = NSA_HEADS // NSA_GROUPS
NSA_DH = 64
NSA_ROT = NSA_DH // 4
NSA_CMP_LEN = 32
NSA_CMP_STRIDE = 16
NSA_CMP_HIDDEN = 128
NSA_SLC_LEN = 64
NSA_TOP_N = 16
NSA_WINDOW = 512
NSA_SLC_Q_BLOCK = 64

DIFF_HEADS = 8
DIFF_DH = 64
DIFF_ROT = DIFF_DH // 4

MLA_IN = MLA_Q_RANK + MLA_KV_RANK + MLA_ROPE
NSA_Q_W = NSA_HEADS * NSA_DH
NSA_KV_W = 3 * 2 * NSA_GROUPS * NSA_DH
NSA_GATE_W = 3 * NSA_HEADS
HY_IN = MLA_IN + NSA_Q_W + NSA_KV_W + NSA_GATE_W
HY_OUT = MLA_HEADS * MLA_V + NSA_HEADS * NSA_DH
HY_SPLITS = [MLA_Q_RANK, MLA_Q_RANK + MLA_KV_RANK, MLA_IN, MLA_IN + NSA_Q_W, MLA_IN + NSA_Q_W + NSA_KV_W]
DIFF_W = DIFF_HEADS * 2 * DIFF_DH

kernel_name = "hybrid_mla_nsa_diffattn_trunk"


def _rms(x, gain):
    xf = x.astype(jnp.float32)
    y = xf * lax.rsqrt(jnp.mean(xf * xf, axis=-1, keepdims=True) + EPS)
    return (y * gain.astype(jnp.float32)).astype(x.dtype)


def _rope(x, pos, rot):
    half = rot // 2
    inv_freq = ROPE_THETA ** (-jnp.arange(half, dtype=jnp.float32) / half)
    ang = pos.astype(jnp.float32)[..., None] * inv_freq
    cos, sin = jnp.cos(ang), jnp.sin(ang)
    xr = x[..., :rot].astype(jnp.float32)
    x1, x2 = xr[..., :half], xr[..., half:]
    xr = jnp.concatenate([x1 * cos - x2 * sin, x1 * sin + x2 * cos], axis=-1)
    return jnp.concatenate([xr.astype(x.dtype), x[..., rot:]], axis=-1)


def _causal_attention(q, k, v, map_w, scale):
    B, H, M, S, dk = q.shape
    dv = v.shape[-1]
    nb = S // Q_BLOCK
    qb = jnp.moveaxis(q.reshape(B, H, M, nb, Q_BLOCK, dk), 3, 0)
    kpos = jnp.arange(S)
    wf = map_w.astype(jnp.float32)

    def one(args):
        qblk, s0 = args
        s = jnp.einsum('bhmqd,bhmkd->bhmqk', qblk, k, preferred_element_type=jnp.float32) * scale
        mask = kpos[None, :] <= (s0 + jnp.arange(Q_BLOCK))[:, None]
        p = jax.nn.softmax(jnp.where(mask, s, NEG), axis=-1)
        a = jnp.einsum('m,bhmqk->bhqk', wf, p)
        return jnp.einsum('bhqk,bhkd->bhqd', a.astype(v.dtype), v)

    o = lax.map(one, (qb, jnp.arange(nb) * Q_BLOCK))
    return jnp.moveaxis(o, 0, 2).reshape(B, H, S, dv)


def _mla_mixer(cq_raw, ckv_raw, kpe_raw, pos, q_norm, w_uq, kv_norm, w_ukv, q_gain, k_gain):
    B, S, _ = cq_raw.shape
    H = MLA_HEADS
    q = (_rms(cq_raw, q_norm) @ w_uq).reshape(B, S, H, MLA_ROPE + MLA_NOPE).transpose(0, 2, 1, 3)
    kv = (_rms(ckv_raw, kv_norm) @ w_ukv).reshape(B, S, H, MLA_NOPE + MLA_V).transpose(0, 2, 1, 3)
    k_nope, v = kv[..., :MLA_NOPE], kv[..., MLA_NOPE:]
    k_pe = jnp.broadcast_to(kpe_raw[:, None], (B, H, S, MLA_ROPE))
    k = jnp.concatenate([k_pe, k_nope], axis=-1)
    p = pos[:, None, :]
    q = _rope(_rms(q, q_gain), p, MLA_ROPE)
    k = _rope(_rms(k, k_gain), p, MLA_ROPE)
    o = _causal_attention(q[:, :, None], k[:, :, None], v, jnp.ones((1,), jnp.float32),
                          (MLA_ROPE + MLA_NOPE) ** -0.5)
    return o.transpose(0, 2, 1, 3).reshape(B, S, H * MLA_V)


def _nsa_mixer(q_raw, kv_raw, gate_raw, pos, q_gain, k_gain, cmp_pos, cmp_w1, cmp_w2):
    B, S, _ = q_raw.shape
    G, HG, DH = NSA_GROUPS, NSA_HPG, NSA_DH
    scale = DH ** -0.5
    tpos = jnp.arange(S)
    q = q_raw.reshape(B, S, G, HG, DH).transpose(0, 2, 3, 1, 4)
    q = _rope(_rms(q, q_gain), pos[:, None, None, :], NSA_ROT)
    kv = kv_raw.reshape(B, S, 3, 2, G, DH).transpose(2, 3, 0, 4, 1, 5)

    nc = (S - NSA_CMP_LEN) // NSA_CMP_STRIDE + 1
    c_start = jnp.arange(nc) * NSA_CMP_STRIDE
    c_end = c_start + NSA_CMP_LEN - 1
    blk_idx = c_start[:, None] + jnp.arange(NSA_CMP_LEN)[None, :]

    def compress(tok, j):
        blocks = (tok[:, :, blk_idx] + cmp_pos[j]).reshape(B, G, nc, NSA_CMP_LEN * DH)
        return jax.nn.gelu(blocks @ cmp_w1[j]) @ cmp_w2[j]

    kc = _rope(_rms(compress(kv[0, 0], 0), k_gain[0]), pos[:, c_end][:, None, :], NSA_ROT)
    vc = compress(kv[0, 1], 1)
    s = jnp.einsum('bghqd,bgcd->bghqc', q, kc, preferred_element_type=jnp.float32) * scale
    cmask = c_end[None, :] <= tpos[:, None]
    p_cmp = jax.nn.softmax(jnp.where(cmask, s, NEG), axis=-1) * cmask
    o_cmp = jnp.einsum('bghqc,bgcd->bghqd', p_cmp.astype(vc.dtype), vc)

    ns = S // NSA_SLC_LEN
    n_sel = min(NSA_TOP_N, ns)
    j_start = jnp.arange(ns) * NSA_SLC_LEN
    cover = ((c_start[:, None] <= j_start[None, :] + NSA_SLC_LEN - 1)
             & (c_end[:, None] >= j_start[None, :])).astype(jnp.float32)
    imp = jnp.einsum('bghqc,cj->bgqj', p_cmp, cover)
    jt = tpos // NSA_SLC_LEN
    jj = jnp.arange(ns)
    allowed = jj[None, :] <= jt[:, None]
    forced = allowed & ((jj[None, :] == 0) | (jj[None, :] >= jt[:, None] - 1))
    imp = jnp.where(forced, FORCED, jnp.where(allowed, imp, NEG))
    top_val, top_idx = lax.top_k(imp, n_sel)
    top_ok = top_val > 0.5 * NEG
    ks = _rope(_rms(kv[1, 0], k_gain[1]), pos[:, None, :], NSA_ROT)
    k_blk = ks.reshape(B, G, ns, NSA_SLC_LEN, DH)
    v_blk = kv[1, 1].reshape(B, G, ns, NSA_SLC_LEN, DH)
    bi = jnp.arange(B)[:, None, None, None]
    gi = jnp.arange(G)[None, :, None, None]
    qb_n = NSA_SLC_Q_BLOCK

    def sel_block(args):
        qb, ib, okb, s0 = args
        kg = k_blk[bi, gi, ib]
        vg = v_blk[bi, gi, ib]
        sc = jnp.einsum('bghqd,bgqnld->bghqnl', qb, kg, preferred_element_type=jnp.float32) * scale
        qpos = s0 + jnp.arange(qb_n)
        kpos = ib[..., None] * NSA_SLC_LEN + jnp.arange(NSA_SLC_LEN)
        m = ((kpos <= qpos[:, None, None]) & okb[..., None])[:, :, None]
        sc = jnp.where(m, sc, NEG).reshape(B, G, HG, qb_n, n_sel * NSA_SLC_LEN)
        pr = jax.nn.softmax(sc, axis=-1).reshape(B, G, HG, qb_n, n_sel, NSA_SLC_LEN) * m
        return jnp.einsum('bghqnl,bgqnld->bghqd', pr.astype(vg.dtype), vg)

    nqb = S // qb_n
    o_slc = lax.map(sel_block, (
        jnp.moveaxis(q.reshape(B, G, HG, nqb, qb_n, DH), 3, 0),
        jnp.moveaxis(top_idx.reshape(B, G, nqb, qb_n, n_sel), 2, 0),
        jnp.moveaxis(top_ok.reshape(B, G, nqb, qb_n, n_sel), 2, 0),
        jnp.arange(nqb) * qb_n))
    o_slc = jnp.moveaxis(o_slc, 0, 3).reshape(B, G, HG, S, DH)

    kw = _rope(_rms(kv[2, 0], k_gain[2]), pos[:, None, :], NSA_ROT)
    pad = ((0, 0), (0, 0), (NSA_WINDOW, 0), (0, 0))
    kp, vp = jnp.pad(kw, pad), jnp.pad(kv[2, 1], pad)
    span = NSA_WINDOW + Q_BLOCK

    def win_block(args):
        qb, s0 = args
        kb = lax.dynamic_slice_in_dim(kp, s0, span, axis=2)
        vb = lax.dynamic_slice_in_dim(vp, s0, span, axis=2)
        sc = jnp.einsum('bghqd,bgkd->bghqk', qb, kb, preferred_element_type=jnp.float32) * scale
        qpos = (s0 + jnp.arange(Q_BLOCK))[:, None]
        kpos = (s0 - NSA_WINDOW + jnp.arange(span))[None, :]
        m = (kpos <= qpos) & (kpos > qpos - NSA_WINDOW) & (kpos >= 0)
        pr = jax.nn.softmax(jnp.where(m, sc, NEG), axis=-1)
        return jnp.einsum('bghqk,bgkd->bghqd', pr.astype(vb.dtype), vb)

    nb = S // Q_BLOCK
    o_win = lax.map(win_block, (jnp.moveaxis(q.reshape(B, G, HG, nb, Q_BLOCK, DH), 3, 0),
                                jnp.arange(nb) * Q_BLOCK))
    o_win = jnp.moveaxis(o_win, 0, 3).reshape(B, G, HG, S, DH)

    g = jax.nn.sigmoid(gate_raw).reshape(B, S, 3, G, HG).transpose(2, 0, 3, 4, 1)[..., None]
    o = g[0] * o_cmp.astype(g.dtype) + g[1] * o_slc.astype(g.dtype) + g[2] * o_win.astype(g.dtype)
    return o.transpose(0, 3, 1, 2, 4).reshape(B, S, NSA_HEADS * DH)


def _diff_mixer(h, w_qkv, w_out, q_gain, k_gain, lam, sub_gain, pos, lam_init):
    B, S, _ = h.shape
    H, d = DIFF_HEADS, DIFF_DH
    q, k, v = jnp.split(h @ w_qkv, 3, axis=-1)
    q = q.reshape(B, S, H, 2, d).transpose(0, 2, 3, 1, 4)
    k = k.reshape(B, S, H, 2, d).transpose(0, 2, 3, 1, 4)
    v = v.reshape(B, S, H, 2 * d).transpose(0, 2, 1, 3)
    p = pos[:, None, None, :]
    q = _rope(_rms(q, q_gain), p, DIFF_ROT)
    k = _rope(_rms(k, k_gain), p, DIFF_ROT)
    lf = lam.astype(jnp.float32)
    lmb = jnp.exp(jnp.sum(lf[0] * lf[1])) - jnp.exp(jnp.sum(lf[2] * lf[3])) + lam_init
    o = _causal_attention(q, k, v, jnp.stack([jnp.ones_like(lmb), -lmb]), d ** -0.5)
    o = _rms(o, sub_gain) * (1.0 - lam_init)
    return o.transpose(0, 2, 1, 3).reshape(B, S, DIFF_W) @ w_out


def setup_inputs(seed: int = 0) -> dict:
    key = jax.random.key(seed)
    ks = jax.random.split(key, 28)
    f32 = jnp.float32
    D = D_MODEL

    def nrm(k, shape, scale):
        return jax.random.normal(k, shape, f32) * scale

    def gain(k, shape):
        return 1.0 + 0.02 * jax.random.normal(k, shape, f32)

    positions = (jax.random.randint(ks[2], (BATCH, 1), 0, POS_OFFSET_MAX, dtype=jnp.int32)
                 + jnp.arange(SEQ, dtype=jnp.int32)[None, :])
    return {
        "x": nrm(ks[0], (BATCH, SEQ, D), 1.0),
        "c": nrm(ks[1], (BATCH, D), 1.0),
        "positions": positions,
        "ada_w": nrm(ks[3], (DEPTH, D, 6 * D), 0.5 * D ** -0.5),
        "ada_b": nrm(ks[4], (DEPTH, 6 * D), 0.02),
        "norm_mix": gain(ks[5], (DEPTH, D)),
        "norm_mlp": gain(ks[6], (DEPTH, D)),
        "mlp_w1": nrm(ks[7], (DEPTH, D, D_FF), D ** -0.5),
        "mlp_w2": nrm(ks[8], (DEPTH, D_FF, D), D_FF ** -0.5),
        "hy_w_in": nrm(ks[9], (N_EVEN, D, HY_IN), D ** -0.5),
        "hy_w_out": nrm(ks[10], (N_EVEN, HY_OUT, D), HY_OUT ** -0.5),
        "mla_q_norm": gain(ks[11], (N_EVEN, MLA_Q_RANK)),
        "mla_w_uq": nrm(ks[12], (N_EVEN, MLA_Q_RANK, MLA_HEADS * (MLA_ROPE + MLA_NOPE)), MLA_Q_RANK ** -0.5),
        "mla_kv_norm": gain(ks[13], (N_EVEN, MLA_KV_RANK)),
        "mla_w_ukv": nrm(ks[14], (N_EVEN, MLA_KV_RANK, MLA_HEADS * (MLA_NOPE + MLA_V)), MLA_KV_RANK ** -0.5),
        "mla_q_gain": gain(ks[15], (N_EVEN, MLA_ROPE + MLA_NOPE)),
        "mla_k_gain": gain(ks[16], (N_EVEN, MLA_ROPE + MLA_NOPE)),
        "nsa_q_gain": gain(ks[17], (N_EVEN, NSA_DH)),
        "nsa_k_gain": gain(ks[18], (N_EVEN, 3, NSA_DH)),
        "nsa_cmp_pos": nrm(ks[19], (N_EVEN, 2, NSA_CMP_LEN, NSA_DH), 0.1),
        "nsa_cmp_w1": nrm(ks[20], (N_EVEN, 2, NSA_CMP_LEN * NSA_DH, NSA_CMP_HIDDEN), (NSA_CMP_LEN * NSA_DH) ** -0.5),
        "nsa_cmp_w2": nrm(ks[21], (N_EVEN, 2, NSA_CMP_HIDDEN, NSA_DH), NSA_CMP_HIDDEN ** -0.5),
        "diff_w_qkv": nrm(ks[22], (N_ODD, D, 3 * DIFF_W), D ** -0.5),
        "diff_w_out": nrm(ks[23], (N_ODD, DIFF_W, D), DIFF_W ** -0.5),
        "diff_q_gain": gain(ks[24], (N_ODD, DIFF_DH)),
        "diff_k_gain": gain(ks[25], (N_ODD, DIFF_DH)),
        "diff_lambda": nrm(ks[26], (N_ODD, 4, DIFF_DH), 0.1),
        "diff_sub_gain": gain(ks[27], (N_ODD, 2 * DIFF_DH)),
    }


def reference(x, c, positions, ada_w, ada_b, norm_mix, norm_mlp, mlp_w1, mlp_w2,
              hy_w_in, hy_w_out, mla_q_norm, mla_w_uq, mla_kv_norm, mla_w_ukv, mla_q_gain, mla_k_gain,
              nsa_q_gain, nsa_k_gain, nsa_cmp_pos, nsa_cmp_w1, nsa_cmp_w2,
              diff_w_qkv, diff_w_out, diff_q_gain, diff_k_gain, diff_lambda, diff_sub_gain):
    cond = jax.nn.silu(c)
    for i in range(DEPTH):
        mod = (cond @ ada_w[i] + ada_b[i])[:, None, :]
        sh1, sc1, g1, sh2, sc2, g2 = jnp.split(mod, 6, axis=-1)
        h = _rms(x, norm_mix[i]) * (1 + sc1) + sh1
        j = i // 2
        if i % 2 == 0:
            u = h @ hy_w_in[j]
            cq, ckv, kpe, nq, nkv, ngate = jnp.split(u, HY_SPLITS, axis=-1)
            y_mla = _mla_mixer(cq, ckv, kpe, positions, mla_q_norm[j], mla_w_uq[j], mla_kv_norm[j],
                               mla_w_ukv[j], mla_q_gain[j], mla_k_gain[j])
            y_nsa = _nsa_mixer(nq, nkv, ngate, positions, nsa_q_gain[j], nsa_k_gain[j],
                               nsa_cmp_pos[j], nsa_cmp_w1[j], nsa_cmp_w2[j])
            y = jnp.concatenate([y_mla, y_nsa.astype(y_mla.dtype)], axis=-1) @ hy_w_out[j]
        else:
            lam_init = 0.8 - 0.6 * math.exp(-0.3 * i)
            y = _diff_mixer(h, diff_w_qkv[j], diff_w_out[j], diff_q_gain[j], diff_k_gain[j],
                            diff_lambda[j], diff_sub_gain[j], positions, lam_init)
        x = x + g1 * y
        h = _rms(x, norm_mlp[i]) * (1 + sc2) + sh2
        x = x + g2 * (jnp.square(jax.nn.relu(h @ mlp_w1[i])) @ mlp_w2[i])
    return x
```

```cpp
#include <hip/hip_runtime.h>
#include <hip/hip_bf16.h>
#include <cstdio>
#include <cstdint>
#include <cmath>
namespace nv {
constexpr int B = 8, S = 2048, D = 1024, T = B * S, FF = 4096, HYIN = 1848;
constexpr float EPS = 1e-6f;
constexpr size_t Mi = 1u << 20;
constexpr size_t R_MOD = 0;
constexpr size_t R_COND = 196608;
constexpr size_t R_CS8 = 204800;
constexpr size_t R_CS16 = R_CS8 + 262144;
constexpr size_t R_SMALL = R_CS16 + 524288;
constexpr size_t R_U = 2 * Mi;
constexpr size_t R_A = R_U + 29 * Mi;
constexpr size_t R_B = R_A + 12 * Mi;
constexpr size_t R_C = R_B + 16 * Mi;
constexpr size_t R_D = R_C + 12 * Mi;
constexpr size_t R_H = R_D + 8 * Mi;
constexpr size_t R_END = R_H + 16 * Mi;

__global__ void k_silu(const float* c, float* o, int n) { int i = blockIdx.x * 256 + threadIdx.x; if (i < n) { float v = c[i]; o[i] = v / (1.f + expf(-v)); } }
__global__ void k_mod(const float* cond, const float* W, const float* bias, float* mod) {
    int i = blockIdx.y, n = blockIdx.x * 256 + threadIdx.x;
    const float* w = W + (size_t)i * D * 6144 + n; float acc[8] = {0, 0, 0, 0, 0, 0, 0, 0};
    for (int k = 0; k < D; ++k) { float wv = w[(size_t)k * 6144];
#pragma unroll
        for (int b = 0; b < 8; ++b) acc[b] += cond[b * D + k] * wv; }
#pragma unroll
    for (int b = 0; b < 8; ++b) mod[((size_t)i * 8 + b) * 6144 + n] = acc[b] + bias[i * 6144 + n];
}
__global__ void k_ropetab(const int* pos, float* cs8, float* cs16) {
    int g = blockIdx.x * 256 + threadIdx.x; int m = g / 24, i = g % 24; if (m >= T) return;
    double p = (double)pos[m];
    if (i < 8) { double f = pow(500000.0, -(double)i / 8.0); double a = p * f; cs8[(m * 8 + i) * 2] = (float)cos(a); cs8[(m * 8 + i) * 2 + 1] = (float)sin(a); }
    else { int k = i - 8; double f = pow(500000.0, -(double)k / 16.0); double a = p * f; cs16[(m * 16 + k) * 2] = (float)cos(a); cs16[(m * 16 + k) * 2 + 1] = (float)sin(a); }
}
__device__ __forceinline__ float block_sum256(float v, float* red) {
#pragma unroll
    for (int o = 32; o > 0; o >>= 1) v += __shfl_xor(v, o);
    __syncthreads(); if ((threadIdx.x & 63) == 0) red[threadIdx.x >> 6] = v; __syncthreads();
    return red[0] + red[1] + red[2] + red[3];
}
__global__ __launch_bounds__(256) void k_rmsmod(const float* x, const float* gain, const float* sh, const float* sc, float* h) {
    __shared__ float red[4]; int m = blockIdx.x, b = m / S; const float* xr = x + (size_t)m * D; float v[4]; float s = 0;
#pragma unroll
    for (int j = 0; j < 4; ++j) { v[j] = xr[threadIdx.x + 256 * j]; s += v[j] * v[j]; }
    float tot = block_sum256(s, red); float rs = rsqrtf(tot / D + EPS);
#pragma unroll
    for (int j = 0; j < 4; ++j) { int n = threadIdx.x + 256 * j; h[(size_t)m * D + n] = v[j] * rs * gain[n] * (1.f + sc[b * 6144 + n]) + sh[b * 6144 + n]; }
}
__global__ __launch_bounds__(256) void k_gemm(const float* A, int lda, const float* Bm, int ldb, float* C, int ldc, int M, int N, int K, int mode, const float* gate, int mrow0) {
    __shared__ float As[8][132], Bs[8][132];
    const int tid = threadIdx.x, m0 = blockIdx.y * 128, n0 = blockIdx.x * 128, tx = tid % 16, ty = tid / 16;
    float acc[8][8];
#pragma unroll
    for (int i = 0; i < 8; ++i)
#pragma unroll
        for (int j = 0; j < 8; ++j) acc[i][j] = 0.f;
    const int arow = tid / 2, acol = (tid % 2) * 4, brow = tid / 32, bcol = (tid % 32) * 4;
    for (int k0 = 0; k0 < K; k0 += 8) {
        float4 a = make_float4(0, 0, 0, 0), b = make_float4(0, 0, 0, 0);
        if (m0 + arow < M) a = *(const float4*)(A + (size_t)(m0 + arow) * lda + k0 + acol);
        if (n0 + bcol < N) b = *(const float4*)(Bm + (size_t)(k0 + brow) * ldb + n0 + bcol);
        As[acol + 0][arow] = a.x; As[acol + 1][arow] = a.y; As[acol + 2][arow] = a.z; As[acol + 3][arow] = a.w;
        *(float4*)&Bs[brow][bcol] = b;
        __syncthreads();
#pragma unroll
        for (int kk = 0; kk < 8; ++kk) {
            float av[8], bv[8];
#pragma unroll
            for (int i = 0; i < 8; ++i) av[i] = As[kk][ty * 8 + i];
#pragma unroll
            for (int j = 0; j < 8; ++j) bv[j] = Bs[kk][tx * 8 + j];
#pragma unroll
            for (int i = 0; i < 8; ++i)
#pragma unroll
                for (int j = 0; j < 8; ++j) acc[i][j] += av[i] * bv[j];
        }
        __syncthreads();
    }
#pragma unroll
    for (int i = 0; i < 8; ++i) { int m = m0 + ty * 8 + i; if (m >= M) continue;
#pragma unroll
        for (int j = 0; j < 8; ++j) { int n = n0 + tx * 8 + j; if (n >= N) continue; float v = acc[i][j]; size_t o = (size_t)m * ldc + n;
            if (mode == 0) C[o] = v; else if (mode == 1) { v = v > 0.f ? v : 0.f; C[o] = v * v; } else C[o] += gate[(size_t)((m + mrow0) / S) * 6144 + n] * v; } }
}
__global__ __launch_bounds__(256) void k_rmsrow(const float* in, int ldi, int off, const float* gain, float* out, int ldo, int n) {
    __shared__ float red[4]; int m = blockIdx.x; float v = threadIdx.x < n ? in[(size_t)m * ldi + off + threadIdx.x] : 0.f;
    float tot = block_sum256(v * v, red); float rs = rsqrtf(tot / n + EPS);
    if (threadIdx.x < n) out[(size_t)m * ldo + threadIdx.x] = v * rs * gain[threadIdx.x];
}
__global__ __launch_bounds__(256) void k_headnorm(const float* srcA, int ldA, int nA, const float* srcB, int ldB, int hsB, float* dst, int ldd, int dhs,
                                                  int n, const float* gain, int rot, const float* tab, int nheads) {
    int w = (blockIdx.x * 256 + threadIdx.x) >> 6, lane = threadIdx.x & 63; int m = w / nheads, h = w % nheads; if (m >= T) return;
    float v[2]; float s = 0;
#pragma unroll
    for (int j = 0; j < 2; ++j) { int d = lane + 64 * j; v[j] = 0.f; if (d < n) v[j] = d < nA ? srcA[(size_t)m * ldA + d] : srcB[(size_t)m * ldB + h * hsB + d - nA]; s += v[j] * v[j]; }
#pragma unroll
    for (int o = 32; o > 0; o >>= 1) s += __shfl_xor(s, o);
    float rs = rsqrtf(s / n + EPS);
    float y0 = v[0] * rs * (lane < n ? gain[lane] : 0.f);
    const int half = rot / 2;
    float other = __shfl_xor(y0, half);
    if (lane < rot) { int i = lane & (half - 1); float cs = tab[((size_t)m * half + i) * 2], sn = tab[((size_t)m * half + i) * 2 + 1];
        y0 = lane < half ? y0 * cs - other * sn : other * sn + y0 * cs; }
    if (lane < n) dst[(size_t)m * ldd + h * dhs + lane] = y0;
    int d1 = lane + 64; if (d1 < n) dst[(size_t)m * ldd + h * dhs + d1] = v[1] * rs * gain[d1];
}
__global__ __launch_bounds__(128) void k_compress(const float* U, const float* cpos, const float* w1, const float* w2, const float* kgain0, const float* cs8, float* KC, float* VC) {
    __shared__ float blk[2048]; __shared__ float hid[128]; __shared__ float outv[64]; __shared__ float red[2];
    const int c = blockIdx.x, bg = blockIdx.y, j = blockIdx.z, b = bg >> 1, g = bg & 1, tid = threadIdx.x;
    for (int e = tid; e < 2048; e += 128) { int l = e >> 6, d = e & 63; blk[e] = U[(size_t)(b * S + 16 * c + l) * HYIN + 1056 + j * 128 + g * 64 + d] + cpos[(j * 32 + l) * 64 + d]; }
    __syncthreads();
    { const float* w = w1 + (size_t)j * 2048 * 128 + tid; float a = 0; for (int k = 0; k < 2048; ++k) a += blk[k] * w[(size_t)k * 128];
      float x = a; float t = tanhf(0.7978845608028654f * (x + 0.044715f * x * x * x)); hid[tid] = 0.5f * x * (1.f + t); }
    __syncthreads();
    float o = 0;
    if (tid < 64) { const float* w = w2 + (size_t)j * 128 * 64 + tid; for (int n = 0; n < 128; ++n) o += hid[n] * w[n * 64]; }
    if (j == 1) { if (tid < 64) VC[((size_t)bg * 128 + c) * 64 + tid] = o; return; }
    float s = tid < 64 ? o * o : 0.f;
#pragma unroll
    for (int of = 32; of > 0; of >>= 1) s += __shfl_xor(s, of);
    if ((tid & 63) == 0) red[tid >> 6] = s; __syncthreads();
    float rs = rsqrtf((red[0] + red[1]) / 64.f + EPS);
    if (tid < 64) outv[tid] = o * rs * kgain0[tid]; __syncthreads();
    if (tid < 64) { float y = outv[tid]; if (tid < 16) { int i = tid & 7; size_t ti = ((size_t)(b * S + 16 * c + 31) * 8 + i) * 2; float cs = cs8[ti], sn = cs8[ti + 1]; float x1 = outv[i], x2 = outv[i + 8];
            y = tid < 8 ? x1 * cs - x2 * sn : x1 * sn + x2 * cs; }
        KC[((size_t)bg * 128 + c) * 64 + tid] = y; }
}
struct AP { const float* Q; size_t qbs; int qhs, ldq; const float* K; size_t kbs; int khs, ldk, kdiv; const float* V; size_t vbs; int vhs, ldv, vdiv;
            float* O; size_t obs; int ohs, ldo; float* P; const unsigned* sel; int dk, dv, nqh, mode; float scale; };
__global__ __launch_bounds__(256) void k_attn(AP a) {
    __shared__ float sc[4][2048]; __shared__ float qs[4][128];
    const int w = threadIdx.x >> 6, lane = threadIdx.x & 63, t = blockIdx.x * 4 + w, qh = blockIdx.y, b = blockIdx.z;
    const float* q = a.Q + b * a.qbs + (size_t)qh * a.qhs + (size_t)t * a.ldq;
    for (int d = lane; d < a.dk; d += 64) qs[w][d] = q[d];
    int lo = 0, hi = t;
    if (a.mode == 1) lo = t - 511 > 0 ? t - 511 : 0;
    if (a.mode == 2) { hi = t < 31 ? -1 : (t - 31) / 16; }
    unsigned selm = 0xffffffffu; if (a.mode == 3) selm = a.sel[((size_t)b * 2 + qh / 4) * S + t];
    __syncthreads();
    const float* Kb = a.K + b * a.kbs + (size_t)(qh / a.kdiv) * a.khs;
    float mx = -3.0e38f;
    for (int key = lo + lane; key <= hi; key += 64) {
        const float* kr = Kb + (size_t)key * a.ldk; float s = 0;
        for (int d = 0; d < a.dk; d += 4) { float4 kv = *(const float4*)(kr + d); s += qs[w][d] * kv.x + qs[w][d + 1] * kv.y + qs[w][d + 2] * kv.z + qs[w][d + 3] * kv.w; }
        s *= a.scale; if (!((selm >> (key >> 6)) & 1u)) s = -3.0e38f;
        sc[w][key - lo] = s; mx = fmaxf(mx, s);
    }
#pragma unroll
    for (int o = 32; o > 0; o >>= 1) mx = fmaxf(mx, __shfl_xor(mx, o));
    float sum = 0;
    for (int key = lo + lane; key <= hi; key += 64) { float s = sc[w][key - lo]; float p = s < -1.0e38f ? 0.f : expf(s - mx); sc[w][key - lo] = p; sum += p; }
#pragma unroll
    for (int o = 32; o > 0; o >>= 1) sum += __shfl_xor(sum, o);
    __syncthreads();
    const float inv = (hi >= lo) ? 1.f / sum : 0.f;
    const float* Vb = a.V + b * a.vbs + (size_t)(qh / a.vdiv) * a.vhs;
    float* op = a.O + b * a.obs + (size_t)qh * a.ohs + (size_t)t * a.ldo;
    for (int d = lane; d < a.dv; d += 64) { float acc = 0; for (int key = lo; key <= hi; ++key) acc += sc[w][key - lo] * Vb[(size_t)key * a.ldv + d]; op[d] = acc * inv; }
    if (a.P) { float* pp = a.P + (((size_t)b * a.nqh + qh) * S + t) * 128; for (int c = lane; c < 128; c += 64) pp[c] = (c <= hi) ? sc[w][c] * inv : 0.f; }
}
__global__ __launch_bounds__(256) void k_topk(const float* P, unsigned* sel) {
    int gi = (blockIdx.x * 256 + threadIdx.x) >> 5, j = threadIdx.x & 31; int t = gi % S, bg = gi / S, b = bg >> 1, g = bg & 1;
    float imp = 0;
    for (int hg = 0; hg < 4; ++hg) { const float* pp = P + (((size_t)b * 8 + g * 4 + hg) * S + t) * 128;
        for (int c = 4 * j - 1; c <= 4 * j + 3; ++c) if (c >= 0 && c < 127) imp += pp[c]; }
    int jt = t >> 6; bool allowed = j <= jt; bool forced = allowed && (j == 0 || j >= jt - 1);
    float v = forced ? 1e9f : (allowed ? imp : -1e30f);
    int rank = 0;
    for (int i = 0; i < 32; ++i) { float vi = __shfl(v, (threadIdx.x & 32) + i); rank += (vi > v || (vi == v && i < j)) ? 1 : 0; }
    bool selb = allowed && rank < 16;
    unsigned long long bal = __ballot(selb);
    if (j == 0) sel[(size_t)bg * S + t] = (unsigned)(bal >> (threadIdx.x & 32));
}
__global__ void k_nsa_comb(const float* U, const float* oc, const float* os, const float* ow, float* y) {
    size_t i = (size_t)blockIdx.x * 256 + threadIdx.x; int m = i / 512, c = i % 512, h = c / 64;
    const float* gr = U + (size_t)m * HYIN + 1824; float g0 = 1.f / (1.f + expf(-gr[h])), g1 = 1.f / (1.f + expf(-gr[8 + h])), g2 = 1.f / (1.f + expf(-gr[16 + h]));
    y[(size_t)m * 1024 + 512 + c] = g0 * oc[i] + g1 * os[i] + g2 * ow[i];
}
__global__ __launch_bounds__(256) void k_diff_comb(const float* O, const float* lam, const float* sg, float lam_init, float* y) {
    int w = (blockIdx.x * 256 + threadIdx.x) >> 6, lane = threadIdx.x & 63; int m = w >> 3, h = w & 7;
    float a = lam[lane] * lam[64 + lane], c = lam[128 + lane] * lam[192 + lane];
#pragma unroll
    for (int o = 32; o > 0; o >>= 1) { a += __shfl_xor(a, o); c += __shfl_xor(c, o); }
    float lmb = expf(a) - expf(c) + lam_init;
    const float* o0 = O + (size_t)m * 2048 + (h * 2) * 128; const float* o1 = o0 + 128;
    float v0 = o0[lane] - lmb * o1[lane], v1 = o0[lane + 64] - lmb * o1[lane + 64]; float s = v0 * v0 + v1 * v1;
#pragma unroll
    for (int o = 32; o > 0; o >>= 1) s += __shfl_xor(s, o);
    float rs = rsqrtf(s / 128.f + EPS) * (1.f - lam_init);
    y[(size_t)m * 1024 + h * 128 + lane] = v0 * rs * sg[lane]; y[(size_t)m * 1024 + h * 128 + lane + 64] = v1 * rs * sg[lane + 64];
}

struct In { const float* p[28]; const int* pos; };
inline void gemm(hipStream_t st, const float* A, int lda, const float* Bm, int ldb, float* C, int ldc, int M, int N, int K, int mode, const float* gate, int mrow0 = 0) {
    dim3 g((N + 127) / 128, (M + 127) / 128); hipLaunchKernelGGL(k_gemm, g, dim3(256), 0, st, A, lda, Bm, ldb, C, ldc, M, N, K, mode, gate, mrow0);
}
inline void forward(const In& in, float* xo, float* ws, hipStream_t st, int stop_layer = 4) {
    float *MOD = ws + R_MOD, *COND = ws + R_COND, *CS8 = ws + R_CS8, *CS16 = ws + R_CS16, *SM = ws + R_SMALL;
    float *H = ws + R_H, *U = ws + R_U, *RA = ws + R_A, *RB = ws + R_B, *RC = ws + R_C, *RD = ws + R_D;
    hipMemcpyAsync(xo, in.p[0], (size_t)T * D * 4, hipMemcpyDeviceToDevice, st);
    hipLaunchKernelGGL(k_silu, dim3(32), dim3(256), 0, st, in.p[1], COND, 8192);
    hipLaunchKernelGGL(k_mod, dim3(24, 4), dim3(256), 0, st, COND, in.p[3], in.p[4], MOD);
    hipLaunchKernelGGL(k_ropetab, dim3(T * 24 / 256), dim3(256), 0, st, in.pos, CS8, CS16);
    for (int i = 0; i < stop_layer; ++i) {
        const int j = i / 2; const float* mod = MOD + (size_t)i * 8 * 6144;
        hipLaunchKernelGGL(k_rmsmod, dim3(T), dim3(256), 0, st, xo, in.p[5] + i * D, mod + 0, mod + 1024, H);
        if (i % 2 == 0) {
            gemm(st, H, D, in.p[9] + (size_t)j * D * HYIN, HYIN, U, HYIN, T, HYIN, D, 0, nullptr);
            float *rq = RA, *rkv = RA + 4 * Mi, *kvu = RB, *qlat = RC, *Km = RA, *ycat = H;
            hipLaunchKernelGGL(k_rmsrow, dim3(T), dim3(256), 0, st, U, HYIN, 0, in.p[11] + j * 256, rq, 256, 256);
            hipLaunchKernelGGL(k_rmsrow, dim3(T), dim3(256), 0, st, U, HYIN, 256, in.p[13] + j * 256, rkv, 256, 256);
            gemm(st, rq, 256, in.p[12] + (size_t)j * 256 * 768, 768, qlat, 768, T, 768, 256, 0, nullptr);
            gemm(st, rkv, 256, in.p[14] + (size_t)j * 256 * 1024, 1024, kvu, 1024, T, 1024, 256, 0, nullptr);
            hipLaunchKernelGGL(k_headnorm, dim3(T * 8 / 4), dim3(256), 0, st, (const float*)nullptr, 0, 0, qlat, 768, 96, qlat, 768, 96, 96, in.p[15] + j * 96, 32, CS16, 8);
            hipLaunchKernelGGL(k_headnorm, dim3(T * 8 / 4), dim3(256), 0, st, U + 512, HYIN, 32, kvu, 1024, 128, Km, 768, 96, 96, in.p[16] + j * 96, 32, CS16, 8);
            { AP a{}; a.Q = qlat; a.qbs = (size_t)S * 768; a.qhs = 96; a.ldq = 768; a.K = Km; a.kbs = (size_t)S * 768; a.khs = 96; a.ldk = 768; a.kdiv = 1;
              a.V = kvu + 64; a.vbs = (size_t)S * 1024; a.vhs = 128; a.ldv = 1024; a.vdiv = 1; a.O = ycat; a.obs = (size_t)S * 1024; a.ohs = 64; a.ldo = 1024; a.P = nullptr; a.sel = nullptr;
              a.dk = 96; a.dv = 64; a.nqh = 8; a.mode = 0; a.scale = 1.f / sqrtf(96.f);
              hipLaunchKernelGGL(k_attn, dim3(S / 4, 8, B), dim3(256), 0, st, a); }
            float *Qn = RD, *kslc = RA, *kwin = RA + 2 * Mi, *oslc = RA + 4 * Mi, *Pc = RB, *ocmp = RC, *owin = RB;
            float *KC = SM, *VC = SM + 16 * 128 * 64; unsigned* sel = (unsigned*)(SM + 2 * 16 * 128 * 64);
            hipLaunchKernelGGL(k_headnorm, dim3(T * 8 / 4), dim3(256), 0, st, (const float*)nullptr, 0, 0, U + 544, HYIN, 64, Qn, 512, 64, 64, in.p[17] + j * 64, 16, CS8, 8);
            hipLaunchKernelGGL(k_compress, dim3(127, 16, 2), dim3(128), 0, st, U, in.p[19] + (size_t)j * 2 * 32 * 64, in.p[20] + (size_t)j * 2 * 2048 * 128, in.p[21] + (size_t)j * 2 * 128 * 64, in.p[18] + j * 192, CS8, KC, VC);
            { AP a{}; a.Q = Qn; a.qbs = (size_t)S * 512; a.qhs = 64; a.ldq = 512; a.K = KC; a.kbs = 2 * 128 * 64; a.khs = 128 * 64; a.ldk = 64; a.kdiv = 4;
              a.V = VC; a.vbs = 2 * 128 * 64; a.vhs = 128 * 64; a.ldv = 64; a.vdiv = 4; a.O = ocmp; a.obs = (size_t)S * 512; a.ohs = 64; a.ldo = 512; a.P = Pc; a.sel = nullptr;
              a.dk = 64; a.dv = 64; a.nqh = 8; a.mode = 2; a.scale = 0.125f;
              hipLaunchKernelGGL(k_attn, dim3(S / 4, 8, B), dim3(256), 0, st, a); }
            hipLaunchKernelGGL(k_topk, dim3(T * 2 * 32 / 256), dim3(256), 0, st, Pc, sel);
            hipLaunchKernelGGL(k_headnorm, dim3(T * 2 / 4), dim3(256), 0, st, (const float*)nullptr, 0, 0, U + 1056 + 256, HYIN, 64, kslc, 128, 64, 64, in.p[18] + j * 192 + 64, 16, CS8, 2);
            hipLaunchKernelGGL(k_headnorm, dim3(T * 2 / 4), dim3(256), 0, st, (const float*)nullptr, 0, 0, U + 1056 + 512, HYIN, 64, kwin, 128, 64, 64, in.p[18] + j * 192 + 128, 16, CS8, 2);
            { AP a{}; a.Q = Qn; a.qbs = (size_t)S * 512; a.qhs = 64; a.ldq = 512; a.K = kslc; a.kbs = (size_t)S * 128; a.khs = 64; a.ldk = 128; a.kdiv = 4;
              a.V = U + 1056 + 256 + 128; a.vbs = (size_t)S * HYIN; a.vhs = 64; a.ldv = HYIN; a.vdiv = 4; a.O = oslc; a.obs = (size_t)S * 512; a.ohs = 64; a.ldo = 512; a.P = nullptr; a.sel = sel;
              a.dk = 64; a.dv = 64; a.nqh = 8; a.mode = 3; a.scale = 0.125f;
              hipLaunchKernelGGL(k_attn, dim3(S / 4, 8, B), dim3(256), 0, st, a);
              a.K = kwin; a.V = U + 1056 + 512 + 128; a.O = owin; a.sel = nullptr; a.mode = 1;
              hipLaunchKernelGGL(k_attn, dim3(S / 4, 8, B), dim3(256), 0, st, a); }
            hipLaunchKernelGGL(k_nsa_comb, dim3(T * 512 / 256), dim3(256), 0, st, U, ocmp, oslc, owin, ycat);
            gemm(st, ycat, 1024, in.p[10] + (size_t)j * 1024 * 1024, 1024, xo, 1024, T, 1024, 1024, 2, mod + 2048);
        } else {
            float* QKV = U; float* Om = U + 48 * Mi; float* on = U;
            gemm(st, H, D, in.p[22] + (size_t)j * D * 3072, 3072, QKV, 3072, T, 3072, D, 0, nullptr);
            hipLaunchKernelGGL(k_headnorm, dim3(T * 16 / 4), dim3(256), 0, st, (const float*)nullptr, 0, 0, QKV, 3072, 64, QKV, 3072, 64, 64, in.p[24] + j * 64, 16, CS8, 16);
            hipLaunchKernelGGL(k_headnorm, dim3(T * 16 / 4), dim3(256), 0, st, (const float*)nullptr, 0, 0, QKV + 1024, 3072, 64, QKV + 1024, 3072, 64, 64, in.p[25] + j * 64, 16, CS8, 16);
            { AP a{}; a.Q = QKV; a.qbs = (size_t)S * 3072; a.qhs = 64; a.ldq = 3072; a.K = QKV + 1024; a.kbs = (size_t)S * 3072; a.khs = 64; a.ldk = 3072; a.kdiv = 1;
              a.V = QKV + 2048; a.vbs = (size_t)S * 3072; a.vhs = 128; a.ldv = 3072; a.vdiv = 2; a.O = Om; a.obs = (size_t)S * 2048; a.ohs = 128; a.ldo = 2048; a.P = nullptr; a.sel = nullptr;
              a.dk = 64; a.dv = 128; a.nqh = 16; a.mode = 0; a.scale = 0.125f;
              hipLaunchKernelGGL(k_attn, dim3(S / 4, 16, B), dim3(256), 0, st, a); }
            float lam_init = 0.8f - 0.6f * expf(-0.3f * (float)i);
            hipLaunchKernelGGL(k_diff_comb, dim3(T * 8 / 4), dim3(256), 0, st, Om, in.p[26] + j * 256, in.p[27] + j * 128, lam_init, on);
            gemm(st, on, 1024, in.p[23] + (size_t)j * 1024 * 1024, 1024, xo, 1024, T, 1024, 1024, 2, mod + 2048);
        }
        hipLaunchKernelGGL(k_rmsmod, dim3(T), dim3(256), 0, st, xo, in.p[6] + i * D, mod + 3072, mod + 4096, H);
        for (int ch = 0; ch < 4; ++ch) {
            float* hid = U;
            gemm(st, H + (size_t)ch * 4096 * D, D, in.p[7] + (size_t)i * D * FF, FF, hid, FF, 4096, FF, D, 1, nullptr);
            gemm(st, hid, FF, in.p[8] + (size_t)i * FF * D, D, xo + (size_t)ch * 4096 * D, D, 4096, D, FF, 2, mod + 5120, ch * 4096);
        }
    }
}
}
extern "C" void kernel_launch(void* const* d_in, const int* in_sizes, int n_in, void* d_out, int out_size, void* d_ws, size_t ws_size, hipStream_t stream) {
    nv::In in{};
    for (int i = 0; i < 28; ++i) in.p[i] = (const float*)d_in[i];
    in.pos = (const int*)d_in[2];
    if (ws_size < nv::R_END * 4) { fprintf(stderr, "ws too small: %zu < %zu\n", ws_size, (size_t)nv::R_END * 4); }
    nv::forward(in, (float*)d_out, (float*)d_ws, stream, 4);
}
```

```cpp
#define FX_MODE 0

#include <hip/hip_runtime.h>
#include <hip/hip_bf16.h>
#include <cstdio>
#include <cstdint>
#include <cmath>
#include <hip/hip_cooperative_groups.h>
namespace pg8 {
#define PG8_LAS __attribute__((address_space(3)))
typedef unsigned short bf16_t;
typedef short bf16x8 __attribute__((ext_vector_type(8)));
typedef float f32x4 __attribute__((ext_vector_type(4)));
typedef unsigned u32x4 __attribute__((ext_vector_type(4)));
constexpr int BM = 256, BK = 64, HALF = 128, HTB = HALF * BK * 2  , STAGE_BYTES = 8 * HTB, NXCD = 8, WGM = 8;

__host__ __device__ __forceinline__ int lds_byte(int r, int c) { const int st = (r >> 4) * 2 + (c >> 5), rr = r & 15, cc = c & 31, ob = rr * 64 + cc * 2; return st * 1024 + (ob ^ (((ob >> 9) & 1) << 5)); }
__host__ __device__ __forceinline__ void stage_rc(int b, int& R, int& C) { const int st = b / 1024, sb = b % 1024, swz = sb ^ (((sb >> 9) & 1) << 5); R = (st >> 1) * 16 + swz / 64; C = (st & 1) * 32 + (swz % 64) / 2; }
__host__ __device__ __forceinline__ int perm32(int rho) { const int n = rho >> 4, i = rho & 15; return 8 * (i >> 2) + 4 * n + (i & 3); }

struct Unit { int pm, pn; int aoff; };
struct Gemm { const bf16_t* A; const bf16_t* Bt; int M, N, K, lda; };

struct StaticOrder {
    int nM, nN, nwg, G, c;
    __host__ __device__ void init(int M, int N, int G_, int c_) { nM = M / BM; nN = N / BM; nwg = nM * nN; G = G_; c = c_; }
    __host__ __device__ bool next(int i, Unit& u) const {
        const long L = (long)i * G + c; if (L >= nwg) return false;
        int wgid = (int)L; { const int q = nwg / NXCD, r = nwg % NXCD, xcd = wgid % NXCD, off = wgid / NXCD; wgid = (xcd < r ? xcd * (q + 1) : r * (q + 1) + (xcd - r) * q) + off; }
        const int nig = WGM * nN, gid = wgid / nig, fm = gid * WGM, gsz = (nM - fm) < WGM ? (nM - fm) : WGM;
        u.pm = fm + ((wgid % nig) % gsz); u.pn = (wgid % nig) / gsz; u.aoff = 0; return true;
    }
    __device__ __forceinline__ void a_ready(const Unit&) const {}
    __device__ __forceinline__ void done(const Unit&) const {}
};

__device__ __forceinline__ unsigned cvt_pk_bf16(float lo, float hi) { unsigned r; asm volatile("v_cvt_pk_bf16_f32 %0, %1, %2" : "=v"(r) : "v"(lo), "v"(hi)); return r; }
typedef float f32x2 __attribute__((ext_vector_type(2)));
__device__ __forceinline__ f32x2 gelu_pk(f32x2 v) {
    const f32x2 av = __builtin_elementwise_abs(v), d = av * 0.2316418882f + 1.0f;
    f32x2 t; t.x = __builtin_amdgcn_rcpf(d.x); t.y = __builtin_amdgcn_rcpf(d.y);
    f32x2 q = t * 0.5307027145f + (-0.7265760135f); q = q * t + 0.7107068705f; q = q * t + (-0.142248368f); q = q * t + 0.127414796f; q = q * t;
    const f32x2 s = (v * v) * (-0.72134752044f);
    f32x2 e; e.x = __builtin_amdgcn_exp2f(s.x); e.y = __builtin_amdgcn_exp2f(s.y);
    const f32x2 m = v * (q * e), r = v - m;
    f32x2 o; o.x = v.x < 0.f ? m.x : r.x; o.y = v.y < 0.f ? m.y : r.y; return o;
}

template <int ACT  > struct EpiBf16 {
    static constexpr bool PERM = true, AFTER_DRAIN = false; static_assert(ACT == 0 || ACT == 1, "EpiBf16: ACT is 0 (none) or 1 (gelu_pk)");
    bf16_t* O; int ldc; const float* bias; int split_cols; size_t split_stride; float scale0;
    __device__ __forceinline__ void operator()(const f32x4 (&acc)[2][2][4][2], const Unit& u, int wr, int wc, int fr, int fq) const {
        const int row0 = u.pm * BM + wr * 64 + fr; int colt = u.pn * BM; bf16_t* base = O;
        float sc = 1.f; if (split_cols) { const int t = colt / split_cols; base += (size_t)t * split_stride; colt -= t * split_cols; if (t == 0) sc = scale0; }
        const int col0 = colt + wc * 32 + 8 * fq, bcol0 = u.pn * BM + wc * 32 + 8 * fq;
        f32x4 bv[2][2];
#pragma unroll
        for (int bj = 0; bj < 2; ++bj)
#pragma unroll
            for (int n = 0; n < 2; ++n) bv[bj][n] = bias ? *(const f32x4*)(bias + bcol0 + bj * HALF + 4 * n) : (f32x4){0.f, 0.f, 0.f, 0.f};
#pragma unroll
        for (int ai = 0; ai < 2; ++ai)
#pragma unroll
            for (int m = 0; m < 4; ++m) { bf16_t* rowp = base + (size_t)(row0 + ai * HALF + m * 16) * ldc + col0;
#pragma unroll
                for (int bj = 0; bj < 2; ++bj) { f32x4 v0 = acc[ai][bj][m][0] + bv[bj][0], v1 = acc[ai][bj][m][1] + bv[bj][1];
                    if (ACT == 1) { f32x2 a = gelu_pk((f32x2){v0[0], v0[1]}), b = gelu_pk((f32x2){v0[2], v0[3]}), c = gelu_pk((f32x2){v1[0], v1[1]}), d = gelu_pk((f32x2){v1[2], v1[3]});
                        v0 = (f32x4){a.x, a.y, b.x, b.y}; v1 = (f32x4){c.x, c.y, d.x, d.y}; }
                    v0 = v0 * sc; v1 = v1 * sc; u32x4 w; w.x = cvt_pk_bf16(v0[0], v0[1]); w.y = cvt_pk_bf16(v0[2], v0[3]); w.z = cvt_pk_bf16(v1[0], v1[1]); w.w = cvt_pk_bf16(v1[2], v1[3]);
                    *(u32x4*)(rowp + bj * HALF) = w; } }
    }
};

template <class Epi, class Sched, bool ALIGN_EPI = false, bool SP2 = false>
__device__ __forceinline__ void gemm_phase(PG8_LAS unsigned char* lds, const Gemm g, const Sched& S, const Epi& E) {
    int tid_ = threadIdx.x; asm volatile("" : "+v"(tid_)); const int tid = tid_, wid = __builtin_amdgcn_readfirstlane(tid >> 6), lane = tid & 63, wr = wid >> 2, wc = wid & 3, fr = lane & 15, fq = lane >> 4;
    const int K = g.K, nt = K / BK;
    unsigned voffA[2], voffB[2];
#pragma unroll
    for (int i = 0; i < 2; ++i) { int R, C; stage_rc(tid * 16 + i * 8192, R, C); const int Rb = Epi::PERM ? ((R & ~31) + perm32(R & 31)) : R;
        voffA[i] = (unsigned)(R * g.lda + C) * 2u; voffB[i] = (unsigned)(Rb * K + C) * 2u; }
    const size_t kstep = (size_t)(BK * 2);
    const size_t hstep = (size_t)HALF * K * 2;
    const size_t hstepA = (size_t)HALF * g.lda * 2, tstepA = 2 * hstepA;
    const size_t tstep = 2 * hstep;
    const unsigned ldsw = (unsigned)wid * 1024u;
    const int aoff = lds_byte(wr * 64 + fr, fq * 8), boff = lds_byte(wc * 32 + fr, fq * 8);
#define PG8_SA(b, h) (((b) * 2 + (h)) * HTB)
#define PG8_SB(b, h) ((4 + (b) * 2 + (h)) * HTB)
#define PG8_STAGE(bufoff, gbase, voff) do { _Pragma("unroll") for (int _i = 0; _i < 2; ++_i) \
        __builtin_amdgcn_global_load_lds((const unsigned*)((const char*)(gbase) + (voff)[_i]), (PG8_LAS unsigned*)(lds + (bufoff) + ldsw + _i * 8192), 16, 0, 0); } while (0)
#define PG8_LDA(dst, b, h) do { _Pragma("unroll") for (int m = 0; m < 4; ++m) _Pragma("unroll") for (int k = 0; k < 2; ++k) dst[m][k] = *(const PG8_LAS bf16x8*)(lds + PG8_SA(b, h) + aoff + m * 2048 + k * 1024); } while (0)
#define PG8_LDB(dst, b, h) do { _Pragma("unroll") for (int n = 0; n < 2; ++n) _Pragma("unroll") for (int k = 0; k < 2; ++k) dst[n][k] = *(const PG8_LAS bf16x8*)(lds + PG8_SB(b, h) + boff + n * 2048 + k * 1024); } while (0)
#define PG8_MMA(ai, bj, At, Bt) do { __builtin_amdgcn_s_setprio(1); _Pragma("unroll") for (int m = 0; m < 4; ++m) _Pragma("unroll") for (int n = 0; n < 2; ++n) _Pragma("unroll") for (int k = 0; k < 2; ++k) \
        acc[ai][bj][m][n] = __builtin_amdgcn_mfma_f32_16x16x32_bf16(Bt[n][k], At[m][k], acc[ai][bj][m][n], 0, 0, 0); __builtin_amdgcn_s_setprio(0); } while (0)
#define PG8_WAIT_V(n) asm volatile("s_waitcnt vmcnt(" #n ")" ::: "memory")
#define PG8_WAIT_L(n) asm volatile("s_waitcnt lgkmcnt(" #n ")" ::: "memory")
#define PG8_BAR __builtin_amdgcn_s_barrier()
#define PG8_SCHED __builtin_amdgcn_sched_barrier(0)
    Unit cur, nxt; int ui = 0;
    if (!S.next(0, cur)) return;
    f32x4 acc[2][2][4][2];
#pragma unroll
    for (int a = 0; a < 2; ++a)
#pragma unroll
        for (int b = 0; b < 2; ++b)
#pragma unroll
            for (int m = 0; m < 4; ++m)
#pragma unroll
                for (int n = 0; n < 2; ++n) acc[a][b][m][n] = (f32x4){0.f, 0.f, 0.f, 0.f};
    bf16x8 At[4][2], B0[2][2], B1[2][2];
    const char* cA = (const char*)g.A + (size_t)cur.pm * tstepA + (size_t)cur.aoff * 2; const char* cB = (const char*)g.Bt + (size_t)cur.pn * tstep;
    S.a_ready(cur);
    if constexpr (SP2) {
        PG8_STAGE(PG8_SB(0, 0), cB, voffB); PG8_STAGE(PG8_SB(0, 1), cB + hstep, voffB); PG8_STAGE(PG8_SA(0, 0), cA, voffA); PG8_STAGE(PG8_SA(0, 1), cA + hstepA, voffA);
        if (wr == 1) PG8_BAR;
        PG8_WAIT_V(2); PG8_BAR;
        PG8_STAGE(PG8_SB(1, 0), cB + kstep, voffB); PG8_STAGE(PG8_SA(1, 0), cA + kstep, voffA); PG8_STAGE(PG8_SB(1, 1), cB + hstep + kstep, voffB);
        PG8_WAIT_V(6); PG8_BAR;
    } else {
        PG8_STAGE(PG8_SB(0, 0), cB, voffB); PG8_STAGE(PG8_SA(0, 0), cA, voffA); PG8_STAGE(PG8_SB(0, 1), cB + hstep, voffB); PG8_STAGE(PG8_SA(0, 1), cA + hstepA, voffA);
        if (wr == 1) PG8_BAR;
        PG8_WAIT_V(4); PG8_BAR;
        PG8_STAGE(PG8_SB(1, 0), cB + kstep, voffB); PG8_STAGE(PG8_SA(1, 0), cA + kstep, voffA); PG8_STAGE(PG8_SB(1, 1), cB + hstep + kstep, voffB);
        PG8_WAIT_V(6); PG8_BAR;
    }
    for (;;) {
        const bool has_next = S.next(ui + 1, nxt);
        const char* nA = has_next ? (const char*)g.A + (size_t)nxt.pm * tstepA + (size_t)nxt.aoff * 2 : cA; const char* nB = has_next ? (const char*)g.Bt + (size_t)nxt.pn * tstep : cB;
        for (int t = 0; t < nt; t += 2) {
            const bool last = (t == nt - 2);
            const char* a1 = cA + (size_t)(t + 1) * kstep;
            const char* a2 = last ? nA : cA + (size_t)(t + 2) * kstep; const char* b2 = last ? nB : cB + (size_t)(t + 2) * kstep;
            const char* a3 = a2 + kstep; const char* b3 = b2 + kstep;
            if (last && has_next) S.a_ready(nxt);
            if constexpr (SP2) {
            PG8_LDB(B0, 0, 0); PG8_LDB(B1, 0, 1); PG8_SCHED; PG8_LDA(At, 0, 0); PG8_STAGE(PG8_SA(1, 1), a1 + hstepA, voffA);
            PG8_WAIT_V(8); PG8_WAIT_L(0); PG8_BAR; PG8_MMA(0, 0, At, B0); PG8_MMA(0, 1, At, B1); PG8_BAR; PG8_SCHED;
            PG8_LDA(At, 0, 1); PG8_STAGE(PG8_SB(0, 0), b2, voffB); PG8_STAGE(PG8_SB(0, 1), b2 + hstep, voffB); PG8_STAGE(PG8_SA(0, 0), a2, voffA);
            PG8_WAIT_V(8); PG8_WAIT_L(0); PG8_BAR; PG8_MMA(1, 0, At, B0); PG8_MMA(1, 1, At, B1); PG8_BAR; PG8_SCHED;
            PG8_LDB(B0, 1, 0); PG8_LDB(B1, 1, 1); PG8_SCHED; PG8_LDA(At, 1, 0); PG8_STAGE(PG8_SA(0, 1), a2 + hstepA, voffA);
            PG8_WAIT_V(8); PG8_WAIT_L(0); PG8_BAR; PG8_MMA(0, 0, At, B0); PG8_MMA(0, 1, At, B1); PG8_BAR; PG8_SCHED;
            PG8_LDA(At, 1, 1); PG8_STAGE(PG8_SB(1, 0), b3, voffB); PG8_STAGE(PG8_SB(1, 1), b3 + hstep, voffB); PG8_STAGE(PG8_SA(1, 0), a3, voffA);
            PG8_WAIT_V(8); PG8_WAIT_L(0); PG8_BAR; PG8_MMA(1, 0, At, B0); PG8_MMA(1, 1, At, B1); PG8_BAR; PG8_SCHED;
            } else {
            PG8_LDB(B0, 0, 0); PG8_SCHED; PG8_LDA(At, 0, 0); PG8_STAGE(PG8_SA(1, 1), a1 + hstepA, voffA);
            PG8_WAIT_L(8); PG8_BAR; PG8_WAIT_L(0); PG8_MMA(0, 0, At, B0); PG8_BAR; PG8_SCHED;
            PG8_LDB(B1, 0, 1); PG8_STAGE(PG8_SB(0, 0), b2, voffB);
            PG8_BAR; PG8_WAIT_L(0); PG8_MMA(0, 1, At, B1); PG8_BAR;
            PG8_LDA(At, 0, 1); PG8_STAGE(PG8_SA(0, 0), a2, voffA);
            PG8_BAR; PG8_WAIT_L(0); PG8_MMA(1, 0, At, B0); PG8_BAR; PG8_SCHED;
            PG8_STAGE(PG8_SB(0, 1), b2 + hstep, voffB);
            PG8_WAIT_V(6); PG8_BAR; PG8_MMA(1, 1, At, B1); PG8_BAR;
            PG8_LDB(B0, 1, 0); PG8_SCHED; PG8_LDA(At, 1, 0); PG8_STAGE(PG8_SA(0, 1), a2 + hstepA, voffA);
            PG8_WAIT_L(8); PG8_BAR; PG8_WAIT_L(0); PG8_MMA(0, 0, At, B0); PG8_BAR; PG8_SCHED;
            PG8_LDB(B1, 1, 1); PG8_STAGE(PG8_SB(1, 0), b3, voffB);
            PG8_BAR; PG8_WAIT_L(0); PG8_MMA(0, 1, At, B1); PG8_BAR;
            PG8_LDA(At, 1, 1); PG8_STAGE(PG8_SA(1, 0), a3, voffA);
            PG8_BAR; PG8_WAIT_L(0); PG8_MMA(1, 0, At, B0); PG8_BAR; PG8_SCHED;
            PG8_STAGE(PG8_SB(1, 1), b3 + hstep, voffB);
            PG8_WAIT_V(6); PG8_BAR; PG8_MMA(1, 1, At, B1); PG8_BAR;
            }
        }
        if constexpr (ALIGN_EPI) { if (wr == 0) PG8_BAR; }
        if constexpr (!Epi::AFTER_DRAIN) { E(acc, cur, wr, wc, fr, fq); S.done(cur); }
        if (!has_next) break;
#pragma unroll
        for (int a = 0; a < 2; ++a)
#pragma unroll
            for (int b = 0; b < 2; ++b)
#pragma unroll
                for (int m = 0; m < 4; ++m)
#pragma unroll
                    for (int n = 0; n < 2; ++n) acc[a][b][m][n] = (f32x4){0.f, 0.f, 0.f, 0.f};
        cur = nxt; cA = nA; cB = nB; ++ui;
        if constexpr (ALIGN_EPI) { if (wr == 1) PG8_BAR; }
    }
    PG8_WAIT_V(0);
    if constexpr (!ALIGN_EPI) { if (wr == 0) PG8_BAR; }
    PG8_BAR;
    if constexpr (Epi::AFTER_DRAIN) { E.fused(acc, cur, wr, wc, fr, fq, lds, wid, lane); S.done(cur); }
#undef PG8_SA
#undef PG8_SB
#undef PG8_STAGE
#undef PG8_LDA
#undef PG8_LDB
#undef PG8_MMA
#undef PG8_WAIT_V
#undef PG8_WAIT_L
#undef PG8_BAR
#undef PG8_SCHED
}
}
namespace fx {
#define DI __device__ __forceinline__
#define LAS __attribute__((address_space(3)))
typedef unsigned short bf16_t;
typedef short bf16x8 __attribute__((ext_vector_type(8)));
typedef short s16x4 __attribute__((ext_vector_type(4)));
typedef float f32x4 __attribute__((ext_vector_type(4)));
typedef float f32x16 __attribute__((ext_vector_type(16)));
typedef unsigned u32x4 __attribute__((ext_vector_type(4)));
typedef unsigned u32x2 __attribute__((ext_vector_type(2)));
constexpr int B = 8, S = 2048, D = 1024, T = B * S, FF = 4096, HYIN = 1848, UW = 2048;
constexpr float EPS = 1e-6f, LOG2E = 1.4426950408889634f;
constexpr int NW = 8, NT = 512;
constexpr size_t MiB = 1u << 20;
constexpr size_t WS_CTL = 0;
constexpr size_t WS_MOD = 1 * MiB;
constexpr size_t WS_CS8 = 2 * MiB;
constexpr size_t WS_CS16 = 3 * MiB;
constexpr size_t WS_MISC = 5 * MiB;
constexpr size_t WS_W = 6 * MiB;
constexpr size_t W_EVEN = 9 * MiB, W_ODD = 8 * MiB, W_MLP = 16 * MiB;
constexpr size_t WE_IN = 0, WE_OUT = 4 * MiB, WE_UP = 6 * MiB, WE_C1 = 7 * MiB, WE_C2 = 8 * MiB;
constexpr size_t WO_QKV = 0, WO_O = 6 * MiB;
constexpr size_t WS_WEVEN = WS_W, WS_WODD = WS_W + 2 * W_EVEN, WS_WMLP = WS_WODD + 2 * W_ODD;
constexpr size_t WS_XN = 104 * MiB;
constexpr size_t WS_YC = 136 * MiB;
constexpr size_t WS_BIG = 168 * MiB;
constexpr size_t BIG_U = 0, BIG_UP = 64 * MiB + 64 * 1024;
constexpr int UPW = 1792;
constexpr size_t WS_FAST_END = 296 * MiB;
constexpr size_t WS_NAIVE = 300 * MiB;
constexpr int LDS_MISC = 131072, LDS_BYTES = 147456;

DI unsigned f2bf(float f) { unsigned u = __builtin_bit_cast(unsigned, f); return (u + 0x7fffu + ((u >> 16) & 1u)) >> 16; }
DI unsigned pk2(float lo, float hi) { return f2bf(lo) | (f2bf(hi) << 16); }
DI float bf2f(unsigned short b) { return __builtin_bit_cast(float, (unsigned)b << 16); }
DI float bflo(unsigned u) { return __builtin_bit_cast(float, u << 16); }
DI float bfhi(unsigned u) { return __builtin_bit_cast(float, u & 0xffff0000u); }
template <int O> DI float swz(float v) { static_assert(O < 32, "swz: xor mask < 32"); return __builtin_bit_cast(float, __builtin_amdgcn_ds_swizzle(__builtin_bit_cast(int, v), (O << 10) | 0x1f)); }
template <int O> DI unsigned swzu(unsigned v) { return (unsigned)__builtin_amdgcn_ds_swizzle((int)v, (O << 10) | 0x1f); }
DI void xchg32(unsigned& a, unsigned& b) { asm volatile("s_nop 1\n\tv_permlane32_swap_b32 %0, %1\n\ts_nop 1" : "+v"(a), "+v"(b)); }
DI float sum32(float v) { unsigned a = __builtin_bit_cast(unsigned, v), b = a; xchg32(a, b); return __builtin_bit_cast(float, a) + __builtin_bit_cast(float, b); }
DI float max32(float v) { unsigned a = __builtin_bit_cast(unsigned, v), b = a; xchg32(a, b); return fmaxf(__builtin_bit_cast(float, a), __builtin_bit_cast(float, b)); }
DI unsigned or32(unsigned v) { unsigned a = v, b = v; xchg32(a, b); return a | b; }
#ifdef DBG_SHFL
DI float wave_sum(float v) { for (int o = 1; o < 64; o <<= 1) v += __shfl_xor(v, o); return v; }
#else
DI float wave_sum(float v) { v += swz<1>(v); v += swz<2>(v); v += swz<4>(v); v += swz<8>(v); v += swz<16>(v); return sum32(v); }
#endif

struct Args { const float* in[28]; const int* pos; float* out; unsigned char* ws; int ph_lo, ph_hi; int use_cg; int pad; };
typedef const __attribute__((address_space(4))) Args CArgs;
#define XB_TMO      128
#define XB_XCNT(j)  (256  + 64 * (j))
#define XB_XSUB(j)  (1280 + 64 * (j))
#define XB_XGEN(j)  (2304 + 64 * (j))
#define XB_TOP      3328
#define XB_TOPGEN   3392
#define XCD_BAR_WORDS 3456
#define XB_SPIN_CAP (1u << 20)
DI unsigned xb_ld(unsigned* p)              { return __hip_atomic_load(p, __ATOMIC_RELAXED, __HIP_MEMORY_SCOPE_AGENT); }
DI unsigned xb_add(unsigned* p, unsigned v) { return __hip_atomic_fetch_add(p, v, __ATOMIC_RELAXED, __HIP_MEMORY_SCOPE_AGENT); }
DI unsigned xb_xcc_id() { return (unsigned)__builtin_amdgcn_s_getreg((3 << 11) | 20) & 0xFu; }
#define XB_SPIN(cond, bar) do { unsigned _sp = 0; while (cond) { __builtin_amdgcn_s_sleep(1); \
    if ((++_sp & 255u) == 0u) { if (xb_ld(&(bar)[XB_TMO])) break; if (_sp > XB_SPIN_CAP) { atomicAdd(&(bar)[XB_TMO], 1u); break; } } } } while (0)
struct XcdBarrier { unsigned* bar; unsigned x; volatile LAS unsigned* st; };
DI XcdBarrier xcd_barrier_post(unsigned* bar, volatile LAS unsigned* st) {
    XcdBarrier b; b.bar = bar; b.x = xb_xcc_id(); b.st = st;
    if (threadIdx.x == 0) (void)xb_add(&bar[XB_XCNT(b.x)], 1u);
    return b;
}
DI void xcd_barrier_complete(unsigned* bar, unsigned x, unsigned& nloc, unsigned& nx) {
    const unsigned G = gridDim.x * gridDim.y * gridDim.z;
    unsigned sum, cnt, mine, sp = 0u;
    for (;;) {
        sum = 0u; cnt = 0u; mine = 0u;
#pragma unroll
        for (unsigned j = 0; j < 16; ++j) { const unsigned c = xb_ld(&bar[XB_XCNT(j)]); sum += c; cnt += (c > 0u) ? 1u : 0u; mine = (j == x) ? c : mine; }
        if (sum == G) break;
        __builtin_amdgcn_s_sleep(1);
        if ((++sp & 255u) == 0u) { if (xb_ld(&bar[XB_TMO])) break; if (sp > XB_SPIN_CAP) { atomicAdd(&bar[XB_TMO], 1u); break; } }
    }
    nloc = mine > 0u ? mine : 1u; nx = cnt > 0u ? cnt : 1u;
}
DI void xcd_barrier(const XcdBarrier& b) {
    asm volatile("s_waitcnt vmcnt(0)" ::: "memory");
    __syncthreads();
    int t0_ = threadIdx.x; asm volatile("" : "+v"(t0_));
    if (t0_ == 0) {
        unsigned* bar; { CArgs* p_ = (CArgs*)__builtin_amdgcn_kernarg_segment_ptr(); asm volatile("" : "+s"(p_)); bar = (unsigned*)(p_->ws + WS_CTL) + 4096; }
        __builtin_amdgcn_s_waitcnt(0);
        unsigned nloc = b.st[0], nx = b.st[1];
        if (nloc == 0u) { xcd_barrier_complete(bar, b.x, nloc, nx); b.st[0] = nloc; b.st[1] = nx; }
        const unsigned old = xb_add(&bar[XB_XSUB(b.x)], 1u);
        const unsigned gen = old / nloc;
        if (old + 1u == (gen + 1u) * nloc) {
            __builtin_amdgcn_fence(__ATOMIC_RELEASE, "agent");
            asm volatile("s_waitcnt vmcnt(0)" ::: "memory");
            const unsigned og = xb_add(&bar[XB_TOP], 1u);
            const unsigned tg = og / nx;
            if (og + 1u == (tg + 1u) * nx) xb_add(&bar[XB_TOPGEN], 1u);
            else XB_SPIN(xb_ld(&bar[XB_TOPGEN]) == tg, bar);
            __builtin_amdgcn_fence(__ATOMIC_ACQUIRE, "agent");
            xb_add(&bar[XB_XGEN(b.x)], 1u);
            asm volatile("s_waitcnt vmcnt(0)" ::: "memory");
        } else {
            XB_SPIN(xb_ld(&bar[XB_XGEN(b.x)]) == gen, bar);
            __builtin_amdgcn_fence(__ATOMIC_ACQUIRE, "agent");
            asm volatile("s_waitcnt vmcnt(0)" ::: "memory");
        }
    }
    __syncthreads();
}

struct Ctx {
    LAS unsigned char* lds; int tid, lane, wave, G, bid; unsigned char* ws; CArgs* a;
};
#define RELAUNDER(c) do { int t_ = threadIdx.x; asm volatile("" : "+v"(t_)); (c).tid = t_; (c).lane = t_ & 63; } while (0)

DI void transpose_item(const float* W, int ld, int K, int N, bf16_t* WT, const float* kscale, LAS float* scr, int item, int nblk, int lane) {
    const int kb = item / nblk, nb = item % nblk, k0 = 64 * kb, n0 = 32 * nb;
    const int n = n0 + (lane & 31);
#pragma unroll 8
    for (int i = 0; i < 32; ++i) { const int kk = 2 * i + (lane >> 5); float v = 0.f; if (n < N) { v = W[(size_t)(k0 + kk) * ld + n]; if (kscale) v *= kscale[k0 + kk]; } scr[kk * 33 + (lane & 31)] = v; }
    asm volatile("s_waitcnt lgkmcnt(0)" ::: "memory");
    const int c = lane & 7;
#pragma unroll
    for (int j = 0; j < 4; ++j) { const int nn = (lane >> 3) + 8 * j; const LAS float* s = scr + (8 * c) * 33 + nn;
        u32x4 o; o.x = pk2(s[0 * 33], s[1 * 33]); o.y = pk2(s[2 * 33], s[3 * 33]); o.z = pk2(s[4 * 33], s[5 * 33]); o.w = pk2(s[6 * 33], s[7 * 33]);
        *(u32x4*)(WT + (size_t)(n0 + nn) * K + k0 + 8 * c) = o; }
    asm volatile("s_waitcnt lgkmcnt(0)" ::: "memory");
}
struct MatDesc { const float* src; int ld, K, N, Npad; bf16_t* dst; const float* kscale; };
DI MatDesc get_mat(CArgs& a, unsigned char* ws, int idx) {
    MatDesc m; m.kscale = nullptr;
    if (idx < 16) { const int j = idx >> 3, t = idx & 7; unsigned char* base = ws + WS_WEVEN + j * W_EVEN;
        if (t == 0) { m.src = a.in[9] + (size_t)j * D * HYIN; m.ld = HYIN; m.K = D; m.N = HYIN; m.Npad = UW; m.dst = (bf16_t*)(base + WE_IN); }
        else if (t == 1) { m.src = a.in[10] + (size_t)j * D * D; m.ld = D; m.K = D; m.N = D; m.Npad = D; m.dst = (bf16_t*)(base + WE_OUT); }
        else if (t == 2) { m.src = a.in[12] + (size_t)j * 256 * 768; m.ld = 768; m.K = 256; m.N = 768; m.Npad = 768; m.dst = (bf16_t*)(base + WE_UP); m.kscale = a.in[11] + j * 256; }
        else if (t == 3) { m.src = a.in[14] + (size_t)j * 256 * 1024; m.ld = 1024; m.K = 256; m.N = 1024; m.Npad = 1024; m.dst = (bf16_t*)(base + WE_UP) + 768 * 256; m.kscale = a.in[13] + j * 256; }
        else if (t < 6) { const int jj = t - 4; m.src = a.in[20] + ((size_t)j * 2 + jj) * 2048 * 128; m.ld = 128; m.K = 2048; m.N = 128; m.Npad = 128; m.dst = (bf16_t*)(base + WE_C1) + (size_t)jj * 128 * 2048; }
        else { const int jj = t - 6; m.src = a.in[21] + ((size_t)j * 2 + jj) * 128 * 64; m.ld = 64; m.K = 128; m.N = 64; m.Npad = 64; m.dst = (bf16_t*)(base + WE_C2) + (size_t)jj * 64 * 128; }
    } else if (idx < 20) { const int j = (idx - 16) >> 1, t = idx & 1; unsigned char* base = ws + WS_WODD + j * W_ODD;
        if (t == 0) { m.src = a.in[22] + (size_t)j * D * 3072; m.ld = 3072; m.K = D; m.N = 3072; m.Npad = 3072; m.dst = (bf16_t*)(base + WO_QKV); }
        else { m.src = a.in[23] + (size_t)j * D * D; m.ld = D; m.K = D; m.N = D; m.Npad = D; m.dst = (bf16_t*)(base + WO_O); }
    } else { const int i = (idx - 20) >> 1, t = idx & 1; unsigned char* base = ws + WS_WMLP + i * W_MLP;
        if (t == 0) { m.src = a.in[7] + (size_t)i * D * FF; m.ld = FF; m.K = D; m.N = FF; m.Npad = FF; m.dst = (bf16_t*)base; }
        else { m.src = a.in[8] + (size_t)i * FF * D; m.ld = D; m.K = FF; m.N = D; m.Npad = D; m.dst = (bf16_t*)(base + 8 * MiB); }
    }
    return m;
}
DI void phase_prologue(Ctx& c) {
    CArgs& a = *c.a; unsigned char* ws = c.ws;
    const int gw = c.bid * NW + c.wave, NGW = c.G * NW;
    LAS float* cond = (LAS float*)(c.lds + 98304);
    for (int i = c.tid; i < 8192; i += NT) { float v = a.in[1][i]; cond[i] = v / (1.f + __expf(-v)); }
    __syncthreads();
    float* mod = (float*)(ws + WS_MOD);
    for (int it = gw; it < 384; it += NGW) {
        const int n = it * 64 + c.lane; const int li = n / 6144, nn = n % 6144;
        const float* w = a.in[3] + (size_t)li * D * 6144 + nn; float acc[8] = {0, 0, 0, 0, 0, 0, 0, 0};
#pragma unroll 4
        for (int k = 0; k < D; ++k) { const float wv = w[(size_t)k * 6144];
#pragma unroll
            for (int b = 0; b < 8; ++b) acc[b] += cond[b * D + k] * wv; }
        const float bias = a.in[4][li * 6144 + nn];
#pragma unroll
        for (int b = 0; b < 8; ++b) mod[((size_t)li * 8 + b) * 6144 + nn] = acc[b] + bias;
    }
    LAS float* scr = (LAS float*)(c.lds + c.wave * 8704);
    int base = 0;
    for (int mi = 0; mi < 28; ++mi) {
        const MatDesc m = get_mat(a, ws, mi); const int nblk = m.Npad / 32, nit = (m.K / 64) * nblk;
        for (int it = (gw + NGW - (base % NGW)) % NGW; it < nit; it += NGW) transpose_item(m.src, m.ld, m.K, m.N, m.dst, m.kscale, scr, it, nblk, c.lane);
        base += nit;
    }
    { float* cs8 = (float*)(ws + WS_CS8); float* cs16 = (float*)(ws + WS_CS16);
      for (int g = c.bid * NT + c.tid; g < T * 24; g += c.G * NT) { const int m = g / 24, i = g % 24; const double p = (double)a.pos[m];
          if (i < 8) { const double f = pow(500000.0, -(double)i / 8.0), an = p * f; cs8[(m * 8 + i) * 2] = (float)cos(an); cs8[(m * 8 + i) * 2 + 1] = (float)sin(an); }
          else { const int k = i - 8; const double f = pow(500000.0, -(double)k / 16.0), an = p * f; cs16[(m * 16 + k) * 2] = (float)cos(an); cs16[(m * 16 + k) * 2 + 1] = (float)sin(an); } } }
    { float* bias1 = (float*)(ws + WS_MISC);
      for (int it = gw; it < 8; it += NGW) { const int jj2 = it >> 1, n = (it & 1) * 64 + c.lane;
          const float* cp = a.in[19] + (size_t)jj2 * 2048; const float* w = a.in[20] + (size_t)jj2 * 2048 * 128 + n; float acc = 0.f;
          for (int k = 0; k < 2048; ++k) acc += cp[k] * w[(size_t)k * 128];
          bias1[jj2 * 128 + n] = acc; } }
}

DI void phase_modnorm(Ctx& c, const float* x, const float* gain, const float* sh, const float* sc, bf16_t* XN) {
    const int gw = c.bid * NW + c.wave, NGW = c.G * NW;
    for (int m = gw; m < T; m += NGW) {
        const int b = m >> 11; const f32x4* xr = (const f32x4*)(x + (size_t)m * D) + c.lane; f32x4 v[4]; float s = 0.f;
#pragma unroll
        for (int j = 0; j < 4; ++j) { v[j] = xr[64 * j]; s += (v[j].x * v[j].x + v[j].y * v[j].y) + (v[j].z * v[j].z + v[j].w * v[j].w); }
        const float rs = rsqrtf(wave_sum(s) * (1.f / D) + EPS);
#pragma unroll
        for (int j = 0; j < 4; ++j) { const int n = 4 * c.lane + 256 * j; const f32x4 g = *(const f32x4*)(gain + n), sv = *(const f32x4*)(sc + b * 6144 + n), hv = *(const f32x4*)(sh + b * 6144 + n);
            f32x4 y; y.x = v[j].x * rs * g.x * (1.f + sv.x) + hv.x; y.y = v[j].y * rs * g.y * (1.f + sv.y) + hv.y; y.z = v[j].z * rs * g.z * (1.f + sv.z) + hv.z; y.w = v[j].w * rs * g.w * (1.f + sv.w) + hv.w;
            u32x2 o; o.x = pk2(y.x, y.y); o.y = pk2(y.z, y.w); *(u32x2*)(XN + (size_t)m * D + n) = o; }
    }
}
DI float head64(float x, const float* gain, const float* tabrow, float scale, int lane) {
    const float rs = rsqrtf(wave_sum(x * x) * (1.f / 64.f) + EPS);
    float y = x * rs * gain[lane];
    const float other = swz<8>(y);
    if (lane < 16) { const int i = lane & 7; const float cs = tabrow[2 * i], sn = tabrow[2 * i + 1]; y = lane < 8 ? y * cs - other * sn : other * sn + y * cs; }
    return y * scale;
}
DI void nsa_finalize_row(Ctx& c, bf16_t* U, int m, int j) {
    CArgs& a = *c.a; bf16_t* row = U + (size_t)m * UW; const float* tab = (const float*)(c.ws + WS_CS8) + (size_t)m * 16;
    const float* qg = a.in[17] + j * 64; const float* kg = a.in[18] + j * 192;
#pragma unroll 1
    for (int h = 0; h < 8; ++h) { bf16_t* p = row + 544 + 64 * h + c.lane; const float y = head64(bf2f(*p), qg, tab, 0.125f * LOG2E, c.lane); *p = (bf16_t)f2bf(y); }
#pragma unroll 1
    for (int g = 0; g < 2; ++g) { bf16_t* p = row + 1312 + 64 * g + c.lane; float y = head64(bf2f(*p), kg + 64, tab, 1.f, c.lane); *p = (bf16_t)f2bf(y);
        p = row + 1568 + 64 * g + c.lane; y = head64(bf2f(*p), kg + 128, tab, 1.f, c.lane); *p = (bf16_t)f2bf(y); }
}
DI void diff_finalize_row(Ctx& c, bf16_t* QKV, int m, int j) {
    CArgs& a = *c.a; bf16_t* row = QKV + (size_t)m * 3072; const float* tab = (const float*)(c.ws + WS_CS8) + (size_t)m * 16;
    const float* qg = a.in[24] + j * 64; const float* kg = a.in[25] + j * 64;
#pragma unroll 1
    for (int h = 0; h < 16; ++h) { bf16_t* p = row + 64 * h + c.lane; float y = head64(bf2f(*p), qg, tab, 0.125f * LOG2E, c.lane); *p = (bf16_t)f2bf(y);
        p = row + 1024 + 64 * h + c.lane; y = head64(bf2f(*p), kg, tab, 1.f, c.lane); *p = (bf16_t)f2bf(y); }
}
DI void mla_finalize_row(Ctx& c, const bf16_t* U, bf16_t* QL, const bf16_t* KVUc, bf16_t* KVU, bf16_t* KF, int m, int j) {
    CArgs& a = *c.a; const int lane = c.lane; const bf16_t* urow = U + (size_t)m * UW; const float* tab = (const float*)(c.ws + WS_CS16) + (size_t)m * 32;
    const float* qg = a.in[15] + j * 96; const float* kg = a.in[16] + j * 96;
    float sq = 0.f, sk = 0.f;
    { const u32x2 v = *(const u32x2*)(urow + 4 * lane); const float a0 = bflo(v.x), a1 = bfhi(v.x), a2 = bflo(v.y), a3 = bfhi(v.y); sq = (a0 * a0 + a1 * a1) + (a2 * a2 + a3 * a3);
      const u32x2 w = *(const u32x2*)(urow + 256 + 4 * lane); const float b0 = bflo(w.x), b1 = bfhi(w.x), b2 = bflo(w.y), b3 = bfhi(w.y); sk = (b0 * b0 + b1 * b1) + (b2 * b2 + b3 * b3); }
    const float rsq = rsqrtf(wave_sum(sq) * (1.f / 256.f) + EPS), rskv = rsqrtf(wave_sum(sk) * (1.f / 256.f) + EPS);
    const float kpe = lane < 32 ? bf2f(urow[512 + lane]) : 0.f;
    const float qscale = 0.10206207261596577f * LOG2E;
    const int i16 = lane & 15; const float cs = tab[2 * i16], sn = tab[2 * i16 + 1];
#pragma unroll 1
    for (int h = 0; h < 8; ++h) {
        { bf16_t* q = QL + (size_t)m * UPW + 96 * h; const float x0 = bf2f(q[lane]) * rsq, x1 = lane < 32 ? bf2f(q[64 + lane]) * rsq : 0.f;
          const float rs = rsqrtf(wave_sum(x0 * x0 + x1 * x1) * (1.f / 96.f) + EPS);
          float y0 = x0 * rs * qg[lane]; const float y1 = lane < 32 ? x1 * rs * qg[64 + lane] : 0.f;
          const float other = swz<16>(y0);
          if (lane < 32) y0 = lane < 16 ? y0 * cs - other * sn : other * sn + y0 * cs;
          q[lane] = (bf16_t)f2bf(y0 * qscale); if (lane < 32) q[64 + lane] = (bf16_t)f2bf(y1 * qscale); }
        { const bf16_t* kn = KVUc + (size_t)m * UPW + 128 * h;
          const float x0 = lane < 32 ? kpe : bf2f(kn[lane - 32]) * rskv;
          const float x1 = lane < 32 ? bf2f(kn[32 + lane]) * rskv : 0.f;
          const float rs = rsqrtf(wave_sum(x0 * x0 + x1 * x1) * (1.f / 96.f) + EPS);
          float y0 = x0 * rs * kg[lane]; const float y1 = lane < 32 ? x1 * rs * kg[64 + lane] : 0.f;
          const float other = swz<16>(y0);
          if (lane < 32) y0 = lane < 16 ? y0 * cs - other * sn : other * sn + y0 * cs;
          bf16_t* k = KF + (size_t)m * 768 + 96 * h; k[lane] = (bf16_t)f2bf(y0); if (lane < 32) k[64 + lane] = (bf16_t)f2bf(y1); }
        { bf16_t* v = KVU + (size_t)m * UPW + 128 * h + 64 + lane; *v = (bf16_t)f2bf(bf2f(*v) * rskv); }
    }
}

DI float gelu_tanh(float x) { const float u = 0.7978845608028654f * (x + 0.044715f * x * x * x); const float e = __expf(2.f * u); const float t = 1.f - 2.f / (e + 1.f); return 0.5f * x * (1.f + t); }
DI void compress_item(Ctx& c, const bf16_t* U, int j, int it) {
    RELAUNDER(c);
    CArgs& a = *c.a; const int lane = c.lane, w = c.wave, tid = c.tid;
    const int jj = it >> 7, bg = (it >> 3) & 15, chunk = it & 7, b = bg >> 1, g = bg & 1, c0 = 16 * chunk;
    const bf16_t* W1t = (const bf16_t*)(c.ws + WS_WEVEN + j * W_EVEN + WE_C1) + (size_t)jj * 128 * 2048;
    const bf16_t* W2t = (const bf16_t*)(c.ws + WS_WEVEN + j * W_EVEN + WE_C2) + (size_t)jj * 64 * 128;
    const float* bias1 = (const float*)(c.ws + WS_MISC) + (j * 2 + jj) * 128;
    LAS float* part = (LAS float*)c.lds;
    LAS bf16_t* hid = (LAS bf16_t*)(c.lds + 65536);
    LAS float* outl = (LAS float*)(c.lds + 65536 + 8192);
    const int r16 = lane & 15, q4 = lane >> 4;
    f32x4 acc[8];
#pragma unroll
    for (int n = 0; n < 8; ++n) acc[n] = (f32x4){0.f, 0.f, 0.f, 0.f};
    const bf16_t* arow = U + ((size_t)b * S + 16 * (c0 + r16)) * UW + 1056 + jj * 128 + g * 64 + q4 * 8;
#pragma unroll 2
    for (int ks = 8 * w; ks < 8 * w + 8; ++ks) {
        const bf16x8 af = *(const bf16x8*)(arow + (size_t)(ks >> 1) * UW + (ks & 1) * 32);
#pragma unroll
        for (int n = 0; n < 8; ++n) { const bf16x8 bfr = *(const bf16x8*)(W1t + (size_t)(n * 16 + r16) * 2048 + 32 * ks + q4 * 8);
            acc[n] = __builtin_amdgcn_mfma_f32_16x16x32_bf16(af, bfr, acc[n], 0, 0, 0); }
    }
#pragma unroll
    for (int n = 0; n < 8; ++n)
#pragma unroll
        for (int i = 0; i < 4; ++i) part[(w * 16 + q4 * 4 + i) * 128 + n * 16 + r16] = acc[n][i];
    __syncthreads();
    { const int cc = tid >> 5, n0 = (tid & 31) * 4; float v[4];
#pragma unroll
      for (int e = 0; e < 4; ++e) { float s = 0.f;
#pragma unroll
          for (int ww = 0; ww < 8; ++ww) s += part[(ww * 16 + cc) * 128 + n0 + e];
          v[e] = gelu_tanh(s + bias1[n0 + e]); }
      u32x2 o; o.x = pk2(v[0], v[1]); o.y = pk2(v[2], v[3]); *(LAS u32x2*)(hid + cc * 136 + n0) = o; }
    __syncthreads();
    if (w < 4) {
        f32x4 a2 = (f32x4){0.f, 0.f, 0.f, 0.f};
#pragma unroll
        for (int kst = 0; kst < 4; ++kst) { const bf16x8 af = *(const LAS bf16x8*)(hid + r16 * 136 + 32 * kst + q4 * 8);
            const bf16x8 bfr = *(const bf16x8*)(W2t + (size_t)(w * 16 + r16) * 128 + 32 * kst + q4 * 8);
            a2 = __builtin_amdgcn_mfma_f32_16x16x32_bf16(af, bfr, a2, 0, 0, 0); }
#pragma unroll
        for (int i = 0; i < 4; ++i) outl[(q4 * 4 + i) * 64 + w * 16 + r16] = a2[i];
    }
    __syncthreads();
    if (tid < 256) {
        const int cc = tid >> 4, d0 = (tid & 15) * 4; const int cg = c0 + cc;
        bf16_t* dst = (bf16_t*)(c.ws + WS_MISC + 65536 + (size_t)jj * 262144) + ((size_t)bg * 128 + cg) * 64 + d0;
        float v[4];
#pragma unroll
        for (int e = 0; e < 4; ++e) v[e] = outl[cc * 64 + d0 + e];
        if (jj == 0) {
            float s = (v[0] * v[0] + v[1] * v[1]) + (v[2] * v[2] + v[3] * v[3]);
            s += swz<1>(s); s += swz<2>(s); s += swz<4>(s); s += swz<8>(s);
            const float rs = rsqrtf(s * (1.f / 64.f) + EPS); const float* kg = a.in[18] + j * 192;
            int tok = b * S + 16 * cg + 31; if (tok >= T) tok = T - 1;
            const float* tab = (const float*)(c.ws + WS_CS8) + (size_t)tok * 16;
#pragma unroll
            for (int e = 0; e < 4; ++e) { const int d = d0 + e; float y = v[e] * rs * kg[d];
                if (d < 16) { const float o = outl[cc * 64 + (d ^ 8)] * rs * kg[d ^ 8]; const int i = d & 7; const float cs = tab[2 * i], sn = tab[2 * i + 1]; y = d < 8 ? y * cs - o * sn : o * sn + y * cs; }
                v[e] = y; }
        }
        if (cg == 127) { v[0] = v[1] = v[2] = v[3] = 0.f; }
        u32x2 o; o.x = pk2(v[0], v[1]); o.y = pk2(v[2], v[3]); *(u32x2*)dst = o;
    }
    __syncthreads();
}

DI void lds_add(LAS float* p, float v) { (void)__hip_atomic_fetch_add(p, v, __ATOMIC_RELAXED, __HIP_MEMORY_SCOPE_WORKGROUP); }
DI int crow(int r, int h) { return (r & 3) + 8 * (r >> 2) + 4 * h; }
DI unsigned cvtpk(float lo, float hi) { typedef float f2 __attribute__((ext_vector_type(2))); typedef __bf16 b2 __attribute__((ext_vector_type(2))); f2 v = {lo, hi}; b2 r = __builtin_convertvector(v, b2); return __builtin_bit_cast(unsigned, r); }
typedef short v4i16_t __attribute__((ext_vector_type(4)));
DI s16x4 vtr(const LAS char* p) { return __builtin_bit_cast(s16x4, __builtin_amdgcn_ds_read_tr16_b64_v4i16((LAS v4i16_t*)p)); }
template <int DD> struct TileRegs { u32x4 r[(64 * DD / 8 + NT - 1) / NT]; };
template <int DD> DI void tile_load(TileRegs<DD>& t, const bf16_t* g, int ld, int tid) {
    constexpr int CPR = DD / 8, NCH = 64 * CPR, NI = (NCH + NT - 1) / NT;
#pragma unroll
    for (int i = 0; i < NI; ++i) { const int ch = tid + NT * i; if (NCH % NT == 0 || ch < NCH) { const int row = ch / CPR, c8 = ch % CPR; t.r[i] = *(const u32x4*)(g + (size_t)row * ld + c8 * 8); } }
}
template <int DD> DI void tile_store(const TileRegs<DD>& t, LAS char* buf, int tid) {
    constexpr int CPR = DD / 8, NCH = 64 * CPR, NI = (NCH + NT - 1) / NT, STR = DD * 2 + 16;
#pragma unroll
    for (int i = 0; i < NI; ++i) { const int ch = tid + NT * i; if (NCH % NT == 0 || ch < NCH) { const int row = ch / CPR, c8 = ch % CPR; *(LAS u32x4*)(buf + row * STR + c8 * 16) = t.r[i]; } }
}
template <int DK> DI void qk_tile(const LAS char* Kb, const bf16x8* qf, f32x16& p0, f32x16& p1, int lane) {
    constexpr int KS = DK * 2 + 16; const LAS char* kp = Kb + (lane & 31) * KS + (lane >> 5) * 16;
#pragma unroll
    for (int r = 0; r < 16; ++r) { p0[r] = 0.f; p1[r] = 0.f; }
#pragma unroll
    for (int st = 0; st < DK / 16; ++st) { const bf16x8 a0 = *(const LAS bf16x8*)(kp + st * 32), a1 = *(const LAS bf16x8*)(kp + 32 * KS + st * 32);
        p0 = __builtin_amdgcn_mfma_f32_32x32x16_bf16(a0, qf[st], p0, 0, 0, 0); p1 = __builtin_amdgcn_mfma_f32_32x32x16_bf16(a1, qf[st], p1, 0, 0, 0); }
}
template <int DV> DI void pv_tile(const LAS char* Vb, const f32x16& p0, const f32x16& p1, f32x16* o, int lane) {
    constexpr int VS = DV * 2 + 16;
    const int g = lane >> 4, h = lane >> 5, i16 = lane & 15, q = i16 >> 2, p = i16 & 3;
    const LAS char* base = Vb + (4 * h + q) * VS + (16 * (g & 1) + 4 * p) * 2;
#pragma unroll
    for (int s = 0; s < 4; ++s) {
        u32x4 pw;
        if (s < 2) { pw.x = cvtpk(p0[8 * s], p0[8 * s + 1]); pw.y = cvtpk(p0[8 * s + 2], p0[8 * s + 3]); pw.z = cvtpk(p0[8 * s + 4], p0[8 * s + 5]); pw.w = cvtpk(p0[8 * s + 6], p0[8 * s + 7]); }
        else { const int s2 = s - 2; pw.x = cvtpk(p1[8 * s2], p1[8 * s2 + 1]); pw.y = cvtpk(p1[8 * s2 + 2], p1[8 * s2 + 3]); pw.z = cvtpk(p1[8 * s2 + 4], p1[8 * s2 + 5]); pw.w = cvtpk(p1[8 * s2 + 6], p1[8 * s2 + 7]); }
        const bf16x8 pf = __builtin_bit_cast(bf16x8, pw);
#pragma unroll
        for (int db = 0; db < DV / 32; ++db) {
            const s16x4 lo = vtr(base + (16 * s) * VS + db * 64), hi = vtr(base + (16 * s + 8) * VS + db * 64);
            const bf16x8 vf = (bf16x8){lo[0], lo[1], lo[2], lo[3], hi[0], hi[1], hi[2], hi[3]};
            o[db] = __builtin_amdgcn_mfma_f32_32x32x16_bf16(vf, pf, o[db], 0, 0, 0);
        }
    }
}
DI float rowmax32(const f32x16& p0, const f32x16& p1) {
    float m = fmaxf(p0[0], p1[0]);
#pragma unroll
    for (int r = 1; r < 16; ++r) m = fmaxf(m, fmaxf(p0[r], p1[r]));
    return max32(m);
}
template <int DV> DI void softmax_step(f32x16& p0, f32x16& p1, f32x16* o, float& m, float& l) {
    const float mx = rowmax32(p0, p1); const float mnew = fmaxf(m, mx); const float muse = (mnew == -INFINITY) ? 0.f : mnew;
    const float alpha = __builtin_amdgcn_exp2f(m - muse);
    float s = 0.f;
#pragma unroll
    for (int r = 0; r < 16; ++r) { p0[r] = __builtin_amdgcn_exp2f(p0[r] - muse); p1[r] = __builtin_amdgcn_exp2f(p1[r] - muse); s += p0[r] + p1[r]; }
    l = l * alpha + s; m = mnew;
#pragma unroll
    for (int db = 0; db < DV / 32; ++db)
#pragma unroll
        for (int r = 0; r < 16; ++r) o[db][r] *= alpha;
}
template <int DK> DI void load_qfrag(bf16x8* qf, const bf16_t* qrow  , int h) {
#pragma unroll
    for (int st = 0; st < DK / 16; ++st) qf[st] = *(const bf16x8*)(qrow + 16 * st + 8 * h);
}
template <int DK, int DV> struct SweepLds { static constexpr int KB = 64 * (DK * 2 + 16), VB = 64 * (DV * 2 + 16); };

template <int DK, int DV> DI void causal_sweep(Ctx& c, const bf16_t* Qg, int ldq, const bf16_t* Kg, int ldk, const bf16_t* Vg, int ldv, int q0, f32x16* o, float& lsum) {
    RELAUNDER(c);
    typedef SweepLds<DK, DV> L; LAS char* lds = (LAS char*)c.lds;
    const int lane = c.lane, w = c.wave, tid = c.tid, r32 = lane & 31, h = lane >> 5;
    const int qrow = q0 + 32 * w + r32;
    bf16x8 qf[DK / 16]; load_qfrag<DK>(qf, Qg + (size_t)qrow * ldq, h);
#pragma unroll
    for (int db = 0; db < DV / 32; ++db)
#pragma unroll
        for (int r = 0; r < 16; ++r) o[db][r] = 0.f;
    float m = -INFINITY, l = 0.f;
    const int nt = (q0 >> 6) + 4, wlast = (q0 + 32 * w + 31) >> 6;
    TileRegs<DK> kr; TileRegs<DV> vr;
    tile_load<DK>(kr, Kg, ldk, tid); tile_load<DV>(vr, Vg, ldv, tid);
    __syncthreads();
    tile_store<DK>(kr, lds, tid); tile_store<DV>(vr, lds + 2 * L::KB, tid);
    __syncthreads();
    for (int t = 0; t < nt; ++t) {
        const int cur = t & 1;
        if (t + 1 < nt) { tile_load<DK>(kr, Kg + (size_t)(t + 1) * 64 * ldk, ldk, tid); tile_load<DV>(vr, Vg + (size_t)(t + 1) * 64 * ldv, ldv, tid); }
        if (t <= wlast) {
            f32x16 p0, p1; qk_tile<DK>(lds + cur * L::KB, qf, p0, p1, lane);
            if (t * 64 + 63 > q0 + 32 * w) {
#pragma unroll
                for (int r = 0; r < 16; ++r) { const int kv = t * 64 + crow(r, h); if (kv > qrow) p0[r] = -INFINITY; if (kv + 32 > qrow) p1[r] = -INFINITY; }
            }
            softmax_step<DV>(p0, p1, o, m, l);
            pv_tile<DV>(lds + 2 * L::KB + cur * L::VB, p0, p1, o, lane);
        }
        if (t + 1 < nt) { tile_store<DK>(kr, lds + (cur ^ 1) * L::KB, tid); tile_store<DV>(vr, lds + 2 * L::KB + (cur ^ 1) * L::VB, tid); }
        __syncthreads();
    }
    lsum = sum32(l);
}
template <int DV> DI void store_o(const f32x16* o, float scale, bf16_t* rowp, int h) {
#pragma unroll
    for (int db = 0; db < DV / 32; ++db)
#pragma unroll
        for (int k = 0; k < 4; ++k) { u32x2 v; v.x = cvtpk(o[db][4 * k] * scale, o[db][4 * k + 1] * scale); v.y = cvtpk(o[db][4 * k + 2] * scale, o[db][4 * k + 3] * scale);
            *(u32x2*)(rowp + 32 * db + 8 * k + 4 * h) = v; }
}

DI void mla_unit(Ctx& c, const bf16_t* QL, const bf16_t* KF, const bf16_t* KVU, bf16_t* YC, int b, int hd, int qt) {
    RELAUNDER(c);
    const int q0 = qt * 256; f32x16 o[2]; float l;
    const size_t rb = (size_t)b * S;
    causal_sweep<96, 64>(c, QL + rb * UPW + 96 * hd, UPW, KF + rb * 768 + 96 * hd, 768, KVU + rb * UPW + 128 * hd + 64, UPW, q0, o, l);
    const int qrow = q0 + 32 * c.wave + (c.lane & 31);
    store_o<64>(o, 1.f / l, YC + (rb + qrow) * 1024 + 64 * hd, c.lane >> 5);
}
DI void diff_unit(Ctx& c, const bf16_t* QKV, bf16_t* ON, int b, int hd, int qt, int j, int layer) {
    RELAUNDER(c);
    CArgs& a = *c.a; const int q0 = qt * 256, lane = c.lane, h = lane >> 5; const size_t rb = (size_t)b * S;
    f32x16 o1[4], o2[4]; float l1, l2;
    const bf16_t* base = QKV + rb * 3072;
    causal_sweep<64, 128>(c, base + 128 * hd, 3072, base + 1024 + 128 * hd, 3072, base + 2048 + 128 * hd, 3072, q0, o1, l1);
    { const float i1_ = 1.f / l1;
#pragma unroll
      for (int db = 0; db < 4; ++db)
#pragma unroll
          for (int r = 0; r < 16; ++r) o1[db][r] *= i1_; }
    causal_sweep<64, 128>(c, base + 128 * hd + 64, 3072, base + 1024 + 128 * hd + 64, 3072, base + 2048 + 128 * hd, 3072, q0, o2, l2);
    const float* lam = a.in[26] + j * 256; float s1 = lam[lane] * lam[64 + lane], s2 = lam[128 + lane] * lam[192 + lane];
    s1 = wave_sum(s1); s2 = wave_sum(s2);
    const float lam_init = 0.8f - 0.6f * __expf(-0.3f * (float)layer); const float lmb = __expf(s1) - __expf(s2) + lam_init;
    const float i1 = 1.f, i2 = lmb / l2; float ss = 0.f;
#pragma unroll
    for (int db = 0; db < 4; ++db)
#pragma unroll
        for (int r = 0; r < 16; ++r) { const float v = o1[db][r] * i1 - o2[db][r] * i2; o1[db][r] = v; ss += v * v; }
    ss = sum32(ss);
    const float rs = rsqrtf(ss * (1.f / 128.f) + EPS) * (1.f - lam_init);
    const float* sg = a.in[27] + j * 128;
#pragma unroll
    for (int db = 0; db < 4; ++db)
#pragma unroll
        for (int r = 0; r < 16; ++r) o1[db][r] *= rs * sg[32 * db + crow(r, h)];
    const int qrow = q0 + 32 * c.wave + (lane & 31);
    store_o<128>(o1, 1.f, ON + (rb + qrow) * 1024 + 128 * hd, h);
}

DI void nsa_unit(Ctx& c, const bf16_t* U, bf16_t* YC, int b, int g, int qt) {
    RELAUNDER(c);
    CArgs& a = *c.a; LAS char* lds = (LAS char*)c.lds; typedef SweepLds<64, 64> L;
    const int lane = c.lane, w = c.wave, tid = c.tid, r32 = lane & 31, h = lane >> 5;
    const int hg = w & 3, qsub = w >> 2, head = g * 4 + hg, q0 = qt * 64, jt = qt;
    const int qrow = q0 + 32 * qsub + r32; const size_t rb = (size_t)b * S; const size_t m = rb + qrow;
    LAS float* imp = (LAS float*)(lds + 4 * L::KB);
    LAS unsigned* selw = (LAS unsigned*)(lds + 4 * L::KB + 4 * 64 * 33 * 4);
    bf16x8 qf[4]; load_qfrag<64>(qf, U + m * UW + 544 + 64 * head, h);
    const bf16_t* urow = U + m * UW + 1824;
#ifdef NSA_ONLY
    const float g0 = NSA_ONLY == 0 ? 1.f : 0.f, g1 = NSA_ONLY == 1 ? 1.f : 0.f, g2 = NSA_ONLY == 2 ? 1.f : 0.f; (void)urow;
#else
    const float g0 = 1.f / (1.f + __expf(-bf2f(urow[head]))), g1 = 1.f / (1.f + __expf(-bf2f(urow[8 + head]))), g2 = 1.f / (1.f + __expf(-bf2f(urow[16 + head])));
#endif
    f32x16 acc[2];
#pragma unroll
    for (int db = 0; db < 2; ++db)
#pragma unroll
        for (int r = 0; r < 16; ++r) acc[db][r] = 0.f;
    const int bg = b * 2 + g;
    const bf16_t* KC = (const bf16_t*)(c.ws + WS_MISC + 65536) + (size_t)bg * 128 * 64; const bf16_t* VC = (const bf16_t*)(c.ws + WS_MISC + 65536 + 262144) + (size_t)bg * 128 * 64;
    __syncthreads();
    { TileRegs<64> k0, k1, v0, v1; tile_load<64>(k0, KC, 64, tid); tile_load<64>(k1, KC + 64 * 64, 64, tid); tile_load<64>(v0, VC, 64, tid); tile_load<64>(v1, VC + 64 * 64, 64, tid);
      for (int i = tid; i < 4 * 64 * 33; i += NT) imp[i] = 0.f;
      tile_store<64>(k0, lds, tid); tile_store<64>(k1, lds + L::KB, tid); tile_store<64>(v0, lds + 2 * L::KB, tid); tile_store<64>(v1, lds + 2 * L::KB + L::VB, tid); }
    __syncthreads();
    {
        f32x16 p0, p1, p2, p3; qk_tile<64>(lds, qf, p0, p1, lane); qk_tile<64>(lds + L::KB, qf, p2, p3, lane);
        const int hi = qrow < 31 ? -1 : (qrow - 31) >> 4;
#pragma unroll
        for (int r = 0; r < 16; ++r) { const int cidx = crow(r, h); if (cidx > hi) p0[r] = -INFINITY; if (cidx + 32 > hi) p1[r] = -INFINITY; if (cidx + 64 > hi) p2[r] = -INFINITY; if (cidx + 96 > hi) p3[r] = -INFINITY; }
        float mx = fmaxf(rowmax32(p0, p1), rowmax32(p2, p3)); const float muse = (mx == -INFINITY) ? 0.f : mx; float s = 0.f;
#pragma unroll
        for (int r = 0; r < 16; ++r) { p0[r] = __builtin_amdgcn_exp2f(p0[r] - muse); p1[r] = __builtin_amdgcn_exp2f(p1[r] - muse); p2[r] = __builtin_amdgcn_exp2f(p2[r] - muse); p3[r] = __builtin_amdgcn_exp2f(p3[r] - muse); s += (p0[r] + p1[r]) + (p2[r] + p3[r]); }
        s = sum32(s); const float inv = s > 0.f ? 1.f / s : 0.f;
#pragma unroll
        for (int r = 0; r < 16; ++r) { p0[r] *= inv; p1[r] *= inv; p2[r] *= inv; p3[r] *= inv; }
        LAS float* ir = imp + hg * (64 * 33) + (32 * qsub + r32) * 33;
#define IMP_ADD(P, PI) _Pragma("unroll") for (int k = 0; k < 4; ++k) { const int jb = 8 * (PI) + 2 * k + h; const float s4 = (P[4 * k] + P[4 * k + 1]) + (P[4 * k + 2] + P[4 * k + 3]); lds_add(ir + jb, s4); if (jb + 1 < 32) lds_add(ir + jb + 1, P[4 * k + 3]); }
        IMP_ADD(p0, 0) IMP_ADD(p1, 1) IMP_ADD(p2, 2) IMP_ADD(p3, 3)
#undef IMP_ADD
        f32x16 oc[2];
#pragma unroll
        for (int db = 0; db < 2; ++db)
#pragma unroll
            for (int r = 0; r < 16; ++r) oc[db][r] = 0.f;
        pv_tile<64>(lds + 2 * L::KB, p0, p1, oc, lane); pv_tile<64>(lds + 2 * L::KB + L::VB, p2, p3, oc, lane);
#pragma unroll
        for (int db = 0; db < 2; ++db)
#pragma unroll
            for (int r = 0; r < 16; ++r) acc[db][r] += g0 * oc[db][r];
    }
    __syncthreads();
#pragma unroll 1
    for (int i = 0; i < 4; ++i) { const int id = tid + NT * i, qq = id >> 5, jb = id & 31;
        const bool allowed = jb <= jt, forced = allowed && (jb == 0 || jb >= jt - 1);
        const float iv = (imp[qq * 33 + jb] + imp[64 * 33 + qq * 33 + jb]) + (imp[2 * 64 * 33 + qq * 33 + jb] + imp[3 * 64 * 33 + qq * 33 + jb]);
        const float v = forced ? 1e9f : (allowed ? iv : -1e30f);
        int rank = 0;
        for (int k = 0; k < 32; ++k) { const float vk = __shfl(v, (lane & 32) + k); rank += (vk > v || (vk == v && k < jb)) ? 1 : 0; }
        const unsigned long long bal = __ballot(allowed && rank < 16);
        if (jb == 0) selw[qq] = (unsigned)(bal >> (lane & 32)); }
    __syncthreads();
    const unsigned mysel = selw[32 * qsub + r32];
    unsigned uni = selw[lane];
    uni |= swzu<1>(uni); uni |= swzu<2>(uni); uni |= swzu<4>(uni); uni |= swzu<8>(uni); uni |= swzu<16>(uni); uni = or32(uni);
    uni = __builtin_amdgcn_readfirstlane(uni);
    {
        const bf16_t* Kg = U + rb * UW + 1312 + 64 * g; const bf16_t* Vg = U + rb * UW + 1440 + 64 * g;
        f32x16 o[2];
#pragma unroll
        for (int db = 0; db < 2; ++db)
#pragma unroll
            for (int r = 0; r < 16; ++r) o[db][r] = 0.f;
        float mm = -INFINITY, l = 0.f; unsigned rem = uni; int cur = 0;
        TileRegs<64> kr, vr; int t = __builtin_ctz(rem); rem &= rem - 1;
        tile_load<64>(kr, Kg + (size_t)t * 64 * UW, UW, tid); tile_load<64>(vr, Vg + (size_t)t * 64 * UW, UW, tid);
        tile_store<64>(kr, lds, tid); tile_store<64>(vr, lds + 2 * L::KB, tid);
        __syncthreads();
        for (;;) {
            const int tn = rem ? __builtin_ctz(rem) : -1; rem &= rem - 1;
            if (tn >= 0) { tile_load<64>(kr, Kg + (size_t)tn * 64 * UW, UW, tid); tile_load<64>(vr, Vg + (size_t)tn * 64 * UW, UW, tid); }
            {
                f32x16 p0, p1; qk_tile<64>(lds + cur * L::KB, qf, p0, p1, lane);
                const bool on = (mysel >> t) & 1u;
#pragma unroll
                for (int r = 0; r < 16; ++r) { const int kv = t * 64 + crow(r, h); if (!on || kv > qrow) p0[r] = -INFINITY; if (!on || kv + 32 > qrow) p1[r] = -INFINITY; }
                softmax_step<64>(p0, p1, o, mm, l);
                pv_tile<64>(lds + 2 * L::KB + cur * L::VB, p0, p1, o, lane);
            }
            if (tn >= 0) { tile_store<64>(kr, lds + (cur ^ 1) * L::KB, tid); tile_store<64>(vr, lds + 2 * L::KB + (cur ^ 1) * L::VB, tid); }
            __syncthreads();
            if (tn < 0) break;
            t = tn; cur ^= 1;
        }
        l = sum32(l); const float sc = g1 / l;
#pragma unroll
        for (int db = 0; db < 2; ++db)
#pragma unroll
            for (int r = 0; r < 16; ++r) acc[db][r] += sc * o[db][r];
    }
    {
        const bf16_t* Kg = U + rb * UW + 1568 + 64 * g; const bf16_t* Vg = U + rb * UW + 1696 + 64 * g;
        f32x16 o[2];
#pragma unroll
        for (int db = 0; db < 2; ++db)
#pragma unroll
            for (int r = 0; r < 16; ++r) o[db][r] = 0.f;
        float mm = -INFINITY, l = 0.f; const int t0 = jt - 8 > 0 ? jt - 8 : 0;
        TileRegs<64> kr, vr; tile_load<64>(kr, Kg + (size_t)t0 * 64 * UW, UW, tid); tile_load<64>(vr, Vg + (size_t)t0 * 64 * UW, UW, tid);
        tile_store<64>(kr, lds, tid); tile_store<64>(vr, lds + 2 * L::KB, tid);
        __syncthreads();
        for (int t = t0; t <= jt; ++t) {
            const int cur = (t - t0) & 1;
            if (t < jt) { tile_load<64>(kr, Kg + (size_t)(t + 1) * 64 * UW, UW, tid); tile_load<64>(vr, Vg + (size_t)(t + 1) * 64 * UW, UW, tid); }
            {
                f32x16 p0, p1; qk_tile<64>(lds + cur * L::KB, qf, p0, p1, lane);
                if (t == jt || t == jt - 8) {
#pragma unroll
                    for (int r = 0; r < 16; ++r) { const int kv = t * 64 + crow(r, h); if (kv > qrow || kv <= qrow - 512) p0[r] = -INFINITY; if (kv + 32 > qrow || kv + 32 <= qrow - 512) p1[r] = -INFINITY; }
                }
                softmax_step<64>(p0, p1, o, mm, l);
                pv_tile<64>(lds + 2 * L::KB + cur * L::VB, p0, p1, o, lane);
            }
            if (t < jt) { tile_store<64>(kr, lds + (cur ^ 1) * L::KB, tid); tile_store<64>(vr, lds + 2 * L::KB + (cur ^ 1) * L::VB, tid); }
            __syncthreads();
        }
        l = sum32(l); const float sc = g2 / l;
#pragma unroll
        for (int db = 0; db < 2; ++db)
#pragma unroll
            for (int r = 0; r < 16; ++r) acc[db][r] += sc * o[db][r];
    }
    store_o<64>(acc, 1.f, YC + m * 1024 + 512 + 64 * head, h);
}
}
namespace fx {
template <int ACT  > struct EpiB16 {
    static constexpr bool PERM = true, AFTER_DRAIN = false;
    bf16_t* O; int ldc;
    __device__ __forceinline__ void operator()(const pg8::f32x4 (&acc)[2][2][4][2], const pg8::Unit& u, int wr, int wc, int fr, int fq) const {
        const int row0 = u.pm * 256 + wr * 64 + fr, col0 = u.pn * 256 + wc * 32 + 8 * fq;
#pragma unroll
        for (int ai = 0; ai < 2; ++ai)
#pragma unroll
            for (int m = 0; m < 4; ++m) { bf16_t* rowp = O + (size_t)(row0 + ai * 128 + m * 16) * ldc + col0;
#pragma unroll
                for (int bj = 0; bj < 2; ++bj) { pg8::f32x4 v0 = acc[ai][bj][m][0], v1 = acc[ai][bj][m][1];
                    if (ACT == 1) {
#pragma unroll
                        for (int e = 0; e < 4; ++e) { float a = v0[e] > 0.f ? v0[e] : 0.f; v0[e] = a * a; float b = v1[e] > 0.f ? v1[e] : 0.f; v1[e] = b * b; } }
                    u32x4 w; w.x = pg8::cvt_pk_bf16(v0[0], v0[1]); w.y = pg8::cvt_pk_bf16(v0[2], v0[3]); w.z = pg8::cvt_pk_bf16(v1[0], v1[1]); w.w = pg8::cvt_pk_bf16(v1[2], v1[3]);
                    *(u32x4*)(rowp + bj * 128) = w; } }
    }
};
struct UpOrder : pg8::StaticOrder {
    __device__ bool next(int i, pg8::Unit& u) const { if (!pg8::StaticOrder::next(i, u)) return false; u.aoff = u.pn >= 3 ? 256 : 0; return true; }
};
struct EpiResid {
    static constexpr bool PERM = false, AFTER_DRAIN = false;
    const float* base; float* out; const float* gate;
    __device__ __forceinline__ void operator()(const pg8::f32x4 (&acc)[2][2][4][2], const pg8::Unit& u, int wr, int wc, int fr, int fq) const {
        const int row0 = u.pm * 256 + wr * 64 + fr, col0 = u.pn * 256 + wc * 32 + 4 * fq; const float* gp = gate + (size_t)(u.pm >> 3) * 6144 + col0;
        pg8::f32x4 gv[2][2];
#pragma unroll
        for (int bj = 0; bj < 2; ++bj)
#pragma unroll
            for (int n = 0; n < 2; ++n) gv[bj][n] = *(const pg8::f32x4*)(gp + bj * 128 + n * 16);
#pragma unroll
        for (int ai = 0; ai < 2; ++ai)
#pragma unroll
            for (int m = 0; m < 4; ++m) { const size_t off = (size_t)(row0 + ai * 128 + m * 16) * 1024 + col0;
#pragma unroll
                for (int bj = 0; bj < 2; ++bj)
#pragma unroll
                    for (int n = 0; n < 2; ++n) { const pg8::f32x4 bs = *(const pg8::f32x4*)(base + off + bj * 128 + n * 16); *(pg8::f32x4*)(out + off + bj * 128 + n * 16) = bs + gv[bj][n] * acc[ai][bj][m][n]; } }
    }
};

#ifndef FX_STOP_PHASE
#define FX_STOP_PHASE 1000
#endif
__global__ void __launch_bounds__(NT, 2) mega(Args args) {
    extern __shared__ __attribute__((aligned(16))) unsigned char lds_raw[];
    Ctx c; c.lds = (LAS unsigned char*)lds_raw; c.tid = threadIdx.x; c.lane = c.tid & 63; c.wave = __builtin_amdgcn_readfirstlane(c.tid >> 6); c.G = gridDim.x; c.bid = blockIdx.x; c.a = nullptr; (void)args;
#define KARGS() ({ CArgs* p_ = (CArgs*)__builtin_amdgcn_kernarg_segment_ptr(); asm volatile("" : "+s"(p_)); p_; })
    CArgs* pa0 = KARGS();
    volatile LAS unsigned* MISC = (volatile LAS unsigned*)(c.lds + LDS_MISC);
    for (int i = c.tid; i < 64; i += NT) MISC[i] = 0u;
    __syncthreads();
    XcdBarrier bar = xcd_barrier_post((unsigned*)(pa0->ws + WS_CTL) + 4096, MISC + 8);
    int ph = 0;
    const int lo = pa0->ph_lo, hi = pa0->ph_hi;
#define SEAM() do { if (ph + 1 < hi) xcd_barrier(bar); } while (0)
#define PHASE_BEGIN if (ph >= lo && ph < hi) { CArgs* pa = KARGS(); c.a = pa; unsigned char* ws = pa->ws; c.ws = ws; { int t_ = threadIdx.x; asm volatile("" : "+v"(t_)); c.tid = t_; c.lane = t_ & 63; } \
    const float* MOD = (const float*)(ws + WS_MOD); const float* mod = MOD + (size_t)layer * 8 * 6144; (void)mod; \
    bf16_t* XN = (bf16_t*)(ws + WS_XN); bf16_t* YC = (bf16_t*)(ws + WS_YC); bf16_t* U = (bf16_t*)(ws + WS_BIG + BIG_U); bf16_t* QL = (bf16_t*)(ws + WS_BIG + BIG_UP); bf16_t* KVU = QL + 768; \
    bf16_t* KF = XN; bf16_t* HID = (bf16_t*)(ws + WS_BIG); bf16_t* QKV = (bf16_t*)(ws + WS_BIG); (void)XN; (void)YC; (void)U; (void)QL; (void)KVU; (void)KF; (void)HID; (void)QKV; \
    unsigned char* wb = ws + ((layer & 1) ? WS_WODD + (size_t)(layer >> 1) * W_ODD : WS_WEVEN + (size_t)(layer >> 1) * W_EVEN); unsigned char* wm = ws + WS_WMLP + (size_t)layer * W_MLP; (void)wb; (void)wm;
#define PHASE_END SEAM(); } ++ph;
    const int gw = c.bid * NW + c.wave, NGW = c.G * NW;
    int layer = 0;

    if (lo == 0) { CArgs* pa = KARGS(); c.a = pa; c.ws = pa->ws; RELAUNDER(c);
#ifndef SKIP_PRO
        phase_prologue(c);
#endif
        if (hi > 1) { if (pa->use_cg != 0) cooperative_groups::this_grid().sync(); else xcd_barrier(bar); } }
    ++ph;

#pragma unroll 1
    for (layer = 0; layer < 4; ++layer) {
        const int j = layer >> 1;
        PHASE_BEGIN
#ifndef SKIP_NORM
 phase_modnorm(c, layer == 0 ? pa->in[0] : pa->out, pa->in[5] + layer * D, mod + 0, mod + 1024, XN);
#endif
 PHASE_END
        if ((layer & 1) == 0) {
            PHASE_BEGIN { pg8::Gemm g{XN, (const bf16_t*)(wb + WE_IN), T, UW, D, D}; pg8::StaticOrder so; so.init(T, UW, c.G, c.bid); EpiB16<0> E{U, UW};

#ifndef SKIP_G1
pg8::gemm_phase<EpiB16<0>, pg8::StaticOrder, true, true>(c.lds, g, so, E);
#endif
 } PHASE_END
            PHASE_BEGIN { pg8::Gemm g{U, (const bf16_t*)(wb + WE_UP), T, 1792, 256, UW}; UpOrder so; so.init(T, 1792, c.G, c.bid); EpiB16<0> E{QL, UPW};

#ifndef SKIP_G2
pg8::gemm_phase<EpiB16<0>, UpOrder, false, true>(c.lds, g, so, E);
#endif

                __syncthreads();

#ifndef SKIP_CMP
 for (int it = c.bid; it < 256; it += c.G) compress_item(c, U, j, it);
#endif


#ifndef SKIP_FIN
 RELAUNDER(c); for (int m = gw; m < T; m += NGW) nsa_finalize_row(c, U, m, j);
#endif
 } PHASE_END
            PHASE_BEGIN {
#ifndef SKIP_FIN
 for (int m = gw; m < T; m += NGW) mla_finalize_row(c, U, QL, KVU, KVU, KF, m, j);
#endif

                for (int p = c.bid; p < 256; p += c.G) { const int bg = p >> 4, s = p & 15;
#ifndef SKIP_NSA
 nsa_unit(c, U, YC, bg >> 1, bg & 1, 31 - s); nsa_unit(c, U, YC, bg >> 1, bg & 1, s);
#endif
 } } PHASE_END
            PHASE_BEGIN { for (int p = c.bid; p < 256; p += c.G) { const int bh = p >> 2, s = p & 3;
#ifndef SKIP_MLA
 mla_unit(c, QL, KF, KVU, YC, bh >> 3, bh & 7, 7 - s); mla_unit(c, QL, KF, KVU, YC, bh >> 3, bh & 7, s);
#endif
 } } PHASE_END
            PHASE_BEGIN { pg8::Gemm g{YC, (const bf16_t*)(wb + WE_OUT), T, D, D, D}; pg8::StaticOrder so; so.init(T, D, c.G, c.bid); EpiResid E{layer == 0 ? pa->in[0] : pa->out, pa->out, mod + 2048};

#ifndef SKIP_G3
pg8::gemm_phase<EpiResid, pg8::StaticOrder, true, true>(c.lds, g, so, E);
#endif
 } PHASE_END
        } else {
            PHASE_BEGIN { pg8::Gemm g{XN, (const bf16_t*)(wb + WO_QKV), T, 3072, D, D}; pg8::StaticOrder so; so.init(T, 3072, c.G, c.bid); EpiB16<0> E{QKV, 3072};

#ifndef SKIP_G4
pg8::gemm_phase<EpiB16<0>, pg8::StaticOrder, true, true>(c.lds, g, so, E);
#endif
 } PHASE_END
            PHASE_BEGIN {
#ifndef SKIP_FIN
 for (int m = gw; m < T; m += NGW) diff_finalize_row(c, QKV, m, j);
#endif
 } PHASE_END
            PHASE_BEGIN { for (int p = c.bid; p < 256; p += c.G) { const int bh = p >> 2, s = p & 3;
#ifndef SKIP_DIFF
 diff_unit(c, QKV, YC, bh >> 3, bh & 7, 7 - s, j, layer); diff_unit(c, QKV, YC, bh >> 3, bh & 7, s, j, layer);
#endif
 } } PHASE_END
            PHASE_BEGIN { pg8::Gemm g{YC, (const bf16_t*)(wb + WO_O), T, D, D, D}; pg8::StaticOrder so; so.init(T, D, c.G, c.bid); EpiResid E{pa->out, pa->out, mod + 2048};

#ifndef SKIP_G5
pg8::gemm_phase<EpiResid, pg8::StaticOrder, true, true>(c.lds, g, so, E);
#endif
 } PHASE_END
        }
        PHASE_BEGIN
#ifndef SKIP_NORM
 phase_modnorm(c, pa->out, pa->in[6] + layer * D, mod + 3072, mod + 4096, XN);
#endif
 PHASE_END
        PHASE_BEGIN { pg8::Gemm g{XN, (const bf16_t*)wm, T, FF, D, D}; pg8::StaticOrder so; so.init(T, FF, c.G, c.bid); EpiB16<1> E{HID, FF};

#ifndef SKIP_G6
pg8::gemm_phase<EpiB16<1>, pg8::StaticOrder, true, true>(c.lds, g, so, E);
#endif
 } PHASE_END
        PHASE_BEGIN { pg8::Gemm g{HID, (const bf16_t*)(wm + 8 * MiB), T, D, FF, FF}; pg8::StaticOrder so; so.init(T, D, c.G, c.bid); EpiResid E{pa->out, pa->out, mod + 5120};

#ifndef SKIP_G7
pg8::gemm_phase<EpiResid, pg8::StaticOrder, true, true>(c.lds, g, so, E);
#endif
 } PHASE_END
    }
#undef PHASE_BEGIN
#undef PHASE_END
#undef SEAM
}
constexpr int N_PHASES = 1 + 2 * (1 + 5 + 3) + 2 * (1 + 4 + 3);

inline void launch(const Args& base, int lo, int hi, int use_cg, hipStream_t st) {
    static int grid = 0;
    if (grid == 0) {
        int dev = 0, cus = 0, per_cu = 0;
        (void)hipGetDevice(&dev); (void)hipDeviceGetAttribute(&cus, hipDeviceAttributeMultiprocessorCount, dev);
        (void)hipFuncSetAttribute((const void*)mega, hipFuncAttributeMaxDynamicSharedMemorySize, LDS_BYTES);
        (void)hipOccupancyMaxActiveBlocksPerMultiprocessor(&per_cu, (const void*)mega, NT, LDS_BYTES);
        if (per_cu < 1) { fprintf(stderr, "occupancy query says %d blocks/CU\n", per_cu); per_cu = 1; }
        grid = cus;
        (void)hipGetLastError();
    }
    Args a = base; a.ph_lo = lo; a.ph_hi = hi; a.use_cg = use_cg; a.pad = 0;
    void* kargs[] = {&a};
    hipError_t e = hipLaunchCooperativeKernel((const void*)mega, dim3(grid), dim3(NT), kargs, LDS_BYTES, st);
    if (e != hipSuccess) fprintf(stderr, "cooperative launch failed: %s\n", hipGetErrorString(e));
}
}
#ifndef FX_MODE
#define FX_MODE 0
#endif
#ifndef DBG_LAYERS
#define DBG_LAYERS 1
#endif
#ifndef DBG_B0
#define DBG_B0 5
#endif
#ifndef DBG_STAGE
#define DBG_STAGE 0
#endif
#ifndef DBG_NPH
#define DBG_NPH -1
#endif
namespace dbg {
__global__ void k_cmp(const void* fast, int is_bf16, long fld, const float* ref, long rld, int nrows, int ncols, float fscale, float* acc2) {
    const long n = (long)nrows * ncols; float d2 = 0.f, r2 = 0.f;
    for (long i = (long)blockIdx.x * 256 + threadIdx.x; i < n; i += (long)gridDim.x * 256) { const long r = i / ncols, cidx = i % ncols;
        float a = is_bf16 ? fx::bf2f(((const unsigned short*)fast)[r * fld + cidx]) : ((const float*)fast)[r * fld + cidx]; a *= fscale;
        const float b = ref[r * rld + cidx]; if (!(a == a)) a = 1e6f; d2 += (a - b) * (a - b); r2 += b * b; }
    for (int o = 32; o > 0; o >>= 1) { d2 += __shfl_xor(d2, o); r2 += __shfl_xor(r2, o); }
    if ((threadIdx.x & 63) == 0) { atomicAdd(acc2, d2); atomicAdd(acc2 + 1, r2); }
}
#ifndef DBG_SEL
#define DBG_SEL -1
#endif
__global__ void k_finish(float* out, const float* acc, int nchk, long n) {
    float e = 0.f; int bad = -1; for (int i = 0; i < nchk; ++i) { float v = sqrtf(acc[2 * i] / fmaxf(acc[2 * i + 1], 1e-30f)); if (!(v == v)) v = 100.f; e = fmaxf(e, v); if (bad < 0 && v > 0.05f) bad = i; }
    if (DBG_SEL >= 0) { e = sqrtf(acc[2 * DBG_SEL] / fmaxf(acc[2 * DBG_SEL + 1], 1e-30f)); if (!(e == e)) e = 100.f; bad = -1; }
    if (blockIdx.x == 0 && threadIdx.x == 0 && bad >= 0) out[0] += 1000.f * (bad + 1);
    for (long i = (long)blockIdx.x * 256 + threadIdx.x; i < n; i += (long)gridDim.x * 256) out[i] *= (1.f + e);
}
}
extern "C" void kernel_launch(void* const* d_in, const int* in_sizes, int n_in, void* d_out, int out_size, void* d_ws, size_t ws_size, hipStream_t stream) {
    fx::Args a{};
    for (int i = 0; i < 28; ++i) a.in[i] = (const float*)d_in[i];
    a.pos = (const int*)d_in[2]; a.out = (float*)d_out; a.ws = (unsigned char*)d_ws;
    (void)hipMemsetAsync((char*)d_ws + fx::WS_CTL, 0, 65536, stream);
#if FX_MODE == 0
    fx::launch(a, 0, fx::N_PHASES, 1, stream);
#elif FX_MODE == 1
    for (int p = 0; p < fx::N_PHASES; ++p) fx::launch(a, p, p + 1, 0, stream);
#else
    nv::In in{}; for (int i = 0; i < 28; ++i) in.p[i] = (const float*)d_in[i]; in.pos = (const int*)d_in[2];
    float* errs = (float*)((char*)d_ws + 381 * fx::MiB);
    (void)hipMemsetAsync(errs, 0, 256, stream);
    const int nph = DBG_NPH >= 0 ? DBG_NPH : (DBG_LAYERS == 1 ? 10 : DBG_LAYERS == 2 ? 18 : DBG_LAYERS == 3 ? 27 : 35);
    for (int p = 0; p < nph; ++p) fx::launch(a, p, p + 1, 0, stream);
    float* nws = (float*)((char*)d_ws + fx::WS_NAIVE); float* nx = (float*)((char*)d_ws + fx::WS_NAIVE + 56 * fx::MiB);
    nv::forward(in, nx, nws, stream, DBG_LAYERS, DBG_B0, 1, DBG_STAGE == 8 ? 6 : DBG_STAGE);
    int nchk = 0;
    auto CMPR = [&](const void* f, int isb, long fld, const float* r, long rld, int nrows, int ncols, float fs) { hipLaunchKernelGGL(dbg::k_cmp, dim3(512), dim3(256), 0, stream, f, isb, fld, r, rld, nrows, ncols, fs, errs + 2 * nchk); ++nchk; };
    auto CMP = [&](const void* f, int isb, long fld, const float* r, long rld, int ncols, float fs) { CMPR(f, isb, fld, r, rld, 2048, ncols, fs); };
    const size_t r0 = (size_t)DBG_B0 * 2048;
    unsigned char* ws = (unsigned char*)d_ws;
    const size_t NMi = (size_t)(1u << 20) / 8;
    float* nU = nws + nv::R_U; float* nRA = nU + 29 * NMi; float* nRB = nRA + 12 * NMi; float* nRC = nRB + 16 * NMi; float* nRD = nRC + 12 * NMi; float* nH = nRD + 8 * NMi;
    (void)nRA; (void)nRB; (void)nRC; (void)nRD; (void)nH;
    const fx::bf16_t* fU = (const fx::bf16_t*)(ws + fx::WS_BIG + fx::BIG_U); const fx::bf16_t* fQL = (const fx::bf16_t*)(ws + fx::WS_BIG + fx::BIG_UP);
    const fx::bf16_t* fKVU = fQL + 768; const fx::bf16_t* fXN = (const fx::bf16_t*)(ws + fx::WS_XN); const fx::bf16_t* fYC = (const fx::bf16_t*)(ws + fx::WS_YC);
    (void)fU; (void)fQL; (void)fKVU; (void)fXN; (void)fYC;
#if DBG_STAGE == 0 || DBG_STAGE == 9
    CMP((const float*)d_out + r0 * 1024, 0, 1024, nx, 1024, 1024, 1.f);
#elif DBG_STAGE == 1
    if ((DBG_LAYERS & 1) == 1) { CMP(fU + r0 * 2048, 1, 2048, nU, 1848, 544, 1.f); CMP(fU + r0 * 2048 + 1056, 1, 2048, nU + 1056, 1848, 256, 1.f); CMP(fU + r0 * 2048 + 1824, 1, 2048, nU + 1824, 1848, 24, 1.f); }
    else { CMP(fU + r0 * 3072 + 2048, 1, 3072, nU + 2048, 3072, 1024, 1.f); }
#elif DBG_STAGE == 2
    if ((DBG_LAYERS & 1) == 1) { CMP(fQL + r0 * 1792, 1, 1792, nRC, 768, 768, 1.f / (0.10206207261596577f * 1.4426950408889634f)); CMP(fXN + r0 * 768, 1, 768, nRA, 768, 768, 1.f); }
    else { CMP(fU + r0 * 3072, 1, 3072, nU, 3072, 1024, 1.f / (0.125f * 1.4426950408889634f)); CMP(fU + r0 * 3072 + 1024, 1, 3072, nU + 1024, 3072, 1024, 1.f); }
#elif DBG_STAGE == 3
    CMP(fU + r0 * 2048, 1, 2048, nU, 1848, 544, 1.f); CMP(fU + r0 * 2048 + 1056, 1, 2048, nU + 1056, 1848, 256, 1.f); CMP(fU + r0 * 2048 + 1824, 1, 2048, nU + 1824, 1848, 24, 1.f);
    CMP(fQL + r0 * 1792, 1, 1792, nRC, 768, 768, 1.f / (0.10206207261596577f * 1.4426950408889634f)); CMP(fXN + r0 * 768, 1, 768, nRA, 768, 768, 1.f);
    CMP(fYC + r0 * 1024, 1, 1024, nH, 1024, 512, 1.f);
#elif DBG_STAGE == 4
    if ((DBG_LAYERS & 1) == 1) { CMP(fU + r0 * 2048 + 544, 1, 2048, nRD, 512, 512, 1.f / (0.125f * 1.4426950408889634f)); }
    else { CMP(fYC + r0 * 1024, 1, 1024, nU, 1024, 1024, 1.f); }
#elif DBG_STAGE == 6
    { const float* nSM = nws + nv::R_SMALL; const fx::bf16_t* fKC = (const fx::bf16_t*)(ws + fx::WS_MISC + 65536) + (size_t)DBG_B0 * 2 * 128 * 64; const fx::bf16_t* fVC = fKC + 16 * 128 * 64;
      CMP(fU + r0 * 2048 + 544, 1, 2048, nRD, 512, 512, 1.f / (0.125f * 1.4426950408889634f));
      CMPR(fKC, 1, 64, nSM, 64, 127, 64, 1.f); CMPR(fKC + 128 * 64, 1, 64, nSM + 128 * 64, 64, 127, 64, 1.f);
      CMPR(fVC, 1, 64, nSM + 16 * 128 * 64, 64, 127, 64, 1.f); CMPR(fVC + 128 * 64, 1, 64, nSM + 17 * 128 * 64, 64, 127, 64, 1.f);
      CMP(fU + r0 * 2048 + 1312, 1, 2048, nRA, 128, 128, 1.f); CMP(fU + r0 * 2048 + 1568, 1, 2048, nRA + 2 * NMi, 128, 128, 1.f); }
#elif DBG_STAGE == 8
    { const float* nb_ = NSA_ONLY == 0 ? nRC : NSA_ONLY == 1 ? nRA + 4 * NMi : nRB; CMP(fYC + r0 * 1024 + 512, 1, 1024, nb_, 512, 512, 1.f); }
#elif DBG_STAGE == 7
    CMP(fYC + r0 * 1024, 1, 1024, nH, 1024, 512, 1.f); CMP(fYC + r0 * 1024 + 512, 1, 1024, nH + 512, 1024, 512, 1.f);
#endif
    nv::forward(in, (float*)d_out, (float*)d_ws, stream, 4, 0, 8, 0);
    hipLaunchKernelGGL(dbg::k_finish, dim3(1024), dim3(256), 0, stream, (float*)d_out, errs, nchk, (long)16384 * 1024);
#endif
}
```

```cpp
#define FX_MODE 0

#include <hip/hip_runtime.h>
#include <hip/hip_bf16.h>
#include <cstdio>
#include <cstdint>
#include <cmath>
#include <hip/hip_cooperative_groups.h>
namespace pg8 {
#define PG8_LAS __attribute__((address_space(3)))
typedef unsigned short bf16_t;
typedef short bf16x8 __attribute__((ext_vector_type(8)));
typedef float f32x4 __attribute__((ext_vector_type(4)));
typedef unsigned u32x4 __attribute__((ext_vector_type(4)));
constexpr int BM = 256, BK = 64, HALF = 128, HTB = HALF * BK * 2  , STAGE_BYTES = 8 * HTB, NXCD = 8, WGM = 8;

__host__ __device__ __forceinline__ int lds_byte(int r, int c) { const int st = (r >> 4) * 2 + (c >> 5), rr = r & 15, cc = c & 31, ob = rr * 64 + cc * 2; return st * 1024 + (ob ^ (((ob >> 9) & 1) << 5)); }
__host__ __device__ __forceinline__ void stage_rc(int b, int& R, int& C) { const int st = b / 1024, sb = b % 1024, swz = sb ^ (((sb >> 9) & 1) << 5); R = (st >> 1) * 16 + swz / 64; C = (st & 1) * 32 + (swz % 64) / 2; }
__host__ __device__ __forceinline__ int perm32(int rho) { const int n = rho >> 4, i = rho & 15; return 8 * (i >> 2) + 4 * n + (i & 3); }

struct Unit { int pm, pn; int aoff; };
struct Gemm { const bf16_t* A; const bf16_t* Bt; int M, N, K, lda; };

struct StaticOrder {
    int nM, nN, nwg, G, c;
    __host__ __device__ void init(int M, int N, int G_, int c_) { nM = M / BM; nN = N / BM; nwg = nM * nN; G = G_; c = c_; }
    __host__ __device__ bool next(int i, Unit& u) const {
        const long L = (long)i * G + c; if (L >= nwg) return false;
        int wgid = (int)L; { const int q = nwg / NXCD, r = nwg % NXCD, xcd = wgid % NXCD, off = wgid / NXCD; wgid = (xcd < r ? xcd * (q + 1) : r * (q + 1) + (xcd - r) * q) + off; }
        const int nig = WGM * nN, gid = wgid / nig, fm = gid * WGM, gsz = (nM - fm) < WGM ? (nM - fm) : WGM;
        u.pm = fm + ((wgid % nig) % gsz); u.pn = (wgid % nig) / gsz; u.aoff = 0; return true;
    }
    __device__ __forceinline__ void a_ready(const Unit&) const {}
    __device__ __forceinline__ void done(const Unit&) const {}
};

__device__ __forceinline__ unsigned cvt_pk_bf16(float lo, float hi) { unsigned r; asm volatile("v_cvt_pk_bf16_f32 %0, %1, %2" : "=v"(r) : "v"(lo), "v"(hi)); return r; }
typedef float f32x2 __attribute__((ext_vector_type(2)));
__device__ __forceinline__ f32x2 gelu_pk(f32x2 v) {
    const f32x2 av = __builtin_elementwise_abs(v), d = av * 0.2316418882f + 1.0f;
    f32x2 t; t.x = __builtin_amdgcn_rcpf(d.x); t.y = __builtin_amdgcn_rcpf(d.y);
    f32x2 q = t * 0.5307027145f + (-0.7265760135f); q = q * t + 0.7107068705f; q = q * t + (-0.142248368f); q = q * t + 0.127414796f; q = q * t;
    const f32x2 s = (v * v) * (-0.72134752044f);
    f32x2 e; e.x = __builtin_amdgcn_exp2f(s.x); e.y = __builtin_amdgcn_exp2f(s.y);
    const f32x2 m = v * (q * e), r = v - m;
    f32x2 o; o.x = v.x < 0.f ? m.x : r.x; o.y = v.y < 0.f ? m.y : r.y; return o;
}

template <int ACT  > struct EpiBf16 {
    static constexpr bool PERM = true, AFTER_DRAIN = false; static_assert(ACT == 0 || ACT == 1, "EpiBf16: ACT is 0 (none) or 1 (gelu_pk)");
    bf16_t* O; int ldc; const float* bias; int split_cols; size_t split_stride; float scale0;
    __device__ __forceinline__ void operator()(const f32x4 (&acc)[2][2][4][2], const Unit& u, int wr, int wc, int fr, int fq) const {
        const int row0 = u.pm * BM + wr * 64 + fr; int colt = u.pn * BM; bf16_t* base = O;
        float sc = 1.f; if (split_cols) { const int t = colt / split_cols; base += (size_t)t * split_stride; colt -= t * split_cols; if (t == 0) sc = scale0; }
        const int col0 = colt + wc * 32 + 8 * fq, bcol0 = u.pn * BM + wc * 32 + 8 * fq;
        f32x4 bv[2][2];
#pragma unroll
        for (int bj = 0; bj < 2; ++bj)
#pragma unroll
            for (int n = 0; n < 2; ++n) bv[bj][n] = bias ? *(const f32x4*)(bias + bcol0 + bj * HALF + 4 * n) : (f32x4){0.f, 0.f, 0.f, 0.f};
#pragma unroll
        for (int ai = 0; ai < 2; ++ai)
#pragma unroll
            for (int m = 0; m < 4; ++m) { bf16_t* rowp = base + (size_t)(row0 + ai * HALF + m * 16) * ldc + col0;
#pragma unroll
                for (int bj = 0; bj < 2; ++bj) { f32x4 v0 = acc[ai][bj][m][0] + bv[bj][0], v1 = acc[ai][bj][m][1] + bv[bj][1];
                    if (ACT == 1) { f32x2 a = gelu_pk((f32x2){v0[0], v0[1]}), b = gelu_pk((f32x2){v0[2], v0[3]}), c = gelu_pk((f32x2){v1[0], v1[1]}), d = gelu_pk((f32x2){v1[2], v1[3]});
                        v0 = (f32x4){a.x, a.y, b.x, b.y}; v1 = (f32x4){c.x, c.y, d.x, d.y}; }
                    v0 = v0 * sc; v1 = v1 * sc; u32x4 w; w.x = cvt_pk_bf16(v0[0], v0[1]); w.y = cvt_pk_bf16(v0[2], v0[3]); w.z = cvt_pk_bf16(v1[0], v1[1]); w.w = cvt_pk_bf16(v1[2], v1[3]);
                    *(u32x4*)(rowp + bj * HALF) = w; } }
    }
};

template <class Epi, class Sched, bool ALIGN_EPI = false, bool SP2 = false>
__device__ __forceinline__ void gemm_phase(PG8_LAS unsigned char* lds, const Gemm g, const Sched& S, const Epi& E) {
    int tid_ = threadIdx.x; asm volatile("" : "+v"(tid_)); const int tid = tid_, wid = __builtin_amdgcn_readfirstlane(tid >> 6), lane = tid & 63, wr = wid >> 2, wc = wid & 3, fr = lane & 15, fq = lane >> 4;
    const int K = g.K, nt = K / BK;
    unsigned voffA[2], voffB[2];
#pragma unroll
    for (int i = 0; i < 2; ++i) { int R, C; stage_rc(tid * 16 + i * 8192, R, C); const int Rb = Epi::PERM ? ((R & ~31) + perm32(R & 31)) : R;
        voffA[i] = (unsigned)(R * g.lda + C) * 2u; voffB[i] = (unsigned)(Rb * K + C) * 2u; }
    const size_t kstep = (size_t)(BK * 2);
    const size_t hstep = (size_t)HALF * K * 2;
    const size_t hstepA = (size_t)HALF * g.lda * 2, tstepA = 2 * hstepA;
    const size_t tstep = 2 * hstep;
    const unsigned ldsw = (unsigned)wid * 1024u;
    const int aoff = lds_byte(wr * 64 + fr, fq * 8), boff = lds_byte(wc * 32 + fr, fq * 8);
#define PG8_SA(b, h) (((b) * 2 + (h)) * HTB)
#define PG8_SB(b, h) ((4 + (b) * 2 + (h)) * HTB)
#define PG8_STAGE(bufoff, gbase, voff) do { _Pragma("unroll") for (int _i = 0; _i < 2; ++_i) \
        __builtin_amdgcn_global_load_lds((const unsigned*)((const char*)(gbase) + (voff)[_i]), (PG8_LAS unsigned*)(lds + (bufoff) + ldsw + _i * 8192), 16, 0, 0); } while (0)
#define PG8_LDA(dst, b, h) do { _Pragma("unroll") for (int m = 0; m < 4; ++m) _Pragma("unroll") for (int k = 0; k < 2; ++k) dst[m][k] = *(const PG8_LAS bf16x8*)(lds + PG8_SA(b, h) + aoff + m * 2048 + k * 1024); } while (0)
#define PG8_LDB(dst, b, h) do { _Pragma("unroll") for (int n = 0; n < 2; ++n) _Pragma("unroll") for (int k = 0; k < 2; ++k) dst[n][k] = *(const PG8_LAS bf16x8*)(lds + PG8_SB(b, h) + boff + n * 2048 + k * 1024); } while (0)
#define PG8_MMA(ai, bj, At, Bt) do { __builtin_amdgcn_s_setprio(1); _Pragma("unroll") for (int m = 0; m < 4; ++m) _Pragma("unroll") for (int n = 0; n < 2; ++n) _Pragma("unroll") for (int k = 0; k < 2; ++k) \
        acc[ai][bj][m][n] = __builtin_amdgcn_mfma_f32_16x16x32_bf16(Bt[n][k], At[m][k], acc[ai][bj][m][n], 0, 0, 0); __builtin_amdgcn_s_setprio(0); } while (0)
#define PG8_WAIT_V(n) asm volatile("s_waitcnt vmcnt(" #n ")" ::: "memory")
#define PG8_WAIT_L(n) asm volatile("s_waitcnt lgkmcnt(" #n ")" ::: "memory")
#define PG8_BAR __builtin_amdgcn_s_barrier()
#define PG8_SCHED __builtin_amdgcn_sched_barrier(0)
    Unit cur, nxt; int ui = 0;
    if (!S.next(0, cur)) return;
    f32x4 acc[2][2][4][2];
#pragma unroll
    for (int a = 0; a < 2; ++a)
#pragma unroll
        for (int b = 0; b < 2; ++b)
#pragma unroll
            for (int m = 0; m < 4; ++m)
#pragma unroll
                for (int n = 0; n < 2; ++n) acc[a][b][m][n] = (f32x4){0.f, 0.f, 0.f, 0.f};
    bf16x8 At[4][2], B0[2][2], B1[2][2];
    const char* cA = (const char*)g.A + (size_t)cur.pm * tstepA + (size_t)cur.aoff * 2; const char* cB = (const char*)g.Bt + (size_t)cur.pn * tstep;
    S.a_ready(cur);
    if constexpr (SP2) {
        PG8_STAGE(PG8_SB(0, 0), cB, voffB); PG8_STAGE(PG8_SB(0, 1), cB + hstep, voffB); PG8_STAGE(PG8_SA(0, 0), cA, voffA); PG8_STAGE(PG8_SA(0, 1), cA + hstepA, voffA);
        if (wr == 1) PG8_BAR;
        PG8_WAIT_V(2); PG8_BAR;
        PG8_STAGE(PG8_SB(1, 0), cB + kstep, voffB); PG8_STAGE(PG8_SA(1, 0), cA + kstep, voffA); PG8_STAGE(PG8_SB(1, 1), cB + hstep + kstep, voffB);
        PG8_WAIT_V(6); PG8_BAR;
    } else {
        PG8_STAGE(PG8_SB(0, 0), cB, voffB); PG8_STAGE(PG8_SA(0, 0), cA, voffA); PG8_STAGE(PG8_SB(0, 1), cB + hstep, voffB); PG8_STAGE(PG8_SA(0, 1), cA + hstepA, voffA);
        if (wr == 1) PG8_BAR;
        PG8_WAIT_V(4); PG8_BAR;
        PG8_STAGE(PG8_SB(1, 0), cB + kstep, voffB); PG8_STAGE(PG8_SA(1, 0), cA + kstep, voffA); PG8_STAGE(PG8_SB(1, 1), cB + hstep + kstep, voffB);
        PG8_WAIT_V(6); PG8_BAR;
    }
    for (;;) {
        const bool has_next = S.next(ui + 1, nxt);
        const char* nA = has_next ? (const char*)g.A + (size_t)nxt.pm * tstepA + (size_t)nxt.aoff * 2 : cA; const char* nB = has_next ? (const char*)g.Bt + (size_t)nxt.pn * tstep : cB;
        for (int t = 0; t < nt; t += 2) {
            const bool last = (t == nt - 2);
            const char* a1 = cA + (size_t)(t + 1) * kstep;
            const char* a2 = last ? nA : cA + (size_t)(t + 2) * kstep; const char* b2 = last ? nB : cB + (size_t)(t + 2) * kstep;
            const char* a3 = a2 + kstep; const char* b3 = b2 + kstep;
            if (last && has_next) S.a_ready(nxt);
            if constexpr (SP2) {
            PG8_LDB(B0, 0, 0); PG8_LDB(B1, 0, 1); PG8_SCHED; PG8_LDA(At, 0, 0); PG8_STAGE(PG8_SA(1, 1), a1 + hstepA, voffA);
            PG8_WAIT_V(8); PG8_WAIT_L(0); PG8_BAR; PG8_MMA(0, 0, At, B0); PG8_MMA(0, 1, At, B1); PG8_BAR; PG8_SCHED;
            PG8_LDA(At, 0, 1); PG8_STAGE(PG8_SB(0, 0), b2, voffB); PG8_STAGE(PG8_SB(0, 1), b2 + hstep, voffB); PG8_STAGE(PG8_SA(0, 0), a2, voffA);
            PG8_WAIT_V(8); PG8_WAIT_L(0); PG8_BAR; PG8_MMA(1, 0, At, B0); PG8_MMA(1, 1, At, B1); PG8_BAR; PG8_SCHED;
            PG8_LDB(B0, 1, 0); PG8_LDB(B1, 1, 1); PG8_SCHED; PG8_LDA(At, 1, 0); PG8_STAGE(PG8_SA(0, 1), a2 + hstepA, voffA);
            PG8_WAIT_V(8); PG8_WAIT_L(0); PG8_BAR; PG8_MMA(0, 0, At, B0); PG8_MMA(0, 1, At, B1); PG8_BAR; PG8_SCHED;
            PG8_LDA(At, 1, 1); PG8_STAGE(PG8_SB(1, 0), b3, voffB); PG8_STAGE(PG8_SB(1, 1), b3 + hstep, voffB); PG8_STAGE(PG8_SA(1, 0), a3, voffA);
            PG8_WAIT_V(8); PG8_WAIT_L(0); PG8_BAR; PG8_MMA(1, 0, At, B0); PG8_MMA(1, 1, At, B1); PG8_BAR; PG8_SCHED;
            } else {
            PG8_LDB(B0, 0, 0); PG8_SCHED; PG8_LDA(At, 0, 0); PG8_STAGE(PG8_SA(1, 1), a1 + hstepA, voffA);
            PG8_WAIT_L(8); PG8_BAR; PG8_WAIT_L(0); PG8_MMA(0, 0, At, B0); PG8_BAR; PG8_SCHED;
            PG8_LDB(B1, 0, 1); PG8_STAGE(PG8_SB(0, 0), b2, voffB);
            PG8_BAR; PG8_WAIT_L(0); PG8_MMA(0, 1, At, B1); PG8_BAR;
            PG8_LDA(At, 0, 1); PG8_STAGE(PG8_SA(0, 0), a2, voffA);
            PG8_BAR; PG8_WAIT_L(0); PG8_MMA(1, 0, At, B0); PG8_BAR; PG8_SCHED;
            PG8_STAGE(PG8_SB(0, 1), b2 + hstep, voffB);
            PG8_WAIT_V(6); PG8_BAR; PG8_MMA(1, 1, At, B1); PG8_BAR;
            PG8_LDB(B0, 1, 0); PG8_SCHED; PG8_LDA(At, 1, 0); PG8_STAGE(PG8_SA(0, 1), a2 + hstepA, voffA);
            PG8_WAIT_L(8); PG8_BAR; PG8_WAIT_L(0); PG8_MMA(0, 0, At, B0); PG8_BAR; PG8_SCHED;
            PG8_LDB(B1, 1, 1); PG8_STAGE(PG8_SB(1, 0), b3, voffB);
            PG8_BAR; PG8_WAIT_L(0); PG8_MMA(0, 1, At, B1); PG8_BAR;
            PG8_LDA(At, 1, 1); PG8_STAGE(PG8_SA(1, 0), a3, voffA);
            PG8_BAR; PG8_WAIT_L(0); PG8_MMA(1, 0, At, B0); PG8_BAR; PG8_SCHED;
            PG8_STAGE(PG8_SB(1, 1), b3 + hstep, voffB);
            PG8_WAIT_V(6); PG8_BAR; PG8_MMA(1, 1, At, B1); PG8_BAR;
            }
        }
        if constexpr (ALIGN_EPI) { if (wr == 0) PG8_BAR; }
        if constexpr (!Epi::AFTER_DRAIN) { E(acc, cur, wr, wc, fr, fq); S.done(cur); }
        if (!has_next) break;
#pragma unroll
        for (int a = 0; a < 2; ++a)
#pragma unroll
            for (int b = 0; b < 2; ++b)
#pragma unroll
                for (int m = 0; m < 4; ++m)
#pragma unroll
                    for (int n = 0; n < 2; ++n) acc[a][b][m][n] = (f32x4){0.f, 0.f, 0.f, 0.f};
        cur = nxt; cA = nA; cB = nB; ++ui;
        if constexpr (ALIGN_EPI) { if (wr == 1) PG8_BAR; }
    }
    PG8_WAIT_V(0);
    if constexpr (!ALIGN_EPI) { if (wr == 0) PG8_BAR; }
    PG8_BAR;
    if constexpr (Epi::AFTER_DRAIN) { E.fused(acc, cur, wr, wc, fr, fq, lds, wid, lane); S.done(cur); }
#undef PG8_SA
#undef PG8_SB
#undef PG8_STAGE
#undef PG8_LDA
#undef PG8_LDB
#undef PG8_MMA
#undef PG8_WAIT_V
#undef PG8_WAIT_L
#undef PG8_BAR
#undef PG8_SCHED
}
}
namespace fx {
#define DI __device__ __forceinline__
#define LAS __attribute__((address_space(3)))
typedef unsigned short bf16_t;
typedef short bf16x8 __attribute__((ext_vector_type(8)));
typedef short s16x4 __attribute__((ext_vector_type(4)));
typedef float f32x4 __attribute__((ext_vector_type(4)));
typedef float f32x16 __attribute__((ext_vector_type(16)));
typedef unsigned u32x4 __attribute__((ext_vector_type(4)));
typedef unsigned u32x2 __attribute__((ext_vector_type(2)));
constexpr int B = 8, S = 2048, D = 1024, T = B * S, FF = 4096, HYIN = 1848, UW = 2048;
constexpr float EPS = 1e-6f, LOG2E = 1.4426950408889634f;
constexpr int NW = 8, NT = 512;
constexpr size_t MiB = 1u << 20;
constexpr size_t WS_CTL = 0;
constexpr size_t WS_MOD = 1 * MiB;
constexpr size_t WS_CS8 = 2 * MiB;
constexpr size_t WS_CS16 = 3 * MiB;
constexpr size_t WS_MISC = 5 * MiB;
constexpr size_t WS_W = 6 * MiB;
constexpr size_t W_EVEN = 9 * MiB, W_ODD = 8 * MiB, W_MLP = 16 * MiB;
constexpr size_t WE_IN = 0, WE_OUT = 4 * MiB, WE_UP = 6 * MiB, WE_C1 = 7 * MiB, WE_C2 = 8 * MiB;
constexpr size_t WO_QKV = 0, WO_O = 6 * MiB;
constexpr size_t WS_WEVEN = WS_W, WS_WODD = WS_W + 2 * W_EVEN, WS_WMLP = WS_WODD + 2 * W_ODD;
constexpr size_t WS_XN = 104 * MiB;
constexpr size_t WS_YC = 136 * MiB;
constexpr size_t WS_BIG = 168 * MiB;
constexpr size_t BIG_U = 0, BIG_UP = 64 * MiB + 64 * 1024;
constexpr int UPW = 1792;
constexpr size_t WS_FAST_END = 296 * MiB;
constexpr size_t WS_NAIVE = 300 * MiB;
constexpr int LDS_MISC = 131072, LDS_BYTES = 147456;

DI unsigned f2bf(float f) { unsigned u = __builtin_bit_cast(unsigned, f); return (u + 0x7fffu + ((u >> 16) & 1u)) >> 16; }
DI unsigned pk2(float lo, float hi) { return f2bf(lo) | (f2bf(hi) << 16); }
DI float bf2f(unsigned short b) { return __builtin_bit_cast(float, (unsigned)b << 16); }
DI float bflo(unsigned u) { return __builtin_bit_cast(float, u << 16); }
DI float bfhi(unsigned u) { return __builtin_bit_cast(float, u & 0xffff0000u); }
template <int O> DI float swz(float v) { static_assert(O < 32, "swz: xor mask < 32"); return __builtin_bit_cast(float, __builtin_amdgcn_ds_swizzle(__builtin_bit_cast(int, v), (O << 10) | 0x1f)); }
template <int O> DI unsigned swzu(unsigned v) { return (unsigned)__builtin_amdgcn_ds_swizzle((int)v, (O << 10) | 0x1f); }
DI void xchg32(unsigned& a, unsigned& b) { asm volatile("s_nop 1\n\tv_permlane32_swap_b32 %0, %1\n\ts_nop 1" : "+v"(a), "+v"(b)); }
DI float sum32(float v) { unsigned a = __builtin_bit_cast(unsigned, v), b = a; xchg32(a, b); return __builtin_bit_cast(float, a) + __builtin_bit_cast(float, b); }
DI float max32(float v) { unsigned a = __builtin_bit_cast(unsigned, v), b = a; xchg32(a, b); return fmaxf(__builtin_bit_cast(float, a), __builtin_bit_cast(float, b)); }
DI unsigned or32(unsigned v) { unsigned a = v, b = v; xchg32(a, b); return a | b; }
#ifdef DBG_SHFL
DI float wave_sum(float v) { for (int o = 1; o < 64; o <<= 1) v += __shfl_xor(v, o); return v; }
#else
DI float wave_sum(float v) { v += swz<1>(v); v += swz<2>(v); v += swz<4>(v); v += swz<8>(v); v += swz<16>(v); return sum32(v); }
#endif

struct Args { const float* in[28]; const int* pos; float* out; unsigned char* ws; int ph_lo, ph_hi; int use_cg; int pad; };
typedef const __attribute__((address_space(4))) Args CArgs;
#define XB_TMO      128
#define XB_XCNT(j)  (256  + 64 * (j))
#define XB_XSUB(j)  (1280 + 64 * (j))
#define XB_XGEN(j)  (2304 + 64 * (j))
#define XB_TOP      3328
#define XB_TOPGEN   3392
#define XCD_BAR_WORDS 3456
#define XB_SPIN_CAP (1u << 20)
DI unsigned xb_ld(unsigned* p)              { return __hip_atomic_load(p, __ATOMIC_RELAXED, __HIP_MEMORY_SCOPE_AGENT); }
DI unsigned xb_add(unsigned* p, unsigned v) { return __hip_atomic_fetch_add(p, v, __ATOMIC_RELAXED, __HIP_MEMORY_SCOPE_AGENT); }
DI unsigned xb_xcc_id() { return (unsigned)__builtin_amdgcn_s_getreg((3 << 11) | 20) & 0xFu; }
#define XB_SPIN(cond, bar) do { unsigned _sp = 0; while (cond) { __builtin_amdgcn_s_sleep(1); \
    if ((++_sp & 255u) == 0u) { if (xb_ld(&(bar)[XB_TMO])) break; if (_sp > XB_SPIN_CAP) { atomicAdd(&(bar)[XB_TMO], 1u); break; } } } } while (0)
struct XcdBarrier { unsigned* bar; unsigned x; volatile LAS unsigned* st; };
DI XcdBarrier xcd_barrier_post(unsigned* bar, volatile LAS unsigned* st) {
    XcdBarrier b; b.bar = bar; b.x = xb_xcc_id(); b.st = st;
    if (threadIdx.x == 0) (void)xb_add(&bar[XB_XCNT(b.x)], 1u);
    return b;
}
DI void xcd_barrier_complete(unsigned* bar, unsigned x, unsigned& nloc, unsigned& nx) {
    const unsigned G = gridDim.x * gridDim.y * gridDim.z;
    unsigned sum, cnt, mine, sp = 0u;
    for (;;) {
        sum = 0u; cnt = 0u; mine = 0u;
#pragma unroll
        for (unsigned j = 0; j < 16; ++j) { const unsigned c = xb_ld(&bar[XB_XCNT(j)]); sum += c; cnt += (c > 0u) ? 1u : 0u; mine = (j == x) ? c : mine; }
        if (sum == G) break;
        __builtin_amdgcn_s_sleep(1);
        if ((++sp & 255u) == 0u) { if (xb_ld(&bar[XB_TMO])) break; if (sp > XB_SPIN_CAP) { atomicAdd(&bar[XB_TMO], 1u); break; } }
    }
    nloc = mine > 0u ? mine : 1u; nx = cnt > 0u ? cnt : 1u;
}
DI void xcd_barrier(const XcdBarrier& b) {
    asm volatile("s_waitcnt vmcnt(0)" ::: "memory");
    __syncthreads();
    int t0_ = threadIdx.x; asm volatile("" : "+v"(t0_));
    if (t0_ == 0) {
        unsigned* bar; { CArgs* p_ = (CArgs*)__builtin_amdgcn_kernarg_segment_ptr(); asm volatile("" : "+s"(p_)); bar = (unsigned*)(p_->ws + WS_CTL) + 4096; }
        __builtin_amdgcn_s_waitcnt(0);
        unsigned nloc = b.st[0], nx = b.st[1];
        unsigned bx = b.x; asm volatile("" : "+s"(bx));
        if (nloc == 0u) { xcd_barrier_complete(bar, bx, nloc, nx); b.st[0] = nloc; b.st[1] = nx; }
        const unsigned old = xb_add(&bar[XB_XSUB(bx)], 1u);
        const unsigned gen = old / nloc;
        if (old + 1u == (gen + 1u) * nloc) {
            __builtin_amdgcn_fence(__ATOMIC_RELEASE, "agent");
            asm volatile("s_waitcnt vmcnt(0)" ::: "memory");
            const unsigned og = xb_add(&bar[XB_TOP], 1u);
            const unsigned tg = og / nx;
            if (og + 1u == (tg + 1u) * nx) xb_add(&bar[XB_TOPGEN], 1u);
            else XB_SPIN(xb_ld(&bar[XB_TOPGEN]) == tg, bar);
            __builtin_amdgcn_fence(__ATOMIC_ACQUIRE, "agent");
            xb_add(&bar[XB_XGEN(bx)], 1u);
            asm volatile("s_waitcnt vmcnt(0)" ::: "memory");
        } else {
            XB_SPIN(xb_ld(&bar[XB_XGEN(bx)]) == gen, bar);
            __builtin_amdgcn_fence(__ATOMIC_ACQUIRE, "agent");
            asm volatile("s_waitcnt vmcnt(0)" ::: "memory");
        }
    }
    __syncthreads();
}

struct Ctx {
    LAS unsigned char* lds; int tid, lane, wave, G, bid; unsigned char* ws; CArgs* a;
};
#define RELAUNDER(c) do { int t_ = threadIdx.x; asm volatile("" : "+v"(t_)); (c).tid = t_; (c).lane = t_ & 63; } while (0)

DI void transpose_item(const float* W, int ld, int K, int N, bf16_t* WT, const float* kscale, LAS float* scr, int item, int nblk, int lane) {
    const int kb = item / nblk, nb = item % nblk, k0 = 64 * kb, n0 = 32 * nb;
    const int n = n0 + (lane & 31);
    float tv[32];
#pragma unroll
    for (int i = 0; i < 32; ++i) { const int kk = 2 * i + (lane >> 5); tv[i] = (n < N) ? W[(size_t)(k0 + kk) * ld + n] : 0.f; }
#pragma unroll
    for (int i = 0; i < 32; ++i) { const int kk = 2 * i + (lane >> 5); float v = tv[i]; if (kscale) v *= kscale[k0 + kk]; scr[kk * 33 + (lane & 31)] = v; }
    asm volatile("s_waitcnt lgkmcnt(0)" ::: "memory");
    const int c = lane & 7;
#pragma unroll
    for (int j = 0; j < 4; ++j) { const int nn = (lane >> 3) + 8 * j; const LAS float* s = scr + (8 * c) * 33 + nn;
        u32x4 o; o.x = pk2(s[0 * 33], s[1 * 33]); o.y = pk2(s[2 * 33], s[3 * 33]); o.z = pk2(s[4 * 33], s[5 * 33]); o.w = pk2(s[6 * 33], s[7 * 33]);
        *(u32x4*)(WT + (size_t)(n0 + nn) * K + k0 + 8 * c) = o; }
    asm volatile("s_waitcnt lgkmcnt(0)" ::: "memory");
}
struct MatDesc { const float* src; int ld, K, N, Npad; bf16_t* dst; const float* kscale; };
DI MatDesc get_mat(CArgs& a, unsigned char* ws, int idx) {
    MatDesc m; m.kscale = nullptr;
    if (idx < 16) { const int j = idx >> 3, t = idx & 7; unsigned char* base = ws + WS_WEVEN + j * W_EVEN;
        if (t == 0) { m.src = a.in[9] + (size_t)j * D * HYIN; m.ld = HYIN; m.K = D; m.N = HYIN; m.Npad = UW; m.dst = (bf16_t*)(base + WE_IN); }
        else if (t == 1) { m.src = a.in[10] + (size_t)j * D * D; m.ld = D; m.K = D; m.N = D; m.Npad = D; m.dst = (bf16_t*)(base + WE_OUT); }
        else if (t == 2) { m.src = a.in[12] + (size_t)j * 256 * 768; m.ld = 768; m.K = 256; m.N = 768; m.Npad = 768; m.dst = (bf16_t*)(base + WE_UP); m.kscale = a.in[11] + j * 256; }
        else if (t == 3) { m.src = a.in[14] + (size_t)j * 256 * 1024; m.ld = 1024; m.K = 256; m.N = 1024; m.Npad = 1024; m.dst = (bf16_t*)(base + WE_UP) + 768 * 256; m.kscale = a.in[13] + j * 256; }
        else if (t < 6) { const int jj = t - 4; m.src = a.in[20] + ((size_t)j * 2 + jj) * 2048 * 128; m.ld = 128; m.K = 2048; m.N = 128; m.Npad = 128; m.dst = (bf16_t*)(base + WE_C1) + (size_t)jj * 128 * 2048; }
        else { const int jj = t - 6; m.src = a.in[21] + ((size_t)j * 2 + jj) * 128 * 64; m.ld = 64; m.K = 128; m.N = 64; m.Npad = 64; m.dst = (bf16_t*)(base + WE_C2) + (size_t)jj * 64 * 128; }
    } else if (idx < 20) { const int j = (idx - 16) >> 1, t = idx & 1; unsigned char* base = ws + WS_WODD + j * W_ODD;
        if (t == 0) { m.src = a.in[22] + (size_t)j * D * 3072; m.ld = 3072; m.K = D; m.N = 3072; m.Npad = 3072; m.dst = (bf16_t*)(base + WO_QKV); }
        else { m.src = a.in[23] + (size_t)j * D * D; m.ld = D; m.K = D; m.N = D; m.Npad = D; m.dst = (bf16_t*)(base + WO_O); }
    } else { const int i = (idx - 20) >> 1, t = idx & 1; unsigned char* base = ws + WS_WMLP + i * W_MLP;
        if (t == 0) { m.src = a.in[7] + (size_t)i * D * FF; m.ld = FF; m.K = D; m.N = FF; m.Npad = FF; m.dst = (bf16_t*)base; }
        else { m.src = a.in[8] + (size_t)i * FF * D; m.ld = D; m.K = FF; m.N = D; m.Npad = D; m.dst = (bf16_t*)(base + 8 * MiB); }
    }
    return m;
}
DI void phase_prologue(Ctx& c) {
    CArgs& a = *c.a; unsigned char* ws = c.ws;
    const int gw = c.bid * NW + c.wave, NGW = c.G * NW;
    LAS float* cond = (LAS float*)(c.lds + 98304);
    for (int i = c.tid; i < 8192; i += NT) { float v = a.in[1][i]; cond[i] = v / (1.f + __expf(-v)); }
    __syncthreads();
    float* mod = (float*)(ws + WS_MOD);
    LAS float* red = (LAS float*)c.lds;
    for (int it = c.bid; it < 384; it += c.G) {
        const int n = it * 64 + c.lane; const int li = n / 6144, nn = n % 6144;
        const float* w = a.in[3] + (size_t)li * D * 6144 + (size_t)(c.wave * 128) * 6144 + nn; float acc[8] = {0, 0, 0, 0, 0, 0, 0, 0};
#pragma unroll 32
        for (int k = 0; k < 128; ++k) { const float wv = w[(size_t)k * 6144];
#pragma unroll
            for (int b = 0; b < 8; ++b) acc[b] += cond[b * D + c.wave * 128 + k] * wv; }
#pragma unroll
        for (int b = 0; b < 8; ++b) red[(c.wave * 8 + b) * 64 + c.lane] = acc[b];
        __syncthreads();
        { const int b = c.wave; float s = 0.f;
#pragma unroll
          for (int ww = 0; ww < 8; ++ww) s += red[(ww * 8 + b) * 64 + c.lane];
          mod[((size_t)li * 8 + b) * 6144 + nn] = s + a.in[4][li * 6144 + nn]; }
        __syncthreads();
    }
    { float* bias1 = (float*)(ws + WS_MISC);
      for (int it = c.bid; it < 8; it += c.G) { const int jj2 = it >> 1, n = (it & 1) * 64 + c.lane;
          const float* cp = a.in[19] + (size_t)jj2 * 2048 + c.wave * 256; const float* w = a.in[20] + (size_t)jj2 * 2048 * 128 + (size_t)(c.wave * 256) * 128 + n; float acc = 0.f;
#pragma unroll 16
          for (int k = 0; k < 256; ++k) acc += cp[k] * w[(size_t)k * 128];
          red[c.wave * 64 + c.lane] = acc; __syncthreads();
          if (c.wave == 0) { float s = 0.f;
#pragma unroll
              for (int ww = 0; ww < 8; ++ww) s += red[ww * 64 + c.lane];
              bias1[jj2 * 128 + n] = s; }
          __syncthreads(); } }
    LAS float* scr = (LAS float*)(c.lds + c.wave * 8704);
    int base = 0;
    for (int mi = 0; mi < 28; ++mi) {
        const MatDesc m = get_mat(a, ws, mi); const int nblk = m.Npad / 32, nit = (m.K / 64) * nblk;
        for (int it = (gw + NGW - (base % NGW)) % NGW; it < nit; it += NGW) transpose_item(m.src, m.ld, m.K, m.N, m.dst, m.kscale, scr, it, nblk, c.lane);
        base += nit;
    }
    { float* cs8 = (float*)(ws + WS_CS8); float* cs16 = (float*)(ws + WS_CS16);
      for (int g = c.bid * NT + c.tid; g < T * 24; g += c.G * NT) { const int m = g / 24, i = g % 24; const double p = (double)a.pos[m];
          if (i < 8) { const double f = pow(500000.0, -(double)i / 8.0), an = p * f; cs8[(m * 8 + i) * 2] = (float)cos(an); cs8[(m * 8 + i) * 2 + 1] = (float)sin(an); }
          else { const int k = i - 8; const double f = pow(500000.0, -(double)k / 16.0), an = p * f; cs16[(m * 16 + k) * 2] = (float)cos(an); cs16[(m * 16 + k) * 2 + 1] = (float)sin(an); } } }
}

DI void phase_modnorm(Ctx& c, const float* x, const float* gain, const float* sh, const float* sc, bf16_t* XN) {
    const int gw = c.bid * NW + c.wave, NGW = c.G * NW;
    for (int m = gw; m < T; m += NGW) {
        const int b = m >> 11; const f32x4* xr = (const f32x4*)(x + (size_t)m * D) + c.lane; f32x4 v[4]; float s = 0.f;
#pragma unroll
        for (int j = 0; j < 4; ++j) { v[j] = xr[64 * j]; s += (v[j].x * v[j].x + v[j].y * v[j].y) + (v[j].z * v[j].z + v[j].w * v[j].w); }
        const float rs = rsqrtf(wave_sum(s) * (1.f / D) + EPS);
#pragma unroll
        for (int j = 0; j < 4; ++j) { const int n = 4 * c.lane + 256 * j; const f32x4 g = *(const f32x4*)(gain + n), sv = *(const f32x4*)(sc + b * 6144 + n), hv = *(const f32x4*)(sh + b * 6144 + n);
            f32x4 y; y.x = v[j].x * rs * g.x * (1.f + sv.x) + hv.x; y.y = v[j].y * rs * g.y * (1.f + sv.y) + hv.y; y.z = v[j].z * rs * g.z * (1.f + sv.z) + hv.z; y.w = v[j].w * rs * g.w * (1.f + sv.w) + hv.w;
            u32x2 o; o.x = pk2(y.x, y.y); o.y = pk2(y.z, y.w); *(u32x2*)(XN + (size_t)m * D + n) = o; }
    }
}
constexpr int TB = 8;
constexpr int TBV = 4;
DI void head64_vec(bf16_t* const (&p)[TBV], bool act, const float* gain, const float* const (&tab)[TBV], float scale, int lane) {
    const int sub = lane & 7; float x[TBV][8], ss[TBV];
#pragma unroll
    for (int t = 0; t < TBV; ++t) { u32x4 v = (u32x4){0u, 0u, 0u, 0u}; if (act) v = *(const u32x4*)p[t];
        x[t][0] = bflo(v.x); x[t][1] = bfhi(v.x); x[t][2] = bflo(v.y); x[t][3] = bfhi(v.y); x[t][4] = bflo(v.z); x[t][5] = bfhi(v.z); x[t][6] = bflo(v.w); x[t][7] = bfhi(v.w); }
#pragma unroll
    for (int t = 0; t < TBV; ++t) { float s = 0.f;
#pragma unroll
        for (int e = 0; e < 8; ++e) s += x[t][e] * x[t][e];
        ss[t] = s; }
#pragma unroll
    for (int t = 0; t < TBV; ++t) ss[t] += swz<1>(ss[t]);
#pragma unroll
    for (int t = 0; t < TBV; ++t) ss[t] += swz<2>(ss[t]);
#pragma unroll
    for (int t = 0; t < TBV; ++t) ss[t] += swz<4>(ss[t]);
    const f32x4 ga = *(const f32x4*)(gain + 8 * sub), gb = *(const f32x4*)(gain + 8 * sub + 4);
    const float g[8] = {ga.x, ga.y, ga.z, ga.w, gb.x, gb.y, gb.z, gb.w};
#pragma unroll
    for (int t = 0; t < TBV; ++t) { const float rs = rsqrtf(ss[t] * (1.f / 64.f) + EPS);
        float y[8], o[8];
#pragma unroll
        for (int e = 0; e < 8; ++e) { y[e] = x[t][e] * rs * g[e]; o[e] = swz<1>(y[e]); }
        if (sub < 2) {
            const f32x4 t0 = *(const f32x4*)(tab[t]), t1 = *(const f32x4*)(tab[t] + 4), t2 = *(const f32x4*)(tab[t] + 8), t3 = *(const f32x4*)(tab[t] + 12);
            const float cs[8] = {t0.x, t0.z, t1.x, t1.z, t2.x, t2.z, t3.x, t3.z}, sn[8] = {t0.y, t0.w, t1.y, t1.w, t2.y, t2.w, t3.y, t3.w};
#pragma unroll
            for (int e = 0; e < 8; ++e) y[e] = sub == 0 ? y[e] * cs[e] - o[e] * sn[e] : o[e] * sn[e] + y[e] * cs[e];
        }
        u32x4 w; w.x = pk2(y[0] * scale, y[1] * scale); w.y = pk2(y[2] * scale, y[3] * scale); w.z = pk2(y[4] * scale, y[5] * scale); w.w = pk2(y[6] * scale, y[7] * scale);
        if (act) *(u32x4*)p[t] = w; }
}
DI void nsa_finalize_rows(Ctx& c, bf16_t* U, int m0, int mstride, int j) {
    CArgs& a = *c.a; const float* qg = a.in[17] + j * 64; const float* kg = a.in[18] + j * 192; const int lane = c.lane;
    bf16_t* p[TBV]; const float* tab[TBV];
#pragma unroll
    for (int t = 0; t < TBV; ++t) { const int m = m0 + t * mstride; p[t] = U + (size_t)m * UW + 544 + 8 * lane; tab[t] = (const float*)(c.ws + WS_CS8) + (size_t)m * 16; }
    head64_vec(p, true, qg, tab, 0.125f * LOG2E, lane);
#pragma unroll
    for (int t = 0; t < TBV; ++t) { const int m = m0 + t * mstride; p[t] = U + (size_t)m * UW + (lane < 16 ? 1312 + 8 * lane : 1568 + 8 * (lane & 15)); }
    head64_vec(p, lane < 32, lane < 16 ? kg + 64 : kg + 128, tab, 1.f, lane);
}
DI void diff_finalize_rows(Ctx& c, bf16_t* QKV, int m0, int mstride, int j) {
    CArgs& a = *c.a; const float* qg = a.in[24] + j * 64; const float* kg = a.in[25] + j * 64; const int lane = c.lane;
    bf16_t* p[TBV]; const float* tab[TBV];
#pragma unroll 1
    for (int ch = 0; ch < 4; ++ch) {
#pragma unroll
        for (int t = 0; t < TBV; ++t) { const int m = m0 + t * mstride; p[t] = QKV + (size_t)m * 3072 + 512 * ch + 8 * lane; tab[t] = (const float*)(c.ws + WS_CS8) + (size_t)m * 16; }
        head64_vec(p, true, ch < 2 ? qg : kg, tab, ch < 2 ? 0.125f * LOG2E : 1.f, lane);
    }
}
DI void mla_finalize_rows(Ctx& c, const bf16_t* U, bf16_t* QL, bf16_t* KVU, bf16_t* KF, int m0, int mstride, int j) {
    CArgs& a = *c.a; const int lane = c.lane;
    const float* qg = a.in[15] + j * 96; const float* kg = a.in[16] + j * 96;
    float rsq[TB], rskv[TB], kpe[TB], cs[TB], sn[TB]; int mrow[TB];
    const int i16 = lane & 15;
#pragma unroll
    for (int t = 0; t < TB; ++t) { const int m = m0 + t * mstride; mrow[t] = m; const bf16_t* urow = U + (size_t)m * UW;
        const u32x2 v = *(const u32x2*)(urow + 4 * lane); const float a0 = bflo(v.x), a1 = bfhi(v.x), a2 = bflo(v.y), a3 = bfhi(v.y); rsq[t] = (a0 * a0 + a1 * a1) + (a2 * a2 + a3 * a3);
        const u32x2 w = *(const u32x2*)(urow + 256 + 4 * lane); const float b0 = bflo(w.x), b1 = bfhi(w.x), b2 = bflo(w.y), b3 = bfhi(w.y); rskv[t] = (b0 * b0 + b1 * b1) + (b2 * b2 + b3 * b3);
        kpe[t] = lane < 32 ? bf2f(urow[512 + lane]) : 0.f;
        const float* tab = (const float*)(c.ws + WS_CS16) + (size_t)m * 32; cs[t] = tab[2 * i16]; sn[t] = tab[2 * i16 + 1]; }
#pragma unroll
    for (int t = 0; t < TB; ++t) { rsq[t] = rsqrtf(wave_sum(rsq[t]) * (1.f / 256.f) + EPS); rskv[t] = rsqrtf(wave_sum(rskv[t]) * (1.f / 256.f) + EPS); }
    const float qscale = 0.10206207261596577f * LOG2E;
    const float qg0 = qg[lane], qg1 = lane < 32 ? qg[64 + lane] : 0.f, kg0 = kg[lane], kg1 = lane < 32 ? kg[64 + lane] : 0.f;
#pragma unroll 1
    for (int h = 0; h < 8; ++h) {
        float x0[TB], x1[TB], r[TB];
#pragma unroll
        for (int t = 0; t < TB; ++t) { const bf16_t* q = QL + (size_t)mrow[t] * UPW + 96 * h; x0[t] = bf2f(q[lane]) * rsq[t]; x1[t] = lane < 32 ? bf2f(q[64 + lane]) * rsq[t] : 0.f; r[t] = x0[t] * x0[t] + x1[t] * x1[t]; }
#pragma unroll
        for (int t = 0; t < TB; ++t) r[t] = rsqrtf(wave_sum(r[t]) * (1.f / 96.f) + EPS);
#pragma unroll
        for (int t = 0; t < TB; ++t) { bf16_t* q = QL + (size_t)mrow[t] * UPW + 96 * h; float y0 = x0[t] * r[t] * qg0; const float y1 = x1[t] * r[t] * qg1; const float other = swz<16>(y0);
            if (lane < 32) y0 = lane < 16 ? y0 * cs[t] - other * sn[t] : other * sn[t] + y0 * cs[t];
            q[lane] = (bf16_t)f2bf(y0 * qscale); if (lane < 32) q[64 + lane] = (bf16_t)f2bf(y1 * qscale); }
#pragma unroll
        for (int t = 0; t < TB; ++t) { bf16_t* kn = KVU + (size_t)mrow[t] * UPW + 128 * h; x0[t] = lane < 32 ? kpe[t] : bf2f(kn[lane - 32]) * rskv[t]; x1[t] = lane < 32 ? bf2f(kn[32 + lane]) * rskv[t] : 0.f; r[t] = x0[t] * x0[t] + x1[t] * x1[t];
            bf16_t* v = kn + 64 + lane; *v = (bf16_t)f2bf(bf2f(*v) * rskv[t]); }
#pragma unroll
        for (int t = 0; t < TB; ++t) r[t] = rsqrtf(wave_sum(r[t]) * (1.f / 96.f) + EPS);
#pragma unroll
        for (int t = 0; t < TB; ++t) { float y0 = x0[t] * r[t] * kg0; const float y1 = x1[t] * r[t] * kg1; const float other = swz<16>(y0);
            if (lane < 32) y0 = lane < 16 ? y0 * cs[t] - other * sn[t] : other * sn[t] + y0 * cs[t];
            bf16_t* k = KF + (size_t)mrow[t] * 768 + 96 * h; k[lane] = (bf16_t)f2bf(y0); if (lane < 32) k[64 + lane] = (bf16_t)f2bf(y1); }
    }
}

DI float gelu_tanh(float x) { const float u = 0.7978845608028654f * (x + 0.044715f * x * x * x); const float e = __expf(2.f * u); const float t = 1.f - 2.f / (e + 1.f); return 0.5f * x * (1.f + t); }
DI void compress_item(Ctx& c, const bf16_t* U, int j, int it) {
    RELAUNDER(c);
    CArgs& a = *c.a; const int lane = c.lane, w = c.wave, tid = c.tid;
    const int jj = it >> 7, bg = (it >> 3) & 15, chunk = it & 7, b = bg >> 1, g = bg & 1, c0 = 16 * chunk;
    const bf16_t* W1t = (const bf16_t*)(c.ws + WS_WEVEN + j * W_EVEN + WE_C1) + (size_t)jj * 128 * 2048;
    const bf16_t* W2t = (const bf16_t*)(c.ws + WS_WEVEN + j * W_EVEN + WE_C2) + (size_t)jj * 64 * 128;
    const float* bias1 = (const float*)(c.ws + WS_MISC) + (j * 2 + jj) * 128;
    LAS float* part = (LAS float*)c.lds;
    LAS bf16_t* hid = (LAS bf16_t*)(c.lds + 65536);
    LAS float* outl = (LAS float*)(c.lds + 65536 + 8192);
    const int r16 = lane & 15, q4 = lane >> 4;
    f32x4 acc[8];
#pragma unroll
    for (int n = 0; n < 8; ++n) acc[n] = (f32x4){0.f, 0.f, 0.f, 0.f};
    const bf16_t* arow = U + ((size_t)b * S + 16 * (c0 + r16)) * UW + 1056 + jj * 128 + g * 64 + q4 * 8;
#pragma unroll 2
    for (int ks = 8 * w; ks < 8 * w + 8; ++ks) {
        const bf16x8 af = *(const bf16x8*)(arow + (size_t)(ks >> 1) * UW + (ks & 1) * 32);
#pragma unroll
        for (int n = 0; n < 8; ++n) { const bf16x8 bfr = *(const bf16x8*)(W1t + (size_t)(n * 16 + r16) * 2048 + 32 * ks + q4 * 8);
            acc[n] = __builtin_amdgcn_mfma_f32_16x16x32_bf16(af, bfr, acc[n], 0, 0, 0); }
    }
#pragma unroll
    for (int n = 0; n < 8; ++n)
#pragma unroll
        for (int i = 0; i < 4; ++i) part[(w * 16 + q4 * 4 + i) * 128 + n * 16 + r16] = acc[n][i];
    __syncthreads();
    { const int cc = tid >> 5, n0 = (tid & 31) * 4; float v[4];
#pragma unroll
      for (int e = 0; e < 4; ++e) { float s = 0.f;
#pragma unroll
          for (int ww = 0; ww < 8; ++ww) s += part[(ww * 16 + cc) * 128 + n0 + e];
          v[e] = gelu_tanh(s + bias1[n0 + e]); }
      u32x2 o; o.x = pk2(v[0], v[1]); o.y = pk2(v[2], v[3]); *(LAS u32x2*)(hid + cc * 136 + n0) = o; }
    __syncthreads();
    if (w < 4) {
        f32x4 a2 = (f32x4){0.f, 0.f, 0.f, 0.f};
#pragma unroll
        for (int kst = 0; kst < 4; ++kst) { const bf16x8 af = *(const LAS bf16x8*)(hid + r16 * 136 + 32 * kst + q4 * 8);
            const bf16x8 bfr = *(const bf16x8*)(W2t + (size_t)(w * 16 + r16) * 128 + 32 * kst + q4 * 8);
            a2 = __builtin_amdgcn_mfma_f32_16x16x32_bf16(af, bfr, a2, 0, 0, 0); }
#pragma unroll
        for (int i = 0; i < 4; ++i) outl[(q4 * 4 + i) * 64 + w * 16 + r16] = a2[i];
    }
    __syncthreads();
    if (tid < 256) {
        const int cc = tid >> 4, d0 = (tid & 15) * 4; const int cg = c0 + cc;
        bf16_t* dst = (bf16_t*)(c.ws + WS_MISC + 65536 + (size_t)jj * 262144) + ((size_t)bg * 128 + cg) * 64 + d0;
        float v[4];
#pragma unroll
        for (int e = 0; e < 4; ++e) v[e] = outl[cc * 64 + d0 + e];
        if (jj == 0) {
            float s = (v[0] * v[0] + v[1] * v[1]) + (v[2] * v[2] + v[3] * v[3]);
            s += swz<1>(s); s += swz<2>(s); s += swz<4>(s); s += swz<8>(s);
            const float rs = rsqrtf(s * (1.f / 64.f) + EPS); const float* kg = a.in[18] + j * 192;
            int tok = b * S + 16 * cg + 31; if (tok >= T) tok = T - 1;
            const float* tab = (const float*)(c.ws + WS_CS8) + (size_t)tok * 16;
#pragma unroll
            for (int e = 0; e < 4; ++e) { const int d = d0 + e; float y = v[e] * rs * kg[d];
                if (d < 16) { const float o = outl[cc * 64 + (d ^ 8)] * rs * kg[d ^ 8]; const int i = d & 7; const float cs = tab[2 * i], sn = tab[2 * i + 1]; y = d < 8 ? y * cs - o * sn : o * sn + y * cs; }
                v[e] = y; }
        }
        if (cg == 127) { v[0] = v[1] = v[2] = v[3] = 0.f; }
        u32x2 o; o.x = pk2(v[0], v[1]); o.y = pk2(v[2], v[3]); *(u32x2*)dst = o;
    }
    __syncthreads();
}

DI void lds_add(LAS float* p, float v) { (void)__hip_atomic_fetch_add(p, v, __ATOMIC_RELAXED, __HIP_MEMORY_SCOPE_WORKGROUP); }
DI int crow(int r, int h) { return (r & 3) + 8 * (r >> 2) + 4 * h; }
DI unsigned cvtpk(float lo, float hi) { typedef float f2 __attribute__((ext_vector_type(2))); typedef __bf16 b2 __attribute__((ext_vector_type(2))); f2 v = {lo, hi}; b2 r = __builtin_convertvector(v, b2); return __builtin_bit_cast(unsigned, r); }
typedef short v4i16_t __attribute__((ext_vector_type(4)));
DI s16x4 vtr(const LAS char* p) { return __builtin_bit_cast(s16x4, __builtin_amdgcn_ds_read_tr16_b64_v4i16((LAS v4i16_t*)p)); }
template <int DD> struct TileRegs { u32x4 r[(64 * DD / 8 + NT - 1) / NT]; };
template <int DD> DI void tile_load(TileRegs<DD>& t, const bf16_t* g, int ld, int tid) {
    constexpr int CPR = DD / 8, NCH = 64 * CPR, NI = (NCH + NT - 1) / NT;
#pragma unroll
    for (int i = 0; i < NI; ++i) { const int ch = tid + NT * i; if (NCH % NT == 0 || ch < NCH) { const int row = ch / CPR, c8 = ch % CPR; const unsigned eo = (unsigned)row * (unsigned)ld + (unsigned)c8 * 8u; t.r[i] = *(const u32x4*)(g + eo); } }
}
template <int DD> DI void tile_store(const TileRegs<DD>& t, LAS char* buf, int tid) {
    constexpr int CPR = DD / 8, NCH = 64 * CPR, NI = (NCH + NT - 1) / NT, STR = DD * 2 + 16;
#pragma unroll
    for (int i = 0; i < NI; ++i) { const int ch = tid + NT * i; if (NCH % NT == 0 || ch < NCH) { const int row = ch / CPR, c8 = ch % CPR; *(LAS u32x4*)(buf + row * STR + c8 * 16) = t.r[i]; } }
}
template <int DK> DI void qk_tile(const LAS char* Kb, const bf16x8* qf, f32x16& p0, f32x16& p1, int lane) {
    constexpr int KS = DK * 2 + 16; const LAS char* kp = Kb + (lane & 31) * KS + (lane >> 5) * 16;
#pragma unroll
    for (int r = 0; r < 16; ++r) { p0[r] = 0.f; p1[r] = 0.f; }
#pragma unroll
    for (int st = 0; st < DK / 16; ++st) { const bf16x8 a0 = *(const LAS bf16x8*)(kp + st * 32), a1 = *(const LAS bf16x8*)(kp + 32 * KS + st * 32);
        p0 = __builtin_amdgcn_mfma_f32_32x32x16_bf16(a0, qf[st], p0, 0, 0, 0); p1 = __builtin_amdgcn_mfma_f32_32x32x16_bf16(a1, qf[st], p1, 0, 0, 0); }
}
template <int DV> DI void pv_tile(const LAS char* Vb, const f32x16& p0, const f32x16& p1, f32x16* o, int lane) {
    constexpr int VS = DV * 2 + 16;
    const int g = lane >> 4, h = lane >> 5, i16 = lane & 15, q = i16 >> 2, p = i16 & 3;
    const LAS char* base = Vb + (4 * h + q) * VS + (16 * (g & 1) + 4 * p) * 2;
#pragma unroll
    for (int s = 0; s < 4; ++s) {
        u32x4 pw;
        if (s < 2) { pw.x = cvtpk(p0[8 * s], p0[8 * s + 1]); pw.y = cvtpk(p0[8 * s + 2], p0[8 * s + 3]); pw.z = cvtpk(p0[8 * s + 4], p0[8 * s + 5]); pw.w = cvtpk(p0[8 * s + 6], p0[8 * s + 7]); }
        else { const int s2 = s - 2; pw.x = cvtpk(p1[8 * s2], p1[8 * s2 + 1]); pw.y = cvtpk(p1[8 * s2 + 2], p1[8 * s2 + 3]); pw.z = cvtpk(p1[8 * s2 + 4], p1[8 * s2 + 5]); pw.w = cvtpk(p1[8 * s2 + 6], p1[8 * s2 + 7]); }
        const bf16x8 pf = __builtin_bit_cast(bf16x8, pw);
#pragma unroll
        for (int db = 0; db < DV / 32; ++db) {
            const s16x4 lo = vtr(base + (16 * s) * VS + db * 64), hi = vtr(base + (16 * s + 8) * VS + db * 64);
            const bf16x8 vf = (bf16x8){lo[0], lo[1], lo[2], lo[3], hi[0], hi[1], hi[2], hi[3]};
            o[db] = __builtin_amdgcn_mfma_f32_32x32x16_bf16(vf, pf, o[db], 0, 0, 0);
        }
    }
}
DI float rowmax32(const f32x16& p0, const f32x16& p1) {
    float m = fmaxf(p0[0], p1[0]);
#pragma unroll
    for (int r = 1; r < 16; ++r) m = fmaxf(m, fmaxf(p0[r], p1[r]));
    return max32(m);
}
template <int DV> DI void softmax_step(f32x16& p0, f32x16& p1, f32x16* o, float& m, float& l) {
    const float mx = rowmax32(p0, p1); const float mnew = fmaxf(m, mx); const float muse = (mnew == -INFINITY) ? 0.f : mnew;
    const float alpha = __builtin_amdgcn_exp2f(m - muse);
    float s = 0.f;
#pragma unroll
    for (int r = 0; r < 16; ++r) { p0[r] = __builtin_amdgcn_exp2f(p0[r] - muse); p1[r] = __builtin_amdgcn_exp2f(p1[r] - muse); s += p0[r] + p1[r]; }
    l = l * alpha + s; m = mnew;
#pragma unroll
    for (int db = 0; db < DV / 32; ++db)
#pragma unroll
        for (int r = 0; r < 16; ++r) o[db][r] *= alpha;
}
template <int DK> DI void load_qfrag(bf16x8* qf, const bf16_t* qrow  , int h) {
#pragma unroll
    for (int st = 0; st < DK / 16; ++st) qf[st] = *(const bf16x8*)(qrow + 16 * st + 8 * h);
}
template <int DK, int DV> struct SweepLds { static constexpr int KB = 64 * (DK * 2 + 16), VB = 64 * (DV * 2 + 16); };

template <int DK, int DV> DI void causal_sweep(Ctx& c, const bf16_t* Qg, int ldq, const bf16_t* Kg, int ldk, const bf16_t* Vg, int ldv, int q0, f32x16* o, float& lsum) {
    RELAUNDER(c);
    typedef SweepLds<DK, DV> L; LAS char* lds = (LAS char*)c.lds;
    const int lane = c.lane, w = c.wave, tid = c.tid, r32 = lane & 31, h = lane >> 5;
    const int qrow = q0 + 32 * w + r32;
    bf16x8 qf[DK / 16]; load_qfrag<DK>(qf, Qg + (unsigned)qrow * (unsigned)ldq, h);
#pragma unroll
    for (int db = 0; db < DV / 32; ++db)
#pragma unroll
        for (int r = 0; r < 16; ++r) o[db][r] = 0.f;
    float m = -INFINITY, l = 0.f;
    const int nt = (q0 >> 6) + 4, wlast = (q0 + 32 * w + 31) >> 6;
    TileRegs<DK> kr; TileRegs<DV> vr;
    tile_load<DK>(kr, Kg, ldk, tid); tile_load<DV>(vr, Vg, ldv, tid);
    __syncthreads();
    tile_store<DK>(kr, lds, tid); tile_store<DV>(vr, lds + 2 * L::KB, tid);
    __syncthreads();
    for (int t = 0; t < nt; ++t) {
        const int cur = t & 1;
        if (t + 1 < nt) { tile_load<DK>(kr, Kg + (size_t)(t + 1) * 64 * ldk, ldk, tid); tile_load<DV>(vr, Vg + (size_t)(t + 1) * 64 * ldv, ldv, tid); }
        if (t <= wlast) {
            f32x16 p0, p1; qk_tile<DK>(lds + cur * L::KB, qf, p0, p1, lane);
            if (t * 64 + 63 > q0 + 32 * w) {
#pragma unroll
                for (int r = 0; r < 16; ++r) { const int kv = t * 64 + crow(r, h); if (kv > qrow) p0[r] = -INFINITY; if (kv + 32 > qrow) p1[r] = -INFINITY; }
            }
            softmax_step<DV>(p0, p1, o, m, l);
            pv_tile<DV>(lds + 2 * L::KB + cur * L::VB, p0, p1, o, lane);
        }
        if (t + 1 < nt) { tile_store<DK>(kr, lds + (cur ^ 1) * L::KB, tid); tile_store<DV>(vr, lds + 2 * L::KB + (cur ^ 1) * L::VB, tid); }
        __syncthreads();
    }
    lsum = sum32(l);
}
template <int DV> DI void store_o(const f32x16* o, float scale, bf16_t* rowp, int h) {
#pragma unroll
    for (int db = 0; db < DV / 32; ++db)
#pragma unroll
        for (int k = 0; k < 4; ++k) { u32x2 v; v.x = cvtpk(o[db][4 * k] * scale, o[db][4 * k + 1] * scale); v.y = cvtpk(o[db][4 * k + 2] * scale, o[db][4 * k + 3] * scale);
            *(u32x2*)(rowp + 32 * db + 8 * k + 4 * h) = v; }
}

DI void mla_unit(Ctx& c, const bf16_t* QL, const bf16_t* KF, const bf16_t* KVU, bf16_t* YC, int b, int hd, int qt) {
    RELAUNDER(c);
    const int q0 = qt * 256; f32x16 o[2]; float l;
    const size_t rb = (size_t)b * S;
    causal_sweep<96, 64>(c, QL + rb * UPW + 96 * hd, UPW, KF + rb * 768 + 96 * hd, 768, KVU + rb * UPW + 128 * hd + 64, UPW, q0, o, l);
    const int qrow = q0 + 32 * c.wave + (c.lane & 31);
    store_o<64>(o, 1.f / l, YC + (rb + qrow) * 1024 + 64 * hd, c.lane >> 5);
}
DI void diff_unit(Ctx& c, const bf16_t* QKV, bf16_t* ON, int b, int hd, int qt, int j, int layer) {
    RELAUNDER(c);
    CArgs& a = *c.a; const int q0 = qt * 256, lane = c.lane, h = lane >> 5; const size_t rb = (size_t)b * S;
    f32x16 o1[4], o2[4]; float l1, l2;
    const bf16_t* base = QKV + rb * 3072;
    causal_sweep<64, 128>(c, base + 128 * hd, 3072, base + 1024 + 128 * hd, 3072, base + 2048 + 128 * hd, 3072, q0, o1, l1);
    { const float i1_ = 1.f / l1;
#pragma unroll
      for (int db = 0; db < 4; ++db)
#pragma unroll
          for (int r = 0; r < 16; ++r) o1[db][r] *= i1_; }
    causal_sweep<64, 128>(c, base + 128 * hd + 64, 3072, base + 1024 + 128 * hd + 64, 3072, base + 2048 + 128 * hd, 3072, q0, o2, l2);
    const float* lam = a.in[26] + j * 256; float s1 = lam[lane] * lam[64 + lane], s2 = lam[128 + lane] * lam[192 + lane];
    s1 = wave_sum(s1); s2 = wave_sum(s2);
    const float lam_init = 0.8f - 0.6f * __expf(-0.3f * (float)layer); const float lmb = __expf(s1) - __expf(s2) + lam_init;
    const float i1 = 1.f, i2 = lmb / l2; float ss = 0.f;
#pragma unroll
    for (int db = 0; db < 4; ++db)
#pragma unroll
        for (int r = 0; r < 16; ++r) { const float v = o1[db][r] * i1 - o2[db][r] * i2; o1[db][r] = v; ss += v * v; }
    ss = sum32(ss);
    const float rs = rsqrtf(ss * (1.f / 128.f) + EPS) * (1.f - lam_init);
    const float* sg = a.in[27] + j * 128;
#pragma unroll
    for (int db = 0; db < 4; ++db)
#pragma unroll
        for (int r = 0; r < 16; ++r) o1[db][r] *= rs * sg[32 * db + crow(r, h)];
    const int qrow = q0 + 32 * c.wave + (lane & 31);
    store_o<128>(o1, 1.f, ON + (rb + qrow) * 1024 + 128 * hd, h);
}

DI void nsa_unit(Ctx& c, const bf16_t* U, bf16_t* YC, int b, int g, int qt) {
    RELAUNDER(c);
    CArgs& a = *c.a; LAS char* lds = (LAS char*)c.lds; typedef SweepLds<64, 64> L;
    const int lane = c.lane, w = c.wave, tid = c.tid, r32 = lane & 31, h = lane >> 5;
    const int hg = w & 3, qsub = w >> 2, head = g * 4 + hg, q0 = qt * 64, jt = qt;
    const int qrow = q0 + 32 * qsub + r32; const size_t rb = (size_t)b * S; const size_t m = rb + qrow;
    LAS float* imp = (LAS float*)(lds + 4 * L::KB);
    LAS unsigned* selw = (LAS unsigned*)(lds + 4 * L::KB + 4 * 64 * 33 * 4);
    bf16x8 qf[4]; load_qfrag<64>(qf, U + m * UW + 544 + 64 * head, h);
    const bf16_t* urow = U + m * UW + 1824;
#ifdef NSA_ONLY
    const float g0 = NSA_ONLY == 0 ? 1.f : 0.f, g1 = NSA_ONLY == 1 ? 1.f : 0.f, g2 = NSA_ONLY == 2 ? 1.f : 0.f; (void)urow;
#else
    const float g0 = 1.f / (1.f + __expf(-bf2f(urow[head]))), g1 = 1.f / (1.f + __expf(-bf2f(urow[8 + head]))), g2 = 1.f / (1.f + __expf(-bf2f(urow[16 + head])));
#endif
    f32x16 acc[2];
#pragma unroll
    for (int db = 0; db < 2; ++db)
#pragma unroll
        for (int r = 0; r < 16; ++r) acc[db][r] = 0.f;
    const int bg = b * 2 + g;
    const bf16_t* KC = (const bf16_t*)(c.ws + WS_MISC + 65536) + (size_t)bg * 128 * 64; const bf16_t* VC = (const bf16_t*)(c.ws + WS_MISC + 65536 + 262144) + (size_t)bg * 128 * 64;
    __syncthreads();
    { TileRegs<64> k0, k1, v0, v1; tile_load<64>(k0, KC, 64, tid); tile_load<64>(k1, KC + 64 * 64, 64, tid); tile_load<64>(v0, VC, 64, tid); tile_load<64>(v1, VC + 64 * 64, 64, tid);
      for (int i = tid; i < 4 * 64 * 33; i += NT) imp[i] = 0.f;
      tile_store<64>(k0, lds, tid); tile_store<64>(k1, lds + L::KB, tid); tile_store<64>(v0, lds + 2 * L::KB, tid); tile_store<64>(v1, lds + 2 * L::KB + L::VB, tid); }
    __syncthreads();
    {
        f32x16 p0, p1, p2, p3; qk_tile<64>(lds, qf, p0, p1, lane); qk_tile<64>(lds + L::KB, qf, p2, p3, lane);
        const int hi = qrow < 31 ? -1 : (qrow - 31) >> 4;
#pragma unroll
        for (int r = 0; r < 16; ++r) { const int cidx = crow(r, h); if (cidx > hi) p0[r] = -INFINITY; if (cidx + 32 > hi) p1[r] = -INFINITY; if (cidx + 64 > hi) p2[r] = -INFINITY; if (cidx + 96 > hi) p3[r] = -INFINITY; }
        float mx = fmaxf(rowmax32(p0, p1), rowmax32(p2, p3)); const float muse = (mx == -INFINITY) ? 0.f : mx; float s = 0.f;
#pragma unroll
        for (int r = 0; r < 16; ++r) { p0[r] = __builtin_amdgcn_exp2f(p0[r] - muse); p1[r] = __builtin_amdgcn_exp2f(p1[r] - muse); p2[r] = __builtin_amdgcn_exp2f(p2[r] - muse); p3[r] = __builtin_amdgcn_exp2f(p3[r] - muse); s += (p0[r] + p1[r]) + (p2[r] + p3[r]); }
        s = sum32(s); const float inv = s > 0.f ? 1.f / s : 0.f;
#pragma unroll
        for (int r = 0; r < 16; ++r) { p0[r] *= inv; p1[r] *= inv; p2[r] *= inv; p3[r] *= inv; }
        LAS float* ir = imp + hg * (64 * 33) + (32 * qsub + r32) * 33;
#define IMP_ADD(P, PI) _Pragma("unroll") for (int k = 0; k < 4; ++k) { const int jb = 8 * (PI) + 2 * k + h; const float s4 = (P[4 * k] + P[4 * k + 1]) + (P[4 * k + 2] + P[4 * k + 3]); lds_add(ir + jb, s4); if (jb + 1 < 32) lds_add(ir + jb + 1, P[4 * k + 3]); }
        IMP_ADD(p0, 0) IMP_ADD(p1, 1) IMP_ADD(p2, 2) IMP_ADD(p3, 3)
#undef IMP_ADD
        f32x16 oc[2];
#pragma unroll
        for (int db = 0; db < 2; ++db)
#pragma unroll
            for (int r = 0; r < 16; ++r) oc[db][r] = 0.f;
        pv_tile<64>(lds + 2 * L::KB, p0, p1, oc, lane); pv_tile<64>(lds + 2 * L::KB + L::VB, p2, p3, oc, lane);
#pragma unroll
        for (int db = 0; db < 2; ++db)
#pragma unroll
            for (int r = 0; r < 16; ++r) acc[db][r] += g0 * oc[db][r];
    }
    __syncthreads();
#pragma unroll 1
    for (int i = 0; i < 4; ++i) { const int id = tid + NT * i, qq = id >> 5, jb = id & 31;
        const bool allowed = jb <= jt, forced = allowed && (jb == 0 || jb >= jt - 1);
        const float iv = (imp[qq * 33 + jb] + imp[64 * 33 + qq * 33 + jb]) + (imp[2 * 64 * 33 + qq * 33 + jb] + imp[3 * 64 * 33 + qq * 33 + jb]);
        const float v = forced ? 1e9f : (allowed ? iv : -1e30f);
        int rank = 0;
        for (int k = 0; k < 32; ++k) { const float vk = __shfl(v, (lane & 32) + k); rank += (vk > v || (vk == v && k < jb)) ? 1 : 0; }
        const unsigned long long bal = __ballot(allowed && rank < 16);
        if (jb == 0) selw[qq] = (unsigned)(bal >> (lane & 32)); }
    __syncthreads();
    const unsigned mysel = selw[32 * qsub + r32];
    unsigned uni = selw[lane];
    uni |= swzu<1>(uni); uni |= swzu<2>(uni); uni |= swzu<4>(uni); uni |= swzu<8>(uni); uni |= swzu<16>(uni); uni = or32(uni);
    uni = __builtin_amdgcn_readfirstlane(uni);
    {
        const bf16_t* Kg = U + rb * UW + 1312 + 64 * g; const bf16_t* Vg = U + rb * UW + 1440 + 64 * g;
        f32x16 o[2];
#pragma unroll
        for (int db = 0; db < 2; ++db)
#pragma unroll
            for (int r = 0; r < 16; ++r) o[db][r] = 0.f;
        float mm = -INFINITY, l = 0.f; unsigned rem = uni; int cur = 0;
        TileRegs<64> kr, vr; int t = __builtin_ctz(rem); rem &= rem - 1;
        tile_load<64>(kr, Kg + (size_t)t * 64 * UW, UW, tid); tile_load<64>(vr, Vg + (size_t)t * 64 * UW, UW, tid);
        tile_store<64>(kr, lds, tid); tile_store<64>(vr, lds + 2 * L::KB, tid);
        __syncthreads();
        for (;;) {
            const int tn = rem ? __builtin_ctz(rem) : -1; rem &= rem - 1;
            if (tn >= 0) { tile_load<64>(kr, Kg + (size_t)tn * 64 * UW, UW, tid); tile_load<64>(vr, Vg + (size_t)tn * 64 * UW, UW, tid); }
            {
                f32x16 p0, p1; qk_tile<64>(lds + cur * L::KB, qf, p0, p1, lane);
                const bool on = (mysel >> t) & 1u;
#pragma unroll
                for (int r = 0; r < 16; ++r) { const int kv = t * 64 + crow(r, h); if (!on || kv > qrow) p0[r] = -INFINITY; if (!on || kv + 32 > qrow) p1[r] = -INFINITY; }
                softmax_step<64>(p0, p1, o, mm, l);
                pv_tile<64>(lds + 2 * L::KB + cur * L::VB, p0, p1, o, lane);
            }
            if (tn >= 0) { tile_store<64>(kr, lds + (cur ^ 1) * L::KB, tid); tile_store<64>(vr, lds + 2 * L::KB + (cur ^ 1) * L::VB, tid); }
            __syncthreads();
            if (tn < 0) break;
            t = tn; cur ^= 1;
        }
        l = sum32(l); const float sc = g1 / l;
#pragma unroll
        for (int db = 0; db < 2; ++db)
#pragma unroll
            for (int r = 0; r < 16; ++r) acc[db][r] += sc * o[db][r];
    }
    {
        const bf16_t* Kg = U + rb * UW + 1568 + 64 * g; const bf16_t* Vg = U + rb * UW + 1696 + 64 * g;
        f32x16 o[2];
#pragma unroll
        for (int db = 0; db < 2; ++db)
#pragma unroll
            for (int r = 0; r < 16; ++r) o[db][r] = 0.f;
        float mm = -INFINITY, l = 0.f; const int t0 = jt - 8 > 0 ? jt - 8 : 0;
        TileRegs<64> kr, vr; tile_load<64>(kr, Kg + (size_t)t0 * 64 * UW, UW, tid); tile_load<64>(vr, Vg + (size_t)t0 * 64 * UW, UW, tid);
        tile_store<64>(kr, lds, tid); tile_store<64>(vr, lds + 2 * L::KB, tid);
        __syncthreads();
        for (int t = t0; t <= jt; ++t) {
            const int cur = (t - t0) & 1;
            if (t < jt) { tile_load<64>(kr, Kg + (size_t)(t + 1) * 64 * UW, UW, tid); tile_load<64>(vr, Vg + (size_t)(t + 1) * 64 * UW, UW, tid); }
            {
                f32x16 p0, p1; qk_tile<64>(lds + cur * L::KB, qf, p0, p1, lane);
                if (t == jt || t == jt - 8) {
#pragma unroll
                    for (int r = 0; r < 16; ++r) { const int kv = t * 64 + crow(r, h); if (kv > qrow || kv <= qrow - 512) p0[r] = -INFINITY; if (kv + 32 > qrow || kv + 32 <= qrow - 512) p1[r] = -INFINITY; }
                }
                softmax_step<64>(p0, p1, o, mm, l);
                pv_tile<64>(lds + 2 * L::KB + cur * L::VB, p0, p1, o, lane);
            }
            if (t < jt) { tile_store<64>(kr, lds + (cur ^ 1) * L::KB, tid); tile_store<64>(vr, lds + 2 * L::KB + (cur ^ 1) * L::VB, tid); }
            __syncthreads();
        }
        l = sum32(l); const float sc = g2 / l;
#pragma unroll
        for (int db = 0; db < 2; ++db)
#pragma unroll
            for (int r = 0; r < 16; ++r) acc[db][r] += sc * o[db][r];
    }
    store_o<64>(acc, 1.f, YC + m * 1024 + 512 + 64 * head, h);
}
}
#ifndef FX_MODE
#define FX_MODE 0
#endif
namespace fx {
template <int ACT  > struct EpiB16 {
    static constexpr bool PERM = true, AFTER_DRAIN = false;
    bf16_t* O; int ldc;
    __device__ __forceinline__ void operator()(const pg8::f32x4 (&acc)[2][2][4][2], const pg8::Unit& u, int wr, int wc, int fr, int fq) const {
        const int row0 = u.pm * 256 + wr * 64 + fr, col0 = u.pn * 256 + wc * 32 + 8 * fq;
#pragma unroll
        for (int ai = 0; ai < 2; ++ai)
#pragma unroll
            for (int m = 0; m < 4; ++m) { bf16_t* rowp = O + (size_t)(row0 + ai * 128 + m * 16) * ldc + col0;
#pragma unroll
                for (int bj = 0; bj < 2; ++bj) { pg8::f32x4 v0 = acc[ai][bj][m][0], v1 = acc[ai][bj][m][1];
                    if (ACT == 1) {
#pragma unroll
                        for (int e = 0; e < 4; ++e) { float a = v0[e] > 0.f ? v0[e] : 0.f; v0[e] = a * a; float b = v1[e] > 0.f ? v1[e] : 0.f; v1[e] = b * b; } }
                    u32x4 w; w.x = pg8::cvt_pk_bf16(v0[0], v0[1]); w.y = pg8::cvt_pk_bf16(v0[2], v0[3]); w.z = pg8::cvt_pk_bf16(v1[0], v1[1]); w.w = pg8::cvt_pk_bf16(v1[2], v1[3]);
                    *(u32x4*)(rowp + bj * 128) = w; } }
    }
};
struct UpOrder : pg8::StaticOrder {
    __device__ bool next(int i, pg8::Unit& u) const { if (!pg8::StaticOrder::next(i, u)) return false; u.aoff = u.pn >= 3 ? 256 : 0; return true; }
};
struct EpiResid {
    static constexpr bool PERM = false, AFTER_DRAIN = false;
    const float* base; float* out; const float* gate;
    __device__ __forceinline__ void operator()(const pg8::f32x4 (&acc)[2][2][4][2], const pg8::Unit& u, int wr, int wc, int fr, int fq) const {
        const int row0 = u.pm * 256 + wr * 64 + fr, col0 = u.pn * 256 + wc * 32 + 4 * fq; const float* gp = gate + (size_t)(u.pm >> 3) * 6144 + col0;
        pg8::f32x4 gv[2][2];
#pragma unroll
        for (int bj = 0; bj < 2; ++bj)
#pragma unroll
            for (int n = 0; n < 2; ++n) gv[bj][n] = *(const pg8::f32x4*)(gp + bj * 128 + n * 16);
#pragma unroll
        for (int ai = 0; ai < 2; ++ai)
#pragma unroll
            for (int m = 0; m < 4; ++m) { const size_t off = (size_t)(row0 + ai * 128 + m * 16) * 1024 + col0;
#pragma unroll
                for (int bj = 0; bj < 2; ++bj)
#pragma unroll
                    for (int n = 0; n < 2; ++n) { const pg8::f32x4 bs = *(const pg8::f32x4*)(base + off + bj * 128 + n * 16); *(pg8::f32x4*)(out + off + bj * 128 + n * 16) = bs + gv[bj][n] * acc[ai][bj][m][n]; } }
    }
};

#ifndef FX_REPEAT_KIND
#define FX_REPEAT_KIND 0
#endif
#define REP(kind) for (int rep_ = 0; rep_ < ((FX_REPEAT_KIND == (kind)) ? 2 : 1); ++rep_)
#define DUMMY_OUT ((float*)(ws + 300 * MiB))
__global__ void __launch_bounds__(NT, 2) mega(Args args) {
    extern __shared__ __attribute__((aligned(16))) unsigned char lds_raw[];
    Ctx c; c.lds = (LAS unsigned char*)lds_raw; c.tid = threadIdx.x; c.lane = c.tid & 63; c.wave = __builtin_amdgcn_readfirstlane(c.tid >> 6); c.G = gridDim.x; c.bid = blockIdx.x; c.a = nullptr; (void)args;
#define KARGS() ({ CArgs* p_ = (CArgs*)__builtin_amdgcn_kernarg_segment_ptr(); asm volatile("" : "+s"(p_)); p_; })
    CArgs* pa0 = KARGS();
    volatile LAS unsigned* MISC = (volatile LAS unsigned*)(c.lds + LDS_MISC);
    for (int i = c.tid; i < 64; i += NT) MISC[i] = 0u;
    __syncthreads();
    XcdBarrier bar = xcd_barrier_post((unsigned*)(pa0->ws + WS_CTL) + 4096, MISC + 8);
    int ph = 0;
#if FX_MODE == 0
    constexpr int lo = 0, hi = 35;
#else
    const int lo = pa0->ph_lo, hi = pa0->ph_hi;
#endif
#define SEAM() do { if (ph + 1 < hi) { xcd_barrier(bar); if (FX_REPEAT_KIND == 12) xcd_barrier(bar); } } while (0)
#define PHASE_BEGIN if (ph >= lo && ph < hi) { CArgs* pa = KARGS(); c.a = pa; unsigned char* ws = pa->ws; c.ws = ws; { int t_ = threadIdx.x; asm volatile("" : "+v"(t_)); c.tid = t_; c.lane = t_ & 63; } \
    const float* MOD = (const float*)(ws + WS_MOD); const float* mod = MOD + (size_t)layer * 8 * 6144; (void)mod; \
    bf16_t* XN = (bf16_t*)(ws + WS_XN); bf16_t* YC = (bf16_t*)(ws + WS_YC); bf16_t* U = (bf16_t*)(ws + WS_BIG + BIG_U); bf16_t* QL = (bf16_t*)(ws + WS_BIG + BIG_UP); bf16_t* KVU = QL + 768; \
    bf16_t* KF = XN; bf16_t* HID = (bf16_t*)(ws + WS_BIG); bf16_t* QKV = (bf16_t*)(ws + WS_BIG); (void)XN; (void)YC; (void)U; (void)QL; (void)KVU; (void)KF; (void)HID; (void)QKV; \
    unsigned char* wb = ws + ((layer & 1) ? WS_WODD + (size_t)(layer >> 1) * W_ODD : WS_WEVEN + (size_t)(layer >> 1) * W_EVEN); unsigned char* wm = ws + WS_WMLP + (size_t)layer * W_MLP; (void)wb; (void)wm;
#define PHASE_END SEAM(); } ++ph;
    const int gw = c.bid * NW + c.wave, NGW = c.G * NW;
    int layer = 0;

    if (lo == 0) { CArgs* pa = KARGS(); c.a = pa; c.ws = pa->ws; RELAUNDER(c);
#ifndef SKIP_PRO
        REP(10) phase_prologue(c);
#endif
        if (hi > 1) { if (pa->use_cg != 0) cooperative_groups::this_grid().sync(); else xcd_barrier(bar); } }
    ++ph;

#pragma unroll
    for (layer = 0; layer < 4; ++layer) {
        const int j = layer >> 1;
        PHASE_BEGIN
#ifndef SKIP_NORM
 REP(8) phase_modnorm(c, layer == 0 ? pa->in[0] : pa->out, pa->in[5] + layer * D, mod + 0, mod + 1024, XN);
#endif
 PHASE_END
        if ((layer & 1) == 0) {
            PHASE_BEGIN { pg8::Gemm g{XN, (const bf16_t*)(wb + WE_IN), T, UW, D, D}; pg8::StaticOrder so; so.init(T, UW, c.G, c.bid); EpiB16<0> E{U, UW};

#ifndef SKIP_G1
REP(6) pg8::gemm_phase<EpiB16<0>, pg8::StaticOrder, true, true>(c.lds, g, so, E);
#endif
 } PHASE_END
            PHASE_BEGIN { pg8::Gemm g{U, (const bf16_t*)(wb + WE_UP), T, 1792, 256, UW}; UpOrder so; so.init(T, 1792, c.G, c.bid); EpiB16<0> E{QL, UPW};

#ifndef SKIP_G2
pg8::gemm_phase<EpiB16<0>, UpOrder, false, true>(c.lds, g, so, E);
#endif

                __syncthreads();

#ifndef SKIP_CMP
 for (int it = c.bid; it < 256; it += c.G) compress_item(c, U, j, it);
#endif


#ifndef SKIP_FIN
 RELAUNDER(c); for (int m0 = gw; m0 < T; m0 += NGW * TBV) nsa_finalize_rows(c, U, m0, NGW, j);
#endif
 } PHASE_END
            PHASE_BEGIN {
#ifndef SKIP_FIN
 for (int m0 = gw; m0 < T; m0 += NGW * TB) mla_finalize_rows(c, U, QL, KVU, KF, m0, NGW, j);
#endif

                REP(1) for (int p = c.bid; p < 256; p += c.G) { const int bg = p >> 4, s = p & 15;
#ifndef SKIP_NSA
 nsa_unit(c, U, YC, bg >> 1, bg & 1, 31 - s); nsa_unit(c, U, YC, bg >> 1, bg & 1, s);
#endif
 } } PHASE_END
            PHASE_BEGIN { REP(2) for (int p = c.bid; p < 256; p += c.G) { const int bh = p >> 2, s = p & 3;
#ifndef SKIP_MLA
 mla_unit(c, QL, KF, KVU, YC, bh >> 3, bh & 7, 7 - s); mla_unit(c, QL, KF, KVU, YC, bh >> 3, bh & 7, s);
#endif
 } } PHASE_END
            PHASE_BEGIN { pg8::Gemm g{YC, (const bf16_t*)(wb + WE_OUT), T, D, D, D}; pg8::StaticOrder so; so.init(T, D, c.G, c.bid);
#ifndef SKIP_G3
REP(9) { EpiResid E{layer == 0 ? pa->in[0] : pa->out, rep_ ? DUMMY_OUT : pa->out, mod + 2048}; pg8::gemm_phase<EpiResid, pg8::StaticOrder, true, true>(c.lds, g, so, E); }
#endif
 } PHASE_END
        } else {
            PHASE_BEGIN { pg8::Gemm g{XN, (const bf16_t*)(wb + WO_QKV), T, 3072, D, D}; pg8::StaticOrder so; so.init(T, 3072, c.G, c.bid); EpiB16<0> E{QKV, 3072};

#ifndef SKIP_G4
REP(7) pg8::gemm_phase<EpiB16<0>, pg8::StaticOrder, true, true>(c.lds, g, so, E);
#endif
 } PHASE_END
            PHASE_BEGIN {
#ifndef SKIP_FIN
 for (int m0 = gw; m0 < T; m0 += NGW * TBV) diff_finalize_rows(c, QKV, m0, NGW, j);
#endif
 } PHASE_END
            PHASE_BEGIN { REP(3) for (int p = c.bid; p < 256; p += c.G) { const int bh = p >> 2, s = p & 3;
#ifndef SKIP_DIFF
 diff_unit(c, QKV, YC, bh >> 3, bh & 7, 7 - s, j, layer); diff_unit(c, QKV, YC, bh >> 3, bh & 7, s, j, layer);
#endif
 } } PHASE_END
            PHASE_BEGIN { pg8::Gemm g{YC, (const bf16_t*)(wb + WO_O), T, D, D, D}; pg8::StaticOrder so; so.init(T, D, c.G, c.bid);
#ifndef SKIP_G5
REP(9) { EpiResid E{pa->out, rep_ ? DUMMY_OUT : pa->out, mod + 2048}; pg8::gemm_phase<EpiResid, pg8::StaticOrder, true, true>(c.lds, g, so, E); }
#endif
 } PHASE_END
        }
        PHASE_BEGIN
#ifndef SKIP_NORM
 REP(8) phase_modnorm(c, pa->out, pa->in[6] + layer * D, mod + 3072, mod + 4096, XN);
#endif
 PHASE_END
        PHASE_BEGIN { pg8::Gemm g{XN, (const bf16_t*)wm, T, FF, D, D}; pg8::StaticOrder so; so.init(T, FF, c.G, c.bid); EpiB16<1> E{HID, FF};

#ifndef SKIP_G6
REP(4) pg8::gemm_phase<EpiB16<1>, pg8::StaticOrder, true, true>(c.lds, g, so, E);
#endif
 } PHASE_END
        PHASE_BEGIN { pg8::Gemm g{HID, (const bf16_t*)(wm + 8 * MiB), T, D, FF, FF}; pg8::StaticOrder so; so.init(T, D, c.G, c.bid);
#ifndef SKIP_G7
REP(5) { EpiResid E{pa->out, rep_ ? DUMMY_OUT : pa->out, mod + 5120}; pg8::gemm_phase<EpiResid, pg8::StaticOrder, true, true>(c.lds, g, so, E); }
#endif
 } PHASE_END
    }
#undef PHASE_BEGIN
#undef PHASE_END
#undef SEAM
}
constexpr int N_PHASES = 1 + 2 * (1 + 5 + 3) + 2 * (1 + 4 + 3);
static_assert(N_PHASES == 35, "phase count");

inline void launch(const Args& base, int lo, int hi, int use_cg, hipStream_t st) {
    static int grid = 0;
    if (grid == 0) {
        int dev = 0, cus = 0, per_cu = 0;
        (void)hipGetDevice(&dev); (void)hipDeviceGetAttribute(&cus, hipDeviceAttributeMultiprocessorCount, dev);
        (void)hipFuncSetAttribute((const void*)mega, hipFuncAttributeMaxDynamicSharedMemorySize, LDS_BYTES);
        (void)hipOccupancyMaxActiveBlocksPerMultiprocessor(&per_cu, (const void*)mega, NT, LDS_BYTES);
        if (per_cu < 1) { fprintf(stderr, "occupancy query says %d blocks/CU\n", per_cu); per_cu = 1; }
        grid = cus;
        (void)hipGetLastError();
    }
    Args a = base; a.ph_lo = lo; a.ph_hi = hi; a.use_cg = use_cg; a.pad = 0;
    void* kargs[] = {&a};
    hipError_t e = hipLaunchCooperativeKernel((const void*)mega, dim3(grid), dim3(NT), kargs, LDS_BYTES, st);
    if (e != hipSuccess) fprintf(stderr, "cooperative launch failed: %s\n", hipGetErrorString(e));
}
}
#ifndef FX_MODE
#define FX_MODE 0
#endif
#ifndef DBG_LAYERS
#define DBG_LAYERS 1
#endif
#ifndef DBG_B0
#define DBG_B0 5
#endif
#ifndef DBG_STAGE
#define DBG_STAGE 0
#endif
#ifndef DBG_NPH
#define DBG_NPH -1
#endif
namespace dbg {
__global__ void k_cmp(const void* fast, int is_bf16, long fld, const float* ref, long rld, int nrows, int ncols, float fscale, float* acc2) {
    const long n = (long)nrows * ncols; float d2 = 0.f, r2 = 0.f;
    for (long i = (long)blockIdx.x * 256 + threadIdx.x; i < n; i += (long)gridDim.x * 256) { const long r = i / ncols, cidx = i % ncols;
        float a = is_bf16 ? fx::bf2f(((const unsigned short*)fast)[r * fld + cidx]) : ((const float*)fast)[r * fld + cidx]; a *= fscale;
        const float b = ref[r * rld + cidx]; if (!(a == a)) a = 1e6f; d2 += (a - b) * (a - b); r2 += b * b; }
    for (int o = 32; o > 0; o >>= 1) { d2 += __shfl_xor(d2, o); r2 += __shfl_xor(r2, o); }
    if ((threadIdx.x & 63) == 0) { atomicAdd(acc2, d2); atomicAdd(acc2 + 1, r2); }
}
#ifndef DBG_SEL
#define DBG_SEL -1
#endif
__global__ void k_finish(float* out, const float* acc, int nchk, long n) {
    float e = 0.f; int bad = -1; for (int i = 0; i < nchk; ++i) { float v = sqrtf(acc[2 * i] / fmaxf(acc[2 * i + 1], 1e-30f)); if (!(v == v)) v = 100.f; e = fmaxf(e, v); if (bad < 0 && v > 0.05f) bad = i; }
    if (DBG_SEL >= 0) { e = sqrtf(acc[2 * DBG_SEL] / fmaxf(acc[2 * DBG_SEL + 1], 1e-30f)); if (!(e == e)) e = 100.f; bad = -1; }
    if (blockIdx.x == 0 && threadIdx.x == 0 && bad >= 0) out[0] += 1000.f * (bad + 1);
    for (long i = (long)blockIdx.x * 256 + threadIdx.x; i < n; i += (long)gridDim.x * 256) out[i] *= (1.f + e);
}
}
extern "C" void kernel_launch(void* const* d_in, const int* in_sizes, int n_in, void* d_out, int out_size, void* d_ws, size_t ws_size, hipStream_t stream) {
    fx::Args a{};
    for (int i = 0; i < 28; ++i) a.in[i] = (const float*)d_in[i];
    a.pos = (const int*)d_in[2]; a.out = (float*)d_out; a.ws = (unsigned char*)d_ws;
    (void)hipMemsetAsync((char*)d_ws + fx::WS_CTL, 0, 65536, stream);
#if FX_MODE == 0
    fx::launch(a, 0, fx::N_PHASES, 1, stream);
#elif FX_MODE == 1
    for (int p = 0; p < fx::N_PHASES; ++p) fx::launch(a, p, p + 1, 0, stream);
#else
    nv::In in{}; for (int i = 0; i < 28; ++i) in.p[i] = (const float*)d_in[i]; in.pos = (const int*)d_in[2];
    float* errs = (float*)((char*)d_ws + 381 * fx::MiB);
    (void)hipMemsetAsync(errs, 0, 256, stream);
    const int nph = DBG_NPH >= 0 ? DBG_NPH : (DBG_LAYERS == 1 ? 10 : DBG_LAYERS == 2 ? 18 : DBG_LAYERS == 3 ? 27 : 35);
    for (int p = 0; p < nph; ++p) fx::launch(a, p, p + 1, 0, stream);
    float* nws = (float*)((char*)d_ws + fx::WS_NAIVE); float* nx = (float*)((char*)d_ws + fx::WS_NAIVE + 56 * fx::MiB);
    nv::forward(in, nx, nws, stream, DBG_LAYERS, DBG_B0, 1, DBG_STAGE == 8 ? 6 : DBG_STAGE);
    int nchk = 0;
    auto CMPR = [&](const void* f, int isb, long fld, const float* r, long rld, int nrows, int ncols, float fs) { hipLaunchKernelGGL(dbg::k_cmp, dim3(512), dim3(256), 0, stream, f, isb, fld, r, rld, nrows, ncols, fs, errs + 2 * nchk); ++nchk; };
    auto CMP = [&](const void* f, int isb, long fld, const float* r, long rld, int ncols, float fs) { CMPR(f, isb, fld, r, rld, 2048, ncols, fs); };
    const size_t r0 = (size_t)DBG_B0 * 2048;
    unsigned char* ws = (unsigned char*)d_ws;
    const size_t NMi = (size_t)(1u << 20) / 8;
    float* nU = nws + nv::R_U; float* nRA = nU + 29 * NMi; float* nRB = nRA + 12 * NMi; float* nRC = nRB + 16 * NMi; float* nRD = nRC + 12 * NMi; float* nH = nRD + 8 * NMi;
    (void)nRA; (void)nRB; (void)nRC; (void)nRD; (void)nH;
    const fx::bf16_t* fU = (const fx::bf16_t*)(ws + fx::WS_BIG + fx::BIG_U); const fx::bf16_t* fQL = (const fx::bf16_t*)(ws + fx::WS_BIG + fx::BIG_UP);
    const fx::bf16_t* fKVU = fQL + 768; const fx::bf16_t* fXN = (const fx::bf16_t*)(ws + fx::WS_XN); const fx::bf16_t* fYC = (const fx::bf16_t*)(ws + fx::WS_YC);
    (void)fU; (void)fQL; (void)fKVU; (void)fXN; (void)fYC;
#if DBG_STAGE == 0 || DBG_STAGE == 9
    CMP((const float*)d_out + r0 * 1024, 0, 1024, nx, 1024, 1024, 1.f);
#elif DBG_STAGE == 1
    if ((DBG_LAYERS & 1) == 1) { CMP(fU + r0 * 2048, 1, 2048, nU, 1848, 544, 1.f); CMP(fU + r0 * 2048 + 1056, 1, 2048, nU + 1056, 1848, 256, 1.f); CMP(fU + r0 * 2048 + 1824, 1, 2048, nU + 1824, 1848, 24, 1.f); }
    else { CMP(fU + r0 * 3072 + 2048, 1, 3072, nU + 2048, 3072, 1024, 1.f); }
#elif DBG_STAGE == 2
    if ((DBG_LAYERS & 1) == 1) { CMP(fQL + r0 * 1792, 1, 1792, nRC, 768, 768, 1.f / (0.10206207261596577f * 1.4426950408889634f)); CMP(fXN + r0 * 768, 1, 768, nRA, 768, 768, 1.f); }
    else { CMP(fU + r0 * 3072, 1, 3072, nU, 3072, 1024, 1.f / (0.125f * 1.4426950408889634f)); CMP(fU + r0 * 3072 + 1024, 1, 3072, nU + 1024, 3072, 1024, 1.f); }
#elif DBG_STAGE == 3
    CMP(fU + r0 * 2048, 1, 2048, nU, 1848, 544, 1.f); CMP(fU + r0 * 2048 + 1056, 1, 2048, nU + 1056, 1848, 256, 1.f); CMP(fU + r0 * 2048 + 1824, 1, 2048, nU + 1824, 1848, 24, 1.f);
    CMP(fQL + r0 * 1792, 1, 1792, nRC, 768, 768, 1.f / (0.10206207261596577f * 1.4426950408889634f)); CMP(fXN + r0 * 768, 1, 768, nRA, 768, 768, 1.f);
    CMP(fYC + r0 * 1024, 1, 1024, nH, 1024, 512, 1.f);
#elif DBG_STAGE == 4
    if ((DBG_LAYERS & 1) == 1) { CMP(fU + r0 * 2048 + 544, 1, 2048, nRD, 512, 512, 1.f / (0.125f * 1.4426950408889634f)); }
    else { CMP(fYC + r0 * 1024, 1, 1024, nU, 1024, 1024, 1.f); }
#elif DBG_STAGE == 6
    { const float* nSM = nws + nv::R_SMALL; const fx::bf16_t* fKC = (const fx::bf16_t*)(ws + fx::WS_MISC + 65536) + (size_t)DBG_B0 * 2 * 128 * 64; const fx::bf16_t* fVC = fKC + 16 * 128 * 64;
      CMP(fU + r0 * 2048 + 544, 1, 2048, nRD, 512, 512, 1.f / (0.125f * 1.4426950408889634f));
      CMPR(fKC, 1, 64, nSM, 64, 127, 64, 1.f); CMPR(fKC + 128 * 64, 1, 64, nSM + 128 * 64, 64, 127, 64, 1.f);
      CMPR(fVC, 1, 64, nSM + 16 * 128 * 64, 64, 127, 64, 1.f); CMPR(fVC + 128 * 64, 1, 64, nSM + 17 * 128 * 64, 64, 127, 64, 1.f);
      CMP(fU + r0 * 2048 + 1312, 1, 2048, nRA, 128, 128, 1.f); CMP(fU + r0 * 2048 + 1568, 1, 2048, nRA + 2 * NMi, 128, 128, 1.f); }
#elif DBG_STAGE == 8
    { const float* nb_ = NSA_ONLY == 0 ? nRC : NSA_ONLY == 1 ? nRA + 4 * NMi : nRB; CMP(fYC + r0 * 1024 + 512, 1, 1024, nb_, 512, 512, 1.f); }
#elif DBG_STAGE == 7
    CMP(fYC + r0 * 1024, 1, 1024, nH, 1024, 512, 1.f); CMP(fYC + r0 * 1024 + 512, 1, 1024, nH + 512, 1024, 512, 1.f);
#endif
    nv::forward(in, (float*)d_out, (float*)d_ws, stream, 4, 0, 8, 0);
    hipLaunchKernelGGL(dbg::k_finish, dim3(1024), dim3(256), 0, stream, (float*)d_out, errs, nchk, (long)16384 * 1024);
#endif
}
```

```cpp
#define FX_MODE 0

#include <hip/hip_runtime.h>
#include <hip/hip_bf16.h>
#include <cstdio>
#include <cstdint>
#include <cmath>
#include <hip/hip_cooperative_groups.h>
namespace pg8 {
#define PG8_LAS __attribute__((address_space(3)))
typedef unsigned short bf16_t;
typedef short bf16x8 __attribute__((ext_vector_type(8)));
typedef float f32x4 __attribute__((ext_vector_type(4)));
typedef unsigned u32x4 __attribute__((ext_vector_type(4)));
constexpr int BM = 256, BK = 64, HALF = 128, HTB = HALF * BK * 2  , STAGE_BYTES = 8 * HTB, NXCD = 8, WGM = 8;

__host__ __device__ __forceinline__ int lds_byte(int r, int c) { const int st = (r >> 4) * 2 + (c >> 5), rr = r & 15, cc = c & 31, ob = rr * 64 + cc * 2; return st * 1024 + (ob ^ (((ob >> 9) & 1) << 5)); }
__host__ __device__ __forceinline__ void stage_rc(int b, int& R, int& C) { const int st = b / 1024, sb = b % 1024, swz = sb ^ (((sb >> 9) & 1) << 5); R = (st >> 1) * 16 + swz / 64; C = (st & 1) * 32 + (swz % 64) / 2; }
__host__ __device__ __forceinline__ int perm32(int rho) { const int n = rho >> 4, i = rho & 15; return 8 * (i >> 2) + 4 * n + (i & 3); }

struct Unit { int pm, pn; int aoff; };
struct Gemm { const bf16_t* A; const bf16_t* Bt; int M, N, K, lda; };

struct StaticOrder {
    int nM, nN, nwg, G, c;
    __host__ __device__ void init(int M, int N, int G_, int c_) { nM = M / BM; nN = N / BM; nwg = nM * nN; G = G_; c = c_; }
    __host__ __device__ bool next(int i, Unit& u) const {
        const long L = (long)i * G + c; if (L >= nwg) return false;
        int wgid = (int)L; { const int q = nwg / NXCD, r = nwg % NXCD, xcd = wgid % NXCD, off = wgid / NXCD; wgid = (xcd < r ? xcd * (q + 1) : r * (q + 1) + (xcd - r) * q) + off; }
        const int nig = WGM * nN, gid = wgid / nig, fm = gid * WGM, gsz = (nM - fm) < WGM ? (nM - fm) : WGM;
        u.pm = fm + ((wgid % nig) % gsz); u.pn = (wgid % nig) / gsz; u.aoff = 0; return true;
    }
    __device__ __forceinline__ void a_ready(const Unit&) const {}
    __device__ __forceinline__ void done(const Unit&) const {}
};

__device__ __forceinline__ unsigned cvt_pk_bf16(float lo, float hi) { unsigned r; asm volatile("v_cvt_pk_bf16_f32 %0, %1, %2" : "=v"(r) : "v"(lo), "v"(hi)); return r; }
typedef float f32x2 __attribute__((ext_vector_type(2)));
__device__ __forceinline__ f32x2 gelu_pk(f32x2 v) {
    const f32x2 av = __builtin_elementwise_abs(v), d = av * 0.2316418882f + 1.0f;
    f32x2 t; t.x = __builtin_amdgcn_rcpf(d.x); t.y = __builtin_amdgcn_rcpf(d.y);
    f32x2 q = t * 0.5307027145f + (-0.7265760135f); q = q * t + 0.7107068705f; q = q * t + (-0.142248368f); q = q * t + 0.127414796f; q = q * t;
    const f32x2 s = (v * v) * (-0.72134752044f);
    f32x2 e; e.x = __builtin_amdgcn_exp2f(s.x); e.y = __builtin_amdgcn_exp2f(s.y);
    const f32x2 m = v * (q * e), r = v - m;
    f32x2 o; o.x = v.x < 0.f ? m.x : r.x; o.y = v.y < 0.f ? m.y : r.y; return o;
}

template <int ACT  > struct EpiBf16 {
    static constexpr bool PERM = true, AFTER_DRAIN = false; static_assert(ACT == 0 || ACT == 1, "EpiBf16: ACT is 0 (none) or 1 (gelu_pk)");
    bf16_t* O; int ldc; const float* bias; int split_cols; size_t split_stride; float scale0;
    __device__ __forceinline__ void operator()(const f32x4 (&acc)[2][2][4][2], const Unit& u, int wr, int wc, int fr, int fq) const {
        const int row0 = u.pm * BM + wr * 64 + fr; int colt = u.pn * BM; bf16_t* base = O;
        float sc = 1.f; if (split_cols) { const int t = colt / split_cols; base += (size_t)t * split_stride; colt -= t * split_cols; if (t == 0) sc = scale0; }
        const int col0 = colt + wc * 32 + 8 * fq, bcol0 = u.pn * BM + wc * 32 + 8 * fq;
        f32x4 bv[2][2];
#pragma unroll
        for (int bj = 0; bj < 2; ++bj)
#pragma unroll
            for (int n = 0; n < 2; ++n) bv[bj][n] = bias ? *(const f32x4*)(bias + bcol0 + bj * HALF + 4 * n) : (f32x4){0.f, 0.f, 0.f, 0.f};
#pragma unroll
        for (int ai = 0; ai < 2; ++ai)
#pragma unroll
            for (int m = 0; m < 4; ++m) { bf16_t* rowp = base + (size_t)(row0 + ai * HALF + m * 16) * ldc + col0;
#pragma unroll
                for (int bj = 0; bj < 2; ++bj) { f32x4 v0 = acc[ai][bj][m][0] + bv[bj][0], v1 = acc[ai][bj][m][1] + bv[bj][1];
                    if (ACT == 1) { f32x2 a = gelu_pk((f32x2){v0[0], v0[1]}), b = gelu_pk((f32x2){v0[2], v0[3]}), c = gelu_pk((f32x2){v1[0], v1[1]}), d = gelu_pk((f32x2){v1[2], v1[3]});
                        v0 = (f32x4){a.x, a.y, b.x, b.y}; v1 = (f32x4){c.x, c.y, d.x, d.y}; }
                    v0 = v0 * sc; v1 = v1 * sc; u32x4 w; w.x = cvt_pk_bf16(v0[0], v0[1]); w.y = cvt_pk_bf16(v0[2], v0[3]); w.z = cvt_pk_bf16(v1[0], v1[1]); w.w = cvt_pk_bf16(v1[2], v1[3]);
                    *(u32x4*)(rowp + bj * HALF) = w; } }
    }
};

template <class Epi, class Sched, bool ALIGN_EPI = false, bool SP2 = false>
__device__ __forceinline__ void gemm_phase(PG8_LAS unsigned char* lds, const Gemm g, const Sched& S, const Epi& E) {
    int tid_ = threadIdx.x; asm volatile("" : "+v"(tid_)); const int tid = tid_, wid = __builtin_amdgcn_readfirstlane(tid >> 6), lane = tid & 63, wr = wid >> 2, wc = wid & 3, fr = lane & 15, fq = lane >> 4;
    const int K = g.K, nt = K / BK;
    unsigned voffA[2], voffB[2];
#pragma unroll
    for (int i = 0; i < 2; ++i) { int R, C; stage_rc(tid * 16 + i * 8192, R, C); const int Rb = Epi::PERM ? ((R & ~31) + perm32(R & 31)) : R;
        voffA[i] = (unsigned)(R * g.lda + C) * 2u; voffB[i] = (unsigned)(Rb * K + C) * 2u; }
    const size_t kstep = (size_t)(BK * 2);
    const size_t hstep = (size_t)HALF * K * 2;
    const size_t hstepA = (size_t)HALF * g.lda * 2, tstepA = 2 * hstepA;
    const size_t tstep = 2 * hstep;
    const unsigned ldsw = (unsigned)wid * 1024u;
    const int aoff = lds_byte(wr * 64 + fr, fq * 8), boff = lds_byte(wc * 32 + fr, fq * 8);
#define PG8_SA(b, h) (((b) * 2 + (h)) * HTB)
#define PG8_SB(b, h) ((4 + (b) * 2 + (h)) * HTB)
#define PG8_STAGE(bufoff, gbase, voff) do { _Pragma("unroll") for (int _i = 0; _i < 2; ++_i) \
        __builtin_amdgcn_global_load_lds((const unsigned*)((const char*)(gbase) + (voff)[_i]), (PG8_LAS unsigned*)(lds + (bufoff) + ldsw + _i * 8192), 16, 0, 0); } while (0)
#define PG8_LDA(dst, b, h) do { _Pragma("unroll") for (int m = 0; m < 4; ++m) _Pragma("unroll") for (int k = 0; k < 2; ++k) dst[m][k] = *(const PG8_LAS bf16x8*)(lds + PG8_SA(b, h) + aoff + m * 2048 + k * 1024); } while (0)
#define PG8_LDB(dst, b, h) do { _Pragma("unroll") for (int n = 0; n < 2; ++n) _Pragma("unroll") for (int k = 0; k < 2; ++k) dst[n][k] = *(const PG8_LAS bf16x8*)(lds + PG8_SB(b, h) + boff + n * 2048 + k * 1024); } while (0)
#define PG8_MMA(ai, bj, At, Bt) do { __builtin_amdgcn_s_setprio(1); _Pragma("unroll") for (int m = 0; m < 4; ++m) _Pragma("unroll") for (int n = 0; n < 2; ++n) _Pragma("unroll") for (int k = 0; k < 2; ++k) \
        acc[ai][bj][m][n] = __builtin_amdgcn_mfma_f32_16x16x32_bf16(Bt[n][k], At[m][k], acc[ai][bj][m][n], 0, 0, 0); __builtin_amdgcn_s_setprio(0); } while (0)
#define PG8_WAIT_V(n) asm volatile("s_waitcnt vmcnt(" #n ")" ::: "memory")
#define PG8_WAIT_L(n) asm volatile("s_waitcnt lgkmcnt(" #n ")" ::: "memory")
#define PG8_BAR __builtin_amdgcn_s_barrier()
#define PG8_SCHED __builtin_amdgcn_sched_barrier(0)
    Unit cur, nxt; int ui = 0;
    if (!S.next(0, cur)) return;
    f32x4 acc[2][2][4][2];
#pragma unroll
    for (int a = 0; a < 2; ++a)
#pragma unroll
        for (int b = 0; b < 2; ++b)
#pragma unroll
            for (int m = 0; m < 4; ++m)
#pragma unroll
                for (int n = 0; n < 2; ++n) acc[a][b][m][n] = (f32x4){0.f, 0.f, 0.f, 0.f};
    bf16x8 At[4][2], B0[2][2], B1[2][2];
    const char* cA = (const char*)g.A + (size_t)cur.pm * tstepA + (size_t)cur.aoff * 2; const char* cB = (const char*)g.Bt + (size_t)cur.pn * tstep;
    S.a_ready(cur);
    if constexpr (SP2) {
        PG8_STAGE(PG8_SB(0, 0), cB, voffB); PG8_STAGE(PG8_SB(0, 1), cB + hstep, voffB); PG8_STAGE(PG8_SA(0, 0), cA, voffA); PG8_STAGE(PG8_SA(0, 1), cA + hstepA, voffA);
        if (wr == 1) PG8_BAR;
        PG8_WAIT_V(2); PG8_BAR;
        PG8_STAGE(PG8_SB(1, 0), cB + kstep, voffB); PG8_STAGE(PG8_SA(1, 0), cA + kstep, voffA); PG8_STAGE(PG8_SB(1, 1), cB + hstep + kstep, voffB);
        PG8_WAIT_V(6); PG8_BAR;
    } else {
        PG8_STAGE(PG8_SB(0, 0), cB, voffB); PG8_STAGE(PG8_SA(0, 0), cA, voffA); PG8_STAGE(PG8_SB(0, 1), cB + hstep, voffB); PG8_STAGE(PG8_SA(0, 1), cA + hstepA, voffA);
        if (wr == 1) PG8_BAR;
        PG8_WAIT_V(4); PG8_BAR;
        PG8_STAGE(PG8_SB(1, 0), cB + kstep, voffB); PG8_STAGE(PG8_SA(1, 0), cA + kstep, voffA); PG8_STAGE(PG8_SB(1, 1), cB + hstep + kstep, voffB);
        PG8_WAIT_V(6); PG8_BAR;
    }
    for (;;) {
        const bool has_next = S.next(ui + 1, nxt);
        const char* nA = has_next ? (const char*)g.A + (size_t)nxt.pm * tstepA + (size_t)nxt.aoff * 2 : cA; const char* nB = has_next ? (const char*)g.Bt + (size_t)nxt.pn * tstep : cB;
        for (int t = 0; t < nt; t += 2) {
            const bool last = (t == nt - 2);
            const char* a1 = cA + (size_t)(t + 1) * kstep;
            const char* a2 = last ? nA : cA + (size_t)(t + 2) * kstep; const char* b2 = last ? nB : cB + (size_t)(t + 2) * kstep;
            const char* a3 = a2 + kstep; const char* b3 = b2 + kstep;
            if (last && has_next) S.a_ready(nxt);
            if constexpr (SP2) {
            PG8_LDB(B0, 0, 0); PG8_LDB(B1, 0, 1); PG8_SCHED; PG8_LDA(At, 0, 0); PG8_STAGE(PG8_SA(1, 1), a1 + hstepA, voffA);
            PG8_WAIT_V(8); PG8_WAIT_L(0); PG8_BAR; PG8_MMA(0, 0, At, B0); PG8_MMA(0, 1, At, B1); PG8_BAR; PG8_SCHED;
            PG8_LDA(At, 0, 1); PG8_STAGE(PG8_SB(0, 0), b2, voffB); PG8_STAGE(PG8_SB(0, 1), b2 + hstep, voffB); PG8_STAGE(PG8_SA(0, 0), a2, voffA);
            PG8_WAIT_V(8); PG8_WAIT_L(0); PG8_BAR; PG8_MMA(1, 0, At, B0); PG8_MMA(1, 1, At, B1); PG8_BAR; PG8_SCHED;
            PG8_LDB(B0, 1, 0); PG8_LDB(B1, 1, 1); PG8_SCHED; PG8_LDA(At, 1, 0); PG8_STAGE(PG8_SA(0, 1), a2 + hstepA, voffA);
            PG8_WAIT_V(8); PG8_WAIT_L(0); PG8_BAR; PG8_MMA(0, 0, At, B0); PG8_MMA(0, 1, At, B1); PG8_BAR; PG8_SCHED;
            PG8_LDA(At, 1, 1); PG8_STAGE(PG8_SB(1, 0), b3, voffB); PG8_STAGE(PG8_SB(1, 1), b3 + hstep, voffB); PG8_STAGE(PG8_SA(1, 0), a3, voffA);
            PG8_WAIT_V(8); PG8_WAIT_L(0); PG8_BAR; PG8_MMA(1, 0, At, B0); PG8_MMA(1, 1, At, B1); PG8_BAR; PG8_SCHED;
            } else {
            PG8_LDB(B0, 0, 0); PG8_SCHED; PG8_LDA(At, 0, 0); PG8_STAGE(PG8_SA(1, 1), a1 + hstepA, voffA);
            PG8_WAIT_L(8); PG8_BAR; PG8_WAIT_L(0); PG8_MMA(0, 0, At, B0); PG8_BAR; PG8_SCHED;
            PG8_LDB(B1, 0, 1); PG8_STAGE(PG8_SB(0, 0), b2, voffB);
            PG8_BAR; PG8_WAIT_L(0); PG8_MMA(0, 1, At, B1); PG8_BAR;
            PG8_LDA(At, 0, 1); PG8_STAGE(PG8_SA(0, 0), a2, voffA);
            PG8_BAR; PG8_WAIT_L(0); PG8_MMA(1, 0, At, B0); PG8_BAR; PG8_SCHED;
            PG8_STAGE(PG8_SB(0, 1), b2 + hstep, voffB);
            PG8_WAIT_V(6); PG8_BAR; PG8_MMA(1, 1, At, B1); PG8_BAR;
            PG8_LDB(B0, 1, 0); PG8_SCHED; PG8_LDA(At, 1, 0); PG8_STAGE(PG8_SA(0, 1), a2 + hstepA, voffA);
            PG8_WAIT_L(8); PG8_BAR; PG8_WAIT_L(0); PG8_MMA(0, 0, At, B0); PG8_BAR; PG8_SCHED;
            PG8_LDB(B1, 1, 1); PG8_STAGE(PG8_SB(1, 0), b3, voffB);
            PG8_BAR; PG8_WAIT_L(0); PG8_MMA(0, 1, At, B1); PG8_BAR;
            PG8_LDA(At, 1, 1); PG8_STAGE(PG8_SA(1, 0), a3, voffA);
            PG8_BAR; PG8_WAIT_L(0); PG8_MMA(1, 0, At, B0); PG8_BAR; PG8_SCHED;
            PG8_STAGE(PG8_SB(1, 1), b3 + hstep, voffB);
            PG8_WAIT_V(6); PG8_BAR; PG8_MMA(1, 1, At, B1); PG8_BAR;
            }
        }
        if constexpr (ALIGN_EPI) { if (wr == 0) PG8_BAR; }
        if constexpr (!Epi::AFTER_DRAIN) { E(acc, cur, wr, wc, fr, fq); S.done(cur); }
        if (!has_next) break;
#pragma unroll
        for (int a = 0; a < 2; ++a)
#pragma unroll
            for (int b = 0; b < 2; ++b)
#pragma unroll
                for (int m = 0; m < 4; ++m)
#pragma unroll
                    for (int n = 0; n < 2; ++n) acc[a][b][m][n] = (f32x4){0.f, 0.f, 0.f, 0.f};
        cur = nxt; cA = nA; cB = nB; ++ui;
        if constexpr (ALIGN_EPI) { if (wr == 1) PG8_BAR; }
    }
    PG8_WAIT_V(0);
    if constexpr (!ALIGN_EPI) { if (wr == 0) PG8_BAR; }
    PG8_BAR;
    if constexpr (Epi::AFTER_DRAIN) { E.fused(acc, cur, wr, wc, fr, fq, lds, wid, lane); S.done(cur); }
#undef PG8_SA
#undef PG8_SB
#undef PG8_STAGE
#undef PG8_LDA
#undef PG8_LDB
#undef PG8_MMA
#undef PG8_WAIT_V
#undef PG8_WAIT_L
#undef PG8_BAR
#undef PG8_SCHED
}
}
namespace fx {
#define DI __device__ __forceinline__
#define LAS __attribute__((address_space(3)))
typedef unsigned short bf16_t;
typedef short bf16x8 __attribute__((ext_vector_type(8)));
typedef short s16x4 __attribute__((ext_vector_type(4)));
typedef float f32x4 __attribute__((ext_vector_type(4)));
typedef float f32x16 __attribute__((ext_vector_type(16)));
typedef unsigned u32x4 __attribute__((ext_vector_type(4)));
typedef unsigned u32x2 __attribute__((ext_vector_type(2)));
constexpr int B = 8, S = 2048, D = 1024, T = B * S, FF = 4096, HYIN = 1848, UW = 2048;
constexpr float EPS = 1e-6f, LOG2E = 1.4426950408889634f;
constexpr int NW = 8, NT = 512;
constexpr size_t MiB = 1u << 20;
constexpr size_t WS_CTL = 0;
constexpr size_t WS_MOD = 1 * MiB;
constexpr size_t WS_CS8 = 2 * MiB;
constexpr size_t WS_CS16 = 3 * MiB;
constexpr size_t WS_MISC = 5 * MiB;
constexpr size_t WS_W = 6 * MiB;
constexpr size_t W_EVEN = 9 * MiB, W_ODD = 8 * MiB, W_MLP = 16 * MiB;
constexpr size_t WE_IN = 0, WE_OUT = 4 * MiB, WE_UP = 6 * MiB, WE_C1 = 7 * MiB, WE_C2 = 8 * MiB;
constexpr size_t WO_QKV = 0, WO_O = 6 * MiB;
constexpr size_t WS_WEVEN = WS_W, WS_WODD = WS_W + 2 * W_EVEN, WS_WMLP = WS_WODD + 2 * W_ODD;
constexpr size_t WS_XN = 104 * MiB;
constexpr size_t WS_YC = 136 * MiB;
constexpr size_t WS_BIG = 168 * MiB;
constexpr size_t BIG_U = 0, BIG_UP = 64 * MiB + 64 * 1024;
constexpr int UPW = 1792;
constexpr size_t WS_FAST_END = 296 * MiB;
constexpr size_t WS_SS = 128 * 1024;
constexpr size_t WS_SHW = 296 * MiB;
constexpr size_t WS_NAIVE = 300 * MiB;
constexpr int LDS_MISC = 131072, LDS_BYTES = 147456;

DI unsigned f2bf(float f) { unsigned u = __builtin_bit_cast(unsigned, f); return (u + 0x7fffu + ((u >> 16) & 1u)) >> 16; }
DI unsigned pk2(float lo, float hi) { return f2bf(lo) | (f2bf(hi) << 16); }
DI float bf2f(unsigned short b) { return __builtin_bit_cast(float, (unsigned)b << 16); }
DI float bflo(unsigned u) { return __builtin_bit_cast(float, u << 16); }
DI float bfhi(unsigned u) { return __builtin_bit_cast(float, u & 0xffff0000u); }
template <int O> DI float swz(float v) { static_assert(O < 32, "swz: xor mask < 32"); return __builtin_bit_cast(float, __builtin_amdgcn_ds_swizzle(__builtin_bit_cast(int, v), (O << 10) | 0x1f)); }
template <int O> DI unsigned swzu(unsigned v) { return (unsigned)__builtin_amdgcn_ds_swizzle((int)v, (O << 10) | 0x1f); }
DI void xchg32(unsigned& a, unsigned& b) { asm volatile("s_nop 1\n\tv_permlane32_swap_b32 %0, %1\n\ts_nop 1" : "+v"(a), "+v"(b)); }
DI float sum32(float v) { unsigned a = __builtin_bit_cast(unsigned, v), b = a; xchg32(a, b); return __builtin_bit_cast(float, a) + __builtin_bit_cast(float, b); }
DI float max32(float v) { unsigned a = __builtin_bit_cast(unsigned, v), b = a; xchg32(a, b); return fmaxf(__builtin_bit_cast(float, a), __builtin_bit_cast(float, b)); }
DI unsigned or32(unsigned v) { unsigned a = v, b = v; xchg32(a, b); return a | b; }
#ifdef DBG_SHFL
DI float wave_sum(float v) { for (int o = 1; o < 64; o <<= 1) v += __shfl_xor(v, o); return v; }
#else
DI float wave_sum(float v) { v += swz<1>(v); v += swz<2>(v); v += swz<4>(v); v += swz<8>(v); v += swz<16>(v); return sum32(v); }
#endif

struct Args { const float* in[28]; const int* pos; float* out; unsigned char* ws; int ph_lo, ph_hi; int use_cg; int pad; };
typedef const __attribute__((address_space(4))) Args CArgs;
#define XB_TMO      128
#define XB_XCNT(j)  (256  + 64 * (j))
#define XB_XSUB(j)  (1280 + 64 * (j))
#define XB_XGEN(j)  (2304 + 64 * (j))
#define XB_TOP      3328
#define XB_TOPGEN   3392
#define XCD_BAR_WORDS 3456
#define XB_SPIN_CAP (1u << 20)
DI unsigned xb_ld(unsigned* p)              { return __hip_atomic_load(p, __ATOMIC_RELAXED, __HIP_MEMORY_SCOPE_AGENT); }
DI unsigned xb_add(unsigned* p, unsigned v) { return __hip_atomic_fetch_add(p, v, __ATOMIC_RELAXED, __HIP_MEMORY_SCOPE_AGENT); }
DI unsigned xb_xcc_id() { return (unsigned)__builtin_amdgcn_s_getreg((3 << 11) | 20) & 0xFu; }
#define XB_SPIN(cond, bar) do { unsigned _sp = 0; while (cond) { __builtin_amdgcn_s_sleep(1); \
    if ((++_sp & 255u) == 0u) { if (xb_ld(&(bar)[XB_TMO])) break; if (_sp > XB_SPIN_CAP) { atomicAdd(&(bar)[XB_TMO], 1u); break; } } } } while (0)
struct XcdBarrier { unsigned* bar; unsigned x; volatile LAS unsigned* st; };
DI XcdBarrier xcd_barrier_post(unsigned* bar, volatile LAS unsigned* st) {
    XcdBarrier b; b.bar = bar; b.x = xb_xcc_id(); b.st = st;
    if (threadIdx.x == 0) (void)xb_add(&bar[XB_XCNT(b.x)], 1u);
    return b;
}
DI void xcd_barrier_complete(unsigned* bar, unsigned x, unsigned& nloc, unsigned& nx) {
    const unsigned G = gridDim.x * gridDim.y * gridDim.z;
    unsigned sum, cnt, mine, sp = 0u;
    for (;;) {
        sum = 0u; cnt = 0u; mine = 0u;
#pragma unroll
        for (unsigned j = 0; j < 16; ++j) { const unsigned c = xb_ld(&bar[XB_XCNT(j)]); sum += c; cnt += (c > 0u) ? 1u : 0u; mine = (j == x) ? c : mine; }
        if (sum == G) break;
        __builtin_amdgcn_s_sleep(1);
        if ((++sp & 255u) == 0u) { if (xb_ld(&bar[XB_TMO])) break; if (sp > XB_SPIN_CAP) { atomicAdd(&bar[XB_TMO], 1u); break; } }
    }
    nloc = mine > 0u ? mine : 1u; nx = cnt > 0u ? cnt : 1u;
}
DI void xcd_barrier(const XcdBarrier& b) {
    asm volatile("s_waitcnt vmcnt(0)" ::: "memory");
    __syncthreads();
    int t0_ = threadIdx.x; asm volatile("" : "+v"(t0_));
    if (t0_ == 0) {
        unsigned* bar; { CArgs* p_ = (CArgs*)__builtin_amdgcn_kernarg_segment_ptr(); asm volatile("" : "+s"(p_)); bar = (unsigned*)(p_->ws + WS_CTL) + 4096; }
        __builtin_amdgcn_s_waitcnt(0);
        unsigned nloc = b.st[0], nx = b.st[1];
        unsigned bx = b.x; asm volatile("" : "+s"(bx));
        if (nloc == 0u) { xcd_barrier_complete(bar, bx, nloc, nx); b.st[0] = nloc; b.st[1] = nx; }
        const unsigned old = xb_add(&bar[XB_XSUB(bx)], 1u);
        const unsigned gen = old / nloc;
        if (old + 1u == (gen + 1u) * nloc) {
            __builtin_amdgcn_fence(__ATOMIC_RELEASE, "agent");
            asm volatile("s_waitcnt vmcnt(0)" ::: "memory");
            const unsigned og = xb_add(&bar[XB_TOP], 1u);
            const unsigned tg = og / nx;
            if (og + 1u == (tg + 1u) * nx) xb_add(&bar[XB_TOPGEN], 1u);
            else XB_SPIN(xb_ld(&bar[XB_TOPGEN]) == tg, bar);
            __builtin_amdgcn_fence(__ATOMIC_ACQUIRE, "agent");
            xb_add(&bar[XB_XGEN(bx)], 1u);
            asm volatile("s_waitcnt vmcnt(0)" ::: "memory");
        } else {
            XB_SPIN(xb_ld(&bar[XB_XGEN(bx)]) == gen, bar);
            __builtin_amdgcn_fence(__ATOMIC_ACQUIRE, "agent");
            asm volatile("s_waitcnt vmcnt(0)" ::: "memory");
        }
    }
    __syncthreads();
}

struct Ctx {
    LAS unsigned char* lds; int tid, lane, wave, G, bid; unsigned char* ws; CArgs* a;
};
#define RELAUNDER(c) do { int t_ = threadIdx.x; asm volatile("" : "+v"(t_)); (c).tid = t_; (c).lane = t_ & 63; int b_ = blockIdx.x, g_ = gridDim.x; asm volatile("" : "+s"(b_), "+s"(g_)); (c).bid = b_; (c).G = g_; } while (0)

DI void transpose_item(const float* W, int ld, int K, int N, bf16_t* WT, const float* kscale, LAS float* scr, int item, int nblk, int lane) {
    const int kb = item / nblk, nb = item % nblk, k0 = 64 * kb, n0 = 32 * nb;
    const int n = n0 + (lane & 31);
    float tv[32];
#pragma unroll
    for (int i = 0; i < 32; ++i) { const int kk = 2 * i + (lane >> 5); tv[i] = (n < N) ? W[(size_t)(k0 + kk) * ld + n] : 0.f; }
#pragma unroll
    for (int i = 0; i < 32; ++i) { const int kk = 2 * i + (lane >> 5); float v = tv[i]; if (kscale) v *= kscale[k0 + kk]; scr[kk * 33 + (lane & 31)] = v; }
    asm volatile("s_waitcnt lgkmcnt(0)" ::: "memory");
    const int c = lane & 7;
#pragma unroll
    for (int j = 0; j < 4; ++j) { const int nn = (lane >> 3) + 8 * j; const LAS float* s = scr + (8 * c) * 33 + nn;
        u32x4 o; o.x = pk2(s[0 * 33], s[1 * 33]); o.y = pk2(s[2 * 33], s[3 * 33]); o.z = pk2(s[4 * 33], s[5 * 33]); o.w = pk2(s[6 * 33], s[7 * 33]);
        *(u32x4*)(WT + (size_t)(n0 + nn) * K + k0 + 8 * c) = o; }
    asm volatile("s_waitcnt lgkmcnt(0)" ::: "memory");
}
struct MatDesc { const float* src; int ld, K, N, Npad; bf16_t* dst; const float* kscale; };
DI MatDesc get_mat(CArgs& a, unsigned char* ws, int idx) {
    MatDesc m; m.kscale = nullptr;
    if (idx < 16) { const int j = idx >> 3, t = idx & 7; unsigned char* base = ws + WS_WEVEN + j * W_EVEN;
        if (t == 0) { m.src = a.in[9] + (size_t)j * D * HYIN; m.ld = HYIN; m.K = D; m.N = HYIN; m.Npad = UW; m.dst = (bf16_t*)(base + WE_IN); }
        else if (t == 1) { m.src = a.in[10] + (size_t)j * D * D; m.ld = D; m.K = D; m.N = D; m.Npad = D; m.dst = (bf16_t*)(base + WE_OUT); }
        else if (t == 2) { m.src = a.in[12] + (size_t)j * 256 * 768; m.ld = 768; m.K = 256; m.N = 768; m.Npad = 768; m.dst = (bf16_t*)(base + WE_UP); m.kscale = a.in[11] + j * 256; }
        else if (t == 3) { m.src = a.in[14] + (size_t)j * 256 * 1024; m.ld = 1024; m.K = 256; m.N = 1024; m.Npad = 1024; m.dst = (bf16_t*)(base + WE_UP) + 768 * 256; m.kscale = a.in[13] + j * 256; }
        else if (t < 6) { const int jj = t - 4; m.src = a.in[20] + ((size_t)j * 2 + jj) * 2048 * 128; m.ld = 128; m.K = 2048; m.N = 128; m.Npad = 128; m.dst = (bf16_t*)(base + WE_C1) + (size_t)jj * 128 * 2048; }
        else { const int jj = t - 6; m.src = a.in[21] + ((size_t)j * 2 + jj) * 128 * 64; m.ld = 64; m.K = 128; m.N = 64; m.Npad = 64; m.dst = (bf16_t*)(base + WE_C2) + (size_t)jj * 64 * 128; }
    } else if (idx < 20) { const int j = (idx - 16) >> 1, t = idx & 1; unsigned char* base = ws + WS_WODD + j * W_ODD;
        if (t == 0) { m.src = a.in[22] + (size_t)j * D * 3072; m.ld = 3072; m.K = D; m.N = 3072; m.Npad = 3072; m.dst = (bf16_t*)(base + WO_QKV); }
        else { m.src = a.in[23] + (size_t)j * D * D; m.ld = D; m.K = D; m.N = D; m.Npad = D; m.dst = (bf16_t*)(base + WO_O); }
    } else { const int i = (idx - 20) >> 1, t = idx & 1; unsigned char* base = ws + WS_WMLP + i * W_MLP;
        if (t == 0) { m.src = a.in[7] + (size_t)i * D * FF; m.ld = FF; m.K = D; m.N = FF; m.Npad = FF; m.dst = (bf16_t*)base; }
        else { m.src = a.in[8] + (size_t)i * FF * D; m.ld = D; m.K = FF; m.N = D; m.Npad = D; m.dst = (bf16_t*)(base + 8 * MiB); }
    }
    return m;
}
DI void phase_prologue(Ctx& c) {
    CArgs& a = *c.a; unsigned char* ws = c.ws;
    const int gw = c.bid * NW + c.wave, NGW = c.G * NW;
    LAS float* cond = (LAS float*)(c.lds + 98304);
    for (int i = c.tid; i < 8192; i += NT) { float v = a.in[1][i]; cond[i] = v / (1.f + __expf(-v)); }
    __syncthreads();
    float* mod = (float*)(ws + WS_MOD);
    LAS float* red = (LAS float*)c.lds;
    for (int it = c.bid; it < 384; it += c.G) {
        const int n = it * 64 + c.lane; const int li = n / 6144, nn = n % 6144;
        const float* w = a.in[3] + (size_t)li * D * 6144 + (size_t)(c.wave * 128) * 6144 + nn; float acc[8] = {0, 0, 0, 0, 0, 0, 0, 0};
#pragma unroll 32
        for (int k = 0; k < 128; ++k) { const float wv = w[(size_t)k * 6144];
#pragma unroll
            for (int b = 0; b < 8; ++b) acc[b] += cond[b * D + c.wave * 128 + k] * wv; }
#pragma unroll
        for (int b = 0; b < 8; ++b) red[(c.wave * 8 + b) * 64 + c.lane] = acc[b];
        __syncthreads();
        { const int b = c.wave; float s = 0.f;
#pragma unroll
          for (int ww = 0; ww < 8; ++ww) s += red[(ww * 8 + b) * 64 + c.lane];
          mod[((size_t)li * 8 + b) * 6144 + nn] = s + a.in[4][li * 6144 + nn]; }
        __syncthreads();
    }
    { float* bias1 = (float*)(ws + WS_MISC);
      for (int it = c.bid; it < 8; it += c.G) { const int jj2 = it >> 1, n = (it & 1) * 64 + c.lane;
          const float* cp = a.in[19] + (size_t)jj2 * 2048 + c.wave * 256; const float* w = a.in[20] + (size_t)jj2 * 2048 * 128 + (size_t)(c.wave * 256) * 128 + n; float acc = 0.f;
#pragma unroll 16
          for (int k = 0; k < 256; ++k) acc += cp[k] * w[(size_t)k * 128];
          red[c.wave * 64 + c.lane] = acc; __syncthreads();
          if (c.wave == 0) { float s = 0.f;
#pragma unroll
              for (int ww = 0; ww < 8; ++ww) s += red[ww * 64 + c.lane];
              bias1[jj2 * 128 + n] = s; }
          __syncthreads(); } }
    { f32x4* z = (f32x4*)(ws + WS_SS); for (int i = c.bid * NT + c.tid; i < 8 * T / 4; i += c.G * NT) z[i] = (f32x4){0.f, 0.f, 0.f, 0.f}; }
    LAS float* scr = (LAS float*)(c.lds + c.wave * 8704);
    int base = 0;
    for (int mi = 0; mi < 28; ++mi) {
        const MatDesc m = get_mat(a, ws, mi); const int nblk = m.Npad / 32, nit = (m.K / 64) * nblk;
        for (int it = (gw + NGW - (base % NGW)) % NGW; it < nit; it += NGW) transpose_item(m.src, m.ld, m.K, m.N, m.dst, m.kscale, scr, it, nblk, c.lane);
        base += nit;
    }
    { float* cs8 = (float*)(ws + WS_CS8); float* cs16 = (float*)(ws + WS_CS16);
      for (int g = c.bid * NT + c.tid; g < T * 24; g += c.G * NT) { const int m = g / 24, i = g % 24; const double p = (double)a.pos[m];
          if (i < 8) { const double f = pow(500000.0, -(double)i / 8.0), an = p * f; cs8[(m * 8 + i) * 2] = (float)cos(an); cs8[(m * 8 + i) * 2 + 1] = (float)sin(an); }
          else { const int k = i - 8; const double f = pow(500000.0, -(double)k / 16.0), an = p * f; cs16[(m * 16 + k) * 2] = (float)cos(an); cs16[(m * 16 + k) * 2 + 1] = (float)sin(an); } } }
}

DI void shw_items(Ctx& c) {
    CArgs& a = *c.a; unsigned char* ws = c.ws; const int gw = c.bid * NW + c.wave, NGW = c.G * NW;
    for (int it = gw; it < 384; it += NGW) {
        int g, r = it;
        if (r < 64) g = 1; else if ((r -= 64) < 48) g = 2; else if ((r -= 48) < 64) g = 3; else if ((r -= 64) < 32) g = 4; else if ((r -= 32) < 64) g = 5; else if ((r -= 64) < 48) g = 6; else { r -= 48; g = 7; }
        const int layer = g >> 1, sub = g & 1;
        const bf16_t* Wt = sub ? (const bf16_t*)(ws + WS_WMLP + (size_t)layer * W_MLP) : ((layer & 1) ? (const bf16_t*)(ws + WS_WODD + (size_t)(layer >> 1) * W_ODD + WO_QKV) : (const bf16_t*)(ws + WS_WEVEN + (size_t)(layer >> 1) * W_EVEN + WE_IN));
        const float* sh = (const float*)(ws + WS_MOD) + (size_t)layer * 8 * 6144 + (sub ? 3072 : 0);
        const int n = r * 64 + c.lane; const bf16_t* wr = Wt + (size_t)n * D;
        float acc[8] = {0, 0, 0, 0, 0, 0, 0, 0};
#pragma unroll 2
        for (int k = 0; k < D; k += 8) { const u32x4 wv = *(const u32x4*)(wr + k);
            const float w0 = bflo(wv.x), w1 = bfhi(wv.x), w2 = bflo(wv.y), w3 = bfhi(wv.y), w4 = bflo(wv.z), w5 = bfhi(wv.z), w6 = bflo(wv.w), w7 = bfhi(wv.w);
#pragma unroll
            for (int b = 0; b < 8; ++b) { const float* s8 = sh + b * 6144 + k;
                acc[b] += (s8[0] * w0 + s8[1] * w1) + (s8[2] * w2 + s8[3] * w3) + (s8[4] * w4 + s8[5] * w5) + (s8[6] * w6 + s8[7] * w7); } }
        float* o = (float*)(ws + WS_SHW) + (size_t)g * 8 * 4096 + n;
#pragma unroll
        for (int b = 0; b < 8; ++b) o[b * 4096] = acc[b];
    }
}
DI void phase_modnorm(Ctx& c, const float* x, const float* gain, const float* sh, const float* sc, bf16_t* XN) {
    const int gw = c.bid * NW + c.wave, NGW = c.G * NW;
    for (int m = gw; m < T; m += NGW) {
        const int b = m >> 11; const f32x4* xr = (const f32x4*)(x + (size_t)m * D) + c.lane; f32x4 v[4]; float s = 0.f;
#pragma unroll
        for (int j = 0; j < 4; ++j) { v[j] = xr[64 * j]; s += (v[j].x * v[j].x + v[j].y * v[j].y) + (v[j].z * v[j].z + v[j].w * v[j].w); }
        const float rs = rsqrtf(wave_sum(s) * (1.f / D) + EPS);
#pragma unroll
        for (int j = 0; j < 4; ++j) { const int n = 4 * c.lane + 256 * j; const f32x4 g = *(const f32x4*)(gain + n), sv = *(const f32x4*)(sc + b * 6144 + n), hv = *(const f32x4*)(sh + b * 6144 + n);
            f32x4 y; y.x = v[j].x * rs * g.x * (1.f + sv.x) + hv.x; y.y = v[j].y * rs * g.y * (1.f + sv.y) + hv.y; y.z = v[j].z * rs * g.z * (1.f + sv.z) + hv.z; y.w = v[j].w * rs * g.w * (1.f + sv.w) + hv.w;
            u32x2 o; o.x = pk2(y.x, y.y); o.y = pk2(y.z, y.w); *(u32x2*)(XN + (size_t)m * D + n) = o; }
    }
}
constexpr int TB = 8;
constexpr int TBV = 4;
DI void head64_vec(bf16_t* const (&p)[TBV], bool act, const float* gain, const float* const (&tab)[TBV], float scale, int lane) {
    const int sub = lane & 7; float x[TBV][8], ss[TBV];
#pragma unroll
    for (int t = 0; t < TBV; ++t) { u32x4 v = (u32x4){0u, 0u, 0u, 0u}; if (act) v = *(const u32x4*)p[t];
        x[t][0] = bflo(v.x); x[t][1] = bfhi(v.x); x[t][2] = bflo(v.y); x[t][3] = bfhi(v.y); x[t][4] = bflo(v.z); x[t][5] = bfhi(v.z); x[t][6] = bflo(v.w); x[t][7] = bfhi(v.w); }
#pragma unroll
    for (int t = 0; t < TBV; ++t) { float s = 0.f;
#pragma unroll
        for (int e = 0; e < 8; ++e) s += x[t][e] * x[t][e];
        ss[t] = s; }
#pragma unroll
    for (int t = 0; t < TBV; ++t) ss[t] += swz<1>(ss[t]);
#pragma unroll
    for (int t = 0; t < TBV; ++t) ss[t] += swz<2>(ss[t]);
#pragma unroll
    for (int t = 0; t < TBV; ++t) ss[t] += swz<4>(ss[t]);
    const f32x4 ga = *(const f32x4*)(gain + 8 * sub), gb = *(const f32x4*)(gain + 8 * sub + 4);
    const float g[8] = {ga.x, ga.y, ga.z, ga.w, gb.x, gb.y, gb.z, gb.w};
#pragma unroll
    for (int t = 0; t < TBV; ++t) { const float rs = rsqrtf(ss[t] * (1.f / 64.f) + EPS);
        float y[8], o[8];
#pragma unroll
        for (int e = 0; e < 8; ++e) { y[e] = x[t][e] * rs * g[e]; o[e] = swz<1>(y[e]); }
        if (sub < 2) {
            const f32x4 t0 = *(const f32x4*)(tab[t]), t1 = *(const f32x4*)(tab[t] + 4), t2 = *(const f32x4*)(tab[t] + 8), t3 = *(const f32x4*)(tab[t] + 12);
            const float cs[8] = {t0.x, t0.z, t1.x, t1.z, t2.x, t2.z, t3.x, t3.z}, sn[8] = {t0.y, t0.w, t1.y, t1.w, t2.y, t2.w, t3.y, t3.w};
#pragma unroll
            for (int e = 0; e < 8; ++e) y[e] = sub == 0 ? y[e] * cs[e] - o[e] * sn[e] : o[e] * sn[e] + y[e] * cs[e];
        }
        u32x4 w; w.x = pk2(y[0] * scale, y[1] * scale); w.y = pk2(y[2] * scale, y[3] * scale); w.z = pk2(y[4] * scale, y[5] * scale); w.w = pk2(y[6] * scale, y[7] * scale);
        if (act) *(u32x4*)p[t] = w; }
}
DI void nsa_finalize_rows(Ctx& c, bf16_t* U, int m0, int mstride, int j) {
    CArgs& a = *c.a; const float* qg = a.in[17] + j * 64; const float* kg = a.in[18] + j * 192; const int lane = c.lane;
    bf16_t* p[TBV]; const float* tab[TBV];
#pragma unroll
    for (int t = 0; t < TBV; ++t) { const int m = m0 + t * mstride; p[t] = U + (size_t)m * UW + 544 + 8 * lane; tab[t] = (const float*)(c.ws + WS_CS8) + (size_t)m * 16; }
    head64_vec(p, true, qg, tab, 0.125f * LOG2E, lane);
#pragma unroll
    for (int t = 0; t < TBV; ++t) { const int m = m0 + t * mstride; p[t] = U + (size_t)m * UW + (lane < 16 ? 1312 + 8 * lane : 1568 + 8 * (lane & 15)); }
    head64_vec(p, lane < 32, lane < 16 ? kg + 64 : kg + 128, tab, 1.f, lane);
}
DI void diff_finalize_rows(Ctx& c, bf16_t* QKV, int m0, int mstride, int j) {
    CArgs& a = *c.a; const float* qg = a.in[24] + j * 64; const float* kg = a.in[25] + j * 64; const int lane = c.lane;
    bf16_t* p[TBV]; const float* tab[TBV];
#pragma unroll 1
    for (int ch = 0; ch < 4; ++ch) {
#pragma unroll
        for (int t = 0; t < TBV; ++t) { const int m = m0 + t * mstride; p[t] = QKV + (size_t)m * 3072 + 512 * ch + 8 * lane; tab[t] = (const float*)(c.ws + WS_CS8) + (size_t)m * 16; }
        head64_vec(p, true, ch < 2 ? qg : kg, tab, ch < 2 ? 0.125f * LOG2E : 1.f, lane);
    }
}
DI void mla_finalize_rows(Ctx& c, const bf16_t* U, bf16_t* QL, bf16_t* KVU, bf16_t* KF, int m0, int mstride, int j) {
    CArgs& a = *c.a; const int lane = c.lane;
    const float* qg = a.in[15] + j * 96; const float* kg = a.in[16] + j * 96;
    float rsq[TB], rskv[TB], kpe[TB], cs[TB], sn[TB]; int mrow[TB];
    const int i16 = lane & 15;
#pragma unroll
    for (int t = 0; t < TB; ++t) { const int m = m0 + t * mstride; mrow[t] = m; const bf16_t* urow = U + (size_t)m * UW;
        const u32x2 v = *(const u32x2*)(urow + 4 * lane); const float a0 = bflo(v.x), a1 = bfhi(v.x), a2 = bflo(v.y), a3 = bfhi(v.y); rsq[t] = (a0 * a0 + a1 * a1) + (a2 * a2 + a3 * a3);
        const u32x2 w = *(const u32x2*)(urow + 256 + 4 * lane); const float b0 = bflo(w.x), b1 = bfhi(w.x), b2 = bflo(w.y), b3 = bfhi(w.y); rskv[t] = (b0 * b0 + b1 * b1) + (b2 * b2 + b3 * b3);
        kpe[t] = lane < 32 ? bf2f(urow[512 + lane]) : 0.f;
        const float* tab = (const float*)(c.ws + WS_CS16) + (size_t)m * 32; cs[t] = tab[2 * i16]; sn[t] = tab[2 * i16 + 1]; }
#pragma unroll
    for (int t = 0; t < TB; ++t) { rsq[t] = rsqrtf(wave_sum(rsq[t]) * (1.f / 256.f) + EPS); rskv[t] = rsqrtf(wave_sum(rskv[t]) * (1.f / 256.f) + EPS); }
    const float qscale = 0.10206207261596577f * LOG2E;
    const float qg0 = qg[lane], qg1 = lane < 32 ? qg[64 + lane] : 0.f, kg0 = kg[lane], kg1 = lane < 32 ? kg[64 + lane] : 0.f;
#pragma unroll 1
    for (int h = 0; h < 8; ++h) {
        float x0[TB], x1[TB], r[TB];
#pragma unroll
        for (int t = 0; t < TB; ++t) { const bf16_t* q = QL + (size_t)mrow[t] * UPW + 96 * h; x0[t] = bf2f(q[lane]) * rsq[t]; x1[t] = lane < 32 ? bf2f(q[64 + lane]) * rsq[t] : 0.f; r[t] = x0[t] * x0[t] + x1[t] * x1[t]; }
#pragma unroll
        for (int t = 0; t < TB; ++t) r[t] = rsqrtf(wave_sum(r[t]) * (1.f / 96.f) + EPS);
#pragma unroll
        for (int t = 0; t < TB; ++t) { bf16_t* q = QL + (size_t)mrow[t] * UPW + 96 * h; float y0 = x0[t] * r[t] * qg0; const float y1 = x1[t] * r[t] * qg1; const float other = swz<16>(y0);
            if (lane < 32) y0 = lane < 16 ? y0 * cs[t] - other * sn[t] : other * sn[t] + y0 * cs[t];
            q[lane] = (bf16_t)f2bf(y0 * qscale); if (lane < 32) q[64 + lane] = (bf16_t)f2bf(y1 * qscale); }
#pragma unroll
        for (int t = 0; t < TB; ++t) { bf16_t* kn = KVU + (size_t)mrow[t] * UPW + 128 * h; x0[t] = lane < 32 ? kpe[t] : bf2f(kn[lane - 32]) * rskv[t]; x1[t] = lane < 32 ? bf2f(kn[32 + lane]) * rskv[t] : 0.f; r[t] = x0[t] * x0[t] + x1[t] * x1[t];
            bf16_t* v = kn + 64 + lane; *v = (bf16_t)f2bf(bf2f(*v) * rskv[t]); }
#pragma unroll
        for (int t = 0; t < TB; ++t) r[t] = rsqrtf(wave_sum(r[t]) * (1.f / 96.f) + EPS);
#pragma unroll
        for (int t = 0; t < TB; ++t) { float y0 = x0[t] * r[t] * kg0; const float y1 = x1[t] * r[t] * kg1; const float other = swz<16>(y0);
            if (lane < 32) y0 = lane < 16 ? y0 * cs[t] - other * sn[t] : other * sn[t] + y0 * cs[t];
            bf16_t* k = KF + (size_t)mrow[t] * 768 + 96 * h; k[lane] = (bf16_t)f2bf(y0); if (lane < 32) k[64 + lane] = (bf16_t)f2bf(y1); }
    }
}

DI float gelu_tanh(float x) { const float u = 0.7978845608028654f * (x + 0.044715f * x * x * x); const float e = __expf(2.f * u); const float t = 1.f - 2.f / (e + 1.f); return 0.5f * x * (1.f + t); }
DI void compress_item(Ctx& c, const bf16_t* U, int j, int it) {
    RELAUNDER(c);
    CArgs& a = *c.a; const int lane = c.lane, w = c.wave, tid = c.tid;
    const int jj = it >> 7, bg = (it >> 3) & 15, chunk = it & 7, b = bg >> 1, g = bg & 1, c0 = 16 * chunk;
    const bf16_t* W1t = (const bf16_t*)(c.ws + WS_WEVEN + j * W_EVEN + WE_C1) + (size_t)jj * 128 * 2048;
    const bf16_t* W2t = (const bf16_t*)(c.ws + WS_WEVEN + j * W_EVEN + WE_C2) + (size_t)jj * 64 * 128;
    const float* bias1 = (const float*)(c.ws + WS_MISC) + (j * 2 + jj) * 128;
    LAS float* part = (LAS float*)c.lds;
    LAS bf16_t* hid = (LAS bf16_t*)(c.lds + 65536);
    LAS float* outl = (LAS float*)(c.lds + 65536 + 8192);
    const int r16 = lane & 15, q4 = lane >> 4;
    f32x4 acc[8];
#pragma unroll
    for (int n = 0; n < 8; ++n) acc[n] = (f32x4){0.f, 0.f, 0.f, 0.f};
    const bf16_t* arow = U + ((size_t)b * S + 16 * (c0 + r16)) * UW + 1056 + jj * 128 + g * 64 + q4 * 8;
#pragma unroll 2
    for (int ks = 8 * w; ks < 8 * w + 8; ++ks) {
        const bf16x8 af = *(const bf16x8*)(arow + (size_t)(ks >> 1) * UW + (ks & 1) * 32);
#pragma unroll
        for (int n = 0; n < 8; ++n) { const bf16x8 bfr = *(const bf16x8*)(W1t + (size_t)(n * 16 + r16) * 2048 + 32 * ks + q4 * 8);
            acc[n] = __builtin_amdgcn_mfma_f32_16x16x32_bf16(af, bfr, acc[n], 0, 0, 0); }
    }
#pragma unroll
    for (int n = 0; n < 8; ++n)
#pragma unroll
        for (int i = 0; i < 4; ++i) part[(w * 16 + q4 * 4 + i) * 128 + n * 16 + r16] = acc[n][i];
    __syncthreads();
    { const int cc = tid >> 5, n0 = (tid & 31) * 4; float v[4];
#pragma unroll
      for (int e = 0; e < 4; ++e) { float s = 0.f;
#pragma unroll
          for (int ww = 0; ww < 8; ++ww) s += part[(ww * 16 + cc) * 128 + n0 + e];
          v[e] = gelu_tanh(s + bias1[n0 + e]); }
      u32x2 o; o.x = pk2(v[0], v[1]); o.y = pk2(v[2], v[3]); *(LAS u32x2*)(hid + cc * 136 + n0) = o; }
    __syncthreads();
    if (w < 4) {
        f32x4 a2 = (f32x4){0.f, 0.f, 0.f, 0.f};
#pragma unroll
        for (int kst = 0; kst < 4; ++kst) { const bf16x8 af = *(const LAS bf16x8*)(hid + r16 * 136 + 32 * kst + q4 * 8);
            const bf16x8 bfr = *(const bf16x8*)(W2t + (size_t)(w * 16 + r16) * 128 + 32 * kst + q4 * 8);
            a2 = __builtin_amdgcn_mfma_f32_16x16x32_bf16(af, bfr, a2, 0, 0, 0); }
#pragma unroll
        for (int i = 0; i < 4; ++i) outl[(q4 * 4 + i) * 64 + w * 16 + r16] = a2[i];
    }
    __syncthreads();
    if (tid < 256) {
        const int cc = tid >> 4, d0 = (tid & 15) * 4; const int cg = c0 + cc;
        bf16_t* dst = (bf16_t*)(c.ws + WS_MISC + 65536 + (size_t)jj * 262144) + ((size_t)bg * 128 + cg) * 64 + d0;
        float v[4];
#pragma unroll
        for (int e = 0; e < 4; ++e) v[e] = outl[cc * 64 + d0 + e];
        if (jj == 0) {
            float s = (v[0] * v[0] + v[1] * v[1]) + (v[2] * v[2] + v[3] * v[3]);
            s += swz<1>(s); s += swz<2>(s); s += swz<4>(s); s += swz<8>(s);
            const float rs = rsqrtf(s * (1.f / 64.f) + EPS); const float* kg = a.in[18] + j * 192;
            int tok = b * S + 16 * cg + 31; if (tok >= T) tok = T - 1;
            const float* tab = (const float*)(c.ws + WS_CS8) + (size_t)tok * 16;
#pragma unroll
            for (int e = 0; e < 4; ++e) { const int d = d0 + e; float y = v[e] * rs * kg[d];
                if (d < 16) { const float o = outl[cc * 64 + (d ^ 8)] * rs * kg[d ^ 8]; const int i = d & 7; const float cs = tab[2 * i], sn = tab[2 * i + 1]; y = d < 8 ? y * cs - o * sn : o * sn + y * cs; }
                v[e] = y; }
        }
        if (cg == 127) { v[0] = v[1] = v[2] = v[3] = 0.f; }
        u32x2 o; o.x = pk2(v[0], v[1]); o.y = pk2(v[2], v[3]); *(u32x2*)dst = o;
    }
    __syncthreads();
}

DI void lds_add(LAS float* p, float v) { (void)__hip_atomic_fetch_add(p, v, __ATOMIC_RELAXED, __HIP_MEMORY_SCOPE_WORKGROUP); }
DI int crow(int r, int h) { return (r & 3) + 8 * (r >> 2) + 4 * h; }
DI unsigned cvtpk(float lo, float hi) { typedef float f2 __attribute__((ext_vector_type(2))); typedef __bf16 b2 __attribute__((ext_vector_type(2))); f2 v = {lo, hi}; b2 r = __builtin_convertvector(v, b2); return __builtin_bit_cast(unsigned, r); }
typedef short v4i16_t __attribute__((ext_vector_type(4)));
DI s16x4 vtr(const LAS char* p) { return __builtin_bit_cast(s16x4, __builtin_amdgcn_ds_read_tr16_b64_v4i16((LAS v4i16_t*)p)); }
template <int DD> struct TileRegs { u32x4 r[(64 * DD / 8 + NT - 1) / NT]; };
template <int DD> DI void tile_load(TileRegs<DD>& t, const bf16_t* g, int ld, int tid) {
    constexpr int CPR = DD / 8, NCH = 64 * CPR, NI = (NCH + NT - 1) / NT;
#pragma unroll
    for (int i = 0; i < NI; ++i) { const int ch = tid + NT * i; if (NCH % NT == 0 || ch < NCH) { const int row = ch / CPR, c8 = ch % CPR; const unsigned eo = (unsigned)row * (unsigned)ld + (unsigned)c8 * 8u; t.r[i] = *(const u32x4*)(g + eo); } }
}
template <int DD> DI void tile_store(const TileRegs<DD>& t, LAS char* buf, int tid) {
    constexpr int CPR = DD / 8, NCH = 64 * CPR, NI = (NCH + NT - 1) / NT, STR = DD * 2 + 16;
#pragma unroll
    for (int i = 0; i < NI; ++i) { const int ch = tid + NT * i; if (NCH % NT == 0 || ch < NCH) { const int row = ch / CPR, c8 = ch % CPR; *(LAS u32x4*)(buf + row * STR + c8 * 16) = t.r[i]; } }
}
template <int DK> DI void qk_tile(const LAS char* Kb, const bf16x8* qf, f32x16& p0, f32x16& p1, int lane) {
    constexpr int KS = DK * 2 + 16; const LAS char* kp = Kb + (lane & 31) * KS + (lane >> 5) * 16;
#pragma unroll
    for (int r = 0; r < 16; ++r) { p0[r] = 0.f; p1[r] = 0.f; }
#pragma unroll
    for (int st = 0; st < DK / 16; ++st) { const bf16x8 a0 = *(const LAS bf16x8*)(kp + st * 32), a1 = *(const LAS bf16x8*)(kp + 32 * KS + st * 32);
        p0 = __builtin_amdgcn_mfma_f32_32x32x16_bf16(a0, qf[st], p0, 0, 0, 0); p1 = __builtin_amdgcn_mfma_f32_32x32x16_bf16(a1, qf[st], p1, 0, 0, 0); }
}
template <int DV> DI void pv_tile(const LAS char* Vb, const f32x16& p0, const f32x16& p1, f32x16* o, int lane) {
    constexpr int VS = DV * 2 + 16;
    const int g = lane >> 4, h = lane >> 5, i16 = lane & 15, q = i16 >> 2, p = i16 & 3;
    const LAS char* base = Vb + (4 * h + q) * VS + (16 * (g & 1) + 4 * p) * 2;
#pragma unroll
    for (int s = 0; s < 4; ++s) {
        u32x4 pw;
        if (s < 2) { pw.x = cvtpk(p0[8 * s], p0[8 * s + 1]); pw.y = cvtpk(p0[8 * s + 2], p0[8 * s + 3]); pw.z = cvtpk(p0[8 * s + 4], p0[8 * s + 5]); pw.w = cvtpk(p0[8 * s + 6], p0[8 * s + 7]); }
        else { const int s2 = s - 2; pw.x = cvtpk(p1[8 * s2], p1[8 * s2 + 1]); pw.y = cvtpk(p1[8 * s2 + 2], p1[8 * s2 + 3]); pw.z = cvtpk(p1[8 * s2 + 4], p1[8 * s2 + 5]); pw.w = cvtpk(p1[8 * s2 + 6], p1[8 * s2 + 7]); }
        const bf16x8 pf = __builtin_bit_cast(bf16x8, pw);
#pragma unroll
        for (int db = 0; db < DV / 32; ++db) {
            const s16x4 lo = vtr(base + (16 * s) * VS + db * 64), hi = vtr(base + (16 * s + 8) * VS + db * 64);
            const bf16x8 vf = __builtin_shufflevector(lo, hi, 0, 1, 2, 3, 4, 5, 6, 7);
            o[db] = __builtin_amdgcn_mfma_f32_32x32x16_bf16(vf, pf, o[db], 0, 0, 0);
        }
    }
}
DI float max3f(float a, float b, float c) { return __builtin_fmaxf(__builtin_fmaxf(a, b), c); }
DI float rowmax32(const f32x16& p0, const f32x16& p1) {
    float a = max3f(p0[0], p0[1], p0[2]), b = max3f(p0[3], p0[4], p0[5]), c = max3f(p1[0], p1[1], p1[2]), d = max3f(p1[3], p1[4], p1[5]);
    a = max3f(a, p0[6], p0[7]); b = max3f(b, p0[8], p0[9]); c = max3f(c, p1[6], p1[7]); d = max3f(d, p1[8], p1[9]);
    a = max3f(a, p0[10], p0[11]); b = max3f(b, p0[12], p0[13]); c = max3f(c, p1[10], p1[11]); d = max3f(d, p1[12], p1[13]);
    a = max3f(a, p0[14], p0[15]); c = max3f(c, p1[14], p1[15]);
    return max32(max3f(max3f(a, b, c), d, d));
}
template <int DV> DI void softmax_step(f32x16& p0, f32x16& p1, f32x16* o, float& m, float& l) {
    const float mx = rowmax32(p0, p1); const float mnew = fmaxf(m, mx); const float muse = (mnew == -INFINITY) ? 0.f : mnew;
    const float alpha = __builtin_amdgcn_exp2f(m - muse);
    float s = 0.f;
#pragma unroll
    for (int r = 0; r < 16; ++r) { p0[r] = __builtin_amdgcn_exp2f(p0[r] - muse); p1[r] = __builtin_amdgcn_exp2f(p1[r] - muse); s += p0[r] + p1[r]; }
    l = l * alpha + s; m = mnew;
#pragma unroll
    for (int db = 0; db < DV / 32; ++db)
#pragma unroll
        for (int r = 0; r < 16; ++r) o[db][r] *= alpha;
}
template <int DK> DI void load_qfrag(bf16x8* qf, const bf16_t* qrow  , int h) {
#pragma unroll
    for (int st = 0; st < DK / 16; ++st) qf[st] = *(const bf16x8*)(qrow + 16 * st + 8 * h);
}
template <int DK, int DV> struct SweepLds { static constexpr int KB = 64 * (DK * 2 + 16), VB = 64 * (DV * 2 + 16); };

template <int DV> DI void softmax_step_lazy(f32x16& p0, f32x16& p1, f32x16* o, float& m, float& l) {
    const float mx = rowmax32(p0, p1); const float mnew = fmaxf(m, mx); const float muse = (mnew == -INFINITY) ? 0.f : mnew;
    const float alpha = __builtin_amdgcn_exp2f(m - muse);
    float s0 = 0.f, s1 = 0.f, s2 = 0.f, s3 = 0.f;
#pragma unroll
    for (int r = 0; r < 16; ++r) { p0[r] = __builtin_amdgcn_exp2f(p0[r] - muse); p1[r] = __builtin_amdgcn_exp2f(p1[r] - muse); }
#pragma unroll
    for (int r = 0; r < 16; r += 2) { s0 += p0[r]; s1 += p0[r + 1]; s2 += p1[r]; s3 += p1[r + 1]; }
    l = l * alpha + ((s0 + s1) + (s2 + s3)); m = mnew;
    if (__builtin_amdgcn_ballot_w64(alpha != 1.f) != 0ull) {
#pragma unroll
        for (int db = 0; db < DV / 32; ++db)
#pragma unroll
            for (int r = 0; r < 16; ++r) o[db][r] *= alpha;
    }
}
template <int DK, int DV, class It, class F> DI void flash_sweep(Ctx& c, const bf16x8* qf, const bf16_t* Kg, int ldk, const bf16_t* Vg, int ldv, It it, const F& f, f32x16* o, float& m, float& l) {
    typedef SweepLds<DK, DV> L; LAS char* lds = (LAS char*)c.lds; const int lane = c.lane, tid = c.tid;
    TileRegs<DK> kA, kB; TileRegs<DV> vA, vB;
    int ta = it.next(); int tb = ta >= 0 ? it.next() : -1;
    if (ta < 0) return;
    tile_load<DK>(kA, Kg + (size_t)ta * 64 * ldk, ldk, tid); tile_load<DV>(vA, Vg + (size_t)ta * 64 * ldv, ldv, tid);
    if (tb >= 0) { tile_load<DK>(kB, Kg + (size_t)tb * 64 * ldk, ldk, tid); tile_load<DV>(vB, Vg + (size_t)tb * 64 * ldv, ldv, tid); }
    __syncthreads();
    tile_store<DK>(kA, lds, tid); tile_store<DV>(vA, lds + 2 * L::KB, tid);
    __syncthreads();
    for (;;) {
        const int tc = tb >= 0 ? it.next() : -1;
        if (tc >= 0) { tile_load<DK>(kA, Kg + (size_t)tc * 64 * ldk, ldk, tid); tile_load<DV>(vA, Vg + (size_t)tc * 64 * ldv, ldv, tid); }
        if (!f.skip(ta)) { f32x16 p0, p1; qk_tile<DK>(lds, qf, p0, p1, lane); f.mask(p0, p1, ta); softmax_step_lazy<DV>(p0, p1, o, m, l); pv_tile<DV>(lds + 2 * L::KB, p0, p1, o, lane); }
        if (tb >= 0) { tile_store<DK>(kB, lds + L::KB, tid); tile_store<DV>(vB, lds + 2 * L::KB + L::VB, tid); }
        __syncthreads();
        if (tb < 0) break;
        const int td = tc >= 0 ? it.next() : -1;
        if (td >= 0) { tile_load<DK>(kB, Kg + (size_t)td * 64 * ldk, ldk, tid); tile_load<DV>(vB, Vg + (size_t)td * 64 * ldv, ldv, tid); }
        if (!f.skip(tb)) { f32x16 p0, p1; qk_tile<DK>(lds + L::KB, qf, p0, p1, lane); f.mask(p0, p1, tb); softmax_step_lazy<DV>(p0, p1, o, m, l); pv_tile<DV>(lds + 2 * L::KB + L::VB, p0, p1, o, lane); }
        if (tc >= 0) { tile_store<DK>(kA, lds, tid); tile_store<DV>(vA, lds + 2 * L::KB, tid); }
        __syncthreads();
        if (tc < 0) break;
        ta = tc; tb = td;
    }
}
struct RangeIt { int t, tend; DI int next() { return t <= tend ? t++ : -1; } };
struct BitsIt { unsigned rem; DI int next() { if (!rem) return -1; const int t = __builtin_ctz(rem); rem &= rem - 1; return t; } };
struct CausalF { int qrow, wfirst, wlast, h;
    DI bool skip(int t) const { return t > wlast; }
    DI void mask(f32x16& p0, f32x16& p1, int t) const { if (t * 64 + 63 > wfirst) {
#pragma unroll
        for (int r = 0; r < 16; ++r) { const int kv = t * 64 + crow(r, h); if (kv > qrow) p0[r] = -INFINITY; if (kv + 32 > qrow) p1[r] = -INFINITY; } } } };
template <int DK, int DV> DI void causal_sweep(Ctx& c, const bf16_t* Qg, int ldq, const bf16_t* Kg, int ldk, const bf16_t* Vg, int ldv, int q0, f32x16* o, float& lsum) {
    RELAUNDER(c);
    const int lane = c.lane, w = c.wave, r32 = lane & 31, h = lane >> 5;
    const int qrow = q0 + 32 * w + r32;
    bf16x8 qf[DK / 16]; load_qfrag<DK>(qf, Qg + (unsigned)qrow * (unsigned)ldq, h);
#pragma unroll
    for (int db = 0; db < DV / 32; ++db)
#pragma unroll
        for (int r = 0; r < 16; ++r) o[db][r] = 0.f;
    float m = -INFINITY, l = 0.f;
    RangeIt it{0, (q0 >> 6) + 3}; CausalF f{qrow, q0 + 32 * w, (q0 + 32 * w + 31) >> 6, h};
    flash_sweep<DK, DV>(c, qf, Kg, ldk, Vg, ldv, it, f, o, m, l);
    lsum = sum32(l);
}
template <int DV> DI void store_o(const f32x16* o, float scale, bf16_t* rowp, int h) {
#pragma unroll
    for (int db = 0; db < DV / 32; ++db)
#pragma unroll
        for (int k = 0; k < 4; ++k) { u32x2 v; v.x = cvtpk(o[db][4 * k] * scale, o[db][4 * k + 1] * scale); v.y = cvtpk(o[db][4 * k + 2] * scale, o[db][4 * k + 3] * scale);
            *(u32x2*)(rowp + 32 * db + 8 * k + 4 * h) = v; }
}

DI void mla_unit(Ctx& c, const bf16_t* QL, const bf16_t* KF, const bf16_t* KVU, bf16_t* YC, int b, int hd, int qt) {
    RELAUNDER(c);
    const int q0 = qt * 256; f32x16 o[2]; float l;
    const size_t rb = (size_t)b * S;
    causal_sweep<96, 64>(c, QL + rb * UPW + 96 * hd, UPW, KF + rb * 768 + 96 * hd, 768, KVU + rb * UPW + 128 * hd + 64, UPW, q0, o, l);
    const int qrow = q0 + 32 * c.wave + (c.lane & 31);
    store_o<64>(o, 1.f / l, YC + (rb + qrow) * 1024 + 64 * hd, c.lane >> 5);
}
DI void diff_unit(Ctx& c, const bf16_t* QKV, bf16_t* ON, int b, int hd, int qt, int j, int layer) {
    RELAUNDER(c);
    CArgs& a = *c.a; const int q0 = qt * 256, lane = c.lane, h = lane >> 5; const size_t rb = (size_t)b * S;
    f32x16 o1[4], o2[4]; float l1, l2;
    const bf16_t* base = QKV + rb * 3072;
    causal_sweep<64, 128>(c, base + 128 * hd, 3072, base + 1024 + 128 * hd, 3072, base + 2048 + 128 * hd, 3072, q0, o1, l1);
    { const float i1_ = 1.f / l1;
#pragma unroll
      for (int db = 0; db < 4; ++db)
#pragma unroll
          for (int r = 0; r < 16; ++r) o1[db][r] *= i1_; }
    causal_sweep<64, 128>(c, base + 128 * hd + 64, 3072, base + 1024 + 128 * hd + 64, 3072, base + 2048 + 128 * hd, 3072, q0, o2, l2);
    const float* lam = a.in[26] + j * 256; float s1 = lam[lane] * lam[64 + lane], s2 = lam[128 + lane] * lam[192 + lane];
    s1 = wave_sum(s1); s2 = wave_sum(s2);
    const float lam_init = 0.8f - 0.6f * __expf(-0.3f * (float)layer); const float lmb = __expf(s1) - __expf(s2) + lam_init;
    const float i1 = 1.f, i2 = lmb / l2; float ss = 0.f;
#pragma unroll
    for (int db = 0; db < 4; ++db)
#pragma unroll
        for (int r = 0; r < 16; ++r) { const float v = o1[db][r] * i1 - o2[db][r] * i2; o1[db][r] = v; ss += v * v; }
    ss = sum32(ss);
    const float rs = rsqrtf(ss * (1.f / 128.f) + EPS) * (1.f - lam_init);
    const float* sg = a.in[27] + j * 128;
#pragma unroll
    for (int db = 0; db < 4; ++db)
#pragma unroll
        for (int r = 0; r < 16; ++r) o1[db][r] *= rs * sg[32 * db + crow(r, h)];
    const int qrow = q0 + 32 * c.wave + (lane & 31);
    store_o<128>(o1, 1.f, ON + (rb + qrow) * 1024 + 128 * hd, h);
}

DI void nsa_unit(Ctx& c, const bf16_t* U, bf16_t* YC, int b, int g, int qt) {
    RELAUNDER(c);
    CArgs& a = *c.a; LAS char* lds = (LAS char*)c.lds; typedef SweepLds<64, 64> L;
    const int lane = c.lane, w = c.wave, tid = c.tid, r32 = lane & 31, h = lane >> 5;
    const int hg = w & 3, qsub = w >> 2, head = g * 4 + hg, q0 = qt * 64, jt = qt;
    const int qrow = q0 + 32 * qsub + r32; const size_t rb = (size_t)b * S; const size_t m = rb + qrow;
    LAS float* imp = (LAS float*)(lds + 4 * L::KB);
    LAS unsigned* selw = (LAS unsigned*)(lds + 4 * L::KB + 4 * 64 * 33 * 4);
    bf16x8 qf[4]; load_qfrag<64>(qf, U + m * UW + 544 + 64 * head, h);
    const bf16_t* urow = U + m * UW + 1824;
#ifdef NSA_ONLY
    const float g0 = NSA_ONLY == 0 ? 1.f : 0.f, g1 = NSA_ONLY == 1 ? 1.f : 0.f, g2 = NSA_ONLY == 2 ? 1.f : 0.f; (void)urow;
#else
    const float g0 = 1.f / (1.f + __expf(-bf2f(urow[head]))), g1 = 1.f / (1.f + __expf(-bf2f(urow[8 + head]))), g2 = 1.f / (1.f + __expf(-bf2f(urow[16 + head])));
#endif
    f32x16 acc[2];
#pragma unroll
    for (int db = 0; db < 2; ++db)
#pragma unroll
        for (int r = 0; r < 16; ++r) acc[db][r] = 0.f;
    const int bg = b * 2 + g;
    const bf16_t* KC = (const bf16_t*)(c.ws + WS_MISC + 65536) + (size_t)bg * 128 * 64; const bf16_t* VC = (const bf16_t*)(c.ws + WS_MISC + 65536 + 262144) + (size_t)bg * 128 * 64;
    __syncthreads();
    { TileRegs<64> k0, k1, v0, v1; tile_load<64>(k0, KC, 64, tid); tile_load<64>(k1, KC + 64 * 64, 64, tid); tile_load<64>(v0, VC, 64, tid); tile_load<64>(v1, VC + 64 * 64, 64, tid);
      for (int i = tid; i < 4 * 64 * 33; i += NT) imp[i] = 0.f;
      tile_store<64>(k0, lds, tid); tile_store<64>(k1, lds + L::KB, tid); tile_store<64>(v0, lds + 2 * L::KB, tid); tile_store<64>(v1, lds + 2 * L::KB + L::VB, tid); }
    __syncthreads();
    {
        f32x16 p0, p1, p2, p3; qk_tile<64>(lds, qf, p0, p1, lane); qk_tile<64>(lds + L::KB, qf, p2, p3, lane);
        const int hi = qrow < 31 ? -1 : (qrow - 31) >> 4;
#pragma unroll
        for (int r = 0; r < 16; ++r) { const int cidx = crow(r, h); if (cidx > hi) p0[r] = -INFINITY; if (cidx + 32 > hi) p1[r] = -INFINITY; if (cidx + 64 > hi) p2[r] = -INFINITY; if (cidx + 96 > hi) p3[r] = -INFINITY; }
        float mx = fmaxf(rowmax32(p0, p1), rowmax32(p2, p3)); const float muse = (mx == -INFINITY) ? 0.f : mx; float s = 0.f;
#pragma unroll
        for (int r = 0; r < 16; ++r) { p0[r] = __builtin_amdgcn_exp2f(p0[r] - muse); p1[r] = __builtin_amdgcn_exp2f(p1[r] - muse); p2[r] = __builtin_amdgcn_exp2f(p2[r] - muse); p3[r] = __builtin_amdgcn_exp2f(p3[r] - muse); s += (p0[r] + p1[r]) + (p2[r] + p3[r]); }
        s = sum32(s); const float inv = s > 0.f ? 1.f / s : 0.f;
#pragma unroll
        for (int r = 0; r < 16; ++r) { p0[r] *= inv; p1[r] *= inv; p2[r] *= inv; p3[r] *= inv; }
        LAS float* ir = imp + hg * (64 * 33) + (32 * qsub + r32) * 33;
#define IMP_ADD(P, PI) _Pragma("unroll") for (int k = 0; k < 4; ++k) { const int jb = 8 * (PI) + 2 * k + h; const float s4 = (P[4 * k] + P[4 * k + 1]) + (P[4 * k + 2] + P[4 * k + 3]); lds_add(ir + jb, s4); if (jb + 1 < 32) lds_add(ir + jb + 1, P[4 * k + 3]); }
        IMP_ADD(p0, 0) IMP_ADD(p1, 1) IMP_ADD(p2, 2) IMP_ADD(p3, 3)
#undef IMP_ADD
        f32x16 oc[2];
#pragma unroll
        for (int db = 0; db < 2; ++db)
#pragma unroll
            for (int r = 0; r < 16; ++r) oc[db][r] = 0.f;
        pv_tile<64>(lds + 2 * L::KB, p0, p1, oc, lane); pv_tile<64>(lds + 2 * L::KB + L::VB, p2, p3, oc, lane);
#pragma unroll
        for (int db = 0; db < 2; ++db)
#pragma unroll
            for (int r = 0; r < 16; ++r) acc[db][r] += g0 * oc[db][r];
    }
    __syncthreads();
#pragma unroll 1
    for (int i = 0; i < 4; ++i) { const int id = tid + NT * i, qq = id >> 5, jb = id & 31;
        const bool allowed = jb <= jt, forced = allowed && (jb == 0 || jb >= jt - 1);
        const float iv = (imp[qq * 33 + jb] + imp[64 * 33 + qq * 33 + jb]) + (imp[2 * 64 * 33 + qq * 33 + jb] + imp[3 * 64 * 33 + qq * 33 + jb]);
        const float v = forced ? 1e9f : (allowed ? iv : -1e30f);
        int rank = 0;
        for (int k = 0; k < 32; ++k) { const float vk = __shfl(v, (lane & 32) + k); rank += (vk > v || (vk == v && k < jb)) ? 1 : 0; }
        const unsigned long long bal = __ballot(allowed && rank < 16);
        if (jb == 0) selw[qq] = (unsigned)(bal >> (lane & 32)); }
    __syncthreads();
    const unsigned mysel = selw[32 * qsub + r32];
    unsigned uni = selw[lane];
    uni |= swzu<1>(uni); uni |= swzu<2>(uni); uni |= swzu<4>(uni); uni |= swzu<8>(uni); uni |= swzu<16>(uni); uni = or32(uni);
    uni = __builtin_amdgcn_readfirstlane(uni);
    {
        struct SlcF { unsigned mysel; int qrow, h, jt; DI bool skip(int) const { return false; }
            DI void mask(f32x16& p0, f32x16& p1, int t) const { const float bias = ((mysel >> t) & 1u) ? 0.f : -INFINITY;
#pragma unroll
                for (int r = 0; r < 16; ++r) { p0[r] += bias; p1[r] += bias; }
                if (t == jt) {
#pragma unroll
                    for (int r = 0; r < 16; ++r) { const int kv = t * 64 + crow(r, h); if (kv > qrow) p0[r] = -INFINITY; if (kv + 32 > qrow) p1[r] = -INFINITY; } } } };
        f32x16 o[2];
#pragma unroll
        for (int db = 0; db < 2; ++db)
#pragma unroll
            for (int r = 0; r < 16; ++r) o[db][r] = 0.f;
        float mm = -INFINITY, l = 0.f;
        flash_sweep<64, 64>(c, qf, U + rb * UW + 1312 + 64 * g, UW, U + rb * UW + 1440 + 64 * g, UW, BitsIt{uni}, SlcF{mysel, qrow, h, jt}, o, mm, l);
        l = sum32(l); const float sc = g1 / l;
#pragma unroll
        for (int db = 0; db < 2; ++db)
#pragma unroll
            for (int r = 0; r < 16; ++r) acc[db][r] += sc * o[db][r];
    }
    {
        struct WinF { int qrow, h, jt; DI bool skip(int) const { return false; }
            DI void mask(f32x16& p0, f32x16& p1, int t) const { if (t == jt || t == jt - 8) {
#pragma unroll
                for (int r = 0; r < 16; ++r) { const int kv = t * 64 + crow(r, h); if (kv > qrow || kv <= qrow - 512) p0[r] = -INFINITY; if (kv + 32 > qrow || kv + 32 <= qrow - 512) p1[r] = -INFINITY; } } } };
        f32x16 o[2];
#pragma unroll
        for (int db = 0; db < 2; ++db)
#pragma unroll
            for (int r = 0; r < 16; ++r) o[db][r] = 0.f;
        float mm = -INFINITY, l = 0.f;
        flash_sweep<64, 64>(c, qf, U + rb * UW + 1568 + 64 * g, UW, U + rb * UW + 1696 + 64 * g, UW, RangeIt{jt - 8 > 0 ? jt - 8 : 0, jt}, WinF{qrow, h, jt}, o, mm, l);
        l = sum32(l); const float sc = g2 / l;
#pragma unroll
        for (int db = 0; db < 2; ++db)
#pragma unroll
            for (int r = 0; r < 16; ++r) acc[db][r] += sc * o[db][r];
    }
    store_o<64>(acc, 1.f, YC + m * 1024 + 512 + 64 * head, h);
}
}
#ifndef FX_MODE
#define FX_MODE 0
#endif
namespace fx {
template <int ACT  > struct EpiB16 {
    static constexpr bool PERM = true, AFTER_DRAIN = false;
    bf16_t* O; int ldc; const float* ss; const float* shw;
    __device__ __forceinline__ void operator()(const pg8::f32x4 (&acc)[2][2][4][2], const pg8::Unit& u, int wr, int wc, int fr, int fq) const {
        const int row0 = u.pm * 256 + wr * 64 + fr, col0 = u.pn * 256 + wc * 32 + 8 * fq;
        const bool FUSED = ss != nullptr; pg8::f32x4 sv[2][2];
        if (FUSED) { const float* sp = shw + (size_t)(u.pm >> 3) * 4096 + col0;
#pragma unroll
            for (int bj = 0; bj < 2; ++bj) { sv[bj][0] = *(const pg8::f32x4*)(sp + bj * 128); sv[bj][1] = *(const pg8::f32x4*)(sp + bj * 128 + 4); } }
#pragma unroll
        for (int ai = 0; ai < 2; ++ai)
#pragma unroll
            for (int m = 0; m < 4; ++m) { const int row = row0 + ai * 128 + m * 16; bf16_t* rowp = O + (size_t)row * ldc + col0;
                float rs = 1.f; if (FUSED) rs = rsqrtf(ss[row] * (1.f / 1024.f) + EPS);
#pragma unroll
                for (int bj = 0; bj < 2; ++bj) { pg8::f32x4 v0 = acc[ai][bj][m][0], v1 = acc[ai][bj][m][1];
                    if (FUSED) { v0 = v0 * rs + sv[bj][0]; v1 = v1 * rs + sv[bj][1]; }
                    if (ACT == 1) {
#pragma unroll
                        for (int e = 0; e < 4; ++e) { float a = v0[e] > 0.f ? v0[e] : 0.f; v0[e] = a * a; float b = v1[e] > 0.f ? v1[e] : 0.f; v1[e] = b * b; } }
                    u32x4 w; w.x = pg8::cvt_pk_bf16(v0[0], v0[1]); w.y = pg8::cvt_pk_bf16(v0[2], v0[3]); w.z = pg8::cvt_pk_bf16(v1[0], v1[1]); w.w = pg8::cvt_pk_bf16(v1[2], v1[3]);
                    *(u32x4*)(rowp + bj * 128) = w; } }
    }
};
struct UpOrder : pg8::StaticOrder {
    __device__ bool next(int i, pg8::Unit& u) const { if (!pg8::StaticOrder::next(i, u)) return false; u.aoff = u.pn >= 3 ? 256 : 0; return true; }
};
struct EpiResid {
    static constexpr bool PERM = true, AFTER_DRAIN = false;
    const float* base; float* out; const float* gate; bf16_t* xa; const float* ngain; const float* nsc; float* ss;
    __device__ __forceinline__ void operator()(const pg8::f32x4 (&acc)[2][2][4][2], const pg8::Unit& u, int wr, int wc, int fr, int fq) const {
        const int row0 = u.pm * 256 + wr * 64 + fr, col0 = u.pn * 256 + wc * 32 + 8 * fq; const int b = u.pm >> 3; const float* gp = gate + (size_t)b * 6144 + col0;
        pg8::f32x4 gv[2][2], av[2][2];
#pragma unroll
        for (int bj = 0; bj < 2; ++bj)
#pragma unroll
            for (int n = 0; n < 2; ++n) { gv[bj][n] = *(const pg8::f32x4*)(gp + bj * 128 + n * 4);
                if (xa) { const pg8::f32x4 g = *(const pg8::f32x4*)(ngain + col0 + bj * 128 + n * 4), sc = *(const pg8::f32x4*)(nsc + (size_t)b * 6144 + col0 + bj * 128 + n * 4); av[bj][n] = g * (sc + 1.f); } }
#pragma unroll
        for (int ai = 0; ai < 2; ++ai)
#pragma unroll
            for (int m = 0; m < 4; ++m) { const int row = row0 + ai * 128 + m * 16; const size_t off = (size_t)row * 1024 + col0; float sq = 0.f;
#pragma unroll
                for (int bj = 0; bj < 2; ++bj) { pg8::f32x4 xn[2];
#pragma unroll
                    for (int n = 0; n < 2; ++n) { const pg8::f32x4 bs = *(const pg8::f32x4*)(base + off + bj * 128 + n * 4); xn[n] = bs + gv[bj][n] * acc[ai][bj][m][n];
                        *(pg8::f32x4*)(out + off + bj * 128 + n * 4) = xn[n]; }
                    if (xa) { sq += ((xn[0][0] * xn[0][0] + xn[0][1] * xn[0][1]) + (xn[0][2] * xn[0][2] + xn[0][3] * xn[0][3])) + ((xn[1][0] * xn[1][0] + xn[1][1] * xn[1][1]) + (xn[1][2] * xn[1][2] + xn[1][3] * xn[1][3]));
                        const pg8::f32x4 y0 = xn[0] * av[bj][0], y1 = xn[1] * av[bj][1];
                        u32x4 w; w.x = pg8::cvt_pk_bf16(y0[0], y0[1]); w.y = pg8::cvt_pk_bf16(y0[2], y0[3]); w.z = pg8::cvt_pk_bf16(y1[0], y1[1]); w.w = pg8::cvt_pk_bf16(y1[2], y1[3]);
                        *(u32x4*)(xa + off + bj * 128) = w; } }
                if (xa) { sq += swz<16>(sq); sq = sum32(sq); if (fq == 0) atomicAdd(ss + row, sq); } }
    }
};

#ifndef FX_REPEAT_KIND
#define FX_REPEAT_KIND 0
#endif
#define REP(kind) for (int rep_ = 0; rep_ < ((FX_REPEAT_KIND == (kind)) ? 2 : 1); ++rep_)
#define DUMMY_OUT ((float*)(ws + 300 * MiB))
__global__ void __launch_bounds__(NT, 2) mega(Args args) {
    extern __shared__ __attribute__((aligned(16))) unsigned char lds_raw[];
    Ctx c; c.lds = (LAS unsigned char*)lds_raw; c.tid = threadIdx.x; c.lane = c.tid & 63; c.wave = __builtin_amdgcn_readfirstlane(c.tid >> 6); c.G = gridDim.x; c.bid = blockIdx.x; c.a = nullptr; (void)args;
#define KARGS() ({ CArgs* p_ = (CArgs*)__builtin_amdgcn_kernarg_segment_ptr(); asm volatile("" : "+s"(p_)); p_; })
    CArgs* pa0 = KARGS();
    volatile LAS unsigned* MISC = (volatile LAS unsigned*)(c.lds + LDS_MISC);
    for (int i = c.tid; i < 64; i += NT) MISC[i] = 0u;
    __syncthreads();
    XcdBarrier bar = xcd_barrier_post((unsigned*)(pa0->ws + WS_CTL) + 4096, MISC + 8);
    int ph = 0;
#if FX_MODE == 0
    constexpr int lo = 0, hi = 28;
#else
    const int lo = pa0->ph_lo, hi = pa0->ph_hi;
#endif
#define SEAM() do { if (ph + 1 < hi) { xcd_barrier(bar); if (FX_REPEAT_KIND == 12) xcd_barrier(bar); } } while (0)
#define PHASE_BEGIN if (ph >= lo && ph < hi) { CArgs* pa = KARGS(); c.a = pa; unsigned char* ws = pa->ws; c.ws = ws; RELAUNDER(c); const int gw = c.bid * NW + c.wave, NGW = c.G * NW; (void)gw; (void)NGW; \
    const float* MOD = (const float*)(ws + WS_MOD); const float* mod = MOD + (size_t)layer * 8 * 6144; (void)mod; \
    bf16_t* XN = (bf16_t*)(ws + WS_XN); bf16_t* YC = (bf16_t*)(ws + WS_YC); bf16_t* U = (bf16_t*)(ws + WS_BIG + BIG_U); bf16_t* QL = (bf16_t*)(ws + WS_BIG + BIG_UP); bf16_t* KVU = QL + 768; \
    bf16_t* KF = XN; bf16_t* HID = (bf16_t*)(ws + WS_BIG); bf16_t* QKV = (bf16_t*)(ws + WS_BIG); float* SS = (float*)(ws + WS_SS); const float* SHW = (const float*)(ws + WS_SHW); (void)SS; (void)SHW; (void)XN; (void)YC; (void)U; (void)QL; (void)KVU; (void)KF; (void)HID; (void)QKV; \
    unsigned char* wb = ws + ((layer & 1) ? WS_WODD + (size_t)(layer >> 1) * W_ODD : WS_WEVEN + (size_t)(layer >> 1) * W_EVEN); unsigned char* wm = ws + WS_WMLP + (size_t)layer * W_MLP; (void)wb; (void)wm;
#define PHASE_END SEAM(); } ++ph;
    int layer = 0;

    if (lo == 0) { CArgs* pa = KARGS(); c.a = pa; c.ws = pa->ws; RELAUNDER(c);
#ifndef SKIP_PRO
        REP(10) phase_prologue(c);
#endif
        if (hi > 1) { if (pa->use_cg != 0) cooperative_groups::this_grid().sync(); else xcd_barrier(bar); } }
    ++ph;

#pragma unroll
    for (layer = 0; layer < 4; ++layer) {
        const int j = layer >> 1;
        if (layer == 0) {
        PHASE_BEGIN
            REP(8) phase_modnorm(c, pa->in[0], pa->in[5], mod + 0, mod + 1024, XN);
            shw_items(c);
        PHASE_END
        }
        if ((layer & 1) == 0) {
            PHASE_BEGIN { pg8::Gemm g{XN, (const bf16_t*)(wb + WE_IN), T, UW, D, D}; pg8::StaticOrder so; so.init(T, UW, c.G, c.bid); EpiB16<0> E{U, UW, layer == 0 ? nullptr : SS + (size_t)(2 * layer) * T, SHW + (size_t)(2 * layer) * 8 * 4096};

#ifndef SKIP_G1
REP(6) pg8::gemm_phase<EpiB16<0>, pg8::StaticOrder, true, true>(c.lds, g, so, E);
#endif
 } PHASE_END
            PHASE_BEGIN { pg8::Gemm g{U, (const bf16_t*)(wb + WE_UP), T, 1792, 256, UW}; UpOrder so; so.init(T, 1792, c.G, c.bid); EpiB16<0> E{QL, UPW, nullptr, nullptr};

#ifndef SKIP_G2
pg8::gemm_phase<EpiB16<0>, UpOrder, false, true>(c.lds, g, so, E);
#endif

                __syncthreads();

#ifndef SKIP_CMP
 for (int it = c.bid; it < 256; it += c.G) compress_item(c, U, j, it);
#endif


#ifndef SKIP_FIN
 RELAUNDER(c); for (int m0 = gw; m0 < T; m0 += NGW * TBV) nsa_finalize_rows(c, U, m0, NGW, j);
#endif
 } PHASE_END
            PHASE_BEGIN {
#ifndef SKIP_FIN
 for (int m0 = gw; m0 < T; m0 += NGW * TB) mla_finalize_rows(c, U, QL, KVU, KF, m0, NGW, j);
#endif

                REP(1) for (int p = c.bid; p < 256; p += c.G) { const int bg = p >> 4, s = p & 15;
#ifndef SKIP_NSA
 nsa_unit(c, U, YC, bg >> 1, bg & 1, 31 - s); nsa_unit(c, U, YC, bg >> 1, bg & 1, s);
#endif
 } } PHASE_END
            PHASE_BEGIN { REP(2) for (int p = c.bid; p < 256; p += c.G) { const int bh = p >> 2, s = p & 3;
#ifndef SKIP_MLA
 mla_unit(c, QL, KF, KVU, YC, bh >> 3, bh & 7, 7 - s); mla_unit(c, QL, KF, KVU, YC, bh >> 3, bh & 7, s);
#endif
 } } PHASE_END
            PHASE_BEGIN { pg8::Gemm g{YC, (const bf16_t*)(wb + WE_OUT), T, D, D, D}; pg8::StaticOrder so; so.init(T, D, c.G, c.bid);
#ifndef SKIP_G3
REP(9) { EpiResid E{layer == 0 ? pa->in[0] : pa->out, rep_ ? DUMMY_OUT : pa->out, mod + 2048, XN, pa->in[6] + layer * D, mod + 4096, SS + (size_t)(2 * layer + 1) * T}; pg8::gemm_phase<EpiResid, pg8::StaticOrder, true, true>(c.lds, g, so, E); }
#endif
 } PHASE_END
        } else {
            PHASE_BEGIN { pg8::Gemm g{XN, (const bf16_t*)(wb + WO_QKV), T, 3072, D, D}; pg8::StaticOrder so; so.init(T, 3072, c.G, c.bid); EpiB16<0> E{QKV, 3072, SS + (size_t)(2 * layer) * T, SHW + (size_t)(2 * layer) * 8 * 4096};

#ifndef SKIP_G4
REP(7) pg8::gemm_phase<EpiB16<0>, pg8::StaticOrder, true, true>(c.lds, g, so, E);
#endif
 } PHASE_END
            PHASE_BEGIN {
#ifndef SKIP_FIN
 for (int m0 = gw; m0 < T; m0 += NGW * TBV) diff_finalize_rows(c, QKV, m0, NGW, j);
#endif
 } PHASE_END
            PHASE_BEGIN { REP(3) for (int p = c.bid; p < 256; p += c.G) { const int bh = p >> 2, s = p & 3;
#ifndef SKIP_DIFF
 diff_unit(c, QKV, YC, bh >> 3, bh & 7, 7 - s, j, layer); diff_unit(c, QKV, YC, bh >> 3, bh & 7, s, j, layer);
#endif
 } } PHASE_END
            PHASE_BEGIN { pg8::Gemm g{YC, (const bf16_t*)(wb + WO_O), T, D, D, D}; pg8::StaticOrder so; so.init(T, D, c.G, c.bid);
#ifndef SKIP_G5
REP(9) { EpiResid E{pa->out, rep_ ? DUMMY_OUT : pa->out, mod + 2048, XN, pa->in[6] + layer * D, mod + 4096, SS + (size_t)(2 * layer + 1) * T}; pg8::gemm_phase<EpiResid, pg8::StaticOrder, true, true>(c.lds, g, so, E); }
#endif
 } PHASE_END
        }
        PHASE_BEGIN { pg8::Gemm g{XN, (const bf16_t*)wm, T, FF, D, D}; pg8::StaticOrder so; so.init(T, FF, c.G, c.bid); EpiB16<1> E{HID, FF, SS + (size_t)(2 * layer + 1) * T, SHW + (size_t)(2 * layer + 1) * 8 * 4096};

#ifndef SKIP_G6
REP(4) pg8::gemm_phase<EpiB16<1>, pg8::StaticOrder, true, true>(c.lds, g, so, E);
#endif
 } PHASE_END
        PHASE_BEGIN { pg8::Gemm g{HID, (const bf16_t*)(wm + 8 * MiB), T, D, FF, FF}; pg8::StaticOrder so; so.init(T, D, c.G, c.bid);
#ifndef SKIP_G7
REP(5) { EpiResid E{pa->out, rep_ ? DUMMY_OUT : pa->out, mod + 5120, layer < 3 ? XN : nullptr, pa->in[5] + (layer + 1) * D, MOD + (size_t)(layer + 1) * 8 * 6144 + 1024, SS + (size_t)(2 * layer + 2) * T}; pg8::gemm_phase<EpiResid, pg8::StaticOrder, true, true>(c.lds, g, so, E); }
#endif
 } PHASE_END
    }
#undef PHASE_BEGIN
#undef PHASE_END
#undef SEAM
}
constexpr int N_PHASES = 1 + 1 + 2 * (5 + 2) + 2 * (4 + 2);
static_assert(N_PHASES == 28, "phase count");

inline void launch(const Args& base, int lo, int hi, int use_cg, hipStream_t st) {
    static int grid = 0;
    if (grid == 0) {
        int dev = 0, cus = 0, per_cu = 0;
        (void)hipGetDevice(&dev); (void)hipDeviceGetAttribute(&cus, hipDeviceAttributeMultiprocessorCount, dev);
        (void)hipFuncSetAttribute((const void*)mega, hipFuncAttributeMaxDynamicSharedMemorySize, LDS_BYTES);
        (void)hipOccupancyMaxActiveBlocksPerMultiprocessor(&per_cu, (const void*)mega, NT, LDS_BYTES);
        if (per_cu < 1) { fprintf(stderr, "occupancy query says %d blocks/CU\n", per_cu); per_cu = 1; }
        grid = cus;
        (void)hipGetLastError();
    }
    Args a = base; a.ph_lo = lo; a.ph_hi = hi; a.use_cg = use_cg; a.pad = 0;
    void* kargs[] = {&a};
    hipError_t e = hipLaunchCooperativeKernel((const void*)mega, dim3(grid), dim3(NT), kargs, LDS_BYTES, st);
    if (e != hipSuccess) fprintf(stderr, "cooperative launch failed: %s\n", hipGetErrorString(e));
}
}
#ifndef FX_MODE
#define FX_MODE 0
#endif
#ifndef DBG_LAYERS
#define DBG_LAYERS 1
#endif
#ifndef DBG_B0
#define DBG_B0 5
#endif
#ifndef DBG_STAGE
#define DBG_STAGE 0
#endif
#ifndef DBG_NPH
#define DBG_NPH -1
#endif
namespace dbg {
__global__ void k_cmp(const void* fast, int is_bf16, long fld, const float* ref, long rld, int nrows, int ncols, float fscale, float* acc2) {
    const long n = (long)nrows * ncols; float d2 = 0.f, r2 = 0.f;
    for (long i = (long)blockIdx.x * 256 + threadIdx.x; i < n; i += (long)gridDim.x * 256) { const long r = i / ncols, cidx = i % ncols;
        float a = is_bf16 ? fx::bf2f(((const unsigned short*)fast)[r * fld + cidx]) : ((const float*)fast)[r * fld + cidx]; a *= fscale;
        const float b = ref[r * rld + cidx]; if (!(a == a)) a = 1e6f; d2 += (a - b) * (a - b); r2 += b * b; }
    for (int o = 32; o > 0; o >>= 1) { d2 += __shfl_xor(d2, o); r2 += __shfl_xor(r2, o); }
    if ((threadIdx.x & 63) == 0) { atomicAdd(acc2, d2); atomicAdd(acc2 + 1, r2); }
}
#ifndef DBG_SEL
#define DBG_SEL -1
#endif
__global__ void k_finish(float* out, const float* acc, int nchk, long n) {
    float e = 0.f; int bad = -1; for (int i = 0; i < nchk; ++i) { float v = sqrtf(acc[2 * i] / fmaxf(acc[2 * i + 1], 1e-30f)); if (!(v == v)) v = 100.f; e = fmaxf(e, v); if (bad < 0 && v > 0.05f) bad = i; }
    if (DBG_SEL >= 0) { e = sqrtf(acc[2 * DBG_SEL] / fmaxf(acc[2 * DBG_SEL + 1], 1e-30f)); if (!(e == e)) e = 100.f; bad = -1; }
    if (blockIdx.x == 0 && threadIdx.x == 0 && bad >= 0) out[0] += 1000.f * (bad + 1);
    for (long i = (long)blockIdx.x * 256 + threadIdx.x; i < n; i += (long)gridDim.x * 256) out[i] *= (1.f + e);
}
}
extern "C" void kernel_launch(void* const* d_in, const int* in_sizes, int n_in, void* d_out, int out_size, void* d_ws, size_t ws_size, hipStream_t stream) {
    fx::Args a{};
    for (int i = 0; i < 28; ++i) a.in[i] = (const float*)d_in[i];
    a.pos = (const int*)d_in[2]; a.out = (float*)d_out; a.ws = (unsigned char*)d_ws;
    (void)hipMemsetAsync((char*)d_ws + fx::WS_CTL, 0, 65536, stream);
#if FX_MODE == 0
    fx::launch(a, 0, fx::N_PHASES, 1, stream);
#elif FX_MODE == 1
    for (int p = 0; p < fx::N_PHASES; ++p) fx::launch(a, p, p + 1, 0, stream);
#else
    nv::In in{}; for (int i = 0; i < 28; ++i) in.p[i] = (const float*)d_in[i]; in.pos = (const int*)d_in[2];
    float* errs = (float*)((char*)d_ws + 381 * fx::MiB);
    (void)hipMemsetAsync(errs, 0, 256, stream);
    const int nph = DBG_NPH >= 0 ? DBG_NPH : (DBG_LAYERS == 1 ? 9 : DBG_LAYERS == 2 ? 15 : DBG_LAYERS == 3 ? 22 : 28);
    for (int p = 0; p < nph; ++p) fx::launch(a, p, p + 1, 0, stream);
    float* nws = (float*)((char*)d_ws + fx::WS_NAIVE); float* nx = (float*)((char*)d_ws + fx::WS_NAIVE + 56 * fx::MiB);
    nv::forward(in, nx, nws, stream, DBG_LAYERS, DBG_B0, 1, DBG_STAGE == 8 ? 6 : DBG_STAGE);
    int nchk = 0;
    auto CMPR = [&](const void* f, int isb, long fld, const float* r, long rld, int nrows, int ncols, float fs) { hipLaunchKernelGGL(dbg::k_cmp, dim3(512), dim3(256), 0, stream, f, isb, fld, r, rld, nrows, ncols, fs, errs + 2 * nchk); ++nchk; };
    auto CMP = [&](const void* f, int isb, long fld, const float* r, long rld, int ncols, float fs) { CMPR(f, isb, fld, r, rld, 2048, ncols, fs); };
    const size_t r0 = (size_t)DBG_B0 * 2048;
    unsigned char* ws = (unsigned char*)d_ws;
    const size_t NMi = (size_t)(1u << 20) / 8;
    float* nU = nws + nv::R_U; float* nRA = nU + 29 * NMi; float* nRB = nRA + 12 * NMi; float* nRC = nRB + 16 * NMi; float* nRD = nRC + 12 * NMi; float* nH = nRD + 8 * NMi;
    (void)nRA; (void)nRB; (void)nRC; (void)nRD; (void)nH;
    const fx::bf16_t* fU = (const fx::bf16_t*)(ws + fx::WS_BIG + fx::BIG_U); const fx::bf16_t* fQL = (const fx::bf16_t*)(ws + fx::WS_BIG + fx::BIG_UP);
    const fx::bf16_t* fKVU = fQL + 768; const fx::bf16_t* fXN = (const fx::bf16_t*)(ws + fx::WS_XN); const fx::bf16_t* fYC = (const fx::bf16_t*)(ws + fx::WS_YC);
    (void)fU; (void)fQL; (void)fKVU; (void)fXN; (void)fYC;
#if DBG_STAGE == 0 || DBG_STAGE == 9
    CMP((const float*)d_out + r0 * 1024, 0, 1024, nx, 1024, 1024, 1.f);
#elif DBG_STAGE == 1
    if ((DBG_LAYERS & 1) == 1) { CMP(fU + r0 * 2048, 1, 2048, nU, 1848, 544, 1.f); CMP(fU + r0 * 2048 + 1056, 1, 2048, nU + 1056, 1848, 256, 1.f); CMP(fU + r0 * 2048 + 1824, 1, 2048, nU + 1824, 1848, 24, 1.f); }
    else { CMP(fU + r0 * 3072 + 2048, 1, 3072, nU + 2048, 3072, 1024, 1.f); }
#elif DBG_STAGE == 2
    if ((DBG_LAYERS & 1) == 1) { CMP(fQL + r0 * 1792, 1, 1792, nRC, 768, 768, 1.f / (0.10206207261596577f * 1.4426950408889634f)); CMP(fXN + r0 * 768, 1, 768, nRA, 768, 768, 1.f); }
    else { CMP(fU + r0 * 3072, 1, 3072, nU, 3072, 1024, 1.f / (0.125f * 1.4426950408889634f)); CMP(fU + r0 * 3072 + 1024, 1, 3072, nU + 1024, 3072, 1024, 1.f); }
#elif DBG_STAGE == 3
    CMP(fU + r0 * 2048, 1, 2048, nU, 1848, 544, 1.f); CMP(fU + r0 * 2048 + 1056, 1, 2048, nU + 1056, 1848, 256, 1.f); CMP(fU + r0 * 2048 + 1824, 1, 2048, nU + 1824, 1848, 24, 1.f);
    CMP(fQL + r0 * 1792, 1, 1792, nRC, 768, 768, 1.f / (0.10206207261596577f * 1.4426950408889634f)); CMP(fXN + r0 * 768, 1, 768, nRA, 768, 768, 1.f);
    CMP(fYC + r0 * 1024, 1, 1024, nH, 1024, 512, 1.f);
#elif DBG_STAGE == 4
    if ((DBG_LAYERS & 1) == 1) { CMP(fU + r0 * 2048 + 544, 1, 2048, nRD, 512, 512, 1.f / (0.125f * 1.4426950408889634f)); }
    else { CMP(fYC + r0 * 1024, 1, 1024, nU, 1024, 1024, 1.f); }
#elif DBG_STAGE == 6
    { const float* nSM = nws + nv::R_SMALL; const fx::bf16_t* fKC = (const fx::bf16_t*)(ws + fx::WS_MISC + 65536) + (size_t)DBG_B0 * 2 * 128 * 64; const fx::bf16_t* fVC = fKC + 16 * 128 * 64;
      CMP(fU + r0 * 2048 + 544, 1, 2048, nRD, 512, 512, 1.f / (0.125f * 1.4426950408889634f));
      CMPR(fKC, 1, 64, nSM, 64, 127, 64, 1.f); CMPR(fKC + 128 * 64, 1, 64, nSM + 128 * 64, 64, 127, 64, 1.f);
      CMPR(fVC, 1, 64, nSM + 16 * 128 * 64, 64, 127, 64, 1.f); CMPR(fVC + 128 * 64, 1, 64, nSM + 17 * 128 * 64, 64, 127, 64, 1.f);
      CMP(fU + r0 * 2048 + 1312, 1, 2048, nRA, 128, 128, 1.f); CMP(fU + r0 * 2048 + 1568, 1, 2048, nRA + 2 * NMi, 128, 128, 1.f); }
#elif DBG_STAGE == 8
    { const float* nb_ = NSA_ONLY == 0 ? nRC : NSA_ONLY == 1 ? nRA + 4 * NMi : nRB; CMP(fYC + r0 * 1024 + 512, 1, 1024, nb_, 512, 512, 1.f); }
#elif DBG_STAGE == 7
    CMP(fYC + r0 * 1024, 1, 1024, nH, 1024, 512, 1.f); CMP(fYC + r0 * 1024 + 512, 1, 1024, nH + 512, 1024, 512, 1.f);
#endif
    nv::forward(in, (float*)d_out, (float*)d_ws, stream, 4, 0, 8, 0);
    hipLaunchKernelGGL(dbg::k_finish, dim3(1024), dim3(256), 0, stream, (float*)d_out, errs, nchk, (long)16384 * 1024);
#endif
}
```

```cpp
#define FX_MODE 0

#include <hip/hip_runtime.h>
#include <hip/hip_bf16.h>
#include <cstdio>
#include <cstdint>
#include <cmath>
#include <hip/hip_cooperative_groups.h>
namespace pg8 {
#define PG8_LAS __attribute__((address_space(3)))
typedef unsigned short bf16_t;
typedef short bf16x8 __attribute__((ext_vector_type(8)));
typedef float f32x4 __attribute__((ext_vector_type(4)));
typedef unsigned u32x4 __attribute__((ext_vector_type(4)));
constexpr int BM = 256, BK = 64, HALF = 128, HTB = HALF * BK * 2  , STAGE_BYTES = 8 * HTB, NXCD = 8, WGM = 8;

__host__ __device__ __forceinline__ int lds_byte(int r, int c) { const int st = (r >> 4) * 2 + (c >> 5), rr = r & 15, cc = c & 31, ob = rr * 64 + cc * 2; return st * 1024 + (ob ^ (((ob >> 9) & 1) << 5)); }
__host__ __device__ __forceinline__ void stage_rc(int b, int& R, int& C) { const int st = b / 1024, sb = b % 1024, swz = sb ^ (((sb >> 9) & 1) << 5); R = (st >> 1) * 16 + swz / 64; C = (st & 1) * 32 + (swz % 64) / 2; }
__host__ __device__ __forceinline__ int perm32(int rho) { const int n = rho >> 4, i = rho & 15; return 8 * (i >> 2) + 4 * n + (i & 3); }

struct Unit { int pm, pn; int aoff; };
struct Gemm { const bf16_t* A; const bf16_t* Bt; int M, N, K, lda; };

struct StaticOrder {
    int nM, nN, nwg, G, c;
    __host__ __device__ void init(int M, int N, int G_, int c_) { nM = M / BM; nN = N / BM; nwg = nM * nN; G = G_; c = c_; }
    __host__ __device__ bool next(int i, Unit& u) const {
        const long L = (long)i * G + c; if (L >= nwg) return false;
        int wgid = (int)L; { const int q = nwg / NXCD, r = nwg % NXCD, xcd = wgid % NXCD, off = wgid / NXCD; wgid = (xcd < r ? xcd * (q + 1) : r * (q + 1) + (xcd - r) * q) + off; }
        const int nig = WGM * nN, gid = wgid / nig, fm = gid * WGM, gsz = (nM - fm) < WGM ? (nM - fm) : WGM;
        u.pm = fm + ((wgid % nig) % gsz); u.pn = (wgid % nig) / gsz; u.aoff = 0; return true;
    }
    __device__ __forceinline__ void a_ready(const Unit&) const {}
    __device__ __forceinline__ void done(const Unit&) const {}
};

__device__ __forceinline__ unsigned cvt_pk_bf16(float lo, float hi) { unsigned r; asm volatile("v_cvt_pk_bf16_f32 %0, %1, %2" : "=v"(r) : "v"(lo), "v"(hi)); return r; }
typedef float f32x2 __attribute__((ext_vector_type(2)));
__device__ __forceinline__ f32x2 gelu_pk(f32x2 v) {
    const f32x2 av = __builtin_elementwise_abs(v), d = av * 0.2316418882f + 1.0f;
    f32x2 t; t.x = __builtin_amdgcn_rcpf(d.x); t.y = __builtin_amdgcn_rcpf(d.y);
    f32x2 q = t * 0.5307027145f + (-0.7265760135f); q = q * t + 0.7107068705f; q = q * t + (-0.142248368f); q = q * t + 0.127414796f; q = q * t;
    const f32x2 s = (v * v) * (-0.72134752044f);
    f32x2 e; e.x = __builtin_amdgcn_exp2f(s.x); e.y = __builtin_amdgcn_exp2f(s.y);
    const f32x2 m = v * (q * e), r = v - m;
    f32x2 o; o.x = v.x < 0.f ? m.x : r.x; o.y = v.y < 0.f ? m.y : r.y; return o;
}

template <int ACT  > struct EpiBf16 {
    static constexpr bool PERM = true, AFTER_DRAIN = false; static_assert(ACT == 0 || ACT == 1, "EpiBf16: ACT is 0 (none) or 1 (gelu_pk)");
    bf16_t* O; int ldc; const float* bias; int split_cols; size_t split_stride; float scale0;
    __device__ __forceinline__ void operator()(const f32x4 (&acc)[2][2][4][2], const Unit& u, int wr, int wc, int fr, int fq) const {
        const int row0 = u.pm * BM + wr * 64 + fr; int colt = u.pn * BM; bf16_t* base = O;
        float sc = 1.f; if (split_cols) { const int t = colt / split_cols; base += (size_t)t * split_stride; colt -= t * split_cols; if (t == 0) sc = scale0; }
        const int col0 = colt + wc * 32 + 8 * fq, bcol0 = u.pn * BM + wc * 32 + 8 * fq;
        f32x4 bv[2][2];
#pragma unroll
        for (int bj = 0; bj < 2; ++bj)
#pragma unroll
            for (int n = 0; n < 2; ++n) bv[bj][n] = bias ? *(const f32x4*)(bias + bcol0 + bj * HALF + 4 * n) : (f32x4){0.f, 0.f, 0.f, 0.f};
#pragma unroll
        for (int ai = 0; ai < 2; ++ai)
#pragma unroll
            for (int m = 0; m < 4; ++m) { bf16_t* rowp = base + (size_t)(row0 + ai * HALF + m * 16) * ldc + col0;
#pragma unroll
                for (int bj = 0; bj < 2; ++bj) { f32x4 v0 = acc[ai][bj][m][0] + bv[bj][0], v1 = acc[ai][bj][m][1] + bv[bj][1];
                    if (ACT == 1) { f32x2 a = gelu_pk((f32x2){v0[0], v0[1]}), b = gelu_pk((f32x2){v0[2], v0[3]}), c = gelu_pk((f32x2){v1[0], v1[1]}), d = gelu_pk((f32x2){v1[2], v1[3]});
                        v0 = (f32x4){a.x, a.y, b.x, b.y}; v1 = (f32x4){c.x, c.y, d.x, d.y}; }
                    v0 = v0 * sc; v1 = v1 * sc; u32x4 w; w.x = cvt_pk_bf16(v0[0], v0[1]); w.y = cvt_pk_bf16(v0[2], v0[3]); w.z = cvt_pk_bf16(v1[0], v1[1]); w.w = cvt_pk_bf16(v1[2], v1[3]);
                    *(u32x4*)(rowp + bj * HALF) = w; } }
    }
};

template <class Epi, class Sched, bool ALIGN_EPI = false, bool SP2 = false>
__device__ __forceinline__ void gemm_phase(PG8_LAS unsigned char* lds, const Gemm g, const Sched& S, const Epi& E) {
    int tid_ = threadIdx.x; asm volatile("" : "+v"(tid_)); const int tid = tid_, wid = __builtin_amdgcn_readfirstlane(tid >> 6), lane = tid & 63, wr = wid >> 2, wc = wid & 3, fr = lane & 15, fq = lane >> 4;
    const int K = g.K, nt = K / BK;
    unsigned voffA[2], voffB[2];
#pragma unroll
    for (int i = 0; i < 2; ++i) { int R, C; stage_rc(tid * 16 + i * 8192, R, C); const int Rb = Epi::PERM ? ((R & ~31) + perm32(R & 31)) : R;
        voffA[i] = (unsigned)(R * g.lda + C) * 2u; voffB[i] = (unsigned)(Rb * K + C) * 2u; }
    const size_t kstep = (size_t)(BK * 2);
    const size_t hstep = (size_t)HALF * K * 2;
    const size_t hstepA = (size_t)HALF * g.lda * 2, tstepA = 2 * hstepA;
    const size_t tstep = 2 * hstep;
    const unsigned ldsw = (unsigned)wid * 1024u;
    const int aoff = lds_byte(wr * 64 + fr, fq * 8), boff = lds_byte(wc * 32 + fr, fq * 8);
#define PG8_SA(b, h) (((b) * 2 + (h)) * HTB)
#define PG8_SB(b, h) ((4 + (b) * 2 + (h)) * HTB)
#define PG8_STAGE(bufoff, gbase, voff) do { _Pragma("unroll") for (int _i = 0; _i < 2; ++_i) \
        __builtin_amdgcn_global_load_lds((const unsigned*)((const char*)(gbase) + (voff)[_i]), (PG8_LAS unsigned*)(lds + (bufoff) + ldsw + _i * 8192), 16, 0, 0); } while (0)
#define PG8_LDA(dst, b, h) do { _Pragma("unroll") for (int m = 0; m < 4; ++m) _Pragma("unroll") for (int k = 0; k < 2; ++k) dst[m][k] = *(const PG8_LAS bf16x8*)(lds + PG8_SA(b, h) + aoff + m * 2048 + k * 1024); } while (0)
#define PG8_LDB(dst, b, h) do { _Pragma("unroll") for (int n = 0; n < 2; ++n) _Pragma("unroll") for (int k = 0; k < 2; ++k) dst[n][k] = *(const PG8_LAS bf16x8*)(lds + PG8_SB(b, h) + boff + n * 2048 + k * 1024); } while (0)
#define PG8_MMA(ai, bj, At, Bt) do { __builtin_amdgcn_s_setprio(1); _Pragma("unroll") for (int m = 0; m < 4; ++m) _Pragma("unroll") for (int n = 0; n < 2; ++n) _Pragma("unroll") for (int k = 0; k < 2; ++k) \
        acc[ai][bj][m][n] = __builtin_amdgcn_mfma_f32_16x16x32_bf16(Bt[n][k], At[m][k], acc[ai][bj][m][n], 0, 0, 0); __builtin_amdgcn_s_setprio(0); } while (0)
#define PG8_WAIT_V(n) asm volatile("s_waitcnt vmcnt(" #n ")" ::: "memory")
#define PG8_WAIT_L(n) asm volatile("s_waitcnt lgkmcnt(" #n ")" ::: "memory")
#define PG8_BAR __builtin_amdgcn_s_barrier()
#define PG8_SCHED __builtin_amdgcn_sched_barrier(0)
    Unit cur, nxt; int ui = 0;
    if (!S.next(0, cur)) return;
    f32x4 acc[2][2][4][2];
#pragma unroll
    for (int a = 0; a < 2; ++a)
#pragma unroll
        for (int b = 0; b < 2; ++b)
#pragma unroll
            for (int m = 0; m < 4; ++m)
#pragma unroll
                for (int n = 0; n < 2; ++n) acc[a][b][m][n] = (f32x4){0.f, 0.f, 0.f, 0.f};
    bf16x8 At[4][2], B0[2][2], B1[2][2];
    const char* cA = (const char*)g.A + (size_t)cur.pm * tstepA + (size_t)cur.aoff * 2; const char* cB = (const char*)g.Bt + (size_t)cur.pn * tstep;
    S.a_ready(cur);
    if constexpr (SP2) {
        PG8_STAGE(PG8_SB(0, 0), cB, voffB); PG8_STAGE(PG8_SB(0, 1), cB + hstep, voffB); PG8_STAGE(PG8_SA(0, 0), cA, voffA); PG8_STAGE(PG8_SA(0, 1), cA + hstepA, voffA);
        if (wr == 1) PG8_BAR;
        PG8_WAIT_V(2); PG8_BAR;
        PG8_STAGE(PG8_SB(1, 0), cB + kstep, voffB); PG8_STAGE(PG8_SA(1, 0), cA + kstep, voffA); PG8_STAGE(PG8_SB(1, 1), cB + hstep + kstep, voffB);
        PG8_WAIT_V(6); PG8_BAR;
    } else {
        PG8_STAGE(PG8_SB(0, 0), cB, voffB); PG8_STAGE(PG8_SA(0, 0), cA, voffA); PG8_STAGE(PG8_SB(0, 1), cB + hstep, voffB); PG8_STAGE(PG8_SA(0, 1), cA + hstepA, voffA);
        if (wr == 1) PG8_BAR;
        PG8_WAIT_V(4); PG8_BAR;
        PG8_STAGE(PG8_SB(1, 0), cB + kstep, voffB); PG8_STAGE(PG8_SA(1, 0), cA + kstep, voffA); PG8_STAGE(PG8_SB(1, 1), cB + hstep + kstep, voffB);
        PG8_WAIT_V(6); PG8_BAR;
    }
    for (;;) {
        const bool has_next = S.next(ui + 1, nxt);
        const char* nA = has_next ? (const char*)g.A + (size_t)nxt.pm * tstepA + (size_t)nxt.aoff * 2 : cA; const char* nB = has_next ? (const char*)g.Bt + (size_t)nxt.pn * tstep : cB;
        for (int t = 0; t < nt; t += 2) {
            const bool last = (t == nt - 2);
            const char* a1 = cA + (size_t)(t + 1) * kstep;
            const char* a2 = last ? nA : cA + (size_t)(t + 2) * kstep; const char* b2 = last ? nB : cB + (size_t)(t + 2) * kstep;
            const char* a3 = a2 + kstep; const char* b3 = b2 + kstep;
            if (last && has_next) S.a_ready(nxt);
            if constexpr (SP2) {
            PG8_LDB(B0, 0, 0); PG8_LDB(B1, 0, 1); PG8_SCHED; PG8_LDA(At, 0, 0); PG8_STAGE(PG8_SA(1, 1), a1 + hstepA, voffA);
            PG8_WAIT_V(8); PG8_WAIT_L(0); PG8_BAR; PG8_MMA(0, 0, At, B0); PG8_MMA(0, 1, At, B1); PG8_BAR; PG8_SCHED;
            PG8_LDA(At, 0, 1); PG8_STAGE(PG8_SB(0, 0), b2, voffB); PG8_STAGE(PG8_SB(0, 1), b2 + hstep, voffB); PG8_STAGE(PG8_SA(0, 0), a2, voffA);
            PG8_WAIT_V(8); PG8_WAIT_L(0); PG8_BAR; PG8_MMA(1, 0, At, B0); PG8_MMA(1, 1, At, B1); PG8_BAR; PG8_SCHED;
            PG8_LDB(B0, 1, 0); PG8_LDB(B1, 1, 1); PG8_SCHED; PG8_LDA(At, 1, 0); PG8_STAGE(PG8_SA(0, 1), a2 + hstepA, voffA);
            PG8_WAIT_V(8); PG8_WAIT_L(0); PG8_BAR; PG8_MMA(0, 0, At, B0); PG8_MMA(0, 1, At, B1); PG8_BAR; PG8_SCHED;
            PG8_LDA(At, 1, 1); PG8_STAGE(PG8_SB(1, 0), b3, voffB); PG8_STAGE(PG8_SB(1, 1), b3 + hstep, voffB); PG8_STAGE(PG8_SA(1, 0), a3, voffA);
            PG8_WAIT_V(8); PG8_WAIT_L(0); PG8_BAR; PG8_MMA(1, 0, At, B0); PG8_MMA(1, 1, At, B1); PG8_BAR; PG8_SCHED;
            } else {
            PG8_LDB(B0, 0, 0); PG8_SCHED; PG8_LDA(At, 0, 0); PG8_STAGE(PG8_SA(1, 1), a1 + hstepA, voffA);
            PG8_WAIT_L(8); PG8_BAR; PG8_WAIT_L(0); PG8_MMA(0, 0, At, B0); PG8_BAR; PG8_SCHED;
            PG8_LDB(B1, 0, 1); PG8_STAGE(PG8_SB(0, 0), b2, voffB);
            PG8_BAR; PG8_WAIT_L(0); PG8_MMA(0, 1, At, B1); PG8_BAR;
            PG8_LDA(At, 0, 1); PG8_STAGE(PG8_SA(0, 0), a2, voffA);
            PG8_BAR; PG8_WAIT_L(0); PG8_MMA(1, 0, At, B0); PG8_BAR; PG8_SCHED;
            PG8_STAGE(PG8_SB(0, 1), b2 + hstep, voffB);
            PG8_WAIT_V(6); PG8_BAR; PG8_MMA(1, 1, At, B1); PG8_BAR;
            PG8_LDB(B0, 1, 0); PG8_SCHED; PG8_LDA(At, 1, 0); PG8_STAGE(PG8_SA(0, 1), a2 + hstepA, voffA);
            PG8_WAIT_L(8); PG8_BAR; PG8_WAIT_L(0); PG8_MMA(0, 0, At, B0); PG8_BAR; PG8_SCHED;
            PG8_LDB(B1, 1, 1); PG8_STAGE(PG8_SB(1, 0), b3, voffB);
            PG8_BAR; PG8_WAIT_L(0); PG8_MMA(0, 1, At, B1); PG8_BAR;
            PG8_LDA(At, 1, 1); PG8_STAGE(PG8_SA(1, 0), a3, voffA);
            PG8_BAR; PG8_WAIT_L(0); PG8_MMA(1, 0, At, B0); PG8_BAR; PG8_SCHED;
            PG8_STAGE(PG8_SB(1, 1), b3 + hstep, voffB);
            PG8_WAIT_V(6); PG8_BAR; PG8_MMA(1, 1, At, B1); PG8_BAR;
            }
        }
        if constexpr (ALIGN_EPI) { if (wr == 0) PG8_BAR; }
        if constexpr (!Epi::AFTER_DRAIN) { E(acc, cur, wr, wc, fr, fq); S.done(cur); }
        if (!has_next) break;
#pragma unroll
        for (int a = 0; a < 2; ++a)
#pragma unroll
            for (int b = 0; b < 2; ++b)
#pragma unroll
                for (int m = 0; m < 4; ++m)
#pragma unroll
                    for (int n = 0; n < 2; ++n) acc[a][b][m][n] = (f32x4){0.f, 0.f, 0.f, 0.f};
        cur = nxt; cA = nA; cB = nB; ++ui;
        if constexpr (ALIGN_EPI) { if (wr == 1) PG8_BAR; }
    }
    PG8_WAIT_V(0);
    if constexpr (!ALIGN_EPI) { if (wr == 0) PG8_BAR; }
    PG8_BAR;
    if constexpr (Epi::AFTER_DRAIN) { E.fused(acc, cur, wr, wc, fr, fq, lds, wid, lane); S.done(cur); }
#undef PG8_SA
#undef PG8_SB
#undef PG8_STAGE
#undef PG8_LDA
#undef PG8_LDB
#undef PG8_MMA
#undef PG8_WAIT_V
#undef PG8_WAIT_L
#undef PG8_BAR
#undef PG8_SCHED
}
}
#ifndef FX_REPEAT_KIND
#define FX_REPEAT_KIND 0
#endif
#define REP(kind) for (int rep_ = 0; rep_ < ((FX_REPEAT_KIND == (kind)) ? 2 : 1); ++rep_)
namespace fx {
#define DI __device__ __forceinline__
#define LAS __attribute__((address_space(3)))
typedef unsigned short bf16_t;
typedef short bf16x8 __attribute__((ext_vector_type(8)));
typedef short s16x4 __attribute__((ext_vector_type(4)));
typedef float f32x4 __attribute__((ext_vector_type(4)));
typedef float f32x16 __attribute__((ext_vector_type(16)));
typedef unsigned u32x4 __attribute__((ext_vector_type(4)));
typedef unsigned u32x2 __attribute__((ext_vector_type(2)));
constexpr int B = 8, S = 2048, D = 1024, T = B * S, FF = 4096, HYIN = 1848, UW = 2048;
constexpr float EPS = 1e-6f, LOG2E = 1.4426950408889634f;
constexpr int NW = 8, NT = 512;
constexpr size_t MiB = 1u << 20;
constexpr size_t WS_CTL = 0;
constexpr size_t WS_MOD = 1 * MiB;
constexpr size_t WS_CS8 = 2 * MiB;
constexpr size_t WS_CS16 = 3 * MiB;
constexpr size_t WS_MISC = 5 * MiB;
constexpr size_t WS_W = 6 * MiB;
constexpr size_t W_EVEN = 9 * MiB, W_ODD = 8 * MiB, W_MLP = 16 * MiB;
constexpr size_t WE_IN = 0, WE_OUT = 4 * MiB, WE_UP = 6 * MiB, WE_C1 = 7 * MiB, WE_C2 = 8 * MiB;
constexpr size_t WO_QKV = 0, WO_O = 6 * MiB;
constexpr size_t WS_WEVEN = WS_W, WS_WODD = WS_W + 2 * W_EVEN, WS_WMLP = WS_WODD + 2 * W_ODD;
constexpr size_t WS_XN = 104 * MiB;
constexpr size_t WS_YC = 136 * MiB;
constexpr size_t WS_BIG = 168 * MiB;
constexpr size_t BIG_U = 0, BIG_UP = 64 * MiB + 64 * 1024;
constexpr int UPW = 1792;
constexpr size_t WS_FAST_END = 296 * MiB;
constexpr size_t WS_SS = 128 * 1024;
constexpr size_t WS_SHW = 296 * MiB;
constexpr size_t WS_NAIVE = 300 * MiB;
constexpr int LDS_MISC = 131072, LDS_BYTES = 147456;

DI unsigned f2bf(float f) { unsigned u = __builtin_bit_cast(unsigned, f); return (u + 0x7fffu + ((u >> 16) & 1u)) >> 16; }
DI unsigned pk2(float lo, float hi) { return f2bf(lo) | (f2bf(hi) << 16); }
DI float bf2f(unsigned short b) { return __builtin_bit_cast(float, (unsigned)b << 16); }
DI float bflo(unsigned u) { return __builtin_bit_cast(float, u << 16); }
DI float bfhi(unsigned u) { return __builtin_bit_cast(float, u & 0xffff0000u); }
typedef short v4i16_t_ __attribute__((ext_vector_type(4)));
DI s16x4 vtr(const LAS char* p) { return __builtin_bit_cast(s16x4, __builtin_amdgcn_ds_read_tr16_b64_v4i16((LAS v4i16_t_*)p)); }
template <int O> DI float swz(float v) { static_assert(O < 32, "swz: xor mask < 32"); return __builtin_bit_cast(float, __builtin_amdgcn_ds_swizzle(__builtin_bit_cast(int, v), (O << 10) | 0x1f)); }
template <int O> DI unsigned swzu(unsigned v) { return (unsigned)__builtin_amdgcn_ds_swizzle((int)v, (O << 10) | 0x1f); }
DI void xchg32(unsigned& a, unsigned& b) { asm volatile("s_nop 1\n\tv_permlane32_swap_b32 %0, %1\n\ts_nop 1" : "+v"(a), "+v"(b)); }
DI float sum32(float v) { unsigned a = __builtin_bit_cast(unsigned, v), b = a; xchg32(a, b); return __builtin_bit_cast(float, a) + __builtin_bit_cast(float, b); }
DI float max32(float v) { unsigned a = __builtin_bit_cast(unsigned, v), b = a; xchg32(a, b); return fmaxf(__builtin_bit_cast(float, a), __builtin_bit_cast(float, b)); }
DI unsigned or32(unsigned v) { unsigned a = v, b = v; xchg32(a, b); return a | b; }
#ifdef DBG_SHFL
DI float wave_sum(float v) { for (int o = 1; o < 64; o <<= 1) v += __shfl_xor(v, o); return v; }
#else
DI float wave_sum(float v) { v += swz<1>(v); v += swz<2>(v); v += swz<4>(v); v += swz<8>(v); v += swz<16>(v); return sum32(v); }
#endif

struct Args { const float* in[28]; const int* pos; float* out; unsigned char* ws; int ph_lo, ph_hi; int use_cg; int pad; };
typedef const __attribute__((address_space(4))) Args CArgs;
#define XB_TMO      128
#define XB_XCNT(j)  (256  + 64 * (j))
#define XB_XSUB(j)  (1280 + 64 * (j))
#define XB_XGEN(j)  (2304 + 64 * (j))
#define XB_TOP      3328
#define XB_TOPGEN   3392
#define XCD_BAR_WORDS 3456
#define XB_SPIN_CAP (1u << 20)
DI unsigned xb_ld(unsigned* p)              { return __hip_atomic_load(p, __ATOMIC_RELAXED, __HIP_MEMORY_SCOPE_AGENT); }
DI unsigned xb_add(unsigned* p, unsigned v) { return __hip_atomic_fetch_add(p, v, __ATOMIC_RELAXED, __HIP_MEMORY_SCOPE_AGENT); }
DI unsigned xb_xcc_id() { return (unsigned)__builtin_amdgcn_s_getreg((3 << 11) | 20) & 0xFu; }
#define XB_SPIN(cond, bar) do { unsigned _sp = 0; while (cond) { __builtin_amdgcn_s_sleep(1); \
    if ((++_sp & 255u) == 0u) { if (xb_ld(&(bar)[XB_TMO])) break; if (_sp > XB_SPIN_CAP) { atomicAdd(&(bar)[XB_TMO], 1u); break; } } } } while (0)
struct XcdBarrier { unsigned* bar; unsigned x; volatile LAS unsigned* st; };
DI XcdBarrier xcd_barrier_post(unsigned* bar, volatile LAS unsigned* st) {
    XcdBarrier b; b.bar = bar; b.x = xb_xcc_id(); b.st = st;
    if (threadIdx.x == 0) (void)xb_add(&bar[XB_XCNT(b.x)], 1u);
    return b;
}
DI void xcd_barrier_complete(unsigned* bar, unsigned x, unsigned& nloc, unsigned& nx) {
    const unsigned G = gridDim.x * gridDim.y * gridDim.z;
    unsigned sum, cnt, mine, sp = 0u;
    for (;;) {
        sum = 0u; cnt = 0u; mine = 0u;
#pragma unroll
        for (unsigned j = 0; j < 16; ++j) { const unsigned c = xb_ld(&bar[XB_XCNT(j)]); sum += c; cnt += (c > 0u) ? 1u : 0u; mine = (j == x) ? c : mine; }
        if (sum == G) break;
        __builtin_amdgcn_s_sleep(1);
        if ((++sp & 255u) == 0u) { if (xb_ld(&bar[XB_TMO])) break; if (sp > XB_SPIN_CAP) { atomicAdd(&bar[XB_TMO], 1u); break; } }
    }
    nloc = mine > 0u ? mine : 1u; nx = cnt > 0u ? cnt : 1u;
}
DI void xcd_barrier(const XcdBarrier& b) {
    asm volatile("s_waitcnt vmcnt(0)" ::: "memory");
    __syncthreads();
    int t0_ = threadIdx.x; asm volatile("" : "+v"(t0_));
    if (t0_ == 0) {
        unsigned* bar; { CArgs* p_ = (CArgs*)__builtin_amdgcn_kernarg_segment_ptr(); asm volatile("" : "+s"(p_)); bar = (unsigned*)(p_->ws + WS_CTL) + 4096; }
        __builtin_amdgcn_s_waitcnt(0);
        unsigned nloc = b.st[0], nx = b.st[1];
        unsigned bx = b.x; asm volatile("" : "+s"(bx));
        if (nloc == 0u) { xcd_barrier_complete(bar, bx, nloc, nx); b.st[0] = nloc; b.st[1] = nx; }
        const unsigned old = xb_add(&bar[XB_XSUB(bx)], 1u);
        const unsigned gen = old / nloc;
        if (old + 1u == (gen + 1u) * nloc) {
            __builtin_amdgcn_fence(__ATOMIC_RELEASE, "agent");
            asm volatile("s_waitcnt vmcnt(0)" ::: "memory");
            const unsigned og = xb_add(&bar[XB_TOP], 1u);
            const unsigned tg = og / nx;
            if (og + 1u == (tg + 1u) * nx) xb_add(&bar[XB_TOPGEN], 1u);
            else XB_SPIN(xb_ld(&bar[XB_TOPGEN]) == tg, bar);
            __builtin_amdgcn_fence(__ATOMIC_ACQUIRE, "agent");
            xb_add(&bar[XB_XGEN(bx)], 1u);
            asm volatile("s_waitcnt vmcnt(0)" ::: "memory");
        } else {
            XB_SPIN(xb_ld(&bar[XB_XGEN(bx)]) == gen, bar);
            __builtin_amdgcn_fence(__ATOMIC_ACQUIRE, "agent");
            asm volatile("s_waitcnt vmcnt(0)" ::: "memory");
        }
    }
    __syncthreads();
}

struct Ctx {
    LAS unsigned char* lds; int tid, lane, wave, G, bid; unsigned char* ws; int var; CArgs* a;
};
#define RELAUNDER(c) do { int t_ = threadIdx.x; asm volatile("" : "+v"(t_)); (c).tid = t_; (c).lane = t_ & 63; int b_ = blockIdx.x, g_ = gridDim.x; asm volatile("" : "+s"(b_), "+s"(g_)); (c).bid = b_; (c).G = g_; } while (0)

DI void transpose_item(const float* W, int ld, int K, int N, int Npad, bf16_t* WT, const float* kscale, LAS char* scr, int item, int nblk, int lane) {
    constexpr int RS = 288;
    const int kb = item / nblk, nb0 = item % nblk, k0 = 32 * kb, n0 = 128 * nb0;
    const int kr = lane >> 5, nq = lane & 31, n = n0 + 4 * nq;
    f32x4 tv[16];
#pragma unroll
    for (int i = 0; i < 16; ++i) { tv[i] = (f32x4){0.f, 0.f, 0.f, 0.f}; if (n < N) tv[i] = *(const f32x4*)(W + (size_t)(k0 + 2 * i + kr) * ld + n); }
#pragma unroll
    for (int i = 0; i < 16; ++i) { f32x4 v = tv[i]; if (kscale) v = v * kscale[k0 + 2 * i + kr];
        u32x2 w; w.x = pk2(v.x, v.y); w.y = pk2(v.z, v.w); *(LAS u32x2*)(scr + (2 * i + kr) * RS + nq * 8) = w; }
    const int g = lane >> 4, i16 = lane & 15, q = i16 >> 2, p = i16 & 3;
    const LAS char* rb = scr + (8 * g + q) * RS + 8 * p;
#pragma unroll
    for (int nb = 0; nb < 8; ++nb) { const s16x4 lo = vtr(rb + nb * 32), hi = vtr(rb + 4 * RS + nb * 32);
        const int nn = n0 + nb * 16 + i16;
        if (nn < Npad) *(bf16x8*)(WT + (size_t)nn * K + k0 + 8 * g) = __builtin_shufflevector(lo, hi, 0, 1, 2, 3, 4, 5, 6, 7); }
    asm volatile("s_waitcnt lgkmcnt(0)" ::: "memory");
}
struct MatDesc { const float* src; int ld, K, N, Npad; bf16_t* dst; const float* kscale; };
DI MatDesc get_mat(CArgs& a, unsigned char* ws, int idx) {
    MatDesc m; m.kscale = nullptr;
    if (idx < 16) { const int j = idx >> 3, t = idx & 7; unsigned char* base = ws + WS_WEVEN + j * W_EVEN;
        if (t == 0) { m.src = a.in[9] + (size_t)j * D * HYIN; m.ld = HYIN; m.K = D; m.N = HYIN; m.Npad = UW; m.dst = (bf16_t*)(base + WE_IN); }
        else if (t == 1) { m.src = a.in[10] + (size_t)j * D * D; m.ld = D; m.K = D; m.N = D; m.Npad = D; m.dst = (bf16_t*)(base + WE_OUT); }
        else if (t == 2) { m.src = a.in[12] + (size_t)j * 256 * 768; m.ld = 768; m.K = 256; m.N = 768; m.Npad = 768; m.dst = (bf16_t*)(base + WE_UP); m.kscale = a.in[11] + j * 256; }
        else if (t == 3) { m.src = a.in[14] + (size_t)j * 256 * 1024; m.ld = 1024; m.K = 256; m.N = 1024; m.Npad = 1024; m.dst = (bf16_t*)(base + WE_UP) + 768 * 256; m.kscale = a.in[13] + j * 256; }
        else if (t < 6) { const int jj = t - 4; m.src = a.in[20] + ((size_t)j * 2 + jj) * 2048 * 128; m.ld = 128; m.K = 2048; m.N = 128; m.Npad = 128; m.dst = (bf16_t*)(base + WE_C1) + (size_t)jj * 128 * 2048; }
        else { const int jj = t - 6; m.src = a.in[21] + ((size_t)j * 2 + jj) * 128 * 64; m.ld = 64; m.K = 128; m.N = 64; m.Npad = 64; m.dst = (bf16_t*)(base + WE_C2) + (size_t)jj * 64 * 128; }
    } else if (idx < 20) { const int j = (idx - 16) >> 1, t = idx & 1; unsigned char* base = ws + WS_WODD + j * W_ODD;
        if (t == 0) { m.src = a.in[22] + (size_t)j * D * 3072; m.ld = 3072; m.K = D; m.N = 3072; m.Npad = 3072; m.dst = (bf16_t*)(base + WO_QKV); }
        else { m.src = a.in[23] + (size_t)j * D * D; m.ld = D; m.K = D; m.N = D; m.Npad = D; m.dst = (bf16_t*)(base + WO_O); }
    } else { const int i = (idx - 20) >> 1, t = idx & 1; unsigned char* base = ws + WS_WMLP + i * W_MLP;
        if (t == 0) { m.src = a.in[7] + (size_t)i * D * FF; m.ld = FF; m.K = D; m.N = FF; m.Npad = FF; m.dst = (bf16_t*)base; }
        else { m.src = a.in[8] + (size_t)i * FF * D; m.ld = D; m.K = FF; m.N = D; m.Npad = D; m.dst = (bf16_t*)(base + 8 * MiB); }
    }
    return m;
}
DI void phase_prologue(Ctx& c) {
    CArgs& a = *c.a; unsigned char* ws = c.ws;
    const int gw = c.bid * NW + c.wave, NGW = c.G * NW;
    LAS float* cond = (LAS float*)(c.lds + 98304);
    for (int i = c.tid; i < 8192; i += NT) { float v = a.in[1][i]; cond[i] = v / (1.f + __expf(-v)); }
    __syncthreads();
    float* mod = (float*)(ws + WS_MOD);
    LAS float* red = (LAS float*)c.lds;
    REP(18) for (int it = c.bid; it < 384; it += c.G) {
        const int n = it * 64 + c.lane; const int li = n / 6144, nn = n % 6144;
        const float* w = a.in[3] + (size_t)li * D * 6144 + (size_t)(c.wave * 128) * 6144 + nn; float acc[8] = {0, 0, 0, 0, 0, 0, 0, 0};
#pragma unroll 32
        for (int k = 0; k < 128; ++k) { const float wv = w[(size_t)k * 6144];
#pragma unroll
            for (int b = 0; b < 8; ++b) acc[b] += cond[b * D + c.wave * 128 + k] * wv; }
#pragma unroll
        for (int b = 0; b < 8; ++b) red[(c.wave * 8 + b) * 64 + c.lane] = acc[b];
        __syncthreads();
        { const int b = c.wave; float s = 0.f;
#pragma unroll
          for (int ww = 0; ww < 8; ++ww) s += red[(ww * 8 + b) * 64 + c.lane];
          mod[((size_t)li * 8 + b) * 6144 + nn] = s + a.in[4][li * 6144 + nn]; }
        __syncthreads();
    }
    { float* P = (float*)(ws + WS_MISC);
      for (int it = gw; it < 256; it += NGW) { const int jj2 = it >> 6, kc = (it >> 1) & 31, n = (it & 1) * 64 + c.lane;
          const float* cp = a.in[19] + (size_t)jj2 * 2048 + kc * 64; const float* w = a.in[20] + (size_t)jj2 * 2048 * 128 + (size_t)(kc * 64) * 128 + n; float acc = 0.f;
#pragma unroll 16
          for (int k = 0; k < 64; ++k) acc += cp[k] * w[(size_t)k * 128];
          P[(jj2 * 32 + kc) * 128 + n] = acc; } }
    { f32x4* z = (f32x4*)(ws + WS_SS); for (int i = c.bid * NT + c.tid; i < 8 * T / 4; i += c.G * NT) z[i] = (f32x4){0.f, 0.f, 0.f, 0.f}; }
    LAS char* scr = (LAS char*)(c.lds + c.wave * 9216);
    REP(16) { int base = 0;
    for (int mi = 0; mi < 28; ++mi) {
        const MatDesc m = get_mat(a, ws, mi); const int nblk = (m.Npad + 127) / 128, nit = (m.K / 32) * nblk;
        for (int it = (gw + NGW - (base % NGW)) % NGW; it < nit; it += NGW) transpose_item(m.src, m.ld, m.K, m.N, m.Npad, m.dst, m.kscale, scr, it, nblk, c.lane);
        base += nit;
    } }
    { float* cs8 = (float*)(ws + WS_CS8); float* cs16 = (float*)(ws + WS_CS16);
      REP(17) for (int g = c.bid * NT + c.tid; g < T * 24; g += c.G * NT) { const int m = g / 24, i = g % 24; const double p = (double)a.pos[m];
          if (i < 8) { const double f = pow(500000.0, -(double)i / 8.0), an = p * f; cs8[(m * 8 + i) * 2] = (float)cos(an); cs8[(m * 8 + i) * 2 + 1] = (float)sin(an); }
          else { const int k = i - 8; const double f = pow(500000.0, -(double)k / 16.0), an = p * f; cs16[(m * 16 + k) * 2] = (float)cos(an); cs16[(m * 16 + k) * 2 + 1] = (float)sin(an); } } }
}

DI void shw_items(Ctx& c) {
    unsigned char* ws = c.ws; const int gw = c.bid * NW + c.wave, NGW = c.G * NW, lane = c.lane, r16 = lane & 15, q4 = lane >> 4;
    for (int it = gw; it < 1536; it += NGW) {
        int g, r = it;
        if (r < 256) g = 1; else if ((r -= 256) < 192) g = 2; else if ((r -= 192) < 256) g = 3; else if ((r -= 256) < 128) g = 4; else if ((r -= 128) < 256) g = 5; else if ((r -= 256) < 192) g = 6; else { r -= 192; g = 7; }
        const int layer = g >> 1, sub = g & 1;
        const bf16_t* Wt = sub ? (const bf16_t*)(ws + WS_WMLP + (size_t)layer * W_MLP) : ((layer & 1) ? (const bf16_t*)(ws + WS_WODD + (size_t)(layer >> 1) * W_ODD + WO_QKV) : (const bf16_t*)(ws + WS_WEVEN + (size_t)(layer >> 1) * W_EVEN + WE_IN));
        const float* sh = (const float*)(ws + WS_MOD) + (size_t)layer * 8 * 6144 + (sub ? 3072 : 0) + (size_t)(r16 & 7) * 6144 + 8 * q4;
        const bf16_t* wr = Wt + (size_t)(r * 16 + r16) * D + 8 * q4;
        f32x4 acc = (f32x4){0.f, 0.f, 0.f, 0.f};
#pragma unroll 8
        for (int ks = 0; ks < 32; ++ks) {
            const bf16x8 af = *(const bf16x8*)(wr + 32 * ks);
            const f32x4 s0 = *(const f32x4*)(sh + 32 * ks), s1 = *(const f32x4*)(sh + 32 * ks + 4);
            u32x4 bw; bw.x = pk2(s0.x, s0.y); bw.y = pk2(s0.z, s0.w); bw.z = pk2(s1.x, s1.y); bw.w = pk2(s1.z, s1.w);
            if (r16 >= 8) bw = (u32x4){0u, 0u, 0u, 0u};
            acc = __builtin_amdgcn_mfma_f32_16x16x32_bf16(af, __builtin_bit_cast(bf16x8, bw), acc, 0, 0, 0);
        }
        if (r16 < 8) { float* o = (float*)(ws + WS_SHW) + (size_t)g * 8 * 4096 + (size_t)r16 * 4096 + r * 16 + q4 * 4; *(f32x4*)o = acc; }
    }
}
DI void phase_modnorm(Ctx& c, const float* x, const float* gain, const float* sh, const float* sc, bf16_t* XN) {
    const int gw = c.bid * NW + c.wave, NGW = c.G * NW;
    for (int m = gw; m < T; m += NGW) {
        const int b = m >> 11; const f32x4* xr = (const f32x4*)(x + (size_t)m * D) + c.lane; f32x4 v[4]; float s = 0.f;
#pragma unroll
        for (int j = 0; j < 4; ++j) { v[j] = xr[64 * j]; s += (v[j].x * v[j].x + v[j].y * v[j].y) + (v[j].z * v[j].z + v[j].w * v[j].w); }
        const float rs = rsqrtf(wave_sum(s) * (1.f / D) + EPS);
#pragma unroll
        for (int j = 0; j < 4; ++j) { const int n = 4 * c.lane + 256 * j; const f32x4 g = *(const f32x4*)(gain + n), sv = *(const f32x4*)(sc + b * 6144 + n), hv = *(const f32x4*)(sh + b * 6144 + n);
            f32x4 y; y.x = v[j].x * rs * g.x * (1.f + sv.x) + hv.x; y.y = v[j].y * rs * g.y * (1.f + sv.y) + hv.y; y.z = v[j].z * rs * g.z * (1.f + sv.z) + hv.z; y.w = v[j].w * rs * g.w * (1.f + sv.w) + hv.w;
            u32x2 o; o.x = pk2(y.x, y.y); o.y = pk2(y.z, y.w); *(u32x2*)(XN + (size_t)m * D + n) = o; }
    }
}
constexpr int TB = 8;
constexpr int TBV = 4;
DI void head64_vec(bf16_t* const (&p)[TBV], bool act, const float* gain, const float* const (&tab)[TBV], float scale, int lane) {
    const int sub = lane & 7; float x[TBV][8], ss[TBV];
#pragma unroll
    for (int t = 0; t < TBV; ++t) { u32x4 v = (u32x4){0u, 0u, 0u, 0u}; if (act) v = *(const u32x4*)p[t];
        x[t][0] = bflo(v.x); x[t][1] = bfhi(v.x); x[t][2] = bflo(v.y); x[t][3] = bfhi(v.y); x[t][4] = bflo(v.z); x[t][5] = bfhi(v.z); x[t][6] = bflo(v.w); x[t][7] = bfhi(v.w); }
#pragma unroll
    for (int t = 0; t < TBV; ++t) { float s = 0.f;
#pragma unroll
        for (int e = 0; e < 8; ++e) s += x[t][e] * x[t][e];
        ss[t] = s; }
#pragma unroll
    for (int t = 0; t < TBV; ++t) ss[t] += swz<1>(ss[t]);
#pragma unroll
    for (int t = 0; t < TBV; ++t) ss[t] += swz<2>(ss[t]);
#pragma unroll
    for (int t = 0; t < TBV; ++t) ss[t] += swz<4>(ss[t]);
    const f32x4 ga = *(const f32x4*)(gain + 8 * sub), gb = *(const f32x4*)(gain + 8 * sub + 4);
    const float g[8] = {ga.x, ga.y, ga.z, ga.w, gb.x, gb.y, gb.z, gb.w};
#pragma unroll
    for (int t = 0; t < TBV; ++t) { const float rs = rsqrtf(ss[t] * (1.f / 64.f) + EPS);
        float y[8], o[8];
#pragma unroll
        for (int e = 0; e < 8; ++e) { y[e] = x[t][e] * rs * g[e]; o[e] = swz<1>(y[e]); }
        if (sub < 2) {
            const f32x4 t0 = *(const f32x4*)(tab[t]), t1 = *(const f32x4*)(tab[t] + 4), t2 = *(const f32x4*)(tab[t] + 8), t3 = *(const f32x4*)(tab[t] + 12);
            const float cs[8] = {t0.x, t0.z, t1.x, t1.z, t2.x, t2.z, t3.x, t3.z}, sn[8] = {t0.y, t0.w, t1.y, t1.w, t2.y, t2.w, t3.y, t3.w};
#pragma unroll
            for (int e = 0; e < 8; ++e) y[e] = sub == 0 ? y[e] * cs[e] - o[e] * sn[e] : o[e] * sn[e] + y[e] * cs[e];
        }
        u32x4 w; w.x = pk2(y[0] * scale, y[1] * scale); w.y = pk2(y[2] * scale, y[3] * scale); w.z = pk2(y[4] * scale, y[5] * scale); w.w = pk2(y[6] * scale, y[7] * scale);
        if (act) *(u32x4*)p[t] = w; }
}
DI void nsa_finalize_rows(Ctx& c, bf16_t* U, int m0, int mstride, int j) {
    CArgs& a = *c.a; const float* qg = a.in[17] + j * 64; const float* kg = a.in[18] + j * 192; const int lane = c.lane;
    bf16_t* p[TBV]; const float* tab[TBV];
#pragma unroll
    for (int t = 0; t < TBV; ++t) { const int m = m0 + t * mstride; p[t] = U + (size_t)m * UW + 544 + 8 * lane; tab[t] = (const float*)(c.ws + WS_CS8) + (size_t)m * 16; }
    head64_vec(p, true, qg, tab, 0.125f * LOG2E, lane);
#pragma unroll
    for (int t = 0; t < TBV; ++t) { const int m = m0 + t * mstride; p[t] = U + (size_t)m * UW + (lane < 16 ? 1312 + 8 * lane : 1568 + 8 * (lane & 15)); }
    head64_vec(p, lane < 32, lane < 16 ? kg + 64 : kg + 128, tab, 1.f, lane);
}
DI void diff_finalize_rows(Ctx& c, bf16_t* QKV, int m0, int mstride, int j) {
    CArgs& a = *c.a; const float* qg = a.in[24] + j * 64; const float* kg = a.in[25] + j * 64; const int lane = c.lane;
    bf16_t* p[TBV]; const float* tab[TBV];
#pragma unroll 1
    for (int ch = 0; ch < 4; ++ch) {
#pragma unroll
        for (int t = 0; t < TBV; ++t) { const int m = m0 + t * mstride; p[t] = QKV + (size_t)m * 3072 + 512 * ch + 8 * lane; tab[t] = (const float*)(c.ws + WS_CS8) + (size_t)m * 16; }
        head64_vec(p, true, ch < 2 ? qg : kg, tab, ch < 2 ? 0.125f * LOG2E : 1.f, lane);
    }
}
DI void unpack8(const u32x4 v, float (&x)[8]) { x[0] = bflo(v.x); x[1] = bfhi(v.x); x[2] = bflo(v.y); x[3] = bfhi(v.y); x[4] = bflo(v.z); x[5] = bfhi(v.z); x[6] = bflo(v.w); x[7] = bfhi(v.w); }
DI float sumsq8(const float (&x)[8]) { return ((x[0] * x[0] + x[1] * x[1]) + (x[2] * x[2] + x[3] * x[3])) + ((x[4] * x[4] + x[5] * x[5]) + (x[6] * x[6] + x[7] * x[7])); }
DI u32x4 mla_chunk(const float (&x)[8], float ss, const float* g96, const float* tab, int ci, float scale) {
    const float rs = rsqrtf(ss * (1.f / 96.f) + EPS);
    const f32x4 ga = *(const f32x4*)(g96 + 8 * ci), gb = *(const f32x4*)(g96 + 8 * ci + 4);
    float y[8] = {x[0] * rs * ga.x, x[1] * rs * ga.y, x[2] * rs * ga.z, x[3] * rs * ga.w, x[4] * rs * gb.x, x[5] * rs * gb.y, x[6] * rs * gb.z, x[7] * rs * gb.w};
    float o[8];
#pragma unroll
    for (int e = 0; e < 8; ++e) o[e] = swz<2>(y[e]);
    if (ci < 4) { const float* tp = tab + 16 * (ci & 1);
        const f32x4 t0 = *(const f32x4*)tp, t1 = *(const f32x4*)(tp + 4), t2 = *(const f32x4*)(tp + 8), t3 = *(const f32x4*)(tp + 12);
        const float cs[8] = {t0.x, t0.z, t1.x, t1.z, t2.x, t2.z, t3.x, t3.z}, sn[8] = {t0.y, t0.w, t1.y, t1.w, t2.y, t2.w, t3.y, t3.w};
#pragma unroll
        for (int e = 0; e < 8; ++e) y[e] = ci < 2 ? y[e] * cs[e] - o[e] * sn[e] : o[e] * sn[e] + y[e] * cs[e]; }
    u32x4 w; w.x = pk2(y[0] * scale, y[1] * scale); w.y = pk2(y[2] * scale, y[3] * scale); w.z = pk2(y[4] * scale, y[5] * scale); w.w = pk2(y[6] * scale, y[7] * scale);
    return w;
}
DI float head_ss(const LAS float* tbl, int h) { const f32x4 a = *(const LAS f32x4*)(tbl + 12 * h), b = *(const LAS f32x4*)(tbl + 12 * h + 4), cc = *(const LAS f32x4*)(tbl + 12 * h + 8); return ((a.x + a.y) + (a.z + a.w)) + ((b.x + b.y) + (b.z + b.w)) + ((cc.x + cc.y) + (cc.z + cc.w)); }
DI void mla_finalize_rows(Ctx& c, const bf16_t* U, bf16_t* QL, bf16_t* KVU, bf16_t* KF, int m0, int mstride, int j) {
    CArgs& a = *c.a; const int lane = c.lane;
    const float* qg = a.in[15] + j * 96; const float* kg = a.in[16] + j * 96;
    LAS float* tbl = (LAS float*)(c.lds + c.wave * 4096);
    const int cA = lane, hA = cA / 12, ciA = cA % 12, cB = 64 + (lane & 31), hB = cB / 12, ciB = cB % 12; const bool actB = lane < 32;
    const float qscale = 0.10206207261596577f * LOG2E;
    float xqA[TBV][8], xqB[TBV][8], xkA[TBV][8], xkB[TBV][8], rskv[TBV]; int mrow[TBV];
#pragma unroll
    for (int t = 0; t < TBV; ++t) { const int m = m0 + t * mstride; mrow[t] = m; const bf16_t* urow = U + (size_t)m * UW;
        float lx[8]; unpack8(*(const u32x4*)(urow + 8 * lane), lx); float sl = sumsq8(lx);
        sl += swz<1>(sl); sl += swz<2>(sl); sl += swz<4>(sl); sl += swz<8>(sl); sl += swz<16>(sl);
        const float rsq = rsqrtf(__builtin_bit_cast(float, __builtin_amdgcn_readlane(__builtin_bit_cast(int, sl), 0)) * (1.f / 256.f) + EPS);
        rskv[t] = rsqrtf(__builtin_bit_cast(float, __builtin_amdgcn_readlane(__builtin_bit_cast(int, sl), 32)) * (1.f / 256.f) + EPS);
        { const bf16_t* q = QL + (size_t)m * UPW; unpack8(*(const u32x4*)(q + 8 * cA), xqA[t]); u32x4 vb = (u32x4){0u, 0u, 0u, 0u}; if (actB) vb = *(const u32x4*)(q + 8 * cB); unpack8(vb, xqB[t]);
#pragma unroll
          for (int e = 0; e < 8; ++e) { xqA[t][e] *= rsq; xqB[t][e] *= rsq; }
          tbl[t * 192 + cA] = sumsq8(xqA[t]); if (actB) tbl[t * 192 + cB] = sumsq8(xqB[t]); }
        { const bf16_t* kn = KVU + (size_t)m * UPW;
          unpack8(*(const u32x4*)(ciA < 4 ? urow + 512 + 8 * ciA : kn + 128 * hA + 8 * (ciA - 4)), xkA[t]);
          u32x4 vb = (u32x4){0u, 0u, 0u, 0u}; if (actB) vb = *(const u32x4*)(ciB < 4 ? urow + 512 + 8 * ciB : kn + 128 * hB + 8 * (ciB - 4)); unpack8(vb, xkB[t]);
          const float fa = ciA < 4 ? 1.f : rskv[t], fb = ciB < 4 ? 1.f : rskv[t];
#pragma unroll
          for (int e = 0; e < 8; ++e) { xkA[t][e] *= fa; xkB[t][e] *= fb; }
          tbl[t * 192 + 96 + cA] = sumsq8(xkA[t]); if (actB) tbl[t * 192 + 96 + cB] = sumsq8(xkB[t]); }
    }
#pragma unroll
    for (int t = 0; t < TBV; ++t) { const int m = mrow[t]; const float* tab = (const float*)(c.ws + WS_CS16) + (size_t)m * 32;
        { bf16_t* q = QL + (size_t)m * UPW;
          const u32x4 wA = mla_chunk(xqA[t], head_ss(tbl + t * 192, hA), qg, tab, ciA, qscale); const u32x4 wB = mla_chunk(xqB[t], head_ss(tbl + t * 192, hB), qg, tab, ciB, qscale);
          *(u32x4*)(q + 8 * cA) = wA; if (actB) *(u32x4*)(q + 8 * cB) = wB; }
        { bf16_t* k = KF + (size_t)m * 768;
          const u32x4 wA = mla_chunk(xkA[t], head_ss(tbl + t * 192 + 96, hA), kg, tab, ciA, 1.f); const u32x4 wB = mla_chunk(xkB[t], head_ss(tbl + t * 192 + 96, hB), kg, tab, ciB, 1.f);
          *(u32x4*)(k + 8 * cA) = wA; if (actB) *(u32x4*)(k + 8 * cB) = wB; }
        { bf16_t* v = KVU + (size_t)m * UPW + 128 * (lane >> 3) + 64 + 8 * (lane & 7); float xv[8]; unpack8(*(const u32x4*)v, xv); const float f = rskv[t];
          u32x4 w; w.x = pk2(xv[0] * f, xv[1] * f); w.y = pk2(xv[2] * f, xv[3] * f); w.z = pk2(xv[4] * f, xv[5] * f); w.w = pk2(xv[6] * f, xv[7] * f); *(u32x4*)v = w; }
    }
}

DI float gelu_tanh(float x) { const float u = 0.7978845608028654f * (x + 0.044715f * x * x * x); const float e = __expf(2.f * u); const float t = 1.f - 2.f / (e + 1.f); return 0.5f * x * (1.f + t); }
DI void compress_item(Ctx& c, const bf16_t* U, int j, int it) {
    RELAUNDER(c);
    CArgs& a = *c.a; const int lane = c.lane, w = c.wave, tid = c.tid;
    const int jj = it >> 7, bg = (it >> 3) & 15, chunk = it & 7, b = bg >> 1, g = bg & 1, c0 = 16 * chunk;
    const bf16_t* W1t = (const bf16_t*)(c.ws + WS_WEVEN + j * W_EVEN + WE_C1) + (size_t)jj * 128 * 2048;
    const bf16_t* W2t = (const bf16_t*)(c.ws + WS_WEVEN + j * W_EVEN + WE_C2) + (size_t)jj * 64 * 128;
    const float* biasP = (const float*)(c.ws + WS_MISC) + (size_t)(j * 2 + jj) * 32 * 128;
    LAS float* part = (LAS float*)c.lds;
    LAS bf16_t* hid = (LAS bf16_t*)(c.lds + 65536);
    LAS float* outl = (LAS float*)(c.lds + 65536 + 8192);
    const int r16 = lane & 15, q4 = lane >> 4;
    f32x4 acc[8];
#pragma unroll
    for (int n = 0; n < 8; ++n) acc[n] = (f32x4){0.f, 0.f, 0.f, 0.f};
    const bf16_t* arow = U + ((size_t)b * S + 16 * (c0 + r16)) * UW + 1056 + jj * 128 + g * 64 + q4 * 8;
#pragma unroll 2
    for (int ks = 8 * w; ks < 8 * w + 8; ++ks) {
        const bf16x8 af = *(const bf16x8*)(arow + (size_t)(ks >> 1) * UW + (ks & 1) * 32);
#pragma unroll
        for (int n = 0; n < 8; ++n) { const bf16x8 bfr = *(const bf16x8*)(W1t + (size_t)(n * 16 + r16) * 2048 + 32 * ks + q4 * 8);
            acc[n] = __builtin_amdgcn_mfma_f32_16x16x32_bf16(af, bfr, acc[n], 0, 0, 0); }
    }
#pragma unroll
    for (int n = 0; n < 8; ++n)
#pragma unroll
        for (int i = 0; i < 4; ++i) part[(w * 16 + q4 * 4 + i) * 128 + n * 16 + r16] = acc[n][i];
    __syncthreads();
    { const int cc = tid >> 5, n0 = (tid & 31) * 4; float v[4];
#pragma unroll
      for (int e = 0; e < 4; ++e) { float s = 0.f;
#pragma unroll
          for (int ww = 0; ww < 8; ++ww) s += part[(ww * 16 + cc) * 128 + n0 + e];
          v[e] = s; }
      { f32x4 bs = (f32x4){0.f, 0.f, 0.f, 0.f};
#pragma unroll 8
        for (int kc = 0; kc < 32; ++kc) bs += *(const f32x4*)(biasP + kc * 128 + n0);
        v[0] = gelu_tanh(v[0] + bs.x); v[1] = gelu_tanh(v[1] + bs.y); v[2] = gelu_tanh(v[2] + bs.z); v[3] = gelu_tanh(v[3] + bs.w); }
      u32x2 o; o.x = pk2(v[0], v[1]); o.y = pk2(v[2], v[3]); *(LAS u32x2*)(hid + cc * 136 + n0) = o; }
    __syncthreads();
    if (w < 4) {
        f32x4 a2 = (f32x4){0.f, 0.f, 0.f, 0.f};
#pragma unroll
        for (int kst = 0; kst < 4; ++kst) { const bf16x8 af = *(const LAS bf16x8*)(hid + r16 * 136 + 32 * kst + q4 * 8);
            const bf16x8 bfr = *(const bf16x8*)(W2t + (size_t)(w * 16 + r16) * 128 + 32 * kst + q4 * 8);
            a2 = __builtin_amdgcn_mfma_f32_16x16x32_bf16(af, bfr, a2, 0, 0, 0); }
#pragma unroll
        for (int i = 0; i < 4; ++i) outl[(q4 * 4 + i) * 64 + w * 16 + r16] = a2[i];
    }
    __syncthreads();
    if (tid < 256) {
        const int cc = tid >> 4, d0 = (tid & 15) * 4; const int cg = c0 + cc;
        bf16_t* dst = (bf16_t*)(c.ws + WS_MISC + 65536 + (size_t)jj * 262144) + ((size_t)bg * 128 + cg) * 64 + d0;
        float v[4];
#pragma unroll
        for (int e = 0; e < 4; ++e) v[e] = outl[cc * 64 + d0 + e];
        if (jj == 0) {
            float s = (v[0] * v[0] + v[1] * v[1]) + (v[2] * v[2] + v[3] * v[3]);
            s += swz<1>(s); s += swz<2>(s); s += swz<4>(s); s += swz<8>(s);
            const float rs = rsqrtf(s * (1.f / 64.f) + EPS); const float* kg = a.in[18] + j * 192;
            int tok = b * S + 16 * cg + 31; if (tok >= T) tok = T - 1;
            const float* tab = (const float*)(c.ws + WS_CS8) + (size_t)tok * 16;
#pragma unroll
            for (int e = 0; e < 4; ++e) { const int d = d0 + e; float y = v[e] * rs * kg[d];
                if (d < 16) { const float o = outl[cc * 64 + (d ^ 8)] * rs * kg[d ^ 8]; const int i = d & 7; const float cs = tab[2 * i], sn = tab[2 * i + 1]; y = d < 8 ? y * cs - o * sn : o * sn + y * cs; }
                v[e] = y; }
        }
        if (cg == 127) { v[0] = v[1] = v[2] = v[3] = 0.f; }
        u32x2 o; o.x = pk2(v[0], v[1]); o.y = pk2(v[2], v[3]); *(u32x2*)dst = o;
    }
    __syncthreads();
}

DI void lds_add(LAS float* p, float v) { (void)__hip_atomic_fetch_add(p, v, __ATOMIC_RELAXED, __HIP_MEMORY_SCOPE_WORKGROUP); }
DI int crow(int r, int h) { return (r & 3) + 8 * (r >> 2) + 4 * h; }
DI unsigned cvtpk(float lo, float hi) { typedef float f2 __attribute__((ext_vector_type(2))); typedef __bf16 b2 __attribute__((ext_vector_type(2))); f2 v = {lo, hi}; b2 r = __builtin_convertvector(v, b2); return __builtin_bit_cast(unsigned, r); }
template <int DD> struct TileRegs { u32x4 r[(64 * DD / 8 + NT - 1) / NT]; };
template <int DD> DI void tile_load(TileRegs<DD>& t, const bf16_t* g, int ld, int tid) {
    constexpr int CPR = DD / 8, NCH = 64 * CPR, NI = (NCH + NT - 1) / NT;
#pragma unroll
    for (int i = 0; i < NI; ++i) { const int ch = tid + NT * i; if (NCH % NT == 0 || ch < NCH) { const int row = ch / CPR, c8 = ch % CPR; const unsigned eo = (unsigned)row * (unsigned)ld + (unsigned)c8 * 8u; t.r[i] = *(const u32x4*)(g + eo); } }
}
template <int DD> DI void tile_store(const TileRegs<DD>& t, LAS char* buf, int tid) {
    constexpr int CPR = DD / 8, NCH = 64 * CPR, NI = (NCH + NT - 1) / NT, STR = DD * 2 + 16;
#pragma unroll
    for (int i = 0; i < NI; ++i) { const int ch = tid + NT * i; if (NCH % NT == 0 || ch < NCH) { const int row = ch / CPR, c8 = ch % CPR; *(LAS u32x4*)(buf + row * STR + c8 * 16) = t.r[i]; } }
}
template <int DK> DI void qk_tile(const LAS char* Kb, const bf16x8* qf, f32x16& p0, f32x16& p1, int lane) {
    constexpr int KS = DK * 2 + 16, NG = DK / 32; const LAS char* kp = Kb + (lane & 31) * KS + (lane >> 5) * 16;
    bf16x8 kf[2][2][2];
#define QK_LOAD(G_, B_) do { _Pragma("unroll") for (int j_ = 0; j_ < 2; ++j_) { kf[B_][j_][0] = *(const LAS bf16x8*)(kp + (2 * (G_) + j_) * 32); kf[B_][j_][1] = *(const LAS bf16x8*)(kp + 32 * KS + (2 * (G_) + j_) * 32); } } while (0)
    constexpr bool DB = (DK > 64);
    QK_LOAD(0, 0);
#pragma unroll
    for (int r = 0; r < 16; ++r) { p0[r] = 0.f; p1[r] = 0.f; }
#pragma unroll
    for (int g = 0; g < NG; ++g) {
        const int bcur = DB ? (g & 1) : 0;
        if (DB && g + 1 < NG) { if ((g & 1) == 0) QK_LOAD(g + 1, 1); else QK_LOAD(g + 1, 0); }
        __builtin_amdgcn_sched_barrier(0);
#pragma unroll
        for (int j = 0; j < 2; ++j) { p0 = __builtin_amdgcn_mfma_f32_32x32x16_bf16(kf[bcur][j][0], qf[2 * g + j], p0, 0, 0, 0); p1 = __builtin_amdgcn_mfma_f32_32x32x16_bf16(kf[bcur][j][1], qf[2 * g + j], p1, 0, 0, 0); }
        __builtin_amdgcn_sched_barrier(0);
        if (!DB && g + 1 < NG) QK_LOAD(g + 1, 0);
    }
#undef QK_LOAD
}
template <int DV> DI void pv_tile(const LAS char* Vb, const f32x16& p0, const f32x16& p1, f32x16* o, int lane) {
    constexpr int VS = DV * 2 + 16;
    const int g = lane >> 4, h = lane >> 5, i16 = lane & 15, q = i16 >> 2, p = i16 & 3;
    const LAS char* base = Vb + (4 * h + q) * VS + (16 * (g & 1) + 4 * p) * 2;
    constexpr int NDB = DV / 32, GS = (DV == 64) ? 2 : 1;
    bf16x8 pf[4];
#pragma unroll
    for (int s = 0; s < 4; ++s) { u32x4 pw;
        if (s < 2) { pw.x = cvtpk(p0[8 * s], p0[8 * s + 1]); pw.y = cvtpk(p0[8 * s + 2], p0[8 * s + 3]); pw.z = cvtpk(p0[8 * s + 4], p0[8 * s + 5]); pw.w = cvtpk(p0[8 * s + 6], p0[8 * s + 7]); }
        else { const int s2 = s - 2; pw.x = cvtpk(p1[8 * s2], p1[8 * s2 + 1]); pw.y = cvtpk(p1[8 * s2 + 2], p1[8 * s2 + 3]); pw.z = cvtpk(p1[8 * s2 + 4], p1[8 * s2 + 5]); pw.w = cvtpk(p1[8 * s2 + 6], p1[8 * s2 + 7]); }
        pf[s] = __builtin_bit_cast(bf16x8, pw); }
#pragma unroll
    for (int s0 = 0; s0 < 4; s0 += GS) {
        s16x4 lo[GS][NDB], hi[GS][NDB];
#pragma unroll
        for (int s = 0; s < GS; ++s)
#pragma unroll
            for (int db = 0; db < NDB; ++db) { lo[s][db] = vtr(base + (16 * (s0 + s)) * VS + db * 64); hi[s][db] = vtr(base + (16 * (s0 + s) + 8) * VS + db * 64); }
        __builtin_amdgcn_sched_barrier(0);
#pragma unroll
        for (int s = 0; s < GS; ++s)
#pragma unroll
            for (int db = 0; db < NDB; ++db) o[db] = __builtin_amdgcn_mfma_f32_32x32x16_bf16(__builtin_shufflevector(lo[s][db], hi[s][db], 0, 1, 2, 3, 4, 5, 6, 7), pf[s0 + s], o[db], 0, 0, 0);
        __builtin_amdgcn_sched_barrier(0);
    }
}
DI float max3f(float a, float b, float c) { return __builtin_fmaxf(__builtin_fmaxf(a, b), c); }
DI float rowmax32(const f32x16& p0, const f32x16& p1) {
    float a = max3f(p0[0], p0[1], p0[2]), b = max3f(p0[3], p0[4], p0[5]), c = max3f(p1[0], p1[1], p1[2]), d = max3f(p1[3], p1[4], p1[5]);
    a = max3f(a, p0[6], p0[7]); b = max3f(b, p0[8], p0[9]); c = max3f(c, p1[6], p1[7]); d = max3f(d, p1[8], p1[9]);
    a = max3f(a, p0[10], p0[11]); b = max3f(b, p0[12], p0[13]); c = max3f(c, p1[10], p1[11]); d = max3f(d, p1[12], p1[13]);
    a = max3f(a, p0[14], p0[15]); c = max3f(c, p1[14], p1[15]);
    return max32(max3f(max3f(a, b, c), d, d));
}
template <int DV> DI void softmax_step(f32x16& p0, f32x16& p1, f32x16* o, float& m, float& l) {
    const float mx = rowmax32(p0, p1); const float mnew = fmaxf(m, mx); const float muse = (mnew == -INFINITY) ? 0.f : mnew;
    const float alpha = __builtin_amdgcn_exp2f(m - muse);
    float s = 0.f;
#pragma unroll
    for (int r = 0; r < 16; ++r) { p0[r] = __builtin_amdgcn_exp2f(p0[r] - muse); p1[r] = __builtin_amdgcn_exp2f(p1[r] - muse); s += p0[r] + p1[r]; }
    l = l * alpha + s; m = mnew;
#pragma unroll
    for (int db = 0; db < DV / 32; ++db)
#pragma unroll
        for (int r = 0; r < 16; ++r) o[db][r] *= alpha;
}
template <int DK> DI void load_qfrag(bf16x8* qf, const bf16_t* qrow  , int h) {
#pragma unroll
    for (int st = 0; st < DK / 16; ++st) qf[st] = *(const bf16x8*)(qrow + 16 * st + 8 * h);
}
template <int DK, int DV> struct SweepLds { static constexpr int KB = 64 * (DK * 2 + 16), VB = 64 * (DV * 2 + 16); };

template <int DV> DI void softmax_step_lazy(f32x16& p0, f32x16& p1, f32x16* o, float& m, float& l) {
    const float mx = rowmax32(p0, p1); const float mnew = fmaxf(m, mx); const float muse = (mnew == -INFINITY) ? 0.f : mnew;
    const float alpha = __builtin_amdgcn_exp2f(m - muse);
    float s0 = 0.f, s1 = 0.f, s2 = 0.f, s3 = 0.f;
#pragma unroll
    for (int r = 0; r < 16; ++r) { p0[r] = __builtin_amdgcn_exp2f(p0[r] - muse); p1[r] = __builtin_amdgcn_exp2f(p1[r] - muse); }
#pragma unroll
    for (int r = 0; r < 16; r += 2) { s0 += p0[r]; s1 += p0[r + 1]; s2 += p1[r]; s3 += p1[r + 1]; }
    l = l * alpha + ((s0 + s1) + (s2 + s3)); m = mnew;
    if (__builtin_amdgcn_ballot_w64(alpha != 1.f) != 0ull) {
#pragma unroll
        for (int db = 0; db < DV / 32; ++db)
#pragma unroll
            for (int r = 0; r < 16; ++r) o[db][r] *= alpha;
    }
}
template <int DK, int DV> struct SweepLds3 { static constexpr int KB = 64 * (DK * 2 + 16), VB = 64 * (DV * 2 + 16), TOTAL = 2 * KB + 3 * VB; };
template <int DK, int DV, bool late, class It, class F> DI void flash_sweep_impl(Ctx& c, const bf16x8* qf, const bf16_t* Kg, int ldk, const bf16_t* Vg, int ldv, It it, const F& f, f32x16* o, float& m, float& l) {
    typedef SweepLds3<DK, DV> L; LAS char* lds = (LAS char*)c.lds; const int lane = c.lane, tid = c.tid;
    TileRegs<DK> kA, kB; TileRegs<DV> vA, vB;
    int ta = it.next(); int tb = ta >= 0 ? it.next() : -1;
    if (ta < 0) return;
    tile_load<DK>(kA, Kg + (size_t)ta * 64 * ldk, ldk, tid); tile_load<DV>(vA, Vg + (size_t)ta * 64 * ldv, ldv, tid);
    if (tb >= 0) { tile_load<DK>(kB, Kg + (size_t)tb * 64 * ldk, ldk, tid); tile_load<DV>(vB, Vg + (size_t)tb * 64 * ldv, ldv, tid); }
    __syncthreads();
    tile_store<DK>(kA, lds, tid); tile_store<DV>(vA, lds + 2 * L::KB, tid);
    __syncthreads();
    int vprev = 2 * L::KB + 2 * L::VB, vcur = 2 * L::KB, vnext = 2 * L::KB + L::VB;
    f32x16 s0, s1; bool pend = false;
#pragma unroll
    for (int r = 0; r < 16; ++r) { s0[r] = 0.f; s1[r] = 0.f; }
#define FS_QK(P0_, P1_, KOFF_) do { if (c.var != 3) qk_tile<DK>(lds + (KOFF_), qf, P0_, P1_, lane); } while (0)
#define FS_SM(P0_, P1_) do { if (c.var != 2) softmax_step_lazy<DV>(P0_, P1_, o, m, l); } while (0)
#define FS_PV(VOFF_, P0_, P1_) do { if (c.var != 1) pv_tile<DV>(lds + (VOFF_), P0_, P1_, o, lane); } while (0)
#define FS_COMPUTE(T_, KOFF_) do { \
        if (!late) { if (!f.skip(T_)) { f32x16 p0, p1; if (c.var == 3) { p0 = s0; p1 = s1; } FS_QK(p0, p1, KOFF_); f.mask(p0, p1, T_); FS_SM(p0, p1); FS_PV(vcur, p0, p1); } } \
        else { if (pend) { FS_SM(s0, s1); FS_PV(vprev, s0, s1); pend = false; } \
               if (!f.skip(T_)) { FS_QK(s0, s1, KOFF_); f.mask(s0, s1, T_); pend = true; } } } while (0)
#define FS_ROTATE() do { const int t_ = vprev; vprev = vcur; vcur = vnext; vnext = t_; } while (0)
    for (;;) {
        const int tc = tb >= 0 ? it.next() : -1;
        if (tc >= 0) { tile_load<DK>(kA, Kg + (size_t)tc * 64 * ldk, ldk, tid); tile_load<DV>(vA, Vg + (size_t)tc * 64 * ldv, ldv, tid); }
        FS_COMPUTE(ta, 0);
        if (tb >= 0) { tile_store<DK>(kB, lds + L::KB, tid); tile_store<DV>(vB, lds + vnext, tid); }
        __syncthreads(); FS_ROTATE();
        if (tb < 0) break;
        const int td = tc >= 0 ? it.next() : -1;
        if (td >= 0) { tile_load<DK>(kB, Kg + (size_t)td * 64 * ldk, ldk, tid); tile_load<DV>(vB, Vg + (size_t)td * 64 * ldv, ldv, tid); }
        FS_COMPUTE(tb, L::KB);
        if (tc >= 0) { tile_store<DK>(kA, lds, tid); tile_store<DV>(vA, lds + vnext, tid); }
        __syncthreads(); FS_ROTATE();
        if (tc < 0) break;
        ta = tc; tb = td;
    }
    if (late && pend) { FS_SM(s0, s1); FS_PV(vprev, s0, s1); }
#undef FS_COMPUTE
#undef FS_ROTATE
#undef FS_QK
#undef FS_SM
#undef FS_PV
}
template <int DK, int DV, bool STG, class It, class F> DI void flash_sweep(Ctx& c, const bf16x8* qf, const bf16_t* Kg, int ldk, const bf16_t* Vg, int ldv, It it, const F& f, f32x16* o, float& m, float& l) {
    if (STG && c.wave >= 4) flash_sweep_impl<DK, DV, true>(c, qf, Kg, ldk, Vg, ldv, it, f, o, m, l);
    else flash_sweep_impl<DK, DV, false>(c, qf, Kg, ldk, Vg, ldv, it, f, o, m, l);
}
struct RangeIt { int t, tend; DI int next() { return t <= tend ? t++ : -1; } };
struct BitsIt { unsigned rem; DI int next() { if (!rem) return -1; const int t = __builtin_ctz(rem); rem &= rem - 1; return t; } };
struct CausalF { int qrow, wfirst, wlast, h;
    DI bool skip(int t) const { return t > wlast; }
    DI void mask(f32x16& p0, f32x16& p1, int t) const { if (t * 64 + 63 > wfirst) {
#pragma unroll
        for (int r = 0; r < 16; ++r) { const int kv = t * 64 + crow(r, h); if (kv > qrow) p0[r] = -INFINITY; if (kv + 32 > qrow) p1[r] = -INFINITY; } } } };
template <int DK, int DV> DI void causal_sweep(Ctx& c, const bf16_t* Qg, int ldq, const bf16_t* Kg, int ldk, const bf16_t* Vg, int ldv, int q0, f32x16* o, float& lsum) {
    RELAUNDER(c);
    const int lane = c.lane, w = c.wave, r32 = lane & 31, h = lane >> 5;
    const int qrow = q0 + 32 * w + r32;
    bf16x8 qf[DK / 16]; load_qfrag<DK>(qf, Qg + (unsigned)qrow * (unsigned)ldq, h);
#pragma unroll
    for (int db = 0; db < DV / 32; ++db)
#pragma unroll
        for (int r = 0; r < 16; ++r) o[db][r] = 0.f;
    float m = -INFINITY, l = 0.f;
    RangeIt it{0, (q0 >> 6) + 3}; CausalF f{qrow, q0 + 32 * w, (q0 + 32 * w + 31) >> 6, h};
    flash_sweep<DK, DV, (DV == 64)>(c, qf, Kg, ldk, Vg, ldv, it, f, o, m, l);
    lsum = sum32(l);
}
template <int DV> DI void store_o(const f32x16* o, float scale, bf16_t* rowp, int h) {
#pragma unroll
    for (int db = 0; db < DV / 32; ++db)
#pragma unroll
        for (int k = 0; k < 4; ++k) { u32x2 v; v.x = cvtpk(o[db][4 * k] * scale, o[db][4 * k + 1] * scale); v.y = cvtpk(o[db][4 * k + 2] * scale, o[db][4 * k + 3] * scale);
            *(u32x2*)(rowp + 32 * db + 8 * k + 4 * h) = v; }
}

DI void mla_unit(Ctx& c, const bf16_t* QL, const bf16_t* KF, const bf16_t* KVU, bf16_t* YC, int b, int hd, int qt) {
    RELAUNDER(c);
    const int q0 = qt * 256; f32x16 o[2]; float l;
    const size_t rb = (size_t)b * S;
    causal_sweep<96, 64>(c, QL + rb * UPW + 96 * hd, UPW, KF + rb * 768 + 96 * hd, 768, KVU + rb * UPW + 128 * hd + 64, UPW, q0, o, l);
    const int qrow = q0 + 32 * c.wave + (c.lane & 31);
    store_o<64>(o, 1.f / l, YC + (rb + qrow) * 1024 + 64 * hd, c.lane >> 5);
}
DI void diff_unit(Ctx& c, const bf16_t* QKV, bf16_t* ON, int b, int hd, int qt, int j, int layer) {
    RELAUNDER(c);
    CArgs& a = *c.a; const int q0 = qt * 256, lane = c.lane, h = lane >> 5; const size_t rb = (size_t)b * S;
    f32x16 o1[4], o2[4]; float l1, l2;
    const bf16_t* base = QKV + rb * 3072;
    causal_sweep<64, 128>(c, base + 128 * hd, 3072, base + 1024 + 128 * hd, 3072, base + 2048 + 128 * hd, 3072, q0, o1, l1);
    { const float i1_ = 1.f / l1;
#pragma unroll
      for (int db = 0; db < 4; ++db)
#pragma unroll
          for (int r = 0; r < 16; ++r) o1[db][r] *= i1_; }
    causal_sweep<64, 128>(c, base + 128 * hd + 64, 3072, base + 1024 + 128 * hd + 64, 3072, base + 2048 + 128 * hd, 3072, q0, o2, l2);
    const float* lam = a.in[26] + j * 256; float s1 = lam[lane] * lam[64 + lane], s2 = lam[128 + lane] * lam[192 + lane];
    s1 = wave_sum(s1); s2 = wave_sum(s2);
    const float lam_init = 0.8f - 0.6f * __expf(-0.3f * (float)layer); const float lmb = __expf(s1) - __expf(s2) + lam_init;
    const float i1 = 1.f, i2 = lmb / l2; float ss = 0.f;
#pragma unroll
    for (int db = 0; db < 4; ++db)
#pragma unroll
        for (int r = 0; r < 16; ++r) { const float v = o1[db][r] * i1 - o2[db][r] * i2; o1[db][r] = v; ss += v * v; }
    ss = sum32(ss);
    const float rs = rsqrtf(ss * (1.f / 128.f) + EPS) * (1.f - lam_init);
    const float* sg = a.in[27] + j * 128;
#pragma unroll
    for (int db = 0; db < 4; ++db)
#pragma unroll
        for (int r = 0; r < 16; ++r) o1[db][r] *= rs * sg[32 * db + crow(r, h)];
    const int qrow = q0 + 32 * c.wave + (lane & 31);
    store_o<128>(o1, 1.f, ON + (rb + qrow) * 1024 + 128 * hd, h);
}

DI void nsa_unit(Ctx& c, const bf16_t* U, bf16_t* YC, int b, int g, int qt) {
    RELAUNDER(c);
    CArgs& a = *c.a; LAS char* lds = (LAS char*)c.lds; typedef SweepLds<64, 64> L;
    const int lane = c.lane, w = c.wave, tid = c.tid, r32 = lane & 31, h = lane >> 5;
    const int hg = w & 3, qsub = w >> 2, head = g * 4 + hg, q0 = qt * 64, jt = qt;
    const int qrow = q0 + 32 * qsub + r32; const size_t rb = (size_t)b * S; const size_t m = rb + qrow;
    LAS float* imp = (LAS float*)(lds + 5 * L::KB);
    LAS unsigned* selw = (LAS unsigned*)(lds + 5 * L::KB + 4 * 64 * 33 * 4);
    bf16x8 qf[4]; load_qfrag<64>(qf, U + m * UW + 544 + 64 * head, h);
    const bf16_t* urow = U + m * UW + 1824;
#ifdef NSA_ONLY
    const float g0 = NSA_ONLY == 0 ? 1.f : 0.f, g1 = NSA_ONLY == 1 ? 1.f : 0.f, g2 = NSA_ONLY == 2 ? 1.f : 0.f; (void)urow;
#else
    const float g0 = 1.f / (1.f + __expf(-bf2f(urow[head]))), g1 = 1.f / (1.f + __expf(-bf2f(urow[8 + head]))), g2 = 1.f / (1.f + __expf(-bf2f(urow[16 + head])));
#endif
    unsigned accp[2][8];
    const int bg = b * 2 + g;
    const bf16_t* KC = (const bf16_t*)(c.ws + WS_MISC + 65536) + (size_t)bg * 128 * 64; const bf16_t* VC = (const bf16_t*)(c.ws + WS_MISC + 65536 + 262144) + (size_t)bg * 128 * 64;
    __syncthreads();
    { TileRegs<64> k0, k1, v0, v1; tile_load<64>(k0, KC, 64, tid); tile_load<64>(k1, KC + 64 * 64, 64, tid); tile_load<64>(v0, VC, 64, tid); tile_load<64>(v1, VC + 64 * 64, 64, tid);
      for (int i = tid; i < 4 * 64 * 33; i += NT) imp[i] = 0.f;
      tile_store<64>(k0, lds, tid); tile_store<64>(k1, lds + L::KB, tid); tile_store<64>(v0, lds + 2 * L::KB, tid); tile_store<64>(v1, lds + 2 * L::KB + L::VB, tid); }
    __syncthreads();
    {
        f32x16 p0, p1, p2, p3; qk_tile<64>(lds, qf, p0, p1, lane); qk_tile<64>(lds + L::KB, qf, p2, p3, lane);
        const int hi = qrow < 31 ? -1 : (qrow - 31) >> 4;
#pragma unroll
        for (int r = 0; r < 16; ++r) { const int cidx = crow(r, h); if (cidx > hi) p0[r] = -INFINITY; if (cidx + 32 > hi) p1[r] = -INFINITY; if (cidx + 64 > hi) p2[r] = -INFINITY; if (cidx + 96 > hi) p3[r] = -INFINITY; }
        float mx = fmaxf(rowmax32(p0, p1), rowmax32(p2, p3)); const float muse = (mx == -INFINITY) ? 0.f : mx; float s = 0.f;
#pragma unroll
        for (int r = 0; r < 16; ++r) { p0[r] = __builtin_amdgcn_exp2f(p0[r] - muse); p1[r] = __builtin_amdgcn_exp2f(p1[r] - muse); p2[r] = __builtin_amdgcn_exp2f(p2[r] - muse); p3[r] = __builtin_amdgcn_exp2f(p3[r] - muse); s += (p0[r] + p1[r]) + (p2[r] + p3[r]); }
        s = sum32(s); const float inv = s > 0.f ? 1.f / s : 0.f;
#pragma unroll
        for (int r = 0; r < 16; ++r) { p0[r] *= inv; p1[r] *= inv; p2[r] *= inv; p3[r] *= inv; }
        LAS float* ir = imp + hg * (64 * 33) + (32 * qsub + r32) * 33;
#define IMP_ADD(P, PI) _Pragma("unroll") for (int k = 0; k < 4; ++k) { const int jb = 8 * (PI) + 2 * k + h; const float s4 = (P[4 * k] + P[4 * k + 1]) + (P[4 * k + 2] + P[4 * k + 3]); lds_add(ir + jb, s4); if (jb + 1 < 32) lds_add(ir + jb + 1, P[4 * k + 3]); }
        IMP_ADD(p0, 0) IMP_ADD(p1, 1) IMP_ADD(p2, 2) IMP_ADD(p3, 3)
#undef IMP_ADD
        f32x16 oc[2];
#pragma unroll
        for (int db = 0; db < 2; ++db)
#pragma unroll
            for (int r = 0; r < 16; ++r) oc[db][r] = 0.f;
        pv_tile<64>(lds + 2 * L::KB, p0, p1, oc, lane); pv_tile<64>(lds + 2 * L::KB + L::VB, p2, p3, oc, lane);
#pragma unroll
        for (int db = 0; db < 2; ++db)
#pragma unroll
            for (int r = 0; r < 8; ++r) accp[db][r] = cvtpk(g0 * oc[db][2 * r], g0 * oc[db][2 * r + 1]);
    }
    __syncthreads();
    LAS float* vsl = (LAS float*)(lds + 5 * L::KB + 4 * 64 * 33 * 4 + 256);
#pragma unroll 1
    for (int i = 0; i < 4; ++i) { const int id = tid + NT * i, qq = id >> 5, jb = id & 31;
        const bool allowed = jb <= jt, forced = allowed && (jb == 0 || jb >= jt - 1);
        const float iv = (imp[qq * 33 + jb] + imp[64 * 33 + qq * 33 + jb]) + (imp[2 * 64 * 33 + qq * 33 + jb] + imp[3 * 64 * 33 + qq * 33 + jb]);
        vsl[id] = forced ? 1e9f : (allowed ? iv : -1e30f); }
    __syncthreads();
#pragma unroll 1
    for (int i = 0; i < 4; ++i) { const int id = tid + NT * i, qq = id >> 5, jb = id & 31;
        const float v = vsl[id]; int rank = 0;
#pragma unroll
        for (int k4 = 0; k4 < 8; ++k4) { const f32x4 w = *(const LAS f32x4*)(vsl + qq * 32 + 4 * k4);
            rank += (w.x > v || (w.x == v && 4 * k4 + 0 < jb)) ? 1 : 0; rank += (w.y > v || (w.y == v && 4 * k4 + 1 < jb)) ? 1 : 0;
            rank += (w.z > v || (w.z == v && 4 * k4 + 2 < jb)) ? 1 : 0; rank += (w.w > v || (w.w == v && 4 * k4 + 3 < jb)) ? 1 : 0; }
        const unsigned long long bal = __ballot(jb <= jt && rank < 16);
        if (jb == 0) selw[qq] = (unsigned)(bal >> (lane & 32)); }
    __syncthreads();
    const unsigned mysel = selw[32 * qsub + r32];
    unsigned uni = selw[lane];
    uni |= swzu<1>(uni); uni |= swzu<2>(uni); uni |= swzu<4>(uni); uni |= swzu<8>(uni); uni |= swzu<16>(uni); uni = or32(uni);
    uni = __builtin_amdgcn_readfirstlane(uni);
    {
        struct SlcF { unsigned mysel; int qrow, h, jt; DI bool skip(int) const { return false; }
            DI void mask(f32x16& p0, f32x16& p1, int t) const { const float bias = ((mysel >> t) & 1u) ? 0.f : -INFINITY;
#pragma unroll
                for (int r = 0; r < 16; ++r) { p0[r] += bias; p1[r] += bias; }
                if (t == jt) {
#pragma unroll
                    for (int r = 0; r < 16; ++r) { const int kv = t * 64 + crow(r, h); if (kv > qrow) p0[r] = -INFINITY; if (kv + 32 > qrow) p1[r] = -INFINITY; } } } };
        f32x16 o[2];
#pragma unroll
        for (int db = 0; db < 2; ++db)
#pragma unroll
            for (int r = 0; r < 16; ++r) o[db][r] = 0.f;
        float mm = -INFINITY, l = 0.f;
        flash_sweep<64, 64, true>(c, qf, U + rb * UW + 1312 + 64 * g, UW, U + rb * UW + 1440 + 64 * g, UW, BitsIt{uni}, SlcF{mysel, qrow, h, jt}, o, mm, l);
        l = sum32(l); const float sc = g1 / l;
#pragma unroll
        for (int db = 0; db < 2; ++db)
#pragma unroll
            for (int r = 0; r < 8; ++r) accp[db][r] = cvtpk(bflo(accp[db][r]) + sc * o[db][2 * r], bfhi(accp[db][r]) + sc * o[db][2 * r + 1]);
    }
    {
        struct WinF { int qrow, h, jt; DI bool skip(int) const { return false; }
            DI void mask(f32x16& p0, f32x16& p1, int t) const { if (t == jt || t == jt - 8) {
#pragma unroll
                for (int r = 0; r < 16; ++r) { const int kv = t * 64 + crow(r, h); if (kv > qrow || kv <= qrow - 512) p0[r] = -INFINITY; if (kv + 32 > qrow || kv + 32 <= qrow - 512) p1[r] = -INFINITY; } } } };
        f32x16 o[2];
#pragma unroll
        for (int db = 0; db < 2; ++db)
#pragma unroll
            for (int r = 0; r < 16; ++r) o[db][r] = 0.f;
        float mm = -INFINITY, l = 0.f;
        flash_sweep<64, 64, true>(c, qf, U + rb * UW + 1568 + 64 * g, UW, U + rb * UW + 1696 + 64 * g, UW, RangeIt{jt - 8 > 0 ? jt - 8 : 0, jt}, WinF{qrow, h, jt}, o, mm, l);
        l = sum32(l); const float sc = g2 / l;
#pragma unroll
        for (int db = 0; db < 2; ++db)
#pragma unroll
            for (int r = 0; r < 8; ++r) accp[db][r] = cvtpk(bflo(accp[db][r]) + sc * o[db][2 * r], bfhi(accp[db][r]) + sc * o[db][2 * r + 1]);
    }
    { bf16_t* rowp = YC + m * 1024 + 512 + 64 * head;
#pragma unroll
      for (int db = 0; db < 2; ++db)
#pragma unroll
          for (int k = 0; k < 4; ++k) { u32x2 v; v.x = accp[db][2 * k]; v.y = accp[db][2 * k + 1]; *(u32x2*)(rowp + 32 * db + 8 * k + 4 * h) = v; } }
}
}
#ifndef FX_MODE
#define FX_MODE 0
#endif
namespace fx {
template <int ACT  > struct EpiB16 {
    static constexpr bool PERM = true, AFTER_DRAIN = false;
    bf16_t* O; int ldc; const float* ss; const float* shw;
    __device__ __forceinline__ void operator()(const pg8::f32x4 (&acc)[2][2][4][2], const pg8::Unit& u, int wr, int wc, int fr, int fq) const {
        const int row0 = u.pm * 256 + wr * 64 + fr, col0 = u.pn * 256 + wc * 32 + 8 * fq;
        const bool FUSED = ss != nullptr; pg8::f32x4 sv[2][2];
        if (FUSED) { const float* sp = shw + (size_t)(u.pm >> 3) * 4096 + col0;
#pragma unroll
            for (int bj = 0; bj < 2; ++bj) { sv[bj][0] = *(const pg8::f32x4*)(sp + bj * 128); sv[bj][1] = *(const pg8::f32x4*)(sp + bj * 128 + 4); } }
#pragma unroll
        for (int ai = 0; ai < 2; ++ai)
#pragma unroll
            for (int m = 0; m < 4; ++m) { const int row = row0 + ai * 128 + m * 16; bf16_t* rowp = O + (size_t)row * ldc + col0;
                float rs = 1.f; if (FUSED) rs = rsqrtf(ss[row] * (1.f / 1024.f) + EPS);
#pragma unroll
                for (int bj = 0; bj < 2; ++bj) { pg8::f32x4 v0 = acc[ai][bj][m][0], v1 = acc[ai][bj][m][1];
                    if (FUSED) { v0 = v0 * rs + sv[bj][0]; v1 = v1 * rs + sv[bj][1]; }
                    if (ACT == 1) {
#pragma unroll
                        for (int e = 0; e < 4; ++e) { float a = v0[e] > 0.f ? v0[e] : 0.f; v0[e] = a * a; float b = v1[e] > 0.f ? v1[e] : 0.f; v1[e] = b * b; } }
                    u32x4 w; w.x = pg8::cvt_pk_bf16(v0[0], v0[1]); w.y = pg8::cvt_pk_bf16(v0[2], v0[3]); w.z = pg8::cvt_pk_bf16(v1[0], v1[1]); w.w = pg8::cvt_pk_bf16(v1[2], v1[3]);
                    *(u32x4*)(rowp + bj * 128) = w; } }
    }
};
struct UpOrder : pg8::StaticOrder {
    __device__ bool next(int i, pg8::Unit& u) const { if (!pg8::StaticOrder::next(i, u)) return false; u.aoff = u.pn >= 3 ? 256 : 0; return true; }
};
struct EpiResid {
    static constexpr bool PERM = true, AFTER_DRAIN = false;
    const float* base; float* out; const float* gate; bf16_t* xa; const float* ngain; const float* nsc; float* ss;
    __device__ __forceinline__ void operator()(const pg8::f32x4 (&acc)[2][2][4][2], const pg8::Unit& u, int wr, int wc, int fr, int fq) const {
        const int row0 = u.pm * 256 + wr * 64 + fr, col0 = u.pn * 256 + wc * 32 + 8 * fq; const int b = u.pm >> 3; const float* gp = gate + (size_t)b * 6144 + col0;
        pg8::f32x4 gv[2][2], av[2][2];
#pragma unroll
        for (int bj = 0; bj < 2; ++bj)
#pragma unroll
            for (int n = 0; n < 2; ++n) { gv[bj][n] = *(const pg8::f32x4*)(gp + bj * 128 + n * 4);
                if (xa) { const pg8::f32x4 g = *(const pg8::f32x4*)(ngain + col0 + bj * 128 + n * 4), sc = *(const pg8::f32x4*)(nsc + (size_t)b * 6144 + col0 + bj * 128 + n * 4); av[bj][n] = g * (sc + 1.f); } }
#pragma unroll
        for (int ai = 0; ai < 2; ++ai)
#pragma unroll
            for (int m = 0; m < 4; ++m) { const int row = row0 + ai * 128 + m * 16; const size_t off = (size_t)row * 1024 + col0; float sq = 0.f;
#pragma unroll
                for (int bj = 0; bj < 2; ++bj) { pg8::f32x4 xn[2];
#pragma unroll
                    for (int n = 0; n < 2; ++n) { const pg8::f32x4 bs = *(const pg8::f32x4*)(base + off + bj * 128 + n * 4); xn[n] = bs + gv[bj][n] * acc[ai][bj][m][n];
                        *(pg8::f32x4*)(out + off + bj * 128 + n * 4) = xn[n]; }
                    if (xa) { sq += ((xn[0][0] * xn[0][0] + xn[0][1] * xn[0][1]) + (xn[0][2] * xn[0][2] + xn[0][3] * xn[0][3])) + ((xn[1][0] * xn[1][0] + xn[1][1] * xn[1][1]) + (xn[1][2] * xn[1][2] + xn[1][3] * xn[1][3]));
                        const pg8::f32x4 y0 = xn[0] * av[bj][0], y1 = xn[1] * av[bj][1];
                        u32x4 w; w.x = pg8::cvt_pk_bf16(y0[0], y0[1]); w.y = pg8::cvt_pk_bf16(y0[2], y0[3]); w.z = pg8::cvt_pk_bf16(y1[0], y1[1]); w.w = pg8::cvt_pk_bf16(y1[2], y1[3]);
                        *(u32x4*)(xa + off + bj * 128) = w; } }
                if (xa) { sq += swz<16>(sq); sq = sum32(sq); if (fq == 0) atomicAdd(ss + row, sq); } }
    }
};

#ifndef FX_REPEAT_KIND
#define FX_REPEAT_KIND 0
#endif
#ifndef FX_VAR
#define FX_VAR 0
#endif
#define DUMMY_OUT ((float*)(ws + 300 * MiB))
__global__ void __launch_bounds__(NT, 2) mega(Args args) {
    extern __shared__ __attribute__((aligned(16))) unsigned char lds_raw[];
    Ctx c; c.lds = (LAS unsigned char*)lds_raw; c.tid = threadIdx.x; c.lane = c.tid & 63; c.wave = __builtin_amdgcn_readfirstlane(c.tid >> 6); c.G = gridDim.x; c.bid = blockIdx.x; c.a = nullptr; c.var = 0; (void)args;
#define KARGS() ({ CArgs* p_ = (CArgs*)__builtin_amdgcn_kernarg_segment_ptr(); asm volatile("" : "+s"(p_)); p_; })
    CArgs* pa0 = KARGS();
    volatile LAS unsigned* MISC = (volatile LAS unsigned*)(c.lds + LDS_MISC);
    for (int i = c.tid; i < 64; i += NT) MISC[i] = 0u;
    __syncthreads();
    XcdBarrier bar = xcd_barrier_post((unsigned*)(pa0->ws + WS_CTL) + 4096, MISC + 8);
    int ph = 0;
#if FX_MODE == 0
    constexpr int lo = 0, hi = 28;
#else
    const int lo = pa0->ph_lo, hi = pa0->ph_hi;
#endif
#define SEAM() do { if (ph + 1 < hi) { xcd_barrier(bar); if (FX_REPEAT_KIND == 12) xcd_barrier(bar); } } while (0)
#define PHASE_BEGIN if (ph >= lo && ph < hi) { CArgs* pa = KARGS(); c.a = pa; unsigned char* ws = pa->ws; c.ws = ws; RELAUNDER(c); const int gw = c.bid * NW + c.wave, NGW = c.G * NW; (void)gw; (void)NGW; \
    const float* MOD = (const float*)(ws + WS_MOD); const float* mod = MOD + (size_t)layer * 8 * 6144; (void)mod; \
    bf16_t* XN = (bf16_t*)(ws + WS_XN); bf16_t* YC = (bf16_t*)(ws + WS_YC); bf16_t* U = (bf16_t*)(ws + WS_BIG + BIG_U); bf16_t* QL = (bf16_t*)(ws + WS_BIG + BIG_UP); bf16_t* KVU = QL + 768; \
    bf16_t* KF = XN; bf16_t* HID = (bf16_t*)(ws + WS_BIG); bf16_t* QKV = (bf16_t*)(ws + WS_BIG); float* SS = (float*)(ws + WS_SS); const float* SHW = (const float*)(ws + WS_SHW); (void)SS; (void)SHW; (void)XN; (void)YC; (void)U; (void)QL; (void)KVU; (void)KF; (void)HID; (void)QKV; \
    unsigned char* wb = ws + ((layer & 1) ? WS_WODD + (size_t)(layer >> 1) * W_ODD : WS_WEVEN + (size_t)(layer >> 1) * W_EVEN); unsigned char* wm = ws + WS_WMLP + (size_t)layer * W_MLP; (void)wb; (void)wm;
#define PHASE_END SEAM(); } ++ph;
    int layer = 0;

    if (lo == 0) { CArgs* pa = KARGS(); c.a = pa; c.ws = pa->ws; RELAUNDER(c);
#ifndef SKIP_PRO
        REP(10) phase_prologue(c);
#endif
        if (hi > 1) { if (pa->use_cg != 0) cooperative_groups::this_grid().sync(); else xcd_barrier(bar); } }
    ++ph;

#pragma clang loop unroll(full)
    for (layer = 0; layer < 4; ++layer) {
        const int j = layer >> 1;
        if (layer == 0) {
        PHASE_BEGIN
            REP(8) phase_modnorm(c, pa->in[0], pa->in[5], mod + 0, mod + 1024, XN);
            REP(15) shw_items(c);
        PHASE_END
        }
        if ((layer & 1) == 0) {
            PHASE_BEGIN { pg8::Gemm g{XN, (const bf16_t*)(wb + WE_IN), T, UW, D, D}; pg8::StaticOrder so; so.init(T, UW, c.G, c.bid); EpiB16<0> E{U, UW, layer == 0 ? nullptr : SS + (size_t)(2 * layer) * T, SHW + (size_t)(2 * layer) * 8 * 4096};

#ifndef SKIP_G1
REP(6) pg8::gemm_phase<EpiB16<0>, pg8::StaticOrder, true, true>(c.lds, g, so, E);
#endif
 } PHASE_END
            PHASE_BEGIN { pg8::Gemm g{U, (const bf16_t*)(wb + WE_UP), T, 1792, 256, UW}; UpOrder so; so.init(T, 1792, c.G, c.bid); EpiB16<0> E{QL, UPW, nullptr, nullptr};

#ifndef SKIP_G2
REP(13) pg8::gemm_phase<EpiB16<0>, UpOrder, false, true>(c.lds, g, so, E);
#endif

                __syncthreads();

#ifndef SKIP_CMP
 REP(14) for (int it = c.bid; it < 256; it += c.G) compress_item(c, U, j, it);
#endif


#ifndef SKIP_FIN
 RELAUNDER(c); for (int m0 = gw; m0 < T; m0 += NGW * TBV) nsa_finalize_rows(c, U, m0, NGW, j);
#endif
 } PHASE_END
            PHASE_BEGIN {
#ifndef SKIP_FIN
 for (int m0 = gw; m0 < T; m0 += NGW * TBV) mla_finalize_rows(c, U, QL, KVU, KF, m0, NGW, j);
                __syncthreads();
#endif

                REP(1) for (int p = c.bid; p < 256; p += c.G) { const int bg = p >> 4, s = p & 15;
#ifndef SKIP_NSA
 nsa_unit(c, U, YC, bg >> 1, bg & 1, 31 - s); nsa_unit(c, U, YC, bg >> 1, bg & 1, s);
#endif
 } } PHASE_END
            PHASE_BEGIN { REP(2) for (int p = c.bid; p < 256; p += c.G) { const int bh = p >> 2, s = p & 3;
#ifndef SKIP_MLA
 { bf16_t* yo_ = rep_ ? (bf16_t*)(ws + 300 * MiB) : YC; c.var = rep_ ? FX_VAR : 0; mla_unit(c, QL, KF, KVU, yo_, bh >> 3, bh & 7, 7 - s); mla_unit(c, QL, KF, KVU, yo_, bh >> 3, bh & 7, s); c.var = 0; }
#endif
 } } PHASE_END
            PHASE_BEGIN { pg8::Gemm g{YC, (const bf16_t*)(wb + WE_OUT), T, D, D, D}; pg8::StaticOrder so; so.init(T, D, c.G, c.bid);
#ifndef SKIP_G3
REP(9) { EpiResid E{layer == 0 ? pa->in[0] : pa->out, rep_ ? DUMMY_OUT : pa->out, mod + 2048, XN, pa->in[6] + layer * D, mod + 4096, SS + (size_t)(2 * layer + 1) * T}; pg8::gemm_phase<EpiResid, pg8::StaticOrder, true, true>(c.lds, g, so, E); }
#endif
 } PHASE_END
        } else {
            PHASE_BEGIN { pg8::Gemm g{XN, (const bf16_t*)(wb + WO_QKV), T, 3072, D, D}; pg8::StaticOrder so; so.init(T, 3072, c.G, c.bid); EpiB16<0> E{QKV, 3072, SS + (size_t)(2 * layer) * T, SHW + (size_t)(2 * layer) * 8 * 4096};

#ifndef SKIP_G4
REP(7) pg8::gemm_phase<EpiB16<0>, pg8::StaticOrder, true, true>(c.lds, g, so, E);
#endif
 } PHASE_END
            PHASE_BEGIN {
#ifndef SKIP_FIN
 for (int m0 = gw; m0 < T; m0 += NGW * TBV) diff_finalize_rows(c, QKV, m0, NGW, j);
#endif
 } PHASE_END
            PHASE_BEGIN { REP(3) for (int p = c.bid; p < 256; p += c.G) { const int bh = p >> 2, s = p & 3;
#ifndef SKIP_DIFF
 diff_unit(c, QKV, YC, bh >> 3, bh & 7, 7 - s, j, layer); diff_unit(c, QKV, YC, bh >> 3, bh & 7, s, j, layer);
#endif
 } } PHASE_END
            PHASE_BEGIN { pg8::Gemm g{YC, (const bf16_t*)(wb + WO_O), T, D, D, D}; pg8::StaticOrder so; so.init(T, D, c.G, c.bid);
#ifndef SKIP_G5
REP(9) { EpiResid E{pa->out, rep_ ? DUMMY_OUT : pa->out, mod + 2048, XN, pa->in[6] + layer * D, mod + 4096, SS + (size_t)(2 * layer + 1) * T}; pg8::gemm_phase<EpiResid, pg8::StaticOrder, true, true>(c.lds, g, so, E); }
#endif
 } PHASE_END
        }
        PHASE_BEGIN { pg8::Gemm g{XN, (const bf16_t*)wm, T, FF, D, D}; pg8::StaticOrder so; so.init(T, FF, c.G, c.bid); EpiB16<1> E{HID, FF, SS + (size_t)(2 * layer + 1) * T, SHW + (size_t)(2 * layer + 1) * 8 * 4096};

#ifndef SKIP_G6
REP(4) pg8::gemm_phase<EpiB16<1>, pg8::StaticOrder, true, true>(c.lds, g, so, E);
#endif
 } PHASE_END
        PHASE_BEGIN { pg8::Gemm g{HID, (const bf16_t*)(wm + 8 * MiB), T, D, FF, FF}; pg8::StaticOrder so; so.init(T, D, c.G, c.bid);
#ifndef SKIP_G7
REP(5) { EpiResid E{pa->out, rep_ ? DUMMY_OUT : pa->out, mod + 5120, layer < 3 ? XN : nullptr, pa->in[5] + (layer + 1) * D, MOD + (size_t)(layer + 1) * 8 * 6144 + 1024, SS + (size_t)(2 * layer + 2) * T}; pg8::gemm_phase<EpiResid, pg8::StaticOrder, true, true>(c.lds, g, so, E); }
#endif
 } PHASE_END
    }
#undef PHASE_BEGIN
#undef PHASE_END
#undef SEAM
}
constexpr int N_PHASES = 1 + 1 + 2 * (5 + 2) + 2 * (4 + 2);
static_assert(N_PHASES == 28, "phase count");

inline void launch(const Args& base, int lo, int hi, int use_cg, hipStream_t st) {
    static int grid = 0;
    if (grid == 0) {
        int dev = 0, cus = 0, per_cu = 0;
        (void)hipGetDevice(&dev); (void)hipDeviceGetAttribute(&cus, hipDeviceAttributeMultiprocessorCount, dev);
        (void)hipFuncSetAttribute((const void*)mega, hipFuncAttributeMaxDynamicSharedMemorySize, LDS_BYTES);
        (void)hipOccupancyMaxActiveBlocksPerMultiprocessor(&per_cu, (const void*)mega, NT, LDS_BYTES);
        if (per_cu < 1) { fprintf(stderr, "occupancy query says %d blocks/CU\n", per_cu); per_cu = 1; }
        grid = cus;
        (void)hipGetLastError();
    }
    Args a = base; a.ph_lo = lo; a.ph_hi = hi; a.use_cg = use_cg; a.pad = 0;
    void* kargs[] = {&a};
    hipError_t e = hipLaunchCooperativeKernel((const void*)mega, dim3(grid), dim3(NT), kargs, LDS_BYTES, st);
    if (e != hipSuccess) fprintf(stderr, "cooperative launch failed: %s\n", hipGetErrorString(e));
}
}
#ifndef FX_MODE
#define FX_MODE 0
#endif
#ifndef DBG_LAYERS
#define DBG_LAYERS 1
#endif
#ifndef DBG_B0
#define DBG_B0 5
#endif
#ifndef DBG_STAGE
#define DBG_STAGE 0
#endif
#ifndef DBG_NPH
#define DBG_NPH -1
#endif
namespace dbg {
__global__ void k_cmp(const void* fast, int is_bf16, long fld, const float* ref, long rld, int nrows, int ncols, float fscale, float* acc2) {
    const long n = (long)nrows * ncols; float d2 = 0.f, r2 = 0.f;
    for (long i = (long)blockIdx.x * 256 + threadIdx.x; i < n; i += (long)gridDim.x * 256) { const long r = i / ncols, cidx = i % ncols;
        float a = is_bf16 ? fx::bf2f(((const unsigned short*)fast)[r * fld + cidx]) : ((const float*)fast)[r * fld + cidx]; a *= fscale;
        const float b = ref[r * rld + cidx]; if (!(a == a)) a = 1e6f; d2 += (a - b) * (a - b); r2 += b * b; }
    for (int o = 32; o > 0; o >>= 1) { d2 += __shfl_xor(d2, o); r2 += __shfl_xor(r2, o); }
    if ((threadIdx.x & 63) == 0) { atomicAdd(acc2, d2); atomicAdd(acc2 + 1, r2); }
}
#ifndef DBG_SEL
#define DBG_SEL -1
#endif
__global__ void k_finish(float* out, const float* acc, int nchk, long n) {
    float e = 0.f; int bad = -1; for (int i = 0; i < nchk; ++i) { float v = sqrtf(acc[2 * i] / fmaxf(acc[2 * i + 1], 1e-30f)); if (!(v == v)) v = 100.f; e = fmaxf(e, v); if (bad < 0 && v > 0.05f) bad = i; }
    if (DBG_SEL >= 0) { e = sqrtf(acc[2 * DBG_SEL] / fmaxf(acc[2 * DBG_SEL + 1], 1e-30f)); if (!(e == e)) e = 100.f; bad = -1; }
    if (blockIdx.x == 0 && threadIdx.x == 0 && bad >= 0) out[0] += 1000.f * (bad + 1);
    for (long i = (long)blockIdx.x * 256 + threadIdx.x; i < n; i += (long)gridDim.x * 256) out[i] *= (1.f + e);
}
}
extern "C" void kernel_launch(void* const* d_in, const int* in_sizes, int n_in, void* d_out, int out_size, void* d_ws, size_t ws_size, hipStream_t stream) {
    fx::Args a{};
    for (int i = 0; i < 28; ++i) a.in[i] = (const float*)d_in[i];
    a.pos = (const int*)d_in[2]; a.out = (float*)d_out; a.ws = (unsigned char*)d_ws;
    (void)hipMemsetAsync((char*)d_ws + fx::WS_CTL, 0, 65536, stream);
#if FX_MODE == 0
    fx::launch(a, 0, fx::N_PHASES, 1, stream);
#elif FX_MODE == 1
    for (int p = 0; p < fx::N_PHASES; ++p) fx::launch(a, p, p + 1, 0, stream);
#else
    nv::In in{}; for (int i = 0; i < 28; ++i) in.p[i] = (const float*)d_in[i]; in.pos = (const int*)d_in[2];
    float* errs = (float*)((char*)d_ws + 381 * fx::MiB);
    (void)hipMemsetAsync(errs, 0, 256, stream);
    const int nph = DBG_NPH >= 0 ? DBG_NPH : (DBG_LAYERS == 1 ? 9 : DBG_LAYERS == 2 ? 15 : DBG_LAYERS == 3 ? 22 : 28);
    for (int p = 0; p < nph; ++p) fx::launch(a, p, p + 1, 0, stream);
    float* nws = (float*)((char*)d_ws + fx::WS_NAIVE); float* nx = (float*)((char*)d_ws + fx::WS_NAIVE + 56 * fx::MiB);
    nv::forward(in, nx, nws, stream, DBG_LAYERS, DBG_B0, 1, DBG_STAGE == 8 ? 6 : DBG_STAGE);
    int nchk = 0;
    auto CMPR = [&](const void* f, int isb, long fld, const float* r, long rld, int nrows, int ncols, float fs) { hipLaunchKernelGGL(dbg::k_cmp, dim3(512), dim3(256), 0, stream, f, isb, fld, r, rld, nrows, ncols, fs, errs + 2 * nchk); ++nchk; };
    auto CMP = [&](const void* f, int isb, long fld, const float* r, long rld, int ncols, float fs) { CMPR(f, isb, fld, r, rld, 2048, ncols, fs); };
    const size_t r0 = (size_t)DBG_B0 * 2048;
    unsigned char* ws = (unsigned char*)d_ws;
    const size_t NMi = (size_t)(1u << 20) / 8;
    float* nU = nws + nv::R_U; float* nRA = nU + 29 * NMi; float* nRB = nRA + 12 * NMi; float* nRC = nRB + 16 * NMi; float* nRD = nRC + 12 * NMi; float* nH = nRD + 8 * NMi;
    (void)nRA; (void)nRB; (void)nRC; (void)nRD; (void)nH;
    const fx::bf16_t* fU = (const fx::bf16_t*)(ws + fx::WS_BIG + fx::BIG_U); const fx::bf16_t* fQL = (const fx::bf16_t*)(ws + fx::WS_BIG + fx::BIG_UP);
    const fx::bf16_t* fKVU = fQL + 768; const fx::bf16_t* fXN = (const fx::bf16_t*)(ws + fx::WS_XN); const fx::bf16_t* fYC = (const fx::bf16_t*)(ws + fx::WS_YC);
    (void)fU; (void)fQL; (void)fKVU; (void)fXN; (void)fYC;
#if DBG_STAGE == 0 || DBG_STAGE == 9
    CMP((const float*)d_out + r0 * 1024, 0, 1024, nx, 1024, 1024, 1.f);
#elif DBG_STAGE == 1
    if ((DBG_LAYERS & 1) == 1) { CMP(fU + r0 * 2048, 1, 2048, nU, 1848, 544, 1.f); CMP(fU + r0 * 2048 + 1056, 1, 2048, nU + 1056, 1848, 256, 1.f); CMP(fU + r0 * 2048 + 1824, 1, 2048, nU + 1824, 1848, 24, 1.f); }
    else { CMP(fU + r0 * 3072 + 2048, 1, 3072, nU + 2048, 3072, 1024, 1.f); }
#elif DBG_STAGE == 2
    if ((DBG_LAYERS & 1) == 1) { CMP(fQL + r0 * 1792, 1, 1792, nRC, 768, 768, 1.f / (0.10206207261596577f * 1.4426950408889634f)); CMP(fXN + r0 * 768, 1, 768, nRA, 768, 768, 1.f); }
    else { CMP(fU + r0 * 3072, 1, 3072, nU, 3072, 1024, 1.f / (0.125f * 1.4426950408889634f)); CMP(fU + r0 * 3072 + 1024, 1, 3072, nU + 1024, 3072, 1024, 1.f); }
#elif DBG_STAGE == 3
    CMP(fU + r0 * 2048, 1, 2048, nU, 1848, 544, 1.f); CMP(fU + r0 * 2048 + 1056, 1, 2048, nU + 1056, 1848, 256, 1.f); CMP(fU + r0 * 2048 + 1824, 1, 2048, nU + 1824, 1848, 24, 1.f);
    CMP(fQL + r0 * 1792, 1, 1792, nRC, 768, 768, 1.f / (0.10206207261596577f * 1.4426950408889634f)); CMP(fXN + r0 * 768, 1, 768, nRA, 768, 768, 1.f);
    CMP(fYC + r0 * 1024, 1, 1024, nH, 1024, 512, 1.f);
#elif DBG_STAGE == 4
    if ((DBG_LAYERS & 1) == 1) { CMP(fU + r0 * 2048 + 544, 1, 2048, nRD, 512, 512, 1.f / (0.125f * 1.4426950408889634f)); }
    else { CMP(fYC + r0 * 1024, 1, 1024, nU, 1024, 1024, 1.f); }
#elif DBG_STAGE == 6
    { const float* nSM = nws + nv::R_SMALL; const fx::bf16_t* fKC = (const fx::bf16_t*)(ws + fx::WS_MISC + 65536) + (size_t)DBG_B0 * 2 * 128 * 64; const fx::bf16_t* fVC = fKC + 16 * 128 * 64;
      CMP(fU + r0 * 2048 + 544, 1, 2048, nRD, 512, 512, 1.f / (0.125f * 1.4426950408889634f));
      CMPR(fKC, 1, 64, nSM, 64, 127, 64, 1.f); CMPR(fKC + 128 * 64, 1, 64, nSM + 128 * 64, 64, 127, 64, 1.f);
      CMPR(fVC, 1, 64, nSM + 16 * 128 * 64, 64, 127, 64, 1.f); CMPR(fVC + 128 * 64, 1, 64, nSM + 17 * 128 * 64, 64, 127, 64, 1.f);
      CMP(fU + r0 * 2048 + 1312, 1, 2048, nRA, 128, 128, 1.f); CMP(fU + r0 * 2048 + 1568, 1, 2048, nRA + 2 * NMi, 128, 128, 1.f); }
#elif DBG_STAGE == 8
    { const float* nb_ = NSA_ONLY == 0 ? nRC : NSA_ONLY == 1 ? nRA + 4 * NMi : nRB; CMP(fYC + r0 * 1024 + 512, 1, 1024, nb_, 512, 512, 1.f); }
#elif DBG_STAGE == 7
    CMP(fYC + r0 * 1024, 1, 1024, nH, 1024, 512, 1.f); CMP(fYC + r0 * 1024 + 512, 1, 1024, nH + 512, 1024, 512, 1.f);
#endif
    nv::forward(in, (float*)d_out, (float*)d_ws, stream, 4, 0, 8, 0);
    hipLaunchKernelGGL(dbg::k_finish, dim3(1024), dim3(256), 0, stream, (float*)d_out, errs, nchk, (long)16384 * 1024);
#endif
}
```

```cpp
#define FX_MODE 0

#include <hip/hip_runtime.h>
#include <hip/hip_bf16.h>
#include <cstdio>
#include <cstdint>
#include <cmath>
#include <hip/hip_cooperative_groups.h>
namespace pg8 {
#define PG8_LAS __attribute__((address_space(3)))
typedef unsigned short bf16_t;
typedef short bf16x8 __attribute__((ext_vector_type(8)));
typedef float f32x4 __attribute__((ext_vector_type(4)));
typedef unsigned u32x4 __attribute__((ext_vector_type(4)));
constexpr int BM = 256, BK = 64, HALF = 128, HTB = HALF * BK * 2  , STAGE_BYTES = 8 * HTB, NXCD = 8, WGM = 8;

__host__ __device__ __forceinline__ int lds_byte(int r, int c) { const int st = (r >> 4) * 2 + (c >> 5), rr = r & 15, cc = c & 31, ob = rr * 64 + cc * 2; return st * 1024 + (ob ^ (((ob >> 9) & 1) << 5)); }
__host__ __device__ __forceinline__ void stage_rc(int b, int& R, int& C) { const int st = b / 1024, sb = b % 1024, swz = sb ^ (((sb >> 9) & 1) << 5); R = (st >> 1) * 16 + swz / 64; C = (st & 1) * 32 + (swz % 64) / 2; }
__host__ __device__ __forceinline__ int perm32(int rho) { const int n = rho >> 4, i = rho & 15; return 8 * (i >> 2) + 4 * n + (i & 3); }

struct Unit { int pm, pn; int aoff; };
struct Gemm { const bf16_t* A; const bf16_t* Bt; int M, N, K, lda; };

struct StaticOrder {
    int nM, nN, nwg, G, c;
    __host__ __device__ void init(int M, int N, int G_, int c_) { nM = M / BM; nN = N / BM; nwg = nM * nN; G = G_; c = c_; }
    __host__ __device__ bool next(int i, Unit& u) const {
        const long L = (long)i * G + c; if (L >= nwg) return false;
        int wgid = (int)L; { const int q = nwg / NXCD, r = nwg % NXCD, xcd = wgid % NXCD, off = wgid / NXCD; wgid = (xcd < r ? xcd * (q + 1) : r * (q + 1) + (xcd - r) * q) + off; }
        const int nig = WGM * nN, gid = wgid / nig, fm = gid * WGM, gsz = (nM - fm) < WGM ? (nM - fm) : WGM;
        u.pm = fm + ((wgid % nig) % gsz); u.pn = (wgid % nig) / gsz; u.aoff = 0; return true;
    }
    __device__ __forceinline__ void a_ready(const Unit&) const {}
    __device__ __forceinline__ void done(const Unit&) const {}
};

__device__ __forceinline__ unsigned cvt_pk_bf16(float lo, float hi) { unsigned r; asm volatile("v_cvt_pk_bf16_f32 %0, %1, %2" : "=v"(r) : "v"(lo), "v"(hi)); return r; }
typedef float f32x2 __attribute__((ext_vector_type(2)));
__device__ __forceinline__ f32x2 gelu_pk(f32x2 v) {
    const f32x2 av = __builtin_elementwise_abs(v), d = av * 0.2316418882f + 1.0f;
    f32x2 t; t.x = __builtin_amdgcn_rcpf(d.x); t.y = __builtin_amdgcn_rcpf(d.y);
    f32x2 q = t * 0.5307027145f + (-0.7265760135f); q = q * t + 0.7107068705f; q = q * t + (-0.142248368f); q = q * t + 0.127414796f; q = q * t;
    const f32x2 s = (v * v) * (-0.72134752044f);
    f32x2 e; e.x = __builtin_amdgcn_exp2f(s.x); e.y = __builtin_amdgcn_exp2f(s.y);
    const f32x2 m = v * (q * e), r = v - m;
    f32x2 o; o.x = v.x < 0.f ? m.x : r.x; o.y = v.y < 0.f ? m.y : r.y; return o;
}

template <int ACT  > struct EpiBf16 {
    static constexpr bool PERM = true, AFTER_DRAIN = false; static_assert(ACT == 0 || ACT == 1, "EpiBf16: ACT is 0 (none) or 1 (gelu_pk)");
    bf16_t* O; int ldc; const float* bias; int split_cols; size_t split_stride; float scale0;
    __device__ __forceinline__ void operator()(const f32x4 (&acc)[2][2][4][2], const Unit& u, int wr, int wc, int fr, int fq) const {
        const int row0 = u.pm * BM + wr * 64 + fr; int colt = u.pn * BM; bf16_t* base = O;
        float sc = 1.f; if (split_cols) { const int t = colt / split_cols; base += (size_t)t * split_stride; colt -= t * split_cols; if (t == 0) sc = scale0; }
        const int col0 = colt + wc * 32 + 8 * fq, bcol0 = u.pn * BM + wc * 32 + 8 * fq;
        f32x4 bv[2][2];
#pragma unroll
        for (int bj = 0; bj < 2; ++bj)
#pragma unroll
            for (int n = 0; n < 2; ++n) bv[bj][n] = bias ? *(const f32x4*)(bias + bcol0 + bj * HALF + 4 * n) : (f32x4){0.f, 0.f, 0.f, 0.f};
#pragma unroll
        for (int ai = 0; ai < 2; ++ai)
#pragma unroll
            for (int m = 0; m < 4; ++m) { bf16_t* rowp = base + (size_t)(row0 + ai * HALF + m * 16) * ldc + col0;
#pragma unroll
                for (int bj = 0; bj < 2; ++bj) { f32x4 v0 = acc[ai][bj][m][0] + bv[bj][0], v1 = acc[ai][bj][m][1] + bv[bj][1];
                    if (ACT == 1) { f32x2 a = gelu_pk((f32x2){v0[0], v0[1]}), b = gelu_pk((f32x2){v0[2], v0[3]}), c = gelu_pk((f32x2){v1[0], v1[1]}), d = gelu_pk((f32x2){v1[2], v1[3]});
                        v0 = (f32x4){a.x, a.y, b.x, b.y}; v1 = (f32x4){c.x, c.y, d.x, d.y}; }
                    v0 = v0 * sc; v1 = v1 * sc; u32x4 w; w.x = cvt_pk_bf16(v0[0], v0[1]); w.y = cvt_pk_bf16(v0[2], v0[3]); w.z = cvt_pk_bf16(v1[0], v1[1]); w.w = cvt_pk_bf16(v1[2], v1[3]);
                    *(u32x4*)(rowp + bj * HALF) = w; } }
    }
};

template <class Epi, class Sched, bool ALIGN_EPI = false, bool SP2 = false>
__device__ __forceinline__ void gemm_phase(PG8_LAS unsigned char* lds, const Gemm g, const Sched& S, const Epi& E) {
    int tid_ = threadIdx.x; asm volatile("" : "+v"(tid_)); const int tid = tid_, wid = __builtin_amdgcn_readfirstlane(tid >> 6), lane = tid & 63, wr = wid >> 2, wc = wid & 3, fr = lane & 15, fq = lane >> 4;
    const int K = g.K, nt = K / BK;
    unsigned voffA[2], voffB[2];
#pragma unroll
    for (int i = 0; i < 2; ++i) { int R, C; stage_rc(tid * 16 + i * 8192, R, C); const int Rb = Epi::PERM ? ((R & ~31) + perm32(R & 31)) : R;
        voffA[i] = (unsigned)(R * g.lda + C) * 2u; voffB[i] = (unsigned)(Rb * K + C) * 2u; }
    const size_t kstep = (size_t)(BK * 2);
    const size_t hstep = (size_t)HALF * K * 2;
    const size_t hstepA = (size_t)HALF * g.lda * 2, tstepA = 2 * hstepA;
    const size_t tstep = 2 * hstep;
    const unsigned ldsw = (unsigned)wid * 1024u;
    const int aoff = lds_byte(wr * 64 + fr, fq * 8), boff = lds_byte(wc * 32 + fr, fq * 8);
#define PG8_SA(b, h) (((b) * 2 + (h)) * HTB)
#define PG8_SB(b, h) ((4 + (b) * 2 + (h)) * HTB)
#define PG8_STAGE(bufoff, gbase, voff) do { _Pragma("unroll") for (int _i = 0; _i < 2; ++_i) \
        __builtin_amdgcn_global_load_lds((const unsigned*)((const char*)(gbase) + (voff)[_i]), (PG8_LAS unsigned*)(lds + (bufoff) + ldsw + _i * 8192), 16, 0, 0); } while (0)
#define PG8_LDA(dst, b, h) do { _Pragma("unroll") for (int m = 0; m < 4; ++m) _Pragma("unroll") for (int k = 0; k < 2; ++k) dst[m][k] = *(const PG8_LAS bf16x8*)(lds + PG8_SA(b, h) + aoff + m * 2048 + k * 1024); } while (0)
#define PG8_LDB(dst, b, h) do { _Pragma("unroll") for (int n = 0; n < 2; ++n) _Pragma("unroll") for (int k = 0; k < 2; ++k) dst[n][k] = *(const PG8_LAS bf16x8*)(lds + PG8_SB(b, h) + boff + n * 2048 + k * 1024); } while (0)
#define PG8_MMA(ai, bj, At, Bt) do { __builtin_amdgcn_s_setprio(1); _Pragma("unroll") for (int m = 0; m < 4; ++m) _Pragma("unroll") for (int n = 0; n < 2; ++n) _Pragma("unroll") for (int k = 0; k < 2; ++k) \
        acc[ai][bj][m][n] = __builtin_amdgcn_mfma_f32_16x16x32_bf16(Bt[n][k], At[m][k], acc[ai][bj][m][n], 0, 0, 0); __builtin_amdgcn_s_setprio(0); } while (0)
#define PG8_WAIT_V(n) asm volatile("s_waitcnt vmcnt(" #n ")" ::: "memory")
#define PG8_WAIT_L(n) asm volatile("s_waitcnt lgkmcnt(" #n ")" ::: "memory")
#define PG8_BAR __builtin_amdgcn_s_barrier()
#define PG8_SCHED __builtin_amdgcn_sched_barrier(0)
    Unit cur, nxt; int ui = 0;
    if (!S.next(0, cur)) return;
    f32x4 acc[2][2][4][2];
#pragma unroll
    for (int a = 0; a < 2; ++a)
#pragma unroll
        for (int b = 0; b < 2; ++b)
#pragma unroll
            for (int m = 0; m < 4; ++m)
#pragma unroll
                for (int n = 0; n < 2; ++n) acc[a][b][m][n] = (f32x4){0.f, 0.f, 0.f, 0.f};
    bf16x8 At[4][2], B0[2][2], B1[2][2];
    const char* cA = (const char*)g.A + (size_t)cur.pm * tstepA + (size_t)cur.aoff * 2; const char* cB = (const char*)g.Bt + (size_t)cur.pn * tstep;
    S.a_ready(cur);
    if constexpr (SP2) {
        PG8_STAGE(PG8_SB(0, 0), cB, voffB); PG8_STAGE(PG8_SB(0, 1), cB + hstep, voffB); PG8_STAGE(PG8_SA(0, 0), cA, voffA); PG8_STAGE(PG8_SA(0, 1), cA + hstepA, voffA);
        if (wr == 1) PG8_BAR;
        PG8_WAIT_V(2); PG8_BAR;
        PG8_STAGE(PG8_SB(1, 0), cB + kstep, voffB); PG8_STAGE(PG8_SA(1, 0), cA + kstep, voffA); PG8_STAGE(PG8_SB(1, 1), cB + hstep + kstep, voffB);
        PG8_WAIT_V(6); PG8_BAR;
    } else {
        PG8_STAGE(PG8_SB(0, 0), cB, voffB); PG8_STAGE(PG8_SA(0, 0), cA, voffA); PG8_STAGE(PG8_SB(0, 1), cB + hstep, voffB); PG8_STAGE(PG8_SA(0, 1), cA + hstepA, voffA);
        if (wr == 1) PG8_BAR;
        PG8_WAIT_V(4); PG8_BAR;
        PG8_STAGE(PG8_SB(1, 0), cB + kstep, voffB); PG8_STAGE(PG8_SA(1, 0), cA + kstep, voffA); PG8_STAGE(PG8_SB(1, 1), cB + hstep + kstep, voffB);
        PG8_WAIT_V(6); PG8_BAR;
    }
    for (;;) {
        const bool has_next = S.next(ui + 1, nxt);
        const char* nA = has_next ? (const char*)g.A + (size_t)nxt.pm * tstepA + (size_t)nxt.aoff * 2 : cA; const char* nB = has_next ? (const char*)g.Bt + (size_t)nxt.pn * tstep : cB;
        for (int t = 0; t < nt; t += 2) {
            const bool last = (t == nt - 2);
            const char* a1 = cA + (size_t)(t + 1) * kstep;
            const char* a2 = last ? nA : cA + (size_t)(t + 2) * kstep; const char* b2 = last ? nB : cB + (size_t)(t + 2) * kstep;
            const char* a3 = a2 + kstep; const char* b3 = b2 + kstep;
            if (last && has_next) S.a_ready(nxt);
            if constexpr (SP2) {
            PG8_LDB(B0, 0, 0); PG8_LDB(B1, 0, 1); PG8_SCHED; PG8_LDA(At, 0, 0); PG8_STAGE(PG8_SA(1, 1), a1 + hstepA, voffA);
            PG8_WAIT_V(8); PG8_WAIT_L(0); PG8_BAR; PG8_MMA(0, 0, At, B0); PG8_MMA(0, 1, At, B1); PG8_BAR; PG8_SCHED;
            PG8_LDA(At, 0, 1); PG8_STAGE(PG8_SB(0, 0), b2, voffB); PG8_STAGE(PG8_SB(0, 1), b2 + hstep, voffB); PG8_STAGE(PG8_SA(0, 0), a2, voffA);
            PG8_WAIT_V(8); PG8_WAIT_L(0); PG8_BAR; PG8_MMA(1, 0, At, B0); PG8_MMA(1, 1, At, B1); PG8_BAR; PG8_SCHED;
            PG8_LDB(B0, 1, 0); PG8_LDB(B1, 1, 1); PG8_SCHED; PG8_LDA(At, 1, 0); PG8_STAGE(PG8_SA(0, 1), a2 + hstepA, voffA);
            PG8_WAIT_V(8); PG8_WAIT_L(0); PG8_BAR; PG8_MMA(0, 0, At, B0); PG8_MMA(0, 1, At, B1); PG8_BAR; PG8_SCHED;
            PG8_LDA(At, 1, 1); PG8_STAGE(PG8_SB(1, 0), b3, voffB); PG8_STAGE(PG8_SB(1, 1), b3 + hstep, voffB); PG8_STAGE(PG8_SA(1, 0), a3, voffA);
            PG8_WAIT_V(8); PG8_WAIT_L(0); PG8_BAR; PG8_MMA(1, 0, At, B0); PG8_MMA(1, 1, At, B1); PG8_BAR; PG8_SCHED;
            } else {
            PG8_LDB(B0, 0, 0); PG8_SCHED; PG8_LDA(At, 0, 0); PG8_STAGE(PG8_SA(1, 1), a1 + hstepA, voffA);
            PG8_WAIT_L(8); PG8_BAR; PG8_WAIT_L(0); PG8_MMA(0, 0, At, B0); PG8_BAR; PG8_SCHED;
            PG8_LDB(B1, 0, 1); PG8_STAGE(PG8_SB(0, 0), b2, voffB);
            PG8_BAR; PG8_WAIT_L(0); PG8_MMA(0, 1, At, B1); PG8_BAR;
            PG8_LDA(At, 0, 1); PG8_STAGE(PG8_SA(0, 0), a2, voffA);
            PG8_BAR; PG8_WAIT_L(0); PG8_MMA(1, 0, At, B0); PG8_BAR; PG8_SCHED;
            PG8_STAGE(PG8_SB(0, 1), b2 + hstep, voffB);
            PG8_WAIT_V(6); PG8_BAR; PG8_MMA(1, 1, At, B1); PG8_BAR;
            PG8_LDB(B0, 1, 0); PG8_SCHED; PG8_LDA(At, 1, 0); PG8_STAGE(PG8_SA(0, 1), a2 + hstepA, voffA);
            PG8_WAIT_L(8); PG8_BAR; PG8_WAIT_L(0); PG8_MMA(0, 0, At, B0); PG8_BAR; PG8_SCHED;
            PG8_LDB(B1, 1, 1); PG8_STAGE(PG8_SB(1, 0), b3, voffB);
            PG8_BAR; PG8_WAIT_L(0); PG8_MMA(0, 1, At, B1); PG8_BAR;
            PG8_LDA(At, 1, 1); PG8_STAGE(PG8_SA(1, 0), a3, voffA);
            PG8_BAR; PG8_WAIT_L(0); PG8_MMA(1, 0, At, B0); PG8_BAR; PG8_SCHED;
            PG8_STAGE(PG8_SB(1, 1), b3 + hstep, voffB);
            PG8_WAIT_V(6); PG8_BAR; PG8_MMA(1, 1, At, B1); PG8_BAR;
            }
        }
        if constexpr (ALIGN_EPI) { if (wr == 0) PG8_BAR; }
        if constexpr (!Epi::AFTER_DRAIN) { E(acc, cur, wr, wc, fr, fq); S.done(cur); }
        if (!has_next) break;
#pragma unroll
        for (int a = 0; a < 2; ++a)
#pragma unroll
            for (int b = 0; b < 2; ++b)
#pragma unroll
                for (int m = 0; m < 4; ++m)
#pragma unroll
                    for (int n = 0; n < 2; ++n) acc[a][b][m][n] = (f32x4){0.f, 0.f, 0.f, 0.f};
        cur = nxt; cA = nA; cB = nB; ++ui;
        if constexpr (ALIGN_EPI) { if (wr == 1) PG8_BAR; }
    }
    PG8_WAIT_V(0);
    if constexpr (!ALIGN_EPI) { if (wr == 0) PG8_BAR; }
    PG8_BAR;
    if constexpr (Epi::AFTER_DRAIN) { E.fused(acc, cur, wr, wc, fr, fq, lds, wid, lane); S.done(cur); }
#undef PG8_SA
#undef PG8_SB
#undef PG8_STAGE
#undef PG8_LDA
#undef PG8_LDB
#undef PG8_MMA
#undef PG8_WAIT_V
#undef PG8_WAIT_L
#undef PG8_BAR
#undef PG8_SCHED
}
}
#ifndef FX_REPEAT_KIND
#define FX_REPEAT_KIND 0
#endif
#ifndef FX_STG
#define FX_STG true
#endif
#ifndef FX_SWEEP2
#define FX_SWEEP2 0
#endif
#ifndef FX_QKDB
#define FX_QKDB false
#endif
#ifndef FX_PRO_MATS
#define FX_PRO_MATS 28
#endif
#ifndef FX_PRIO
#define FX_PRIO 0
#endif
#ifndef FX_LATE
#define FX_LATE(w) ((w) >= 4)
#endif
#define REP(kind) for (int rep_ = 0; rep_ < ((FX_REPEAT_KIND == (kind)) ? 2 : 1); ++rep_)
namespace fx {
#define DI __device__ __forceinline__
#define LAS __attribute__((address_space(3)))
typedef unsigned short bf16_t;
typedef short bf16x8 __attribute__((ext_vector_type(8)));
typedef short s16x4 __attribute__((ext_vector_type(4)));
typedef float f32x4 __attribute__((ext_vector_type(4)));
typedef float f32x16 __attribute__((ext_vector_type(16)));
typedef unsigned u32x4 __attribute__((ext_vector_type(4)));
typedef unsigned u32x2 __attribute__((ext_vector_type(2)));
constexpr int B = 8, S = 2048, D = 1024, T = B * S, FF = 4096, HYIN = 1848, UW = 2048;
constexpr float EPS = 1e-6f, LOG2E = 1.4426950408889634f;
constexpr int NW = 8, NT = 512;
constexpr size_t MiB = 1u << 20;
constexpr size_t WS_CTL = 0;
constexpr size_t WS_MOD = 1 * MiB;
constexpr size_t WS_CS8 = 2 * MiB;
constexpr size_t WS_CS16 = 3 * MiB;
constexpr size_t WS_MISC = 5 * MiB;
constexpr size_t WS_W = 6 * MiB;
constexpr size_t W_EVEN = 9 * MiB, W_ODD = 8 * MiB, W_MLP = 16 * MiB;
constexpr size_t WE_IN = 0, WE_OUT = 4 * MiB, WE_UP = 6 * MiB, WE_C1 = 7 * MiB, WE_C2 = 8 * MiB;
constexpr size_t WO_QKV = 0, WO_O = 6 * MiB;
constexpr size_t WS_WEVEN = WS_W, WS_WODD = WS_W + 2 * W_EVEN, WS_WMLP = WS_WODD + 2 * W_ODD;
constexpr size_t WS_XN = 104 * MiB;
constexpr size_t WS_YC = 136 * MiB;
constexpr size_t WS_BIG = 168 * MiB;
constexpr size_t BIG_U = 0, BIG_UP = 64 * MiB + 64 * 1024;
constexpr int UPW = 1792;
constexpr size_t WS_FAST_END = 296 * MiB;
constexpr size_t WS_SS = 332 * MiB;
constexpr size_t WS_SHW = 296 * MiB;
constexpr size_t WS_XB = 300 * MiB;
constexpr size_t WS_NAIVE = 300 * MiB;
constexpr int LDS_MISC = 131072, LDS_BYTES = 147456;

DI unsigned f2bf(float f) { unsigned u = __builtin_bit_cast(unsigned, f); return (u + 0x7fffu + ((u >> 16) & 1u)) >> 16; }
DI unsigned pk2(float lo, float hi) { return f2bf(lo) | (f2bf(hi) << 16); }
DI float bf2f(unsigned short b) { return __builtin_bit_cast(float, (unsigned)b << 16); }
DI float bflo(unsigned u) { return __builtin_bit_cast(float, u << 16); }
DI float bfhi(unsigned u) { return __builtin_bit_cast(float, u & 0xffff0000u); }
typedef short v4i16_t_ __attribute__((ext_vector_type(4)));
DI s16x4 vtr(const LAS char* p) { return __builtin_bit_cast(s16x4, __builtin_amdgcn_ds_read_tr16_b64_v4i16((LAS v4i16_t_*)p)); }
template <int O> DI float swz(float v) { static_assert(O < 32, "swz: xor mask < 32"); return __builtin_bit_cast(float, __builtin_amdgcn_ds_swizzle(__builtin_bit_cast(int, v), (O << 10) | 0x1f)); }
template <int O> DI unsigned swzu(unsigned v) { return (unsigned)__builtin_amdgcn_ds_swizzle((int)v, (O << 10) | 0x1f); }
DI void xchg32(unsigned& a, unsigned& b) { asm volatile("s_nop 1\n\tv_permlane32_swap_b32 %0, %1\n\ts_nop 1" : "+v"(a), "+v"(b)); }
DI float sum32(float v) { unsigned a = __builtin_bit_cast(unsigned, v), b = a; xchg32(a, b); return __builtin_bit_cast(float, a) + __builtin_bit_cast(float, b); }
DI float max32(float v) { unsigned a = __builtin_bit_cast(unsigned, v), b = a; xchg32(a, b); return fmaxf(__builtin_bit_cast(float, a), __builtin_bit_cast(float, b)); }
DI unsigned or32(unsigned v) { unsigned a = v, b = v; xchg32(a, b); return a | b; }
#ifdef DBG_SHFL
DI float wave_sum(float v) { for (int o = 1; o < 64; o <<= 1) v += __shfl_xor(v, o); return v; }
#else
DI float wave_sum(float v) { v += swz<1>(v); v += swz<2>(v); v += swz<4>(v); v += swz<8>(v); v += swz<16>(v); return sum32(v); }
#endif

struct Args { const float* in[28]; const int* pos; float* out; unsigned char* ws; int ph_lo, ph_hi; int use_cg; int pad; };
typedef const __attribute__((address_space(4))) Args CArgs;
#define XB_TMO      128
#define XB_XCNT(j)  (256  + 64 * (j))
#define XB_XSUB(j)  (1280 + 64 * (j))
#define XB_XGEN(j)  (2304 + 64 * (j))
#define XB_TOP      3328
#define XB_TOPGEN   3392
#define XCD_BAR_WORDS 3456
#define XB_SPIN_CAP (1u << 20)
DI unsigned xb_ld(unsigned* p)              { return __hip_atomic_load(p, __ATOMIC_RELAXED, __HIP_MEMORY_SCOPE_AGENT); }
DI unsigned xb_add(unsigned* p, unsigned v) { return __hip_atomic_fetch_add(p, v, __ATOMIC_RELAXED, __HIP_MEMORY_SCOPE_AGENT); }
DI unsigned xb_xcc_id() { return (unsigned)__builtin_amdgcn_s_getreg((3 << 11) | 20) & 0xFu; }
#define XB_SPIN(cond, bar) do { unsigned _sp = 0; while (cond) { __builtin_amdgcn_s_sleep(1); \
    if ((++_sp & 255u) == 0u) { if (xb_ld(&(bar)[XB_TMO])) break; if (_sp > XB_SPIN_CAP) { atomicAdd(&(bar)[XB_TMO], 1u); break; } } } } while (0)
struct XcdBarrier { unsigned* bar; unsigned x; volatile LAS unsigned* st; };
DI XcdBarrier xcd_barrier_post(unsigned* bar, volatile LAS unsigned* st) {
    XcdBarrier b; b.bar = bar; b.x = xb_xcc_id(); b.st = st;
    if (threadIdx.x == 0) (void)xb_add(&bar[XB_XCNT(b.x)], 1u);
    return b;
}
DI void xcd_barrier_complete(unsigned* bar, unsigned x, unsigned& nloc, unsigned& nx) {
    const unsigned G = gridDim.x * gridDim.y * gridDim.z;
    unsigned sum, cnt, mine, sp = 0u;
    for (;;) {
        sum = 0u; cnt = 0u; mine = 0u;
#pragma unroll
        for (unsigned j = 0; j < 16; ++j) { const unsigned c = xb_ld(&bar[XB_XCNT(j)]); sum += c; cnt += (c > 0u) ? 1u : 0u; mine = (j == x) ? c : mine; }
        if (sum == G) break;
        __builtin_amdgcn_s_sleep(1);
        if ((++sp & 255u) == 0u) { if (xb_ld(&bar[XB_TMO])) break; if (sp > XB_SPIN_CAP) { atomicAdd(&bar[XB_TMO], 1u); break; } }
    }
    nloc = mine > 0u ? mine : 1u; nx = cnt > 0u ? cnt : 1u;
}
DI void xcd_barrier(const XcdBarrier& b) {
    asm volatile("s_waitcnt vmcnt(0)" ::: "memory");
    __syncthreads();
    int t0_ = threadIdx.x; asm volatile("" : "+v"(t0_));
    if (t0_ == 0) {
        unsigned* bar; { CArgs* p_ = (CArgs*)__builtin_amdgcn_kernarg_segment_ptr(); asm volatile("" : "+s"(p_)); bar = (unsigned*)(p_->ws + WS_CTL) + 4096; }
        __builtin_amdgcn_s_waitcnt(0);
        unsigned nloc = b.st[0], nx = b.st[1];
        unsigned bx = b.x; asm volatile("" : "+s"(bx));
        if (nloc == 0u) { xcd_barrier_complete(bar, bx, nloc, nx); b.st[0] = nloc; b.st[1] = nx; }
        const unsigned old = xb_add(&bar[XB_XSUB(bx)], 1u);
        const unsigned gen = old / nloc;
        if (old + 1u == (gen + 1u) * nloc) {
            __builtin_amdgcn_fence(__ATOMIC_RELEASE, "agent");
            asm volatile("s_waitcnt vmcnt(0)" ::: "memory");
            const unsigned og = xb_add(&bar[XB_TOP], 1u);
            const unsigned tg = og / nx;
            if (og + 1u == (tg + 1u) * nx) xb_add(&bar[XB_TOPGEN], 1u);
            else XB_SPIN(xb_ld(&bar[XB_TOPGEN]) == tg, bar);
            __builtin_amdgcn_fence(__ATOMIC_ACQUIRE, "agent");
            xb_add(&bar[XB_XGEN(bx)], 1u);
            asm volatile("s_waitcnt vmcnt(0)" ::: "memory");
        } else {
            XB_SPIN(xb_ld(&bar[XB_XGEN(bx)]) == gen, bar);
            __builtin_amdgcn_fence(__ATOMIC_ACQUIRE, "agent");
            asm volatile("s_waitcnt vmcnt(0)" ::: "memory");
        }
    }
    __syncthreads();
}

struct Ctx {
    LAS unsigned char* lds; int tid, lane, wave, G, bid; unsigned char* ws; int var; CArgs* a;
};
#define RELAUNDER(c) do { int t_ = threadIdx.x; asm volatile("" : "+v"(t_)); (c).tid = t_; (c).lane = t_ & 63; int b_ = blockIdx.x, g_ = gridDim.x; asm volatile("" : "+s"(b_), "+s"(g_)); (c).bid = b_; (c).G = g_; } while (0)

struct TrRegs { f32x4 tv[8]; };
constexpr int TRS = 544;
DI void transpose_load(TrRegs& r, const float* W, int ld, int N, int item, int nblk, int wave, int lane) {
    const int k0 = 64 * (item / nblk) + 8 * wave, n = 256 * (item % nblk) + 4 * lane;
#pragma unroll
    for (int i = 0; i < 8; ++i) { r.tv[i] = (f32x4){0.f, 0.f, 0.f, 0.f}; if (n < N) r.tv[i] = *(const f32x4*)(W + (size_t)(k0 + i) * ld + n); }
}
DI void transpose_finish(const TrRegs& r, int K, int Npad, bf16_t* WT, const float* kscale, LAS char* img, int item, int nblk, int wave, int lane) {
    const int k0 = 64 * (item / nblk), n0 = 256 * (item % nblk);
#pragma unroll
    for (int i = 0; i < 8; ++i) { f32x4 v = r.tv[i]; if (kscale) v = v * kscale[k0 + 8 * wave + i];
        u32x2 w; w.x = pk2(v.x, v.y); w.y = pk2(v.z, v.w); *(LAS u32x2*)(img + (8 * wave + i) * TRS + lane * 8) = w; }
    __syncthreads();
    const int g = lane >> 4, i16 = lane & 15, q = i16 >> 2, p = i16 & 3;
#pragma unroll
    for (int j = 0; j < 4; ++j) { const int kc = 4 * (j & 1) + g, nb = 2 * wave + (j >> 1);
        const LAS char* rb = img + (8 * kc + q) * TRS + (16 * nb + 4 * p) * 2;
        const s16x4 lo = vtr(rb), hi = vtr(rb + 4 * TRS);
        const int nn = n0 + 16 * nb + i16;
        if (nn < Npad) *(bf16x8*)(WT + (size_t)nn * K + k0 + 8 * kc) = __builtin_shufflevector(lo, hi, 0, 1, 2, 3, 4, 5, 6, 7); }
    __syncthreads();
}
struct MatDesc { const float* src; int ld, K, N, Npad; bf16_t* dst; const float* kscale; };
DI MatDesc get_mat(CArgs& a, unsigned char* ws, int idx) {
    MatDesc m; m.kscale = nullptr;
    if (idx < 16) { const int j = idx >> 3, t = idx & 7; unsigned char* base = ws + WS_WEVEN + j * W_EVEN;
        if (t == 0) { m.src = a.in[9] + (size_t)j * D * HYIN; m.ld = HYIN; m.K = D; m.N = HYIN; m.Npad = UW; m.dst = (bf16_t*)(base + WE_IN); }
        else if (t == 1) { m.src = a.in[10] + (size_t)j * D * D; m.ld = D; m.K = D; m.N = D; m.Npad = D; m.dst = (bf16_t*)(base + WE_OUT); }
        else if (t == 2) { m.src = a.in[12] + (size_t)j * 256 * 768; m.ld = 768; m.K = 256; m.N = 768; m.Npad = 768; m.dst = (bf16_t*)(base + WE_UP); m.kscale = a.in[11] + j * 256; }
        else if (t == 3) { m.src = a.in[14] + (size_t)j * 256 * 1024; m.ld = 1024; m.K = 256; m.N = 1024; m.Npad = 1024; m.dst = (bf16_t*)(base + WE_UP) + 768 * 256; m.kscale = a.in[13] + j * 256; }
        else if (t < 6) { const int jj = t - 4; m.src = a.in[20] + ((size_t)j * 2 + jj) * 2048 * 128; m.ld = 128; m.K = 2048; m.N = 128; m.Npad = 128; m.dst = (bf16_t*)(base + WE_C1) + (size_t)jj * 128 * 2048; }
        else { const int jj = t - 6; m.src = a.in[21] + ((size_t)j * 2 + jj) * 128 * 64; m.ld = 64; m.K = 128; m.N = 64; m.Npad = 64; m.dst = (bf16_t*)(base + WE_C2) + (size_t)jj * 64 * 128; }
    } else if (idx < 20) { const int j = (idx - 16) >> 1, t = idx & 1; unsigned char* base = ws + WS_WODD + j * W_ODD;
        if (t == 0) { m.src = a.in[22] + (size_t)j * D * 3072; m.ld = 3072; m.K = D; m.N = 3072; m.Npad = 3072; m.dst = (bf16_t*)(base + WO_QKV); }
        else { m.src = a.in[23] + (size_t)j * D * D; m.ld = D; m.K = D; m.N = D; m.Npad = D; m.dst = (bf16_t*)(base + WO_O); }
    } else { const int i = (idx - 20) >> 1, t = idx & 1; unsigned char* base = ws + WS_WMLP + i * W_MLP;
        if (t == 0) { m.src = a.in[7] + (size_t)i * D * FF; m.ld = FF; m.K = D; m.N = FF; m.Npad = FF; m.dst = (bf16_t*)base; }
        else { m.src = a.in[8] + (size_t)i * FF * D; m.ld = D; m.K = FF; m.N = D; m.Npad = D; m.dst = (bf16_t*)(base + 8 * MiB); }
    }
    return m;
}
DI void convert_mats(Ctx& c, int lo, int hi) {
    CArgs& a = *c.a; unsigned char* ws = c.ws; LAS char* img = (LAS char*)c.lds;
    int base = 0;
    for (int mi = lo; mi < hi; ++mi) {
        const MatDesc m = get_mat(a, ws, mi); const int nblk = (m.Npad + 255) / 256, nit = (m.K / 64) * nblk;
        for (int it = (c.bid + c.G - (base % c.G)) % c.G; it < nit; it += 2 * c.G) {
            TrRegs ra, rb2; const int it2 = it + c.G; transpose_load(ra, m.src, m.ld, m.N, it, nblk, c.wave, c.lane); if (it2 < nit) transpose_load(rb2, m.src, m.ld, m.N, it2, nblk, c.wave, c.lane);
            transpose_finish(ra, m.K, m.Npad, m.dst, m.kscale, img, it, nblk, c.wave, c.lane); if (it2 < nit) transpose_finish(rb2, m.K, m.Npad, m.dst, m.kscale, img, it2, nblk, c.wave, c.lane); }
        base += nit;
    }
}
DI void phase_prologue(Ctx& c) {
    CArgs& a = *c.a; unsigned char* ws = c.ws;
    const int gw = c.bid * NW + c.wave, NGW = c.G * NW;
    LAS float* cond = (LAS float*)(c.lds + 98304);
    for (int i = c.tid; i < 8192; i += NT) { float v = a.in[1][i]; cond[i] = v / (1.f + __expf(-v)); }
    __syncthreads();
    float* mod = (float*)(ws + WS_MOD);
    LAS float* red = (LAS float*)c.lds;
    REP(18) for (int it = c.bid; it < 384; it += c.G) {
        const int n = it * 64 + c.lane; const int li = n / 6144, nn = n % 6144;
        const float* w = a.in[3] + (size_t)li * D * 6144 + (size_t)(c.wave * 128) * 6144 + nn; float acc[8] = {0, 0, 0, 0, 0, 0, 0, 0};
#pragma unroll 32
        for (int k = 0; k < 128; ++k) { const float wv = w[(size_t)k * 6144];
#pragma unroll
            for (int b = 0; b < 8; ++b) acc[b] += cond[b * D + c.wave * 128 + k] * wv; }
#pragma unroll
        for (int b = 0; b < 8; ++b) red[(c.wave * 8 + b) * 64 + c.lane] = acc[b];
        __syncthreads();
        { const int b = c.wave; float s = 0.f;
#pragma unroll
          for (int ww = 0; ww < 8; ++ww) s += red[(ww * 8 + b) * 64 + c.lane];
          mod[((size_t)li * 8 + b) * 6144 + nn] = s + a.in[4][li * 6144 + nn]; }
        __syncthreads();
    }
    { float* P = (float*)(ws + WS_MISC);
      for (int it = gw; it < 256; it += NGW) { const int jj2 = it >> 6, kc = (it >> 1) & 31, n = (it & 1) * 64 + c.lane;
          const float* cp = a.in[19] + (size_t)jj2 * 2048 + kc * 64; const float* w = a.in[20] + (size_t)jj2 * 2048 * 128 + (size_t)(kc * 64) * 128 + n; float acc = 0.f;
#pragma unroll 16
          for (int k = 0; k < 64; ++k) acc += cp[k] * w[(size_t)k * 128];
          P[(jj2 * 32 + kc) * 128 + n] = acc; } }
    REP(16) convert_mats(c, 0, FX_PRO_MATS);
    { float* cs8 = (float*)(ws + WS_CS8); float* cs16 = (float*)(ws + WS_CS16);
      REP(17) for (int g = c.bid * NT + c.tid; g < T * 24; g += c.G * NT) { const int m = g / 24, i = g % 24; const double p = (double)a.pos[m];
          if (i < 8) { const double f = pow(500000.0, -(double)i / 8.0), an = p * f; cs8[(m * 8 + i) * 2] = (float)cos(an); cs8[(m * 8 + i) * 2 + 1] = (float)sin(an); }
          else { const int k = i - 8; const double f = pow(500000.0, -(double)k / 16.0), an = p * f; cs16[(m * 16 + k) * 2] = (float)cos(an); cs16[(m * 16 + k) * 2 + 1] = (float)sin(an); } } }
}

DI void shw_items(Ctx& c, int set) {
    unsigned char* ws = c.ws; const int gw = c.bid * NW + c.wave, NGW = c.G * NW, lane = c.lane, r16 = lane & 15, q4 = lane >> 4;
    for (int it = gw; it < 768; it += NGW) {
        int g, r = it;
        if (set == 0) { if (r < 256) g = 1; else if ((r -= 256) < 192) g = 2; else if ((r -= 192) < 128) g = 4; else { r -= 128; g = 6; } }
        else { g = 3 + 2 * (r >> 8); r &= 255; }
        const int layer = g >> 1, sub = g & 1;
        const bf16_t* Wt = sub ? (const bf16_t*)(ws + WS_WMLP + (size_t)layer * W_MLP) : ((layer & 1) ? (const bf16_t*)(ws + WS_WODD + (size_t)(layer >> 1) * W_ODD + WO_QKV) : (const bf16_t*)(ws + WS_WEVEN + (size_t)(layer >> 1) * W_EVEN + WE_IN));
        const float* sh = (const float*)(ws + WS_MOD) + (size_t)layer * 8 * 6144 + (sub ? 3072 : 0) + (size_t)(r16 & 7) * 6144 + 8 * q4;
        const bf16_t* wr = Wt + (size_t)(r * 16 + r16) * D + 8 * q4;
        f32x4 acc = (f32x4){0.f, 0.f, 0.f, 0.f};
#pragma unroll 8
        for (int ks = 0; ks < 32; ++ks) {
            const bf16x8 af = *(const bf16x8*)(wr + 32 * ks);
            const f32x4 s0 = *(const f32x4*)(sh + 32 * ks), s1 = *(const f32x4*)(sh + 32 * ks + 4);
            u32x4 bw; bw.x = pk2(s0.x, s0.y); bw.y = pk2(s0.z, s0.w); bw.z = pk2(s1.x, s1.y); bw.w = pk2(s1.z, s1.w);
            if (r16 >= 8) bw = (u32x4){0u, 0u, 0u, 0u};
            acc = __builtin_amdgcn_mfma_f32_16x16x32_bf16(af, __builtin_bit_cast(bf16x8, bw), acc, 0, 0, 0);
        }
        if (r16 < 8) { float* o = (float*)(ws + WS_SHW) + (size_t)g * 8 * 4096 + (size_t)r16 * 4096 + r * 16 + q4 * 4; *(f32x4*)o = acc; }
    }
}
DI void phase_modnorm(Ctx& c, const float* x, const float* gain, const float* sh, const float* sc, bf16_t* XN) {
    const int gw = c.bid * NW + c.wave, NGW = c.G * NW;
    for (int m = gw; m < T; m += NGW) {
        const int b = m >> 11; const f32x4* xr = (const f32x4*)(x + (size_t)m * D) + c.lane; f32x4 v[4]; float s = 0.f;
#pragma unroll
        for (int j = 0; j < 4; ++j) { v[j] = xr[64 * j]; s += (v[j].x * v[j].x + v[j].y * v[j].y) + (v[j].z * v[j].z + v[j].w * v[j].w); }
        const float rs = rsqrtf(wave_sum(s) * (1.f / D) + EPS);
#pragma unroll
        for (int j = 0; j < 4; ++j) { const int n = 4 * c.lane + 256 * j; const f32x4 g = *(const f32x4*)(gain + n), sv = *(const f32x4*)(sc + b * 6144 + n), hv = *(const f32x4*)(sh + b * 6144 + n);
            f32x4 y; y.x = v[j].x * rs * g.x * (1.f + sv.x) + hv.x; y.y = v[j].y * rs * g.y * (1.f + sv.y) + hv.y; y.z = v[j].z * rs * g.z * (1.f + sv.z) + hv.z; y.w = v[j].w * rs * g.w * (1.f + sv.w) + hv.w;
            u32x2 o; o.x = pk2(y.x, y.y); o.y = pk2(y.z, y.w); *(u32x2*)(XN + (size_t)m * D + n) = o; }
    }
}
constexpr int TB = 8;
constexpr int TBV = 4;
DI void head64_vec(bf16_t* const (&p)[TBV], bool act, const float* gain, const float* const (&tab)[TBV], float scale, int lane) {
    const int sub = lane & 7; float x[TBV][8], ss[TBV];
#pragma unroll
    for (int t = 0; t < TBV; ++t) { u32x4 v = (u32x4){0u, 0u, 0u, 0u}; if (act) v = *(const u32x4*)p[t];
        x[t][0] = bflo(v.x); x[t][1] = bfhi(v.x); x[t][2] = bflo(v.y); x[t][3] = bfhi(v.y); x[t][4] = bflo(v.z); x[t][5] = bfhi(v.z); x[t][6] = bflo(v.w); x[t][7] = bfhi(v.w); }
#pragma unroll
    for (int t = 0; t < TBV; ++t) { float s = 0.f;
#pragma unroll
        for (int e = 0; e < 8; ++e) s += x[t][e] * x[t][e];
        ss[t] = s; }
#pragma unroll
    for (int t = 0; t < TBV; ++t) ss[t] += swz<1>(ss[t]);
#pragma unroll
    for (int t = 0; t < TBV; ++t) ss[t] += swz<2>(ss[t]);
#pragma unroll
    for (int t = 0; t < TBV; ++t) ss[t] += swz<4>(ss[t]);
    const f32x4 ga = *(const f32x4*)(gain + 8 * sub), gb = *(const f32x4*)(gain + 8 * sub + 4);
    const float g[8] = {ga.x, ga.y, ga.z, ga.w, gb.x, gb.y, gb.z, gb.w};
#pragma unroll
    for (int t = 0; t < TBV; ++t) { const float rs = rsqrtf(ss[t] * (1.f / 64.f) + EPS);
        float y[8], o[8];
#pragma unroll
        for (int e = 0; e < 8; ++e) { y[e] = x[t][e] * rs * g[e]; o[e] = swz<1>(y[e]); }
        if (sub < 2) {
            const f32x4 t0 = *(const f32x4*)(tab[t]), t1 = *(const f32x4*)(tab[t] + 4), t2 = *(const f32x4*)(tab[t] + 8), t3 = *(const f32x4*)(tab[t] + 12);
            const float cs[8] = {t0.x, t0.z, t1.x, t1.z, t2.x, t2.z, t3.x, t3.z}, sn[8] = {t0.y, t0.w, t1.y, t1.w, t2.y, t2.w, t3.y, t3.w};
#pragma unroll
            for (int e = 0; e < 8; ++e) y[e] = sub == 0 ? y[e] * cs[e] - o[e] * sn[e] : o[e] * sn[e] + y[e] * cs[e];
        }
        u32x4 w; w.x = pk2(y[0] * scale, y[1] * scale); w.y = pk2(y[2] * scale, y[3] * scale); w.z = pk2(y[4] * scale, y[5] * scale); w.w = pk2(y[6] * scale, y[7] * scale);
        if (act) *(u32x4*)p[t] = w; }
}
DI void nsa_finalize_rows(Ctx& c, bf16_t* U, int m0, int mstride, int j) {
    CArgs& a = *c.a; const float* qg = a.in[17] + j * 64; const float* kg = a.in[18] + j * 192; const int lane = c.lane;
    bf16_t* p[TBV]; const float* tab[TBV];
#pragma unroll
    for (int t = 0; t < TBV; ++t) { const int m = m0 + t * mstride; p[t] = U + (size_t)m * UW + 544 + 8 * lane; tab[t] = (const float*)(c.ws + WS_CS8) + (size_t)m * 16; }
    head64_vec(p, true, qg, tab, 0.125f * LOG2E, lane);
#pragma unroll
    for (int t = 0; t < TBV; ++t) { const int m = m0 + t * mstride; p[t] = U + (size_t)m * UW + (lane < 16 ? 1312 + 8 * lane : 1568 + 8 * (lane & 15)); }
    head64_vec(p, lane < 32, lane < 16 ? kg + 64 : kg + 128, tab, 1.f, lane);
}
DI void diff_finalize_rows(Ctx& c, bf16_t* QKV, int m0, int mstride, int j) {
    CArgs& a = *c.a; const float* qg = a.in[24] + j * 64; const float* kg = a.in[25] + j * 64; const int lane = c.lane;
    bf16_t* p[TBV]; const float* tab[TBV];
#pragma unroll 1
    for (int ch = 0; ch < 4; ++ch) {
#pragma unroll
        for (int t = 0; t < TBV; ++t) { const int m = m0 + t * mstride; p[t] = QKV + (size_t)m * 3072 + 512 * ch + 8 * lane; tab[t] = (const float*)(c.ws + WS_CS8) + (size_t)m * 16; }
        head64_vec(p, true, ch < 2 ? qg : kg, tab, ch < 2 ? 0.125f * LOG2E : 1.f, lane);
    }
}
DI void diff_finalize_tile(Ctx& c, bf16_t* QKV, int pm, int pn, int j) {
    CArgs& a = *c.a; const int lane = c.lane; const bool isq = pn < 4;
    const float* g = isq ? a.in[24] + j * 64 : a.in[25] + j * 64; const float sc = isq ? 0.125f * LOG2E : 1.f;
    bf16_t* p[TBV]; const float* tab[TBV];
#pragma unroll 1
    for (int r0 = 0; r0 < 256; r0 += 16 * TBV) {
#pragma unroll
        for (int t = 0; t < TBV; ++t) { const int m = pm * 256 + r0 + t * 16 + 2 * c.wave + (lane >> 5); p[t] = QKV + (size_t)m * 3072 + pn * 256 + 8 * (lane & 31); tab[t] = (const float*)(c.ws + WS_CS8) + (size_t)m * 16; }
        head64_vec(p, true, g, tab, sc, lane);
    }
}
DI void unpack8(const u32x4 v, float (&x)[8]) { x[0] = bflo(v.x); x[1] = bfhi(v.x); x[2] = bflo(v.y); x[3] = bfhi(v.y); x[4] = bflo(v.z); x[5] = bfhi(v.z); x[6] = bflo(v.w); x[7] = bfhi(v.w); }
DI float sumsq8(const float (&x)[8]) { return ((x[0] * x[0] + x[1] * x[1]) + (x[2] * x[2] + x[3] * x[3])) + ((x[4] * x[4] + x[5] * x[5]) + (x[6] * x[6] + x[7] * x[7])); }
DI u32x4 mla_chunk(const float (&x)[8], float ss, const float* g96, const float* tab, int ci, float scale) {
    const float rs = rsqrtf(ss * (1.f / 96.f) + EPS);
    const f32x4 ga = *(const f32x4*)(g96 + 8 * ci), gb = *(const f32x4*)(g96 + 8 * ci + 4);
    float y[8] = {x[0] * rs * ga.x, x[1] * rs * ga.y, x[2] * rs * ga.z, x[3] * rs * ga.w, x[4] * rs * gb.x, x[5] * rs * gb.y, x[6] * rs * gb.z, x[7] * rs * gb.w};
    float o[8];
#pragma unroll
    for (int e = 0; e < 8; ++e) o[e] = swz<2>(y[e]);
    if (ci < 4) { const float* tp = tab + 16 * (ci & 1);
        const f32x4 t0 = *(const f32x4*)tp, t1 = *(const f32x4*)(tp + 4), t2 = *(const f32x4*)(tp + 8), t3 = *(const f32x4*)(tp + 12);
        const float cs[8] = {t0.x, t0.z, t1.x, t1.z, t2.x, t2.z, t3.x, t3.z}, sn[8] = {t0.y, t0.w, t1.y, t1.w, t2.y, t2.w, t3.y, t3.w};
#pragma unroll
        for (int e = 0; e < 8; ++e) y[e] = ci < 2 ? y[e] * cs[e] - o[e] * sn[e] : o[e] * sn[e] + y[e] * cs[e]; }
    u32x4 w; w.x = pk2(y[0] * scale, y[1] * scale); w.y = pk2(y[2] * scale, y[3] * scale); w.z = pk2(y[4] * scale, y[5] * scale); w.w = pk2(y[6] * scale, y[7] * scale);
    return w;
}
DI float head_ss(const LAS float* tbl, int h) { const f32x4 a = *(const LAS f32x4*)(tbl + 12 * h), b = *(const LAS f32x4*)(tbl + 12 * h + 4), cc = *(const LAS f32x4*)(tbl + 12 * h + 8); return ((a.x + a.y) + (a.z + a.w)) + ((b.x + b.y) + (b.z + b.w)) + ((cc.x + cc.y) + (cc.z + cc.w)); }
DI void mla_finalize_rows(Ctx& c, const bf16_t* U, bf16_t* QL, bf16_t* KVU, bf16_t* KF, int m0, int mstride, int j) {
    CArgs& a = *c.a; const int lane = c.lane;
    const float* qg = a.in[15] + j * 96; const float* kg = a.in[16] + j * 96;
    LAS float* tbl = (LAS float*)(c.lds + c.wave * 4096);
    const int cA = lane, hA = cA / 12, ciA = cA % 12, cB = 64 + (lane & 31), hB = cB / 12, ciB = cB % 12; const bool actB = lane < 32;
    const float qscale = 0.10206207261596577f * LOG2E;
    float xqA[TBV][8], xqB[TBV][8], xkA[TBV][8], xkB[TBV][8], rskv[TBV]; int mrow[TBV];
#pragma unroll
    for (int t = 0; t < TBV; ++t) { const int m = m0 + t * mstride; mrow[t] = m; const bf16_t* urow = U + (size_t)m * UW;
        float lx[8]; unpack8(*(const u32x4*)(urow + 8 * lane), lx); float sl = sumsq8(lx);
        sl += swz<1>(sl); sl += swz<2>(sl); sl += swz<4>(sl); sl += swz<8>(sl); sl += swz<16>(sl);
        const float rsq = rsqrtf(__builtin_bit_cast(float, __builtin_amdgcn_readlane(__builtin_bit_cast(int, sl), 0)) * (1.f / 256.f) + EPS);
        rskv[t] = rsqrtf(__builtin_bit_cast(float, __builtin_amdgcn_readlane(__builtin_bit_cast(int, sl), 32)) * (1.f / 256.f) + EPS);
        { const bf16_t* q = QL + (size_t)m * UPW; unpack8(*(const u32x4*)(q + 8 * cA), xqA[t]); u32x4 vb = (u32x4){0u, 0u, 0u, 0u}; if (actB) vb = *(const u32x4*)(q + 8 * cB); unpack8(vb, xqB[t]);
#pragma unroll
          for (int e = 0; e < 8; ++e) { xqA[t][e] *= rsq; xqB[t][e] *= rsq; }
          tbl[t * 192 + cA] = sumsq8(xqA[t]); if (actB) tbl[t * 192 + cB] = sumsq8(xqB[t]); }
        { const bf16_t* kn = KVU + (size_t)m * UPW;
          unpack8(*(const u32x4*)(ciA < 4 ? urow + 512 + 8 * ciA : kn + 128 * hA + 8 * (ciA - 4)), xkA[t]);
          u32x4 vb = (u32x4){0u, 0u, 0u, 0u}; if (actB) vb = *(const u32x4*)(ciB < 4 ? urow + 512 + 8 * ciB : kn + 128 * hB + 8 * (ciB - 4)); unpack8(vb, xkB[t]);
          const float fa = ciA < 4 ? 1.f : rskv[t], fb = ciB < 4 ? 1.f : rskv[t];
#pragma unroll
          for (int e = 0; e < 8; ++e) { xkA[t][e] *= fa; xkB[t][e] *= fb; }
          tbl[t * 192 + 96 + cA] = sumsq8(xkA[t]); if (actB) tbl[t * 192 + 96 + cB] = sumsq8(xkB[t]); }
    }
#pragma unroll
    for (int t = 0; t < TBV; ++t) { const int m = mrow[t]; const float* tab = (const float*)(c.ws + WS_CS16) + (size_t)m * 32;
        { bf16_t* q = QL + (size_t)m * UPW;
          const u32x4 wA = mla_chunk(xqA[t], head_ss(tbl + t * 192, hA), qg, tab, ciA, qscale); const u32x4 wB = mla_chunk(xqB[t], head_ss(tbl + t * 192, hB), qg, tab, ciB, qscale);
          *(u32x4*)(q + 8 * cA) = wA; if (actB) *(u32x4*)(q + 8 * cB) = wB; }
        { bf16_t* k = KF + (size_t)m * 768;
          const u32x4 wA = mla_chunk(xkA[t], head_ss(tbl + t * 192 + 96, hA), kg, tab, ciA, 1.f); const u32x4 wB = mla_chunk(xkB[t], head_ss(tbl + t * 192 + 96, hB), kg, tab, ciB, 1.f);
          *(u32x4*)(k + 8 * cA) = wA; if (actB) *(u32x4*)(k + 8 * cB) = wB; }
        { bf16_t* v = KVU + (size_t)m * UPW + 128 * (lane >> 3) + 64 + 8 * (lane & 7); float xv[8]; unpack8(*(const u32x4*)v, xv); const float f = rskv[t];
          u32x4 w; w.x = pk2(xv[0] * f, xv[1] * f); w.y = pk2(xv[2] * f, xv[3] * f); w.z = pk2(xv[4] * f, xv[5] * f); w.w = pk2(xv[6] * f, xv[7] * f); *(u32x4*)v = w; }
    }
}

DI float gelu_tanh(float x) { const float u = 0.7978845608028654f * (x + 0.044715f * x * x * x); const float e = __expf(2.f * u); const float t = 1.f - 2.f / (e + 1.f); return 0.5f * x * (1.f + t); }
DI void compress_item(Ctx& c, const bf16_t* U, int j, int it) {
    RELAUNDER(c);
    CArgs& a = *c.a; const int lane = c.lane, w = c.wave, tid = c.tid;
    const int jj = it >> 7, bg = (it >> 3) & 15, chunk = it & 7, b = bg >> 1, g = bg & 1, c0 = 16 * chunk;
    const bf16_t* W1t = (const bf16_t*)(c.ws + WS_WEVEN + j * W_EVEN + WE_C1) + (size_t)jj * 128 * 2048;
    const bf16_t* W2t = (const bf16_t*)(c.ws + WS_WEVEN + j * W_EVEN + WE_C2) + (size_t)jj * 64 * 128;
    const float* biasP = (const float*)(c.ws + WS_MISC) + (size_t)(j * 2 + jj) * 32 * 128;
    LAS float* part = (LAS float*)c.lds;
    LAS bf16_t* hid = (LAS bf16_t*)(c.lds + 65536);
    LAS float* outl = (LAS float*)(c.lds + 65536 + 8192);
    const int r16 = lane & 15, q4 = lane >> 4;
    f32x4 acc[8];
#pragma unroll
    for (int n = 0; n < 8; ++n) acc[n] = (f32x4){0.f, 0.f, 0.f, 0.f};
    const bf16_t* arow = U + ((size_t)b * S + 16 * (c0 + r16)) * UW + 1056 + jj * 128 + g * 64 + q4 * 8;
#pragma unroll 2
    for (int ks = 8 * w; ks < 8 * w + 8; ++ks) {
        const bf16x8 af = *(const bf16x8*)(arow + (size_t)(ks >> 1) * UW + (ks & 1) * 32);
#pragma unroll
        for (int n = 0; n < 8; ++n) { const bf16x8 bfr = *(const bf16x8*)(W1t + (size_t)(n * 16 + r16) * 2048 + 32 * ks + q4 * 8);
            acc[n] = __builtin_amdgcn_mfma_f32_16x16x32_bf16(af, bfr, acc[n], 0, 0, 0); }
    }
#pragma unroll
    for (int n = 0; n < 8; ++n)
#pragma unroll
        for (int i = 0; i < 4; ++i) part[(w * 16 + q4 * 4 + i) * 128 + n * 16 + r16] = acc[n][i];
    __syncthreads();
    { const int cc = tid >> 5, n0 = (tid & 31) * 4; float v[4];
#pragma unroll
      for (int e = 0; e < 4; ++e) { float s = 0.f;
#pragma unroll
          for (int ww = 0; ww < 8; ++ww) s += part[(ww * 16 + cc) * 128 + n0 + e];
          v[e] = s; }
      { f32x4 bs = (f32x4){0.f, 0.f, 0.f, 0.f};
#pragma unroll 8
        for (int kc = 0; kc < 32; ++kc) bs += *(const f32x4*)(biasP + kc * 128 + n0);
        v[0] = gelu_tanh(v[0] + bs.x); v[1] = gelu_tanh(v[1] + bs.y); v[2] = gelu_tanh(v[2] + bs.z); v[3] = gelu_tanh(v[3] + bs.w); }
      u32x2 o; o.x = pk2(v[0], v[1]); o.y = pk2(v[2], v[3]); *(LAS u32x2*)(hid + cc * 136 + n0) = o; }
    __syncthreads();
    if (w < 4) {
        f32x4 a2 = (f32x4){0.f, 0.f, 0.f, 0.f};
#pragma unroll
        for (int kst = 0; kst < 4; ++kst) { const bf16x8 af = *(const LAS bf16x8*)(hid + r16 * 136 + 32 * kst + q4 * 8);
            const bf16x8 bfr = *(const bf16x8*)(W2t + (size_t)(w * 16 + r16) * 128 + 32 * kst + q4 * 8);
            a2 = __builtin_amdgcn_mfma_f32_16x16x32_bf16(af, bfr, a2, 0, 0, 0); }
#pragma unroll
        for (int i = 0; i < 4; ++i) outl[(q4 * 4 + i) * 64 + w * 16 + r16] = a2[i];
    }
    __syncthreads();
    if (tid < 256) {
        const int cc = tid >> 4, d0 = (tid & 15) * 4; const int cg = c0 + cc;
        bf16_t* dst = (bf16_t*)(c.ws + WS_MISC + 65536 + (size_t)jj * 262144) + ((size_t)bg * 128 + cg) * 64 + d0;
        float v[4];
#pragma unroll
        for (int e = 0; e < 4; ++e) v[e] = outl[cc * 64 + d0 + e];
        if (jj == 0) {
            float s = (v[0] * v[0] + v[1] * v[1]) + (v[2] * v[2] + v[3] * v[3]);
            s += swz<1>(s); s += swz<2>(s); s += swz<4>(s); s += swz<8>(s);
            const float rs = rsqrtf(s * (1.f / 64.f) + EPS); const float* kg = a.in[18] + j * 192;
            int tok = b * S + 16 * cg + 31; if (tok >= T) tok = T - 1;
            const float* tab = (const float*)(c.ws + WS_CS8) + (size_t)tok * 16;
#pragma unroll
            for (int e = 0; e < 4; ++e) { const int d = d0 + e; float y = v[e] * rs * kg[d];
                if (d < 16) { const float o = outl[cc * 64 + (d ^ 8)] * rs * kg[d ^ 8]; const int i = d & 7; const float cs = tab[2 * i], sn = tab[2 * i + 1]; y = d < 8 ? y * cs - o * sn : o * sn + y * cs; }
                v[e] = y; }
        }
        if (cg == 127) { v[0] = v[1] = v[2] = v[3] = 0.f; }
        u32x2 o; o.x = pk2(v[0], v[1]); o.y = pk2(v[2], v[3]); *(u32x2*)dst = o;
    }
    __syncthreads();
}

DI void lds_add(LAS float* p, float v) { (void)__hip_atomic_fetch_add(p, v, __ATOMIC_RELAXED, __HIP_MEMORY_SCOPE_WORKGROUP); }
DI int crow(int r, int h) { return (r & 3) + 8 * (r >> 2) + 4 * h; }
DI unsigned cvtpk(float lo, float hi) { typedef float f2 __attribute__((ext_vector_type(2))); typedef __bf16 b2 __attribute__((ext_vector_type(2))); f2 v = {lo, hi}; b2 r = __builtin_convertvector(v, b2); return __builtin_bit_cast(unsigned, r); }
template <int DD> struct TileRegs { u32x4 r[(64 * DD / 8 + NT - 1) / NT]; };
template <int DD> DI void tile_load(TileRegs<DD>& t, const bf16_t* g, int ld, int tid) {
    constexpr int CPR = DD / 8, NCH = 64 * CPR, NI = (NCH + NT - 1) / NT;
#pragma unroll
    for (int i = 0; i < NI; ++i) { const int ch = tid + NT * i; if (NCH % NT == 0 || ch < NCH) { const int row = ch / CPR, c8 = ch % CPR; const unsigned eo = (unsigned)row * (unsigned)ld + (unsigned)c8 * 8u; t.r[i] = *(const u32x4*)(g + eo); } }
}
template <int DD> DI void tile_store(const TileRegs<DD>& t, LAS char* buf, int tid) {
    constexpr int CPR = DD / 8, NCH = 64 * CPR, NI = (NCH + NT - 1) / NT, STR = DD * 2 + 16;
#pragma unroll
    for (int i = 0; i < NI; ++i) { const int ch = tid + NT * i; if (NCH % NT == 0 || ch < NCH) { const int row = ch / CPR, c8 = ch % CPR; *(LAS u32x4*)(buf + row * STR + c8 * 16) = t.r[i]; } }
}
template <int DK> DI void qk_tile(const LAS char* Kb, const bf16x8* qf, f32x16& p0, f32x16& p1, int lane) {
    constexpr int KS = DK * 2 + 16, NG = DK / 32; const LAS char* kp = Kb + (lane & 31) * KS + (lane >> 5) * 16;
    bf16x8 kf[2][2][2];
#define QK_LOAD(G_, B_) do { _Pragma("unroll") for (int j_ = 0; j_ < 2; ++j_) { kf[B_][j_][0] = *(const LAS bf16x8*)(kp + (2 * (G_) + j_) * 32); kf[B_][j_][1] = *(const LAS bf16x8*)(kp + 32 * KS + (2 * (G_) + j_) * 32); } } while (0)
    constexpr bool DB = FX_QKDB || (DK > 64);
    QK_LOAD(0, 0);
#pragma unroll
    for (int r = 0; r < 16; ++r) { p0[r] = 0.f; p1[r] = 0.f; }
#pragma unroll
    for (int g = 0; g < NG; ++g) {
        const int bcur = DB ? (g & 1) : 0;
        if (DB && g + 1 < NG) { if ((g & 1) == 0) QK_LOAD(g + 1, 1); else QK_LOAD(g + 1, 0); }
        __builtin_amdgcn_sched_barrier(0);
        if (FX_PRIO) __builtin_amdgcn_s_setprio(1);
#pragma unroll
        for (int j = 0; j < 2; ++j) { p0 = __builtin_amdgcn_mfma_f32_32x32x16_bf16(kf[bcur][j][0], qf[2 * g + j], p0, 0, 0, 0); p1 = __builtin_amdgcn_mfma_f32_32x32x16_bf16(kf[bcur][j][1], qf[2 * g + j], p1, 0, 0, 0); }
        if (FX_PRIO) __builtin_amdgcn_s_setprio(0);
        __builtin_amdgcn_sched_barrier(0);
        if (!DB && g + 1 < NG) QK_LOAD(g + 1, 0);
    }
#undef QK_LOAD
}
template <int DV> DI void pv_tile(const LAS char* Vb, const f32x16& p0, const f32x16& p1, f32x16* o, int lane) {
    constexpr int VS = DV * 2 + 16;
    const int g = lane >> 4, h = lane >> 5, i16 = lane & 15, q = i16 >> 2, p = i16 & 3;
    const LAS char* base = Vb + (4 * h + q) * VS + (16 * (g & 1) + 4 * p) * 2;
    constexpr int NDB = DV / 32, GS = (DV == 64) ? 2 : 1;
    bf16x8 pf[4];
#pragma unroll
    for (int s = 0; s < 4; ++s) { u32x4 pw;
        if (s < 2) { pw.x = cvtpk(p0[8 * s], p0[8 * s + 1]); pw.y = cvtpk(p0[8 * s + 2], p0[8 * s + 3]); pw.z = cvtpk(p0[8 * s + 4], p0[8 * s + 5]); pw.w = cvtpk(p0[8 * s + 6], p0[8 * s + 7]); }
        else { const int s2 = s - 2; pw.x = cvtpk(p1[8 * s2], p1[8 * s2 + 1]); pw.y = cvtpk(p1[8 * s2 + 2], p1[8 * s2 + 3]); pw.z = cvtpk(p1[8 * s2 + 4], p1[8 * s2 + 5]); pw.w = cvtpk(p1[8 * s2 + 6], p1[8 * s2 + 7]); }
        pf[s] = __builtin_bit_cast(bf16x8, pw); }
#pragma unroll
    for (int s0 = 0; s0 < 4; s0 += GS) {
        s16x4 lo[GS][NDB], hi[GS][NDB];
#pragma unroll
        for (int s = 0; s < GS; ++s)
#pragma unroll
            for (int db = 0; db < NDB; ++db) { lo[s][db] = vtr(base + (16 * (s0 + s)) * VS + db * 64); hi[s][db] = vtr(base + (16 * (s0 + s) + 8) * VS + db * 64); }
        __builtin_amdgcn_sched_barrier(0);
#pragma unroll
        for (int s = 0; s < GS; ++s)
#pragma unroll
            for (int db = 0; db < NDB; ++db) o[db] = __builtin_amdgcn_mfma_f32_32x32x16_bf16(__builtin_shufflevector(lo[s][db], hi[s][db], 0, 1, 2, 3, 4, 5, 6, 7), pf[s0 + s], o[db], 0, 0, 0);
        __builtin_amdgcn_sched_barrier(0);
    }
}
DI float max3f(float a, float b, float c) { return __builtin_fmaxf(__builtin_fmaxf(a, b), c); }
DI float rowmax32(const f32x16& p0, const f32x16& p1) {
    float a = max3f(p0[0], p0[1], p0[2]), b = max3f(p0[3], p0[4], p0[5]), c = max3f(p1[0], p1[1], p1[2]), d = max3f(p1[3], p1[4], p1[5]);
    a = max3f(a, p0[6], p0[7]); b = max3f(b, p0[8], p0[9]); c = max3f(c, p1[6], p1[7]); d = max3f(d, p1[8], p1[9]);
    a = max3f(a, p0[10], p0[11]); b = max3f(b, p0[12], p0[13]); c = max3f(c, p1[10], p1[11]); d = max3f(d, p1[12], p1[13]);
    a = max3f(a, p0[14], p0[15]); c = max3f(c, p1[14], p1[15]);
    return max32(max3f(max3f(a, b, c), d, d));
}
template <int DV> DI void softmax_step(f32x16& p0, f32x16& p1, f32x16* o, float& m, float& l) {
    const float mx = rowmax32(p0, p1); const float mnew = fmaxf(m, mx); const float muse = (mnew == -INFINITY) ? 0.f : mnew;
    const float alpha = __builtin_amdgcn_exp2f(m - muse);
    float s = 0.f;
#pragma unroll
    for (int r = 0; r < 16; ++r) { p0[r] = __builtin_amdgcn_exp2f(p0[r] - muse); p1[r] = __builtin_amdgcn_exp2f(p1[r] - muse); s += p0[r] + p1[r]; }
    l = l * alpha + s; m = mnew;
#pragma unroll
    for (int db = 0; db < DV / 32; ++db)
#pragma unroll
        for (int r = 0; r < 16; ++r) o[db][r] *= alpha;
}
template <int DK> DI void load_qfrag(bf16x8* qf, const bf16_t* qrow  , int h) {
#pragma unroll
    for (int st = 0; st < DK / 16; ++st) qf[st] = *(const bf16x8*)(qrow + 16 * st + 8 * h);
}
template <int DK, int DV> struct SweepLds { static constexpr int KB = 64 * (DK * 2 + 16), VB = 64 * (DV * 2 + 16); };

template <int DV> DI void softmax_step_lazy(f32x16& p0, f32x16& p1, f32x16* o, float& m, float& l) {
    const float mx = rowmax32(p0, p1); const float mnew = fmaxf(m, mx); const float muse = (mnew == -INFINITY) ? 0.f : mnew;
    const float alpha = __builtin_amdgcn_exp2f(m - muse);
    float s0 = 0.f, s1 = 0.f, s2 = 0.f, s3 = 0.f;
#pragma unroll
    for (int r = 0; r < 16; ++r) { p0[r] = __builtin_amdgcn_exp2f(p0[r] - muse); p1[r] = __builtin_amdgcn_exp2f(p1[r] - muse); }
#pragma unroll
    for (int r = 0; r < 16; r += 2) { s0 += p0[r]; s1 += p0[r + 1]; s2 += p1[r]; s3 += p1[r + 1]; }
    l = l * alpha + ((s0 + s1) + (s2 + s3)); m = mnew;
    if (__builtin_amdgcn_ballot_w64(alpha != 1.f) != 0ull) {
#pragma unroll
        for (int db = 0; db < DV / 32; ++db)
#pragma unroll
            for (int r = 0; r < 16; ++r) o[db][r] *= alpha;
    }
}
template <int DK, int DV> struct SweepLds3 { static constexpr int KB = 64 * (DK * 2 + 16), VB = 64 * (DV * 2 + 16), TOTAL = 2 * KB + 3 * VB; };
template <int DK, int DV, bool late, class It, class F> DI void flash_sweep_impl(Ctx& c, const bf16x8* qf, const bf16_t* Kg, int ldk, const bf16_t* Vg, int ldv, It it, const F& f, f32x16* o, float& m, float& l) {
    typedef SweepLds3<DK, DV> L; LAS char* lds = (LAS char*)c.lds; const int lane = c.lane, tid = c.tid;
    TileRegs<DK> kA, kB; TileRegs<DV> vA, vB;
    int ta = it.next(); int tb = ta >= 0 ? it.next() : -1;
    if (ta < 0) return;
    tile_load<DK>(kA, Kg + (size_t)ta * 64 * ldk, ldk, tid); tile_load<DV>(vA, Vg + (size_t)ta * 64 * ldv, ldv, tid);
    if (tb >= 0) { tile_load<DK>(kB, Kg + (size_t)tb * 64 * ldk, ldk, tid); tile_load<DV>(vB, Vg + (size_t)tb * 64 * ldv, ldv, tid); }
    __syncthreads();
    tile_store<DK>(kA, lds, tid); tile_store<DV>(vA, lds + 2 * L::KB, tid);
    __syncthreads();
    int vprev = 2 * L::KB + 2 * L::VB, vcur = 2 * L::KB, vnext = 2 * L::KB + L::VB;
    f32x16 s0, s1; bool pend = false;
#pragma unroll
    for (int r = 0; r < 16; ++r) { s0[r] = 0.f; s1[r] = 0.f; }
#define FS_QK(P0_, P1_, KOFF_) do { if (c.var != 3) qk_tile<DK>(lds + (KOFF_), qf, P0_, P1_, lane); } while (0)
#define FS_SM(P0_, P1_) do { if (c.var != 2) softmax_step_lazy<DV>(P0_, P1_, o, m, l); } while (0)
#define FS_PV(VOFF_, P0_, P1_) do { if (c.var != 1) pv_tile<DV>(lds + (VOFF_), P0_, P1_, o, lane); } while (0)
#define FS_COMPUTE(T_, KOFF_) do { \
        if (!late) { if (!f.skip(T_)) { f32x16 p0, p1; if (c.var == 3) { p0 = s0; p1 = s1; } FS_QK(p0, p1, KOFF_); f.mask(p0, p1, T_); FS_SM(p0, p1); FS_PV(vcur, p0, p1); } } \
        else { if (pend) { FS_SM(s0, s1); FS_PV(vprev, s0, s1); pend = false; } \
               if (!f.skip(T_)) { FS_QK(s0, s1, KOFF_); f.mask(s0, s1, T_); pend = true; } } } while (0)
#define FS_ROTATE() do { const int t_ = vprev; vprev = vcur; vcur = vnext; vnext = t_; } while (0)
    for (;;) {
        const int tc = tb >= 0 ? it.next() : -1;
        if (tc >= 0) { tile_load<DK>(kA, Kg + (size_t)tc * 64 * ldk, ldk, tid); tile_load<DV>(vA, Vg + (size_t)tc * 64 * ldv, ldv, tid); }
        FS_COMPUTE(ta, 0);
        if (tb >= 0) { tile_store<DK>(kB, lds + L::KB, tid); tile_store<DV>(vB, lds + vnext, tid); }
        __syncthreads(); FS_ROTATE();
        if (tb < 0) break;
        const int td = tc >= 0 ? it.next() : -1;
        if (td >= 0) { tile_load<DK>(kB, Kg + (size_t)td * 64 * ldk, ldk, tid); tile_load<DV>(vB, Vg + (size_t)td * 64 * ldv, ldv, tid); }
        FS_COMPUTE(tb, L::KB);
        if (tc >= 0) { tile_store<DK>(kA, lds, tid); tile_store<DV>(vA, lds + vnext, tid); }
        __syncthreads(); FS_ROTATE();
        if (tc < 0) break;
        ta = tc; tb = td;
    }
    if (late && pend) { FS_SM(s0, s1); FS_PV(vprev, s0, s1); }
#undef FS_COMPUTE
#undef FS_ROTATE
#undef FS_QK
#undef FS_SM
#undef FS_PV
}
template <int DK, int DV, bool STG, class It, class F> DI void flash_sweep(Ctx& c, const bf16x8* qf, const bf16_t* Kg, int ldk, const bf16_t* Vg, int ldv, It it, const F& f, f32x16* o, float& m, float& l) {
#if FX_SWEEP2
    flash_sweep2<DK, DV>(c, qf, Kg, ldk, Vg, ldv, it, f, o, m, l); return;
#endif
    if (STG && FX_LATE(c.wave)) flash_sweep_impl<DK, DV, true>(c, qf, Kg, ldk, Vg, ldv, it, f, o, m, l);
    else flash_sweep_impl<DK, DV, false>(c, qf, Kg, ldk, Vg, ldv, it, f, o, m, l);
}
template <int DK, int DV, class It, class F> DI void flash_sweep2(Ctx& c, const bf16x8* qf, const bf16_t* Kg, int ldk, const bf16_t* Vg, int ldv, It it, const F& f, f32x16* o, float& m, float& l) {
    constexpr int KB = 64 * (DK * 2 + 16), VB = 64 * (DV * 2 + 16), VOFF = 4 * KB;
    LAS char* lds = (LAS char*)c.lds; const int lane = c.lane, tid = c.tid;
    TileRegs<DK> k0, k1; TileRegs<DV> v0, v1;
    int a = it.next(); if (a < 0) return; int b = it.next();
    tile_load<DK>(k0, Kg + (size_t)a * 64 * ldk, ldk, tid); tile_load<DV>(v0, Vg + (size_t)a * 64 * ldv, ldv, tid);
    if (b >= 0) { tile_load<DK>(k1, Kg + (size_t)b * 64 * ldk, ldk, tid); tile_load<DV>(v1, Vg + (size_t)b * 64 * ldv, ldv, tid); }
    __syncthreads();
    tile_store<DK>(k0, lds, tid); tile_store<DV>(v0, lds + VOFF, tid);
    if (b >= 0) { tile_store<DK>(k1, lds + KB, tid); tile_store<DV>(v1, lds + VOFF + VB, tid); }
    __syncthreads();
    int st = 0;
    for (;;) {
        const int na = b >= 0 ? it.next() : -1; const int nb = na >= 0 ? it.next() : -1;
        if (na >= 0) { tile_load<DK>(k0, Kg + (size_t)na * 64 * ldk, ldk, tid); tile_load<DV>(v0, Vg + (size_t)na * 64 * ldv, ldv, tid); }
        if (nb >= 0) { tile_load<DK>(k1, Kg + (size_t)nb * 64 * ldk, ldk, tid); tile_load<DV>(v1, Vg + (size_t)nb * 64 * ldv, ldv, tid); }
        const int ko = st * 2 * KB, vo = VOFF + st * 2 * VB;
        if (!f.skip(a)) { f32x16 p0, p1; qk_tile<DK>(lds + ko, qf, p0, p1, lane); f.mask(p0, p1, a); softmax_step_lazy<DV>(p0, p1, o, m, l); pv_tile<DV>(lds + vo, p0, p1, o, lane); }
        if (b >= 0 && !f.skip(b)) { f32x16 p0, p1; qk_tile<DK>(lds + ko + KB, qf, p0, p1, lane); f.mask(p0, p1, b); softmax_step_lazy<DV>(p0, p1, o, m, l); pv_tile<DV>(lds + vo + VB, p0, p1, o, lane); }
        const int kn = (st ^ 1) * 2 * KB, vn = VOFF + (st ^ 1) * 2 * VB;
        if (na >= 0) { tile_store<DK>(k0, lds + kn, tid); tile_store<DV>(v0, lds + vn, tid); }
        if (nb >= 0) { tile_store<DK>(k1, lds + kn + KB, tid); tile_store<DV>(v1, lds + vn + VB, tid); }
        __syncthreads();
        if (na < 0) break;
        a = na; b = nb; st ^= 1;
    }
}
struct RangeIt { int t, tend; DI int next() { return t <= tend ? t++ : -1; } };
struct BitsIt { unsigned rem; DI int next() { if (!rem) return -1; const int t = __builtin_ctz(rem); rem &= rem - 1; return t; } };
struct CausalF { int qrow, wfirst, wlast, h;
    DI bool skip(int t) const { return t > wlast; }
    DI void mask(f32x16& p0, f32x16& p1, int t) const { if (t * 64 + 63 > wfirst) {
#pragma unroll
        for (int r = 0; r < 16; ++r) { const int kv = t * 64 + crow(r, h); if (kv > qrow) p0[r] = -INFINITY; if (kv + 32 > qrow) p1[r] = -INFINITY; } } } };
template <int DK, int DV> DI void causal_sweep(Ctx& c, const bf16_t* Qg, int ldq, const bf16_t* Kg, int ldk, const bf16_t* Vg, int ldv, int q0, f32x16* o, float& lsum) {
    RELAUNDER(c);
    const int lane = c.lane, w = c.wave, r32 = lane & 31, h = lane >> 5;
    const int qrow = q0 + 32 * w + r32;
    bf16x8 qf[DK / 16]; load_qfrag<DK>(qf, Qg + (unsigned)qrow * (unsigned)ldq, h);
#pragma unroll
    for (int db = 0; db < DV / 32; ++db)
#pragma unroll
        for (int r = 0; r < 16; ++r) o[db][r] = 0.f;
    float m = -INFINITY, l = 0.f;
    RangeIt it{0, (q0 >> 6) + 3}; CausalF f{qrow, q0 + 32 * w, (q0 + 32 * w + 31) >> 6, h};
    flash_sweep<DK, DV, (DV == 64) && FX_STG>(c, qf, Kg, ldk, Vg, ldv, it, f, o, m, l);
    lsum = sum32(l);
}
template <int DV> DI void store_o(const f32x16* o, float scale, bf16_t* rowp, int h) {
#pragma unroll
    for (int db = 0; db < DV / 32; ++db)
#pragma unroll
        for (int k = 0; k < 4; ++k) { u32x2 v; v.x = cvtpk(o[db][4 * k] * scale, o[db][4 * k + 1] * scale); v.y = cvtpk(o[db][4 * k + 2] * scale, o[db][4 * k + 3] * scale);
            *(u32x2*)(rowp + 32 * db + 8 * k + 4 * h) = v; }
}

DI void mla_unit(Ctx& c, const bf16_t* QL, const bf16_t* KF, const bf16_t* KVU, bf16_t* YC, int b, int hd, int qt) {
    RELAUNDER(c);
    const int q0 = qt * 256; f32x16 o[2]; float l;
    const size_t rb = (size_t)b * S;
    causal_sweep<96, 64>(c, QL + rb * UPW + 96 * hd, UPW, KF + rb * 768 + 96 * hd, 768, KVU + rb * UPW + 128 * hd + 64, UPW, q0, o, l);
    const int qrow = q0 + 32 * c.wave + (c.lane & 31);
    store_o<64>(o, 1.f / l, YC + (rb + qrow) * 1024 + 64 * hd, c.lane >> 5);
}
DI void diff_unit(Ctx& c, const bf16_t* QKV, bf16_t* ON, int b, int hd, int qt, int j, int layer) {
    RELAUNDER(c);
    CArgs& a = *c.a; const int q0 = qt * 256, lane = c.lane, h = lane >> 5; const size_t rb = (size_t)b * S;
    f32x16 o1[4], o2[4]; float l1, l2;
    const bf16_t* base = QKV + rb * 3072;
    causal_sweep<64, 128>(c, base + 128 * hd, 3072, base + 1024 + 128 * hd, 3072, base + 2048 + 128 * hd, 3072, q0, o1, l1);
    { const float i1_ = 1.f / l1;
#pragma unroll
      for (int db = 0; db < 4; ++db)
#pragma unroll
          for (int r = 0; r < 16; ++r) o1[db][r] *= i1_; }
    causal_sweep<64, 128>(c, base + 128 * hd + 64, 3072, base + 1024 + 128 * hd + 64, 3072, base + 2048 + 128 * hd, 3072, q0, o2, l2);
    const float* lam = a.in[26] + j * 256; float s1 = lam[lane] * lam[64 + lane], s2 = lam[128 + lane] * lam[192 + lane];
    s1 = wave_sum(s1); s2 = wave_sum(s2);
    const float lam_init = 0.8f - 0.6f * __expf(-0.3f * (float)layer); const float lmb = __expf(s1) - __expf(s2) + lam_init;
    const float i1 = 1.f, i2 = lmb / l2; float ss = 0.f;
#pragma unroll
    for (int db = 0; db < 4; ++db)
#pragma unroll
        for (int r = 0; r < 16; ++r) { const float v = o1[db][r] * i1 - o2[db][r] * i2; o1[db][r] = v; ss += v * v; }
    ss = sum32(ss);
    const float rs = rsqrtf(ss * (1.f / 128.f) + EPS) * (1.f - lam_init);
    const float* sg = a.in[27] + j * 128;
#pragma unroll
    for (int db = 0; db < 4; ++db)
#pragma unroll
        for (int r = 0; r < 16; ++r) o1[db][r] *= rs * sg[32 * db + crow(r, h)];
    const int qrow = q0 + 32 * c.wave + (lane & 31);
    store_o<128>(o1, 1.f, ON + (rb + qrow) * 1024 + 128 * hd, h);
}

DI void nsa_unit(Ctx& c, const bf16_t* U, bf16_t* YC, int b, int g, int qt) {
    RELAUNDER(c);
    CArgs& a = *c.a; LAS char* lds = (LAS char*)c.lds; typedef SweepLds<64, 64> L;
    const int lane = c.lane, w = c.wave, tid = c.tid, r32 = lane & 31, h = lane >> 5;
    const int hg = w & 3, qsub = w >> 2, head = g * 4 + hg, q0 = qt * 64, jt = qt;
    const int qrow = q0 + 32 * qsub + r32; const size_t rb = (size_t)b * S; const size_t m = rb + qrow;
    LAS float* imp = (LAS float*)(lds + 8 * L::KB);
    LAS unsigned* selw = (LAS unsigned*)(lds + 8 * L::KB + 4 * 64 * 33 * 4);
    bf16x8 qf[4]; load_qfrag<64>(qf, U + m * UW + 544 + 64 * head, h);
    const bf16_t* urow = U + m * UW + 1824;
#ifdef NSA_ONLY
    const float g0 = NSA_ONLY == 0 ? 1.f : 0.f, g1 = NSA_ONLY == 1 ? 1.f : 0.f, g2 = NSA_ONLY == 2 ? 1.f : 0.f; (void)urow;
#else
    const float g0 = 1.f / (1.f + __expf(-bf2f(urow[head]))), g1 = 1.f / (1.f + __expf(-bf2f(urow[8 + head]))), g2 = 1.f / (1.f + __expf(-bf2f(urow[16 + head])));
#endif
    unsigned accp[2][8];
    const int bg = b * 2 + g;
    const bf16_t* KC = (const bf16_t*)(c.ws + WS_MISC + 65536) + (size_t)bg * 128 * 64; const bf16_t* VC = (const bf16_t*)(c.ws + WS_MISC + 65536 + 262144) + (size_t)bg * 128 * 64;
    __syncthreads();
    { TileRegs<64> k0, k1, v0, v1; tile_load<64>(k0, KC, 64, tid); tile_load<64>(k1, KC + 64 * 64, 64, tid); tile_load<64>(v0, VC, 64, tid); tile_load<64>(v1, VC + 64 * 64, 64, tid);
      for (int i = tid; i < 4 * 64 * 33; i += NT) imp[i] = 0.f;
      tile_store<64>(k0, lds, tid); tile_store<64>(k1, lds + L::KB, tid); tile_store<64>(v0, lds + 2 * L::KB, tid); tile_store<64>(v1, lds + 2 * L::KB + L::VB, tid); }
    __syncthreads();
    {
        f32x16 p0, p1, p2, p3; qk_tile<64>(lds, qf, p0, p1, lane); qk_tile<64>(lds + L::KB, qf, p2, p3, lane);
        const int hi = qrow < 31 ? -1 : (qrow - 31) >> 4;
#pragma unroll
        for (int r = 0; r < 16; ++r) { const int cidx = crow(r, h); if (cidx > hi) p0[r] = -INFINITY; if (cidx + 32 > hi) p1[r] = -INFINITY; if (cidx + 64 > hi) p2[r] = -INFINITY; if (cidx + 96 > hi) p3[r] = -INFINITY; }
        float mx = fmaxf(rowmax32(p0, p1), rowmax32(p2, p3)); const float muse = (mx == -INFINITY) ? 0.f : mx; float s = 0.f;
#pragma unroll
        for (int r = 0; r < 16; ++r) { p0[r] = __builtin_amdgcn_exp2f(p0[r] - muse); p1[r] = __builtin_amdgcn_exp2f(p1[r] - muse); p2[r] = __builtin_amdgcn_exp2f(p2[r] - muse); p3[r] = __builtin_amdgcn_exp2f(p3[r] - muse); s += (p0[r] + p1[r]) + (p2[r] + p3[r]); }
        s = sum32(s); const float inv = s > 0.f ? 1.f / s : 0.f;
#pragma unroll
        for (int r = 0; r < 16; ++r) { p0[r] *= inv; p1[r] *= inv; p2[r] *= inv; p3[r] *= inv; }
        LAS float* ir = imp + hg * (64 * 33) + (32 * qsub + r32) * 33;
#define IMP_ADD(P, PI) _Pragma("unroll") for (int k = 0; k < 4; ++k) { const int jb = 8 * (PI) + 2 * k + h; const float s4 = (P[4 * k] + P[4 * k + 1]) + (P[4 * k + 2] + P[4 * k + 3]); lds_add(ir + jb, s4); if (jb + 1 < 32) lds_add(ir + jb + 1, P[4 * k + 3]); }
        IMP_ADD(p0, 0) IMP_ADD(p1, 1) IMP_ADD(p2, 2) IMP_ADD(p3, 3)
#undef IMP_ADD
        f32x16 oc[2];
#pragma unroll
        for (int db = 0; db < 2; ++db)
#pragma unroll
            for (int r = 0; r < 16; ++r) oc[db][r] = 0.f;
        pv_tile<64>(lds + 2 * L::KB, p0, p1, oc, lane); pv_tile<64>(lds + 2 * L::KB + L::VB, p2, p3, oc, lane);
#pragma unroll
        for (int db = 0; db < 2; ++db)
#pragma unroll
            for (int r = 0; r < 8; ++r) accp[db][r] = cvtpk(g0 * oc[db][2 * r], g0 * oc[db][2 * r + 1]);
    }
    __syncthreads();
    LAS float* vsl = (LAS float*)(lds + 8 * L::KB + 4 * 64 * 33 * 4 + 256);
#pragma unroll 1
    for (int i = 0; i < 4; ++i) { const int id = tid + NT * i, qq = id >> 5, jb = id & 31;
        const bool allowed = jb <= jt, forced = allowed && (jb == 0 || jb >= jt - 1);
        const float iv = (imp[qq * 33 + jb] + imp[64 * 33 + qq * 33 + jb]) + (imp[2 * 64 * 33 + qq * 33 + jb] + imp[3 * 64 * 33 + qq * 33 + jb]);
        vsl[id] = forced ? 1e9f : (allowed ? iv : -1e30f); }
    __syncthreads();
#pragma unroll 1
    for (int i = 0; i < 4; ++i) { const int id = tid + NT * i, qq = id >> 5, jb = id & 31;
        const float v = vsl[id]; int rank = 0;
#pragma unroll
        for (int k4 = 0; k4 < 8; ++k4) { const f32x4 w = *(const LAS f32x4*)(vsl + qq * 32 + 4 * k4);
            rank += (w.x > v || (w.x == v && 4 * k4 + 0 < jb)) ? 1 : 0; rank += (w.y > v || (w.y == v && 4 * k4 + 1 < jb)) ? 1 : 0;
            rank += (w.z > v || (w.z == v && 4 * k4 + 2 < jb)) ? 1 : 0; rank += (w.w > v || (w.w == v && 4 * k4 + 3 < jb)) ? 1 : 0; }
        const unsigned long long bal = __ballot(jb <= jt && rank < 16);
        if (jb == 0) selw[qq] = (unsigned)(bal >> (lane & 32)); }
    __syncthreads();
    const unsigned mysel = selw[32 * qsub + r32];
    unsigned uni = selw[lane];
    uni |= swzu<1>(uni); uni |= swzu<2>(uni); uni |= swzu<4>(uni); uni |= swzu<8>(uni); uni |= swzu<16>(uni); uni = or32(uni);
    uni = __builtin_amdgcn_readfirstlane(uni);
    {
        struct SlcF { unsigned mysel; int qrow, h, jt; DI bool skip(int) const { return false; }
            DI void mask(f32x16& p0, f32x16& p1, int t) const { const float bias = ((mysel >> t) & 1u) ? 0.f : -INFINITY;
#pragma unroll
                for (int r = 0; r < 16; ++r) { p0[r] += bias; p1[r] += bias; }
                if (t == jt) {
#pragma unroll
                    for (int r = 0; r < 16; ++r) { const int kv = t * 64 + crow(r, h); if (kv > qrow) p0[r] = -INFINITY; if (kv + 32 > qrow) p1[r] = -INFINITY; } } } };
        f32x16 o[2];
#pragma unroll
        for (int db = 0; db < 2; ++db)
#pragma unroll
            for (int r = 0; r < 16; ++r) o[db][r] = 0.f;
        float mm = -INFINITY, l = 0.f;
        flash_sweep<64, 64, FX_STG>(c, qf, U + rb * UW + 1312 + 64 * g, UW, U + rb * UW + 1440 + 64 * g, UW, BitsIt{uni}, SlcF{mysel, qrow, h, jt}, o, mm, l);
        l = sum32(l); const float sc = g1 / l;
#pragma unroll
        for (int db = 0; db < 2; ++db)
#pragma unroll
            for (int r = 0; r < 8; ++r) accp[db][r] = cvtpk(bflo(accp[db][r]) + sc * o[db][2 * r], bfhi(accp[db][r]) + sc * o[db][2 * r + 1]);
    }
    {
        struct WinF { int qrow, h, jt; DI bool skip(int) const { return false; }
            DI void mask(f32x16& p0, f32x16& p1, int t) const { if (t == jt || t == jt - 8) {
#pragma unroll
                for (int r = 0; r < 16; ++r) { const int kv = t * 64 + crow(r, h); if (kv > qrow || kv <= qrow - 512) p0[r] = -INFINITY; if (kv + 32 > qrow || kv + 32 <= qrow - 512) p1[r] = -INFINITY; } } } };
        f32x16 o[2];
#pragma unroll
        for (int db = 0; db < 2; ++db)
#pragma unroll
            for (int r = 0; r < 16; ++r) o[db][r] = 0.f;
        float mm = -INFINITY, l = 0.f;
        flash_sweep<64, 64, FX_STG>(c, qf, U + rb * UW + 1568 + 64 * g, UW, U + rb * UW + 1696 + 64 * g, UW, RangeIt{jt - 8 > 0 ? jt - 8 : 0, jt}, WinF{qrow, h, jt}, o, mm, l);
        l = sum32(l); const float sc = g2 / l;
#pragma unroll
        for (int db = 0; db < 2; ++db)
#pragma unroll
            for (int r = 0; r < 8; ++r) accp[db][r] = cvtpk(bflo(accp[db][r]) + sc * o[db][2 * r], bfhi(accp[db][r]) + sc * o[db][2 * r + 1]);
    }
    { bf16_t* rowp = YC + m * 1024 + 512 + 64 * head;
#pragma unroll
      for (int db = 0; db < 2; ++db)
#pragma unroll
          for (int k = 0; k < 4; ++k) { u32x2 v; v.x = accp[db][2 * k]; v.y = accp[db][2 * k + 1]; *(u32x2*)(rowp + 32 * db + 8 * k + 4 * h) = v; } }
}
}
#ifndef FX_MODE
#define FX_MODE 0
#endif
namespace fx {
template <int ACT  > struct EpiB16 {
    static constexpr bool PERM = true, AFTER_DRAIN = false;
    bf16_t* O; int ldc; const float* ss; const float* shw;
    __device__ __forceinline__ void operator()(const pg8::f32x4 (&acc)[2][2][4][2], const pg8::Unit& u, int wr, int wc, int fr, int fq) const {
        const int row0 = u.pm * 256 + wr * 64 + fr, col0 = u.pn * 256 + wc * 32 + 8 * fq;
        const bool FUSED = ss != nullptr; pg8::f32x4 sv[2][2];
        if (FUSED) { const float* sp = shw + (size_t)(u.pm >> 3) * 4096 + col0;
#pragma unroll
            for (int bj = 0; bj < 2; ++bj) { sv[bj][0] = *(const pg8::f32x4*)(sp + bj * 128); sv[bj][1] = *(const pg8::f32x4*)(sp + bj * 128 + 4); } }
#pragma unroll
        for (int ai = 0; ai < 2; ++ai)
#pragma unroll
            for (int m = 0; m < 4; ++m) { const int row = row0 + ai * 128 + m * 16; bf16_t* rowp = O + (size_t)row * ldc + col0;
                float rs = 1.f; if (FUSED) { const pg8::f32x4* sp4 = (const pg8::f32x4*)(ss + (size_t)row * 16); const pg8::f32x4 a0 = sp4[0], a1 = sp4[1], a2 = sp4[2], a3 = sp4[3];
                    const float tot = (((a0[0] + a0[1]) + (a0[2] + a0[3])) + ((a1[0] + a1[1]) + (a1[2] + a1[3]))) + (((a2[0] + a2[1]) + (a2[2] + a2[3])) + ((a3[0] + a3[1]) + (a3[2] + a3[3]))); rs = rsqrtf(tot * (1.f / 1024.f) + EPS); }
#pragma unroll
                for (int bj = 0; bj < 2; ++bj) { pg8::f32x4 v0 = acc[ai][bj][m][0], v1 = acc[ai][bj][m][1];
                    if (FUSED) { v0 = v0 * rs + sv[bj][0]; v1 = v1 * rs + sv[bj][1]; }
                    if (ACT == 1) {
#pragma unroll
                        for (int e = 0; e < 4; ++e) { float a = v0[e] > 0.f ? v0[e] : 0.f; v0[e] = a * a; float b = v1[e] > 0.f ? v1[e] : 0.f; v1[e] = b * b; } }
                    u32x4 w; w.x = pg8::cvt_pk_bf16(v0[0], v0[1]); w.y = pg8::cvt_pk_bf16(v0[2], v0[3]); w.z = pg8::cvt_pk_bf16(v1[0], v1[1]); w.w = pg8::cvt_pk_bf16(v1[2], v1[3]);
                    *(u32x4*)(rowp + bj * 128) = w; } }
    }
};
struct UpOrder : pg8::StaticOrder {
    __device__ bool next(int i, pg8::Unit& u) const { if (!pg8::StaticOrder::next(i, u)) return false; u.aoff = u.pn >= 3 ? 256 : 0; return true; }
};
struct EpiResid {
    static constexpr bool PERM = true, AFTER_DRAIN = false;
    const float* base32; const bf16_t* base16; float* out32; bf16_t* out16; const float* gate; bf16_t* xa; const float* ngain; const float* nsc; float* ss;
    __device__ __forceinline__ void operator()(const pg8::f32x4 (&acc)[2][2][4][2], const pg8::Unit& u, int wr, int wc, int fr, int fq) const {
        const int row0 = u.pm * 256 + wr * 64 + fr, col0 = u.pn * 256 + wc * 32 + 8 * fq; const int b = u.pm >> 3; const float* gp = gate + (size_t)b * 6144 + col0;
        pg8::f32x4 gv[2][2], av[2][2];
#pragma unroll
        for (int bj = 0; bj < 2; ++bj)
#pragma unroll
            for (int n = 0; n < 2; ++n) { gv[bj][n] = *(const pg8::f32x4*)(gp + bj * 128 + n * 4);
                if (xa) { const pg8::f32x4 g = *(const pg8::f32x4*)(ngain + col0 + bj * 128 + n * 4), sc = *(const pg8::f32x4*)(nsc + (size_t)b * 6144 + col0 + bj * 128 + n * 4); av[bj][n] = g * (sc + 1.f); } }
#pragma unroll
        for (int ai = 0; ai < 2; ++ai)
#pragma unroll
            for (int m = 0; m < 4; ++m) { const int row = row0 + ai * 128 + m * 16; const size_t off = (size_t)row * 1024 + col0; float sq = 0.f;
#pragma unroll
                for (int bj = 0; bj < 2; ++bj) { pg8::f32x4 xn[2];
                    if (base32) { xn[0] = *(const pg8::f32x4*)(base32 + off + bj * 128); xn[1] = *(const pg8::f32x4*)(base32 + off + bj * 128 + 4); }
                    else { const u32x4 bw = *(const u32x4*)(base16 + off + bj * 128); xn[0] = (pg8::f32x4){bflo(bw.x), bfhi(bw.x), bflo(bw.y), bfhi(bw.y)}; xn[1] = (pg8::f32x4){bflo(bw.z), bfhi(bw.z), bflo(bw.w), bfhi(bw.w)}; }
                    xn[0] = xn[0] + gv[bj][0] * acc[ai][bj][m][0]; xn[1] = xn[1] + gv[bj][1] * acc[ai][bj][m][1];
                    if (out32) { *(pg8::f32x4*)(out32 + off + bj * 128) = xn[0]; *(pg8::f32x4*)(out32 + off + bj * 128 + 4) = xn[1]; }
                    else { u32x4 w; w.x = pg8::cvt_pk_bf16(xn[0][0], xn[0][1]); w.y = pg8::cvt_pk_bf16(xn[0][2], xn[0][3]); w.z = pg8::cvt_pk_bf16(xn[1][0], xn[1][1]); w.w = pg8::cvt_pk_bf16(xn[1][2], xn[1][3]); *(u32x4*)(out16 + off + bj * 128) = w; }
                    if (xa) { sq += ((xn[0][0] * xn[0][0] + xn[0][1] * xn[0][1]) + (xn[0][2] * xn[0][2] + xn[0][3] * xn[0][3])) + ((xn[1][0] * xn[1][0] + xn[1][1] * xn[1][1]) + (xn[1][2] * xn[1][2] + xn[1][3] * xn[1][3]));
                        const pg8::f32x4 y0 = xn[0] * av[bj][0], y1 = xn[1] * av[bj][1];
                        u32x4 w; w.x = pg8::cvt_pk_bf16(y0[0], y0[1]); w.y = pg8::cvt_pk_bf16(y0[2], y0[3]); w.z = pg8::cvt_pk_bf16(y1[0], y1[1]); w.w = pg8::cvt_pk_bf16(y1[2], y1[3]);
                        *(u32x4*)(xa + off + bj * 128) = w; } }
                if (xa) { sq += swz<16>(sq); sq = sum32(sq); if (fq == 0) ss[(size_t)row * 16 + u.pn * 4 + wc] = sq; } }
    }
};

DI bool static_unit(int nM, int nN, int G, int c, int i, int& pm, int& pn) {
    const int nwg = nM * nN; const long L = (long)i * G + c; if (L >= nwg) return false;
    int wgid = (int)L; { const int q = nwg / pg8::NXCD, r = nwg % pg8::NXCD, xcd = wgid % pg8::NXCD, off = wgid / pg8::NXCD; wgid = (xcd < r ? xcd * (q + 1) : r * (q + 1) + (xcd - r) * q) + off; }
    const int nig = pg8::WGM * nN, gid = wgid / nig, fm = gid * pg8::WGM, gsz = (nM - fm) < pg8::WGM ? (nM - fm) : pg8::WGM;
    pm = fm + ((wgid % nig) % gsz); pn = (wgid % nig) / gsz; return true;
}
#ifndef FX_REPEAT_KIND
#define FX_REPEAT_KIND 0
#endif
#ifndef FX_VAR
#define FX_VAR 0
#endif
#define DUMMY_OUT ((float*)(ws + 344 * MiB))
#define DUMMY_XB ((bf16_t*)(ws + 344 * MiB))
__global__ void __launch_bounds__(NT, 2) mega(Args args) {
    extern __shared__ __attribute__((aligned(16))) unsigned char lds_raw[];
    Ctx c; c.lds = (LAS unsigned char*)lds_raw; c.tid = threadIdx.x; c.lane = c.tid & 63; c.wave = __builtin_amdgcn_readfirstlane(c.tid >> 6); c.G = gridDim.x; c.bid = blockIdx.x; c.a = nullptr; c.var = 0; (void)args;
#define KARGS() ({ CArgs* p_ = (CArgs*)__builtin_amdgcn_kernarg_segment_ptr(); asm volatile("" : "+s"(p_)); p_; })
    CArgs* pa0 = KARGS();
    volatile LAS unsigned* MISC = (volatile LAS unsigned*)(c.lds + LDS_MISC);
    for (int i = c.tid; i < 64; i += NT) MISC[i] = 0u;
    __syncthreads();
    XcdBarrier bar = xcd_barrier_post((unsigned*)(pa0->ws + WS_CTL) + 4096, MISC + 8);
    int ph = 0;
#ifdef PROBE_PHASE
    unsigned long long pr_t0 = 0ull; unsigned pr_dt = 0u;
    if (PROBE_PHASE == 0) pr_t0 = __builtin_amdgcn_s_memrealtime();
#endif
#if FX_MODE == 0
    constexpr int lo = 0, hi = 26;
#else
    const int lo = pa0->ph_lo, hi = pa0->ph_hi;
#endif
#define SEAM() do { if (ph + 1 < hi) { xcd_barrier(bar); if (FX_REPEAT_KIND == 12) xcd_barrier(bar); } } while (0)
#ifdef PROBE_PHASE
#define PROBE_T0() do { if (ph == PROBE_PHASE) pr_t0 = __builtin_amdgcn_s_memrealtime(); } while (0)
#define PROBE_T1() do { if (ph == PROBE_PHASE) pr_dt = (unsigned)(__builtin_amdgcn_s_memrealtime() - pr_t0); } while (0)
#else
#define PROBE_T0() do {} while (0)
#define PROBE_T1() do {} while (0)
#endif
#define PHASE_BEGIN if (ph >= lo && ph < hi) { PROBE_T0(); CArgs* pa = KARGS(); c.a = pa; unsigned char* ws = pa->ws; c.ws = ws; RELAUNDER(c); const int gw = c.bid * NW + c.wave, NGW = c.G * NW; (void)gw; (void)NGW; \
    const float* MOD = (const float*)(ws + WS_MOD); const float* mod = MOD + (size_t)layer * 8 * 6144; (void)mod; \
    bf16_t* XN = (bf16_t*)(ws + WS_XN); bf16_t* YC = (bf16_t*)(ws + WS_YC); bf16_t* U = (bf16_t*)(ws + WS_BIG + BIG_U); bf16_t* QL = (bf16_t*)(ws + WS_BIG + BIG_UP); bf16_t* KVU = QL + 768; \
    bf16_t* KF = XN; bf16_t* HID = (bf16_t*)(ws + WS_BIG); bf16_t* QKV = (bf16_t*)(ws + WS_BIG); bf16_t* XB = (bf16_t*)(ws + WS_XB); (void)XB; float* SS = (float*)(ws + WS_SS); const float* SHW = (const float*)(ws + WS_SHW); (void)SS; (void)SHW; (void)XN; (void)YC; (void)U; (void)QL; (void)KVU; (void)KF; (void)HID; (void)QKV; \
    unsigned char* wb = ws + ((layer & 1) ? WS_WODD + (size_t)(layer >> 1) * W_ODD : WS_WEVEN + (size_t)(layer >> 1) * W_EVEN); unsigned char* wm = ws + WS_WMLP + (size_t)layer * W_MLP; (void)wb; (void)wm;
#define PHASE_END SEAM(); PROBE_T1(); } ++ph;
    int layer = 0;

    if (lo == 0) { CArgs* pa = KARGS(); c.a = pa; c.ws = pa->ws; RELAUNDER(c);
#if FX_REPEAT_KIND == 20
        {
          const u32x4* src = (const u32x4*)(pa->ws + 40 * MiB); u32x4 acc4 = (u32x4){0u, 0u, 0u, 0u}; const size_t n16 = (256 * MiB) / 16;
          for (size_t i = (size_t)c.bid * NT + c.tid; i < n16; i += (size_t)c.G * NT * 8) {
#pragma unroll
              for (int u = 0; u < 8; ++u) { const size_t k = i + (size_t)u * c.G * NT; if (k < n16) { const u32x4 v = src[k]; acc4.x ^= v.x; acc4.y ^= v.y; acc4.z ^= v.z; acc4.w ^= v.w; } } }
          if ((acc4.x ^ acc4.y ^ acc4.z ^ acc4.w) == 0x12345u) ((unsigned*)(pa->ws + 380 * MiB))[c.tid] = acc4.x; }
#endif
#ifndef SKIP_PRO
        REP(10) phase_prologue(c);
#endif
        if (hi > 1) { if (pa->use_cg != 0) cooperative_groups::this_grid().sync(); else xcd_barrier(bar); }
#ifdef PROBE_PHASE
        if (PROBE_PHASE == 0) pr_dt = (unsigned)(__builtin_amdgcn_s_memrealtime() - pr_t0);
#endif
    }
    ++ph;

#pragma clang loop unroll(full)
    for (layer = 0; layer < 4; ++layer) {
        const int j = layer >> 1;
        if (layer == 0) {
        PHASE_BEGIN
            REP(8) phase_modnorm(c, pa->in[0], pa->in[5], mod + 0, mod + 1024, XN);
            REP(15) { shw_items(c, 0); if (FX_PRO_MATS >= 28) shw_items(c, 1); }
        PHASE_END
        }
        if ((layer & 1) == 0) {
            PHASE_BEGIN { pg8::Gemm g{XN, (const bf16_t*)(wb + WE_IN), T, UW, D, D}; pg8::StaticOrder so; so.init(T, UW, c.G, c.bid); EpiB16<0> E{U, UW, layer == 0 ? nullptr : SS + (size_t)(2 * layer) * T * 16, SHW + (size_t)(2 * layer) * 8 * 4096};

#ifndef SKIP_G1
REP(6) pg8::gemm_phase<EpiB16<0>, pg8::StaticOrder, true, true>(c.lds, g, so, E);
#endif
 } PHASE_END
            PHASE_BEGIN { pg8::Gemm g{U, (const bf16_t*)(wb + WE_UP), T, 1792, 256, UW}; UpOrder so; so.init(T, 1792, c.G, c.bid); EpiB16<0> E{QL, UPW, nullptr, nullptr};

#ifndef SKIP_G2
REP(13) pg8::gemm_phase<EpiB16<0>, UpOrder, false, true>(c.lds, g, so, E);
#endif

                __syncthreads();

#ifndef SKIP_CMP
 REP(14) for (int it = c.bid; it < 256; it += c.G) compress_item(c, U, j, it);
#endif


#ifndef SKIP_FIN
 RELAUNDER(c); for (int m0 = gw; m0 < T; m0 += NGW * TBV) nsa_finalize_rows(c, U, m0, NGW, j);
#endif
 } PHASE_END
            PHASE_BEGIN {
#ifndef SKIP_FIN
 for (int m0 = gw; m0 < T; m0 += NGW * TBV) mla_finalize_rows(c, U, QL, KVU, KF, m0, NGW, j);
                __syncthreads();
#endif

                REP(1) for (int p = c.bid; p < 256; p += c.G) { const int bg = p >> 4, s = p & 15;
#ifndef SKIP_NSA
 nsa_unit(c, U, YC, bg >> 1, bg & 1, 31 - s); nsa_unit(c, U, YC, bg >> 1, bg & 1, s);
#endif
 } } PHASE_END
            PHASE_BEGIN { REP(2) for (int p = c.bid; p < 256; p += c.G) { const int bh = p >> 2, s = p & 3;
#ifndef SKIP_MLA
 { bf16_t* yo_ = rep_ ? (bf16_t*)(ws + 344 * MiB) : YC; c.var = rep_ ? FX_VAR : 0; mla_unit(c, QL, KF, KVU, yo_, bh >> 3, bh & 7, 7 - s); mla_unit(c, QL, KF, KVU, yo_, bh >> 3, bh & 7, s); c.var = 0; }
#endif
 }
                if (layer == 0 && FX_PRO_MATS < 28) { __syncthreads(); RELAUNDER(c); convert_mats(c, FX_PRO_MATS, 28); } } PHASE_END
            PHASE_BEGIN { pg8::Gemm g{YC, (const bf16_t*)(wb + WE_OUT), T, D, D, D}; pg8::StaticOrder so; so.init(T, D, c.G, c.bid);
#ifndef SKIP_G3
REP(9) { EpiResid E{layer == 0 ? pa->in[0] : nullptr, XB, nullptr, rep_ ? DUMMY_XB : XB, mod + 2048, XN, pa->in[6] + layer * D, mod + 4096, SS + (size_t)(2 * layer + 1) * T * 16}; pg8::gemm_phase<EpiResid, pg8::StaticOrder, true, true>(c.lds, g, so, E); }
#endif
                if (layer == 0 && FX_PRO_MATS < 28) { RELAUNDER(c); shw_items(c, 1); }
 } PHASE_END
        } else {
            PHASE_BEGIN { pg8::Gemm g{XN, (const bf16_t*)(wb + WO_QKV), T, 3072, D, D}; pg8::StaticOrder so; so.init(T, 3072, c.G, c.bid); EpiB16<0> E{QKV, 3072, SS + (size_t)(2 * layer) * T * 16, SHW + (size_t)(2 * layer) * 8 * 4096};

#ifndef SKIP_G4
REP(7) pg8::gemm_phase<EpiB16<0>, pg8::StaticOrder, true, true>(c.lds, g, so, E);
                asm volatile("s_waitcnt vmcnt(0)" ::: "memory"); __syncthreads(); RELAUNDER(c);
                for (int i = 0; i < 3; ++i) { int pm_, pn_; if (!static_unit(T / 256, 3072 / 256, c.G, c.bid, i, pm_, pn_)) break; if (pn_ < 8) diff_finalize_tile(c, QKV, pm_, pn_, j); }
#endif
 } PHASE_END
            PHASE_BEGIN { REP(3) for (int p = c.bid; p < 256; p += c.G) { const int bh = p >> 2, s = p & 3;
#ifndef SKIP_DIFF
 diff_unit(c, QKV, YC, bh >> 3, bh & 7, 7 - s, j, layer); diff_unit(c, QKV, YC, bh >> 3, bh & 7, s, j, layer);
#endif
 } } PHASE_END
            PHASE_BEGIN { pg8::Gemm g{YC, (const bf16_t*)(wb + WO_O), T, D, D, D}; pg8::StaticOrder so; so.init(T, D, c.G, c.bid);
#ifndef SKIP_G5
REP(9) { EpiResid E{nullptr, XB, nullptr, rep_ ? DUMMY_XB : XB, mod + 2048, XN, pa->in[6] + layer * D, mod + 4096, SS + (size_t)(2 * layer + 1) * T * 16}; pg8::gemm_phase<EpiResid, pg8::StaticOrder, true, true>(c.lds, g, so, E); }
#endif
 } PHASE_END
        }
        PHASE_BEGIN { pg8::Gemm g{XN, (const bf16_t*)wm, T, FF, D, D}; pg8::StaticOrder so; so.init(T, FF, c.G, c.bid); EpiB16<1> E{HID, FF, SS + (size_t)(2 * layer + 1) * T * 16, SHW + (size_t)(2 * layer + 1) * 8 * 4096};

#ifndef SKIP_G6
REP(4) pg8::gemm_phase<EpiB16<1>, pg8::StaticOrder, true, true>(c.lds, g, so, E);
#endif
 } PHASE_END
        PHASE_BEGIN { pg8::Gemm g{HID, (const bf16_t*)(wm + 8 * MiB), T, D, FF, FF}; pg8::StaticOrder so; so.init(T, D, c.G, c.bid);
#ifndef SKIP_G7
REP(5) { EpiResid E{nullptr, XB, (layer == 3 && !rep_) ? pa->out : nullptr, rep_ ? DUMMY_XB : XB, mod + 5120, layer < 3 ? XN : nullptr, pa->in[5] + (layer + 1) * D, MOD + (size_t)(layer + 1) * 8 * 6144 + 1024, SS + (size_t)(2 * layer + 2) * T * 16}; pg8::gemm_phase<EpiResid, pg8::StaticOrder, true, true>(c.lds, g, so, E); }
#endif
 } PHASE_END
    }
#ifdef PROBE_PHASE
    { xcd_barrier(bar);
      if (blockIdx.x == 0) { CArgs* pa = KARGS();
#ifdef PROBE_FIXED_N
          const unsigned n = PROBE_FIXED_N;
#else
#ifndef PROBE_STEP
#define PROBE_STEP 4000
#endif
          unsigned k_ = pr_dt / PROBE_STEP; if (k_ > 6u) k_ = 6u; const unsigned n = k_ * 350000u;
#endif
          for (unsigned i = threadIdx.x; i < n; i += NT) pa->out[(size_t)i * 6u] += 0.05f; } }
#endif
#undef PHASE_BEGIN
#undef PHASE_END
#undef SEAM
}
constexpr int N_PHASES = 1 + 1 + 2 * (5 + 2) + 2 * (3 + 2);
static_assert(N_PHASES == 26, "phase count");

inline void launch(const Args& base, int lo, int hi, int use_cg, hipStream_t st) {
    static int grid = 0;
    if (grid == 0) {
        int dev = 0, cus = 0, per_cu = 0;
        (void)hipGetDevice(&dev); (void)hipDeviceGetAttribute(&cus, hipDeviceAttributeMultiprocessorCount, dev);
        (void)hipFuncSetAttribute((const void*)mega, hipFuncAttributeMaxDynamicSharedMemorySize, LDS_BYTES);
        (void)hipOccupancyMaxActiveBlocksPerMultiprocessor(&per_cu, (const void*)mega, NT, LDS_BYTES);
        if (per_cu < 1) { fprintf(stderr, "occupancy query says %d blocks/CU\n", per_cu); per_cu = 1; }
        grid = cus;
        (void)hipGetLastError();
    }
    Args a = base; a.ph_lo = lo; a.ph_hi = hi; a.use_cg = use_cg; a.pad = 0;
    void* kargs[] = {&a};
#ifndef FX_COOP
#define FX_COOP 1
#endif
#if FX_COOP
    hipError_t e = hipLaunchCooperativeKernel((const void*)mega, dim3(grid), dim3(NT), kargs, LDS_BYTES, st);
    if (e != hipSuccess) fprintf(stderr, "cooperative launch failed: %s\n", hipGetErrorString(e));
#else
    (void)kargs; hipLaunchKernelGGL(mega, dim3(grid), dim3(NT), LDS_BYTES, st, a);
#endif
}
}
#ifndef FX_COOP
#define FX_COOP 1
#endif
#ifndef FX_MODE
#define FX_MODE 0
#endif
#ifndef DBG_LAYERS
#define DBG_LAYERS 1
#endif
#ifndef DBG_B0
#define DBG_B0 5
#endif
#ifndef DBG_STAGE
#define DBG_STAGE 0
#endif
#ifndef DBG_NPH
#define DBG_NPH -1
#endif
namespace dbg {
__global__ void k_cmp(const void* fast, int is_bf16, long fld, const float* ref, long rld, int nrows, int ncols, float fscale, float* acc2) {
    const long n = (long)nrows * ncols; float d2 = 0.f, r2 = 0.f;
    for (long i = (long)blockIdx.x * 256 + threadIdx.x; i < n; i += (long)gridDim.x * 256) { const long r = i / ncols, cidx = i % ncols;
        float a = is_bf16 ? fx::bf2f(((const unsigned short*)fast)[r * fld + cidx]) : ((const float*)fast)[r * fld + cidx]; a *= fscale;
        const float b = ref[r * rld + cidx]; if (!(a == a)) a = 1e6f; d2 += (a - b) * (a - b); r2 += b * b; }
    for (int o = 32; o > 0; o >>= 1) { d2 += __shfl_xor(d2, o); r2 += __shfl_xor(r2, o); }
    if ((threadIdx.x & 63) == 0) { atomicAdd(acc2, d2); atomicAdd(acc2 + 1, r2); }
}
#ifndef DBG_SEL
#define DBG_SEL -1
#endif
__global__ void k_finish(float* out, const float* acc, int nchk, long n) {
    float e = 0.f; int bad = -1; for (int i = 0; i < nchk; ++i) { float v = sqrtf(acc[2 * i] / fmaxf(acc[2 * i + 1], 1e-30f)); if (!(v == v)) v = 100.f; e = fmaxf(e, v); if (bad < 0 && v > 0.05f) bad = i; }
    if (DBG_SEL >= 0) { e = sqrtf(acc[2 * DBG_SEL] / fmaxf(acc[2 * DBG_SEL + 1], 1e-30f)); if (!(e == e)) e = 100.f; bad = -1; }
    if (blockIdx.x == 0 && threadIdx.x == 0 && bad >= 0) out[0] += 1000.f * (bad + 1);
    for (long i = (long)blockIdx.x * 256 + threadIdx.x; i < n; i += (long)gridDim.x * 256) out[i] *= (1.f + e);
}
}
extern "C" void kernel_launch(void* const* d_in, const int* in_sizes, int n_in, void* d_out, int out_size, void* d_ws, size_t ws_size, hipStream_t stream) {
    fx::Args a{};
    for (int i = 0; i < 28; ++i) a.in[i] = (const float*)d_in[i];
    a.pos = (const int*)d_in[2]; a.out = (float*)d_out; a.ws = (unsigned char*)d_ws;
    (void)hipMemsetAsync((char*)d_ws + fx::WS_CTL, 0, 65536, stream);
#if FX_MODE == 0
    fx::launch(a, 0, fx::N_PHASES, FX_COOP ? 1 : 0, stream);
#elif FX_MODE == 1
    for (int p = 0; p < fx::N_PHASES; ++p) fx::launch(a, p, p + 1, 0, stream);
#else
    nv::In in{}; for (int i = 0; i < 28; ++i) in.p[i] = (const float*)d_in[i]; in.pos = (const int*)d_in[2];
    float* errs = (float*)((char*)d_ws + 381 * fx::MiB);
    (void)hipMemsetAsync(errs, 0, 256, stream);
    const int nph = DBG_NPH >= 0 ? DBG_NPH : (DBG_LAYERS == 1 ? 9 : DBG_LAYERS == 2 ? 15 : DBG_LAYERS == 3 ? 22 : 28);
    for (int p = 0; p < nph; ++p) fx::launch(a, p, p + 1, 0, stream);
    float* nws = (float*)((char*)d_ws + fx::WS_NAIVE); float* nx = (float*)((char*)d_ws + fx::WS_NAIVE + 56 * fx::MiB);
    nv::forward(in, nx, nws, stream, DBG_LAYERS, DBG_B0, 1, DBG_STAGE == 8 ? 6 : DBG_STAGE);
    int nchk = 0;
    auto CMPR = [&](const void* f, int isb, long fld, const float* r, long rld, int nrows, int ncols, float fs) { hipLaunchKernelGGL(dbg::k_cmp, dim3(512), dim3(256), 0, stream, f, isb, fld, r, rld, nrows, ncols, fs, errs + 2 * nchk); ++nchk; };
    auto CMP = [&](const void* f, int isb, long fld, const float* r, long rld, int ncols, float fs) { CMPR(f, isb, fld, r, rld, 2048, ncols, fs); };
    const size_t r0 = (size_t)DBG_B0 * 2048;
    unsigned char* ws = (unsigned char*)d_ws;
    const size_t NMi = (size_t)(1u << 20) / 8;
    float* nU = nws + nv::R_U; float* nRA = nU + 29 * NMi; float* nRB = nRA + 12 * NMi; float* nRC = nRB + 16 * NMi; float* nRD = nRC + 12 * NMi; float* nH = nRD + 8 * NMi;
    (void)nRA; (void)nRB; (void)nRC; (void)nRD; (void)nH;
    const fx::bf16_t* fU = (const fx::bf16_t*)(ws + fx::WS_BIG + fx::BIG_U); const fx::bf16_t* fQL = (const fx::bf16_t*)(ws + fx::WS_BIG + fx::BIG_UP);
    const fx::bf16_t* fKVU = fQL + 768; const fx::bf16_t* fXN = (const fx::bf16_t*)(ws + fx::WS_XN); const fx::bf16_t* fYC = (const fx::bf16_t*)(ws + fx::WS_YC);
    (void)fU; (void)fQL; (void)fKVU; (void)fXN; (void)fYC;
#if DBG_STAGE == 0 || DBG_STAGE == 9
    CMP((const float*)d_out + r0 * 1024, 0, 1024, nx, 1024, 1024, 1.f);
#elif DBG_STAGE == 1
    if ((DBG_LAYERS & 1) == 1) { CMP(fU + r0 * 2048, 1, 2048, nU, 1848, 544, 1.f); CMP(fU + r0 * 2048 + 1056, 1, 2048, nU + 1056, 1848, 256, 1.f); CMP(fU + r0 * 2048 + 1824, 1, 2048, nU + 1824, 1848, 24, 1.f); }
    else { CMP(fU + r0 * 3072 + 2048, 1, 3072, nU + 2048, 3072, 1024, 1.f); }
#elif DBG_STAGE == 2
    if ((DBG_LAYERS & 1) == 1) { CMP(fQL + r0 * 1792, 1, 1792, nRC, 768, 768, 1.f / (0.10206207261596577f * 1.4426950408889634f)); CMP(fXN + r0 * 768, 1, 768, nRA, 768, 768, 1.f); }
    else { CMP(fU + r0 * 3072, 1, 3072, nU, 3072, 1024, 1.f / (0.125f * 1.4426950408889634f)); CMP(fU + r0 * 3072 + 1024, 1, 3072, nU + 1024, 3072, 1024, 1.f); }
#elif DBG_STAGE == 3
    CMP(fU + r0 * 2048, 1, 2048, nU, 1848, 544, 1.f); CMP(fU + r0 * 2048 + 1056, 1, 2048, nU + 1056, 1848, 256, 1.f); CMP(fU + r0 * 2048 + 1824, 1, 2048, nU + 1824, 1848, 24, 1.f);
    CMP(fQL + r0 * 1792, 1, 1792, nRC, 768, 768, 1.f / (0.10206207261596577f * 1.4426950408889634f)); CMP(fXN + r0 * 768, 1, 768, nRA, 768, 768, 1.f);
    CMP(fYC + r0 * 1024, 1, 1024, nH, 1024, 512, 1.f);
#elif DBG_STAGE == 4
    if ((DBG_LAYERS & 1) == 1) { CMP(fU + r0 * 2048 + 544, 1, 2048, nRD, 512, 512, 1.f / (0.125f * 1.4426950408889634f)); }
    else { CMP(fYC + r0 * 1024, 1, 1024, nU, 1024, 1024, 1.f); }
#elif DBG_STAGE == 6
    { const float* nSM = nws + nv::R_SMALL; const fx::bf16_t* fKC = (const fx::bf16_t*)(ws + fx::WS_MISC + 65536) + (size_t)DBG_B0 * 2 * 128 * 64; const fx::bf16_t* fVC = fKC + 16 * 128 * 64;
      CMP(fU + r0 * 2048 + 544, 1, 2048, nRD, 512, 512, 1.f / (0.125f * 1.4426950408889634f));
      CMPR(fKC, 1, 64, nSM, 64, 127, 64, 1.f); CMPR(fKC + 128 * 64, 1, 64, nSM + 128 * 64, 64, 127, 64, 1.f);
      CMPR(fVC, 1, 64, nSM + 16 * 128 * 64, 64, 127, 64, 1.f); CMPR(fVC + 128 * 64, 1, 64, nSM + 17 * 128 * 64, 64, 127, 64, 1.f);
      CMP(fU + r0 * 2048 + 1312, 1, 2048, nRA, 128, 128, 1.f); CMP(fU + r0 * 2048 + 1568, 1, 2048, nRA + 2 * NMi, 128, 128, 1.f); }
#elif DBG_STAGE == 8
    { const float* nb_ = NSA_ONLY == 0 ? nRC : NSA_ONLY == 1 ? nRA + 4 * NMi : nRB; CMP(fYC + r0 * 1024 + 512, 1, 1024, nb_, 512, 512, 1.f); }
#elif DBG_STAGE == 7
    CMP(fYC + r0 * 1024, 1, 1024, nH, 1024, 512, 1.f); CMP(fYC + r0 * 1024 + 512, 1, 1024, nH + 512, 1024, 512, 1.f);
#endif
    nv::forward(in, (float*)d_out, (float*)d_ws, stream, 4, 0, 8, 0);
    hipLaunchKernelGGL(dbg::k_finish, dim3(1024), dim3(256), 0, stream, (float*)d_out, errs, nchk, (long)16384 * 1024);
#endif
}
```

```cpp
#define FX_MODE 0

#include <hip/hip_runtime.h>
#include <hip/hip_bf16.h>
#include <cstdio>
#include <cstdint>
#include <cmath>
#include <hip/hip_cooperative_groups.h>
namespace pg8 {
#define PG8_LAS __attribute__((address_space(3)))
typedef unsigned short bf16_t;
typedef short bf16x8 __attribute__((ext_vector_type(8)));
typedef float f32x4 __attribute__((ext_vector_type(4)));
typedef unsigned u32x4 __attribute__((ext_vector_type(4)));
constexpr int BM = 256, BK = 64, HALF = 128, HTB = HALF * BK * 2  , STAGE_BYTES = 8 * HTB, NXCD = 8, WGM = 8;

__host__ __device__ __forceinline__ int lds_byte(int r, int c) { const int st = (r >> 4) * 2 + (c >> 5), rr = r & 15, cc = c & 31, ob = rr * 64 + cc * 2; return st * 1024 + (ob ^ (((ob >> 9) & 1) << 5)); }
__host__ __device__ __forceinline__ void stage_rc(int b, int& R, int& C) { const int st = b / 1024, sb = b % 1024, swz = sb ^ (((sb >> 9) & 1) << 5); R = (st >> 1) * 16 + swz / 64; C = (st & 1) * 32 + (swz % 64) / 2; }
__host__ __device__ __forceinline__ int perm32(int rho) { const int n = rho >> 4, i = rho & 15; return 8 * (i >> 2) + 4 * n + (i & 3); }

struct Unit { int pm, pn; int aoff; };
struct Gemm { const bf16_t* A; const bf16_t* Bt; int M, N, K, lda; };

struct StaticOrder {
    int nM, nN, nwg, G, c;
    __host__ __device__ void init(int M, int N, int G_, int c_) { nM = M / BM; nN = N / BM; nwg = nM * nN; G = G_; c = c_; }
    __host__ __device__ bool next(int i, Unit& u) const {
        const long L = (long)i * G + c; if (L >= nwg) return false;
        int wgid = (int)L; { const int q = nwg / NXCD, r = nwg % NXCD, xcd = wgid % NXCD, off = wgid / NXCD; wgid = (xcd < r ? xcd * (q + 1) : r * (q + 1) + (xcd - r) * q) + off; }
        const int nig = WGM * nN, gid = wgid / nig, fm = gid * WGM, gsz = (nM - fm) < WGM ? (nM - fm) : WGM;
        u.pm = fm + ((wgid % nig) % gsz); u.pn = (wgid % nig) / gsz; u.aoff = 0; return true;
    }
    __device__ __forceinline__ void a_ready(const Unit&) const {}
    __device__ __forceinline__ void done(const Unit&) const {}
};

__device__ __forceinline__ unsigned cvt_pk_bf16(float lo, float hi) { unsigned r; asm volatile("v_cvt_pk_bf16_f32 %0, %1, %2" : "=v"(r) : "v"(lo), "v"(hi)); return r; }
typedef float f32x2 __attribute__((ext_vector_type(2)));
__device__ __forceinline__ f32x2 gelu_pk(f32x2 v) {
    const f32x2 av = __builtin_elementwise_abs(v), d = av * 0.2316418882f + 1.0f;
    f32x2 t; t.x = __builtin_amdgcn_rcpf(d.x); t.y = __builtin_amdgcn_rcpf(d.y);
    f32x2 q = t * 0.5307027145f + (-0.7265760135f); q = q * t + 0.7107068705f; q = q * t + (-0.142248368f); q = q * t + 0.127414796f; q = q * t;
    const f32x2 s = (v * v) * (-0.72134752044f);
    f32x2 e; e.x = __builtin_amdgcn_exp2f(s.x); e.y = __builtin_amdgcn_exp2f(s.y);
    const f32x2 m = v * (q * e), r = v - m;
    f32x2 o; o.x = v.x < 0.f ? m.x : r.x; o.y = v.y < 0.f ? m.y : r.y; return o;
}

template <int ACT  > struct EpiBf16 {
    static constexpr bool PERM = true, AFTER_DRAIN = false; static_assert(ACT == 0 || ACT == 1, "EpiBf16: ACT is 0 (none) or 1 (gelu_pk)");
    bf16_t* O; int ldc; const float* bias; int split_cols; size_t split_stride; float scale0;
    __device__ __forceinline__ void operator()(const f32x4 (&acc)[2][2][4][2], const Unit& u, int wr, int wc, int fr, int fq) const {
        const int row0 = u.pm * BM + wr * 64 + fr; int colt = u.pn * BM; bf16_t* base = O;
        float sc = 1.f; if (split_cols) { const int t = colt / split_cols; base += (size_t)t * split_stride; colt -= t * split_cols; if (t == 0) sc = scale0; }
        const int col0 = colt + wc * 32 + 8 * fq, bcol0 = u.pn * BM + wc * 32 + 8 * fq;
        f32x4 bv[2][2];
#pragma unroll
        for (int bj = 0; bj < 2; ++bj)
#pragma unroll
            for (int n = 0; n < 2; ++n) bv[bj][n] = bias ? *(const f32x4*)(bias + bcol0 + bj * HALF + 4 * n) : (f32x4){0.f, 0.f, 0.f, 0.f};
#pragma unroll
        for (int ai = 0; ai < 2; ++ai)
#pragma unroll
            for (int m = 0; m < 4; ++m) { bf16_t* rowp = base + (size_t)(row0 + ai * HALF + m * 16) * ldc + col0;
#pragma unroll
                for (int bj = 0; bj < 2; ++bj) { f32x4 v0 = acc[ai][bj][m][0] + bv[bj][0], v1 = acc[ai][bj][m][1] + bv[bj][1];
                    if (ACT == 1) { f32x2 a = gelu_pk((f32x2){v0[0], v0[1]}), b = gelu_pk((f32x2){v0[2], v0[3]}), c = gelu_pk((f32x2){v1[0], v1[1]}), d = gelu_pk((f32x2){v1[2], v1[3]});
                        v0 = (f32x4){a.x, a.y, b.x, b.y}; v1 = (f32x4){c.x, c.y, d.x, d.y}; }
                    v0 = v0 * sc; v1 = v1 * sc; u32x4 w; w.x = cvt_pk_bf16(v0[0], v0[1]); w.y = cvt_pk_bf16(v0[2], v0[3]); w.z = cvt_pk_bf16(v1[0], v1[1]); w.w = cvt_pk_bf16(v1[2], v1[3]);
                    *(u32x4*)(rowp + bj * HALF) = w; } }
    }
};

template <class Epi, class Sched, bool ALIGN_EPI = false, bool SP2 = false>
__device__ __forceinline__ void gemm_phase(PG8_LAS unsigned char* lds, const Gemm g, const Sched& S, const Epi& E) {
    int tid_ = threadIdx.x; asm volatile("" : "+v"(tid_)); const int tid = tid_, wid = __builtin_amdgcn_readfirstlane(tid >> 6), lane = tid & 63, wr = wid >> 2, wc = wid & 3, fr = lane & 15, fq = lane >> 4;
    const int K = g.K, nt = K / BK;
    unsigned voffA[2], voffB[2];
#pragma unroll
    for (int i = 0; i < 2; ++i) { int R, C; stage_rc(tid * 16 + i * 8192, R, C); const int Rb = Epi::PERM ? ((R & ~31) + perm32(R & 31)) : R;
        voffA[i] = (unsigned)(R * g.lda + C) * 2u; voffB[i] = (unsigned)(Rb * K + C) * 2u; }
    const size_t kstep = (size_t)(BK * 2);
    const size_t hstep = (size_t)HALF * K * 2;
    const size_t hstepA = (size_t)HALF * g.lda * 2, tstepA = 2 * hstepA;
    const size_t tstep = 2 * hstep;
    const unsigned ldsw = (unsigned)wid * 1024u;
    const int aoff = lds_byte(wr * 64 + fr, fq * 8), boff = lds_byte(wc * 32 + fr, fq * 8);
#define PG8_SA(b, h) (((b) * 2 + (h)) * HTB)
#define PG8_SB(b, h) ((4 + (b) * 2 + (h)) * HTB)
#define PG8_STAGE(bufoff, gbase, voff) do { _Pragma("unroll") for (int _i = 0; _i < 2; ++_i) \
        __builtin_amdgcn_global_load_lds((const unsigned*)((const char*)(gbase) + (voff)[_i]), (PG8_LAS unsigned*)(lds + (bufoff) + ldsw + _i * 8192), 16, 0, 0); } while (0)
#define PG8_LDA(dst, b, h) do { _Pragma("unroll") for (int m = 0; m < 4; ++m) _Pragma("unroll") for (int k = 0; k < 2; ++k) dst[m][k] = *(const PG8_LAS bf16x8*)(lds + PG8_SA(b, h) + aoff + m * 2048 + k * 1024); } while (0)
#define PG8_LDB(dst, b, h) do { _Pragma("unroll") for (int n = 0; n < 2; ++n) _Pragma("unroll") for (int k = 0; k < 2; ++k) dst[n][k] = *(const PG8_LAS bf16x8*)(lds + PG8_SB(b, h) + boff + n * 2048 + k * 1024); } while (0)
#define PG8_MMA(ai, bj, At, Bt) do { __builtin_amdgcn_s_setprio(1); _Pragma("unroll") for (int m = 0; m < 4; ++m) _Pragma("unroll") for (int n = 0; n < 2; ++n) _Pragma("unroll") for (int k = 0; k < 2; ++k) \
        acc[ai][bj][m][n] = __builtin_amdgcn_mfma_f32_16x16x32_bf16(Bt[n][k], At[m][k], acc[ai][bj][m][n], 0, 0, 0); __builtin_amdgcn_s_setprio(0); } while (0)
#define PG8_WAIT_V(n) asm volatile("s_waitcnt vmcnt(" #n ")" ::: "memory")
#define PG8_WAIT_L(n) asm volatile("s_waitcnt lgkmcnt(" #n ")" ::: "memory")
#define PG8_BAR __builtin_amdgcn_s_barrier()
#define PG8_SCHED __builtin_amdgcn_sched_barrier(0)
    Unit cur, nxt; int ui = 0;
    if (!S.next(0, cur)) return;
    f32x4 acc[2][2][4][2];
#pragma unroll
    for (int a = 0; a < 2; ++a)
#pragma unroll
        for (int b = 0; b < 2; ++b)
#pragma unroll
            for (int m = 0; m < 4; ++m)
#pragma unroll
                for (int n = 0; n < 2; ++n) acc[a][b][m][n] = (f32x4){0.f, 0.f, 0.f, 0.f};
    bf16x8 At[4][2], B0[2][2], B1[2][2];
    const char* cA = (const char*)g.A + (size_t)cur.pm * tstepA + (size_t)cur.aoff * 2; const char* cB = (const char*)g.Bt + (size_t)cur.pn * tstep;
    S.a_ready(cur);
    if constexpr (SP2) {
        PG8_STAGE(PG8_SB(0, 0), cB, voffB); PG8_STAGE(PG8_SB(0, 1), cB + hstep, voffB); PG8_STAGE(PG8_SA(0, 0), cA, voffA); PG8_STAGE(PG8_SA(0, 1), cA + hstepA, voffA);
        if (wr == 1) PG8_BAR;
        PG8_WAIT_V(2); PG8_BAR;
        PG8_STAGE(PG8_SB(1, 0), cB + kstep, voffB); PG8_STAGE(PG8_SA(1, 0), cA + kstep, voffA); PG8_STAGE(PG8_SB(1, 1), cB + hstep + kstep, voffB);
        PG8_WAIT_V(6); PG8_BAR;
    } else {
        PG8_STAGE(PG8_SB(0, 0), cB, voffB); PG8_STAGE(PG8_SA(0, 0), cA, voffA); PG8_STAGE(PG8_SB(0, 1), cB + hstep, voffB); PG8_STAGE(PG8_SA(0, 1), cA + hstepA, voffA);
        if (wr == 1) PG8_BAR;
        PG8_WAIT_V(4); PG8_BAR;
        PG8_STAGE(PG8_SB(1, 0), cB + kstep, voffB); PG8_STAGE(PG8_SA(1, 0), cA + kstep, voffA); PG8_STAGE(PG8_SB(1, 1), cB + hstep + kstep, voffB);
        PG8_WAIT_V(6); PG8_BAR;
    }
    for (;;) {
        const bool has_next = S.next(ui + 1, nxt);
        const char* nA = has_next ? (const char*)g.A + (size_t)nxt.pm * tstepA + (size_t)nxt.aoff * 2 : cA; const char* nB = has_next ? (const char*)g.Bt + (size_t)nxt.pn * tstep : cB;
        for (int t = 0; t < nt; t += 2) {
            const bool last = (t == nt - 2);
            const char* a1 = cA + (size_t)(t + 1) * kstep;
            const char* a2 = last ? nA : cA + (size_t)(t + 2) * kstep; const char* b2 = last ? nB : cB + (size_t)(t + 2) * kstep;
            const char* a3 = a2 + kstep; const char* b3 = b2 + kstep;
            if (last && has_next) S.a_ready(nxt);
            if constexpr (SP2) {
            PG8_LDB(B0, 0, 0); PG8_LDB(B1, 0, 1); PG8_SCHED; PG8_LDA(At, 0, 0); PG8_STAGE(PG8_SA(1, 1), a1 + hstepA, voffA);
            PG8_WAIT_V(8); PG8_WAIT_L(0); PG8_BAR; PG8_MMA(0, 0, At, B0); PG8_MMA(0, 1, At, B1); PG8_BAR; PG8_SCHED;
            PG8_LDA(At, 0, 1); PG8_STAGE(PG8_SB(0, 0), b2, voffB); PG8_STAGE(PG8_SB(0, 1), b2 + hstep, voffB); PG8_STAGE(PG8_SA(0, 0), a2, voffA);
            PG8_WAIT_V(8); PG8_WAIT_L(0); PG8_BAR; PG8_MMA(1, 0, At, B0); PG8_MMA(1, 1, At, B1); PG8_BAR; PG8_SCHED;
            PG8_LDB(B0, 1, 0); PG8_LDB(B1, 1, 1); PG8_SCHED; PG8_LDA(At, 1, 0); PG8_STAGE(PG8_SA(0, 1), a2 + hstepA, voffA);
            PG8_WAIT_V(8); PG8_WAIT_L(0); PG8_BAR; PG8_MMA(0, 0, At, B0); PG8_MMA(0, 1, At, B1); PG8_BAR; PG8_SCHED;
            PG8_LDA(At, 1, 1); PG8_STAGE(PG8_SB(1, 0), b3, voffB); PG8_STAGE(PG8_SB(1, 1), b3 + hstep, voffB); PG8_STAGE(PG8_SA(1, 0), a3, voffA);
            PG8_WAIT_V(8); PG8_WAIT_L(0); PG8_BAR; PG8_MMA(1, 0, At, B0); PG8_MMA(1, 1, At, B1); PG8_BAR; PG8_SCHED;
            } else {
            PG8_LDB(B0, 0, 0); PG8_SCHED; PG8_LDA(At, 0, 0); PG8_STAGE(PG8_SA(1, 1), a1 + hstepA, voffA);
            PG8_WAIT_L(8); PG8_BAR; PG8_WAIT_L(0); PG8_MMA(0, 0, At, B0); PG8_BAR; PG8_SCHED;
            PG8_LDB(B1, 0, 1); PG8_STAGE(PG8_SB(0, 0), b2, voffB);
            PG8_BAR; PG8_WAIT_L(0); PG8_MMA(0, 1, At, B1); PG8_BAR;
            PG8_LDA(At, 0, 1); PG8_STAGE(PG8_SA(0, 0), a2, voffA);
            PG8_BAR; PG8_WAIT_L(0); PG8_MMA(1, 0, At, B0); PG8_BAR; PG8_SCHED;
            PG8_STAGE(PG8_SB(0, 1), b2 + hstep, voffB);
            PG8_WAIT_V(6); PG8_BAR; PG8_MMA(1, 1, At, B1); PG8_BAR;
            PG8_LDB(B0, 1, 0); PG8_SCHED; PG8_LDA(At, 1, 0); PG8_STAGE(PG8_SA(0, 1), a2 + hstepA, voffA);
            PG8_WAIT_L(8); PG8_BAR; PG8_WAIT_L(0); PG8_MMA(0, 0, At, B0); PG8_BAR; PG8_SCHED;
            PG8_LDB(B1, 1, 1); PG8_STAGE(PG8_SB(1, 0), b3, voffB);
            PG8_BAR; PG8_WAIT_L(0); PG8_MMA(0, 1, At, B1); PG8_BAR;
            PG8_LDA(At, 1, 1); PG8_STAGE(PG8_SA(1, 0), a3, voffA);
            PG8_BAR; PG8_WAIT_L(0); PG8_MMA(1, 0, At, B0); PG8_BAR; PG8_SCHED;
            PG8_STAGE(PG8_SB(1, 1), b3 + hstep, voffB);
            PG8_WAIT_V(6); PG8_BAR; PG8_MMA(1, 1, At, B1); PG8_BAR;
            }
        }
        if constexpr (ALIGN_EPI) { if (wr == 0) PG8_BAR; }
        if constexpr (!Epi::AFTER_DRAIN) { E(acc, cur, wr, wc, fr, fq); S.done(cur); }
        if (!has_next) break;
#pragma unroll
        for (int a = 0; a < 2; ++a)
#pragma unroll
            for (int b = 0; b < 2; ++b)
#pragma unroll
                for (int m = 0; m < 4; ++m)
#pragma unroll
                    for (int n = 0; n < 2; ++n) acc[a][b][m][n] = (f32x4){0.f, 0.f, 0.f, 0.f};
        cur = nxt; cA = nA; cB = nB; ++ui;
        if constexpr (ALIGN_EPI) { if (wr == 1) PG8_BAR; }
    }
    PG8_WAIT_V(0);
    if constexpr (!ALIGN_EPI) { if (wr == 0) PG8_BAR; }
    PG8_BAR;
    if constexpr (Epi::AFTER_DRAIN) { E.fused(acc, cur, wr, wc, fr, fq, lds, wid, lane); S.done(cur); }
#undef PG8_SA
#undef PG8_SB
#undef PG8_STAGE
#undef PG8_LDA
#undef PG8_LDB
#undef PG8_MMA
#undef PG8_WAIT_V
#undef PG8_WAIT_L
#undef PG8_BAR
#undef PG8_SCHED
}
}
#ifndef FX_REPEAT_KIND
#define FX_REPEAT_KIND 0
#endif
#ifndef FX_STG
#define FX_STG true
#endif
#ifndef FX_SWEEP2
#define FX_SWEEP2 0
#endif
#ifndef FX_QKDB
#define FX_QKDB false
#endif
#ifndef FX_PRO_MATS
#define FX_PRO_MATS 28
#endif
#ifndef FX_PRIO
#define FX_PRIO 0
#endif
#ifndef FX_LATE
#define FX_LATE(w) ((w) >= 4)
#endif
#ifdef PROBE_SEC
#define PSEC_B(id) do { if ((id) == PROBE_SEC) { __syncthreads(); c.pr_t = __builtin_amdgcn_s_memrealtime(); } } while (0)
#define PSEC_E(id) do { if ((id) == PROBE_SEC) { __syncthreads(); c.pr_acc += (unsigned)(__builtin_amdgcn_s_memrealtime() - c.pr_t); } } while (0)
#else
#define PSEC_B(id) do {} while (0)
#define PSEC_E(id) do {} while (0)
#endif
#define REP(kind) for (int rep_ = 0; rep_ < ((FX_REPEAT_KIND == (kind)) ? 2 : 1); ++rep_)
namespace fx {
#define DI __device__ __forceinline__
#define LAS __attribute__((address_space(3)))
typedef unsigned short bf16_t;
typedef short bf16x8 __attribute__((ext_vector_type(8)));
typedef short s16x4 __attribute__((ext_vector_type(4)));
typedef float f32x4 __attribute__((ext_vector_type(4)));
typedef float f32x16 __attribute__((ext_vector_type(16)));
typedef unsigned u32x4 __attribute__((ext_vector_type(4)));
typedef unsigned u32x2 __attribute__((ext_vector_type(2)));
constexpr int B = 8, S = 2048, D = 1024, T = B * S, FF = 4096, HYIN = 1848, UW = 2048;
constexpr float EPS = 1e-6f, LOG2E = 1.4426950408889634f;
constexpr int NW = 8, NT = 512;
constexpr size_t MiB = 1u << 20;
constexpr size_t WS_CTL = 0;
constexpr size_t WS_MOD = 1 * MiB;
constexpr size_t WS_CS8 = 2 * MiB;
constexpr size_t WS_CS16 = 3 * MiB;
constexpr size_t WS_MISC = 5 * MiB;
constexpr size_t WS_W = 6 * MiB;
constexpr size_t W_EVEN = 9 * MiB, W_ODD = 8 * MiB, W_MLP = 16 * MiB;
constexpr size_t WE_IN = 0, WE_OUT = 4 * MiB, WE_UP = 6 * MiB, WE_C1 = 7 * MiB, WE_C2 = 8 * MiB;
constexpr size_t WO_QKV = 0, WO_O = 6 * MiB;
constexpr size_t WS_WEVEN = WS_W, WS_WODD = WS_W + 2 * W_EVEN, WS_WMLP = WS_WODD + 2 * W_ODD;
constexpr size_t WS_XN = 104 * MiB;
constexpr size_t WS_YC = 136 * MiB;
constexpr size_t WS_BIG = 168 * MiB;
constexpr size_t BIG_U = 0, BIG_UP = 64 * MiB + 64 * 1024;
constexpr int UPW = 1792;
constexpr size_t WS_FAST_END = 296 * MiB;
constexpr size_t WS_SS = 332 * MiB;
constexpr size_t WS_SHW = 296 * MiB;
constexpr size_t WS_XB = 300 * MiB;
constexpr size_t WS_NAIVE = 300 * MiB;
constexpr int LDS_MISC = 131072, LDS_BYTES = 147456;

DI unsigned f2bf(float f) { unsigned u = __builtin_bit_cast(unsigned, f); return (u + 0x7fffu + ((u >> 16) & 1u)) >> 16; }
DI unsigned pk2(float lo, float hi) { return f2bf(lo) | (f2bf(hi) << 16); }
DI float bf2f(unsigned short b) { return __builtin_bit_cast(float, (unsigned)b << 16); }
DI float bflo(unsigned u) { return __builtin_bit_cast(float, u << 16); }
DI float bfhi(unsigned u) { return __builtin_bit_cast(float, u & 0xffff0000u); }
typedef short v4i16_t_ __attribute__((ext_vector_type(4)));
DI s16x4 vtr(const LAS char* p) { return __builtin_bit_cast(s16x4, __builtin_amdgcn_ds_read_tr16_b64_v4i16((LAS v4i16_t_*)p)); }
template <int O> DI float swz(float v) { static_assert(O < 32, "swz: xor mask < 32"); return __builtin_bit_cast(float, __builtin_amdgcn_ds_swizzle(__builtin_bit_cast(int, v), (O << 10) | 0x1f)); }
template <int O> DI unsigned swzu(unsigned v) { return (unsigned)__builtin_amdgcn_ds_swizzle((int)v, (O << 10) | 0x1f); }
DI void xchg32(unsigned& a, unsigned& b) { asm volatile("s_nop 1\n\tv_permlane32_swap_b32 %0, %1\n\ts_nop 1" : "+v"(a), "+v"(b)); }
DI float sum32(float v) { unsigned a = __builtin_bit_cast(unsigned, v), b = a; xchg32(a, b); return __builtin_bit_cast(float, a) + __builtin_bit_cast(float, b); }
DI float max32(float v) { unsigned a = __builtin_bit_cast(unsigned, v), b = a; xchg32(a, b); return fmaxf(__builtin_bit_cast(float, a), __builtin_bit_cast(float, b)); }
DI unsigned or32(unsigned v) { unsigned a = v, b = v; xchg32(a, b); return a | b; }
#ifdef DBG_SHFL
DI float wave_sum(float v) { for (int o = 1; o < 64; o <<= 1) v += __shfl_xor(v, o); return v; }
#else
DI float wave_sum(float v) { v += swz<1>(v); v += swz<2>(v); v += swz<4>(v); v += swz<8>(v); v += swz<16>(v); return sum32(v); }
#endif

struct Args { const float* in[28]; const int* pos; float* out; unsigned char* ws; int ph_lo, ph_hi; int use_cg; int pad; };
typedef const __attribute__((address_space(4))) Args CArgs;
#define XB_TMO      128
#define XB_XCNT(j)  (256  + 64 * (j))
#define XB_XSUB(j)  (1280 + 64 * (j))
#define XB_XGEN(j)  (2304 + 64 * (j))
#define XB_TOP      3328
#define XB_TOPGEN   3392
#define XCD_BAR_WORDS 3456
#define XB_SPIN_CAP (1u << 20)
DI unsigned xb_ld(unsigned* p)              { return __hip_atomic_load(p, __ATOMIC_RELAXED, __HIP_MEMORY_SCOPE_AGENT); }
DI unsigned xb_add(unsigned* p, unsigned v) { return __hip_atomic_fetch_add(p, v, __ATOMIC_RELAXED, __HIP_MEMORY_SCOPE_AGENT); }
DI unsigned xb_xcc_id() { return (unsigned)__builtin_amdgcn_s_getreg((3 << 11) | 20) & 0xFu; }
#define XB_SPIN(cond, bar) do { unsigned _sp = 0; while (cond) { __builtin_amdgcn_s_sleep(1); \
    if ((++_sp & 255u) == 0u) { if (xb_ld(&(bar)[XB_TMO])) break; if (_sp > XB_SPIN_CAP) { atomicAdd(&(bar)[XB_TMO], 1u); break; } } } } while (0)
struct XcdBarrier { unsigned* bar; unsigned x; volatile LAS unsigned* st; };
DI XcdBarrier xcd_barrier_post(unsigned* bar, volatile LAS unsigned* st) {
    XcdBarrier b; b.bar = bar; b.x = xb_xcc_id(); b.st = st;
    if (threadIdx.x == 0) (void)xb_add(&bar[XB_XCNT(b.x)], 1u);
    return b;
}
DI void xcd_barrier_complete(unsigned* bar, unsigned x, unsigned& nloc, unsigned& nx) {
    const unsigned G = gridDim.x * gridDim.y * gridDim.z;
    unsigned sum, cnt, mine, sp = 0u;
    for (;;) {
        sum = 0u; cnt = 0u; mine = 0u;
#pragma unroll
        for (unsigned j = 0; j < 16; ++j) { const unsigned c = xb_ld(&bar[XB_XCNT(j)]); sum += c; cnt += (c > 0u) ? 1u : 0u; mine = (j == x) ? c : mine; }
        if (sum == G) break;
        __builtin_amdgcn_s_sleep(1);
        if ((++sp & 255u) == 0u) { if (xb_ld(&bar[XB_TMO])) break; if (sp > XB_SPIN_CAP) { atomicAdd(&bar[XB_TMO], 1u); break; } }
    }
    nloc = mine > 0u ? mine : 1u; nx = cnt > 0u ? cnt : 1u;
}
DI void xcd_barrier(const XcdBarrier& b) {
    asm volatile("s_waitcnt vmcnt(0)" ::: "memory");
    __syncthreads();
    int t0_ = threadIdx.x; asm volatile("" : "+v"(t0_));
    if (t0_ == 0) {
        unsigned* bar; { CArgs* p_ = (CArgs*)__builtin_amdgcn_kernarg_segment_ptr(); asm volatile("" : "+s"(p_)); bar = (unsigned*)(p_->ws + WS_CTL) + 4096; }
        __builtin_amdgcn_s_waitcnt(0);
        unsigned nloc = b.st[0], nx = b.st[1];
        unsigned bx = b.x; asm volatile("" : "+s"(bx));
        if (nloc == 0u) { xcd_barrier_complete(bar, bx, nloc, nx); b.st[0] = nloc; b.st[1] = nx; }
        const unsigned old = xb_add(&bar[XB_XSUB(bx)], 1u);
        const unsigned gen = old / nloc;
        if (old + 1u == (gen + 1u) * nloc) {
            __builtin_amdgcn_fence(__ATOMIC_RELEASE, "agent");
            asm volatile("s_waitcnt vmcnt(0)" ::: "memory");
            const unsigned og = xb_add(&bar[XB_TOP], 1u);
            const unsigned tg = og / nx;
            if (og + 1u == (tg + 1u) * nx) xb_add(&bar[XB_TOPGEN], 1u);
            else XB_SPIN(xb_ld(&bar[XB_TOPGEN]) == tg, bar);
            __builtin_amdgcn_fence(__ATOMIC_ACQUIRE, "agent");
            xb_add(&bar[XB_XGEN(bx)], 1u);
            asm volatile("s_waitcnt vmcnt(0)" ::: "memory");
        } else {
            XB_SPIN(xb_ld(&bar[XB_XGEN(bx)]) == gen, bar);
            __builtin_amdgcn_fence(__ATOMIC_ACQUIRE, "agent");
            asm volatile("s_waitcnt vmcnt(0)" ::: "memory");
        }
    }
    __syncthreads();
}

struct Ctx {
    LAS unsigned char* lds; int tid, lane, wave, G, bid; unsigned char* ws; int var; unsigned pr_acc; unsigned long long pr_t; CArgs* a;
};
#define RELAUNDER(c) do { int t_ = threadIdx.x; asm volatile("" : "+v"(t_)); (c).tid = t_; (c).lane = t_ & 63; int b_ = blockIdx.x, g_ = gridDim.x; asm volatile("" : "+s"(b_), "+s"(g_)); (c).bid = b_; (c).G = g_; } while (0)

struct TrRegs { f32x4 tv[8]; };
constexpr int TRS = 544;
DI void transpose_load(TrRegs& r, const float* W, int ld, int N, int item, int nblk, int wave, int lane) {
    const int k0 = 64 * (item / nblk) + 8 * wave, n = 256 * (item % nblk) + 4 * lane;
#pragma unroll
    for (int i = 0; i < 8; ++i) { r.tv[i] = (f32x4){0.f, 0.f, 0.f, 0.f}; if (n < N) r.tv[i] = *(const f32x4*)(W + (size_t)(k0 + i) * ld + n); }
}
DI void transpose_finish(const TrRegs& r, int K, int Npad, bf16_t* WT, const float* kscale, LAS char* img, int item, int nblk, int wave, int lane) {
    const int k0 = 64 * (item / nblk), n0 = 256 * (item % nblk);
#pragma unroll
    for (int i = 0; i < 8; ++i) { f32x4 v = r.tv[i]; if (kscale) v = v * kscale[k0 + 8 * wave + i];
        u32x2 w; w.x = pk2(v.x, v.y); w.y = pk2(v.z, v.w); *(LAS u32x2*)(img + (8 * wave + i) * TRS + lane * 8) = w; }
    __syncthreads();
    const int g = lane >> 4, i16 = lane & 15, q = i16 >> 2, p = i16 & 3;
#pragma unroll
    for (int j = 0; j < 4; ++j) { const int kc = 4 * (j & 1) + g, nb = 2 * wave + (j >> 1);
        const LAS char* rb = img + (8 * kc + q) * TRS + (16 * nb + 4 * p) * 2;
        const s16x4 lo = vtr(rb), hi = vtr(rb + 4 * TRS);
        const int nn = n0 + 16 * nb + i16;
        if (nn < Npad) *(bf16x8*)(WT + (size_t)nn * K + k0 + 8 * kc) = __builtin_shufflevector(lo, hi, 0, 1, 2, 3, 4, 5, 6, 7); }
    __syncthreads();
}
struct MatDesc { const float* src; int ld, K, N, Npad; bf16_t* dst; const float* kscale; };
DI MatDesc get_mat(CArgs& a, unsigned char* ws, int idx) {
    MatDesc m; m.kscale = nullptr;
    if (idx < 16) { const int j = idx >> 3, t = idx & 7; unsigned char* base = ws + WS_WEVEN + j * W_EVEN;
        if (t == 0) { m.src = a.in[9] + (size_t)j * D * HYIN; m.ld = HYIN; m.K = D; m.N = HYIN; m.Npad = UW; m.dst = (bf16_t*)(base + WE_IN); }
        else if (t == 1) { m.src = a.in[10] + (size_t)j * D * D; m.ld = D; m.K = D; m.N = D; m.Npad = D; m.dst = (bf16_t*)(base + WE_OUT); }
        else if (t == 2) { m.src = a.in[12] + (size_t)j * 256 * 768; m.ld = 768; m.K = 256; m.N = 768; m.Npad = 768; m.dst = (bf16_t*)(base + WE_UP); m.kscale = a.in[11] + j * 256; }
        else if (t == 3) { m.src = a.in[14] + (size_t)j * 256 * 1024; m.ld = 1024; m.K = 256; m.N = 1024; m.Npad = 1024; m.dst = (bf16_t*)(base + WE_UP) + 768 * 256; m.kscale = a.in[13] + j * 256; }
        else if (t < 6) { const int jj = t - 4; m.src = a.in[20] + ((size_t)j * 2 + jj) * 2048 * 128; m.ld = 128; m.K = 2048; m.N = 128; m.Npad = 128; m.dst = (bf16_t*)(base + WE_C1) + (size_t)jj * 128 * 2048; }
        else { const int jj = t - 6; m.src = a.in[21] + ((size_t)j * 2 + jj) * 128 * 64; m.ld = 64; m.K = 128; m.N = 64; m.Npad = 64; m.dst = (bf16_t*)(base + WE_C2) + (size_t)jj * 64 * 128; }
    } else if (idx < 20) { const int j = (idx - 16) >> 1, t = idx & 1; unsigned char* base = ws + WS_WODD + j * W_ODD;
        if (t == 0) { m.src = a.in[22] + (size_t)j * D * 3072; m.ld = 3072; m.K = D; m.N = 3072; m.Npad = 3072; m.dst = (bf16_t*)(base + WO_QKV); }
        else { m.src = a.in[23] + (size_t)j * D * D; m.ld = D; m.K = D; m.N = D; m.Npad = D; m.dst = (bf16_t*)(base + WO_O); }
    } else { const int i = (idx - 20) >> 1, t = idx & 1; unsigned char* base = ws + WS_WMLP + i * W_MLP;
        if (t == 0) { m.src = a.in[7] + (size_t)i * D * FF; m.ld = FF; m.K = D; m.N = FF; m.Npad = FF; m.dst = (bf16_t*)base; }
        else { m.src = a.in[8] + (size_t)i * FF * D; m.ld = D; m.K = FF; m.N = D; m.Npad = D; m.dst = (bf16_t*)(base + 8 * MiB); }
    }
    return m;
}
DI void convert_mats(Ctx& c, int lo, int hi) {
    CArgs& a = *c.a; unsigned char* ws = c.ws; LAS char* img = (LAS char*)c.lds;
    int base = 0;
    for (int mi = lo; mi < hi; ++mi) {
        const MatDesc m = get_mat(a, ws, mi); const int nblk = (m.Npad + 255) / 256, nit = (m.K / 64) * nblk;
        for (int it = (c.bid + c.G - (base % c.G)) % c.G; it < nit; it += 2 * c.G) {
            TrRegs ra, rb2; const int it2 = it + c.G; transpose_load(ra, m.src, m.ld, m.N, it, nblk, c.wave, c.lane); if (it2 < nit) transpose_load(rb2, m.src, m.ld, m.N, it2, nblk, c.wave, c.lane);
            transpose_finish(ra, m.K, m.Npad, m.dst, m.kscale, img, it, nblk, c.wave, c.lane); if (it2 < nit) transpose_finish(rb2, m.K, m.Npad, m.dst, m.kscale, img, it2, nblk, c.wave, c.lane); }
        base += nit;
    }
}
DI void phase_prologue(Ctx& c) {
    CArgs& a = *c.a; unsigned char* ws = c.ws;
    const int gw = c.bid * NW + c.wave, NGW = c.G * NW;
    LAS float* cond = (LAS float*)(c.lds + 98304);
    for (int i = c.tid; i < 8192; i += NT) { float v = a.in[1][i]; cond[i] = v / (1.f + __expf(-v)); }
    __syncthreads();
    float* mod = (float*)(ws + WS_MOD);
    LAS float* red = (LAS float*)c.lds;
    REP(18) for (int it = c.bid; it < 384; it += c.G) {
        const int n = it * 64 + c.lane; const int li = n / 6144, nn = n % 6144;
        const float* w = a.in[3] + (size_t)li * D * 6144 + (size_t)(c.wave * 128) * 6144 + nn; float acc[8] = {0, 0, 0, 0, 0, 0, 0, 0};
#pragma unroll 32
        for (int k = 0; k < 128; ++k) { const float wv = w[(size_t)k * 6144];
#pragma unroll
            for (int b = 0; b < 8; ++b) acc[b] += cond[b * D + c.wave * 128 + k] * wv; }
#pragma unroll
        for (int b = 0; b < 8; ++b) red[(c.wave * 8 + b) * 64 + c.lane] = acc[b];
        __syncthreads();
        { const int b = c.wave; float s = 0.f;
#pragma unroll
          for (int ww = 0; ww < 8; ++ww) s += red[(ww * 8 + b) * 64 + c.lane];
          mod[((size_t)li * 8 + b) * 6144 + nn] = s + a.in[4][li * 6144 + nn]; }
        __syncthreads();
    }
    { float* P = (float*)(ws + WS_MISC);
      for (int it = gw; it < 256; it += NGW) { const int jj2 = it >> 6, kc = (it >> 1) & 31, n = (it & 1) * 64 + c.lane;
          const float* cp = a.in[19] + (size_t)jj2 * 2048 + kc * 64; const float* w = a.in[20] + (size_t)jj2 * 2048 * 128 + (size_t)(kc * 64) * 128 + n; float acc = 0.f;
#pragma unroll 16
          for (int k = 0; k < 64; ++k) acc += cp[k] * w[(size_t)k * 128];
          P[(jj2 * 32 + kc) * 128 + n] = acc; } }
    REP(16) convert_mats(c, 0, FX_PRO_MATS);
    { float* cs8 = (float*)(ws + WS_CS8); float* cs16 = (float*)(ws + WS_CS16);
      REP(17) for (int g = c.bid * NT + c.tid; g < T * 24; g += c.G * NT) { const int m = g / 24, i = g % 24; const double p = (double)a.pos[m];
          if (i < 8) { const double f = pow(500000.0, -(double)i / 8.0), an = p * f; cs8[(m * 8 + i) * 2] = (float)cos(an); cs8[(m * 8 + i) * 2 + 1] = (float)sin(an); }
          else { const int k = i - 8; const double f = pow(500000.0, -(double)k / 16.0), an = p * f; cs16[(m * 16 + k) * 2] = (float)cos(an); cs16[(m * 16 + k) * 2 + 1] = (float)sin(an); } } }
}

DI void shw_items(Ctx& c, int set) {
    unsigned char* ws = c.ws; const int lane = c.lane, r16 = lane & 15, q4 = lane >> 4;
    LAS bf16_t* shl = (LAS bf16_t*)c.lds;
    for (int it = c.bid; it < 96; it += c.G) {
        int g, r = it;
        if (set == 0) { if (r < 32) g = 1; else if ((r -= 32) < 24) g = 2; else if ((r -= 24) < 16) g = 4; else { r -= 16; g = 6; } }
        else { g = 3 + 2 * (r >> 5); r &= 31; }
        const int layer = g >> 1, sub = g & 1;
        const bf16_t* Wt = sub ? (const bf16_t*)(ws + WS_WMLP + (size_t)layer * W_MLP) : ((layer & 1) ? (const bf16_t*)(ws + WS_WODD + (size_t)(layer >> 1) * W_ODD + WO_QKV) : (const bf16_t*)(ws + WS_WEVEN + (size_t)(layer >> 1) * W_EVEN + WE_IN));
        const float* sh = (const float*)(ws + WS_MOD) + (size_t)layer * 8 * 6144 + (sub ? 3072 : 0);
        __syncthreads();
        { const int b = c.tid >> 6, k0 = (c.tid & 63) * 16; const float* sp = sh + (size_t)b * 6144 + k0;
          const f32x4 a0 = *(const f32x4*)sp, a1 = *(const f32x4*)(sp + 4), a2 = *(const f32x4*)(sp + 8), a3 = *(const f32x4*)(sp + 12);
          u32x4 w0, w1; w0.x = pk2(a0.x, a0.y); w0.y = pk2(a0.z, a0.w); w0.z = pk2(a1.x, a1.y); w0.w = pk2(a1.z, a1.w); w1.x = pk2(a2.x, a2.y); w1.y = pk2(a2.z, a2.w); w1.z = pk2(a3.x, a3.y); w1.w = pk2(a3.z, a3.w);
          *(LAS u32x4*)(shl + b * 1032 + k0) = w0; *(LAS u32x4*)(shl + b * 1032 + k0 + 8) = w1; }
        __syncthreads();
        const int row0 = r * 128 + c.wave * 16;
        const bf16_t* wr = Wt + (size_t)(row0 + r16) * D + 8 * q4;
        const LAS bf16_t* bp = shl + (r16 & 7) * 1032 + 8 * q4;
        f32x4 acc = (f32x4){0.f, 0.f, 0.f, 0.f};
#pragma unroll 1
        for (int k0 = 0; k0 < 32; k0 += 16) {
            bf16x8 af[16];
#pragma unroll
            for (int i = 0; i < 16; ++i) af[i] = *(const bf16x8*)(wr + 32 * (k0 + i));
#pragma unroll
            for (int i = 0; i < 16; ++i) { bf16x8 bfr = *(const LAS bf16x8*)(bp + 32 * (k0 + i)); if (r16 >= 8) bfr = (bf16x8){0, 0, 0, 0, 0, 0, 0, 0};
                acc = __builtin_amdgcn_mfma_f32_16x16x32_bf16(af[i], bfr, acc, 0, 0, 0); }
        }
        if (r16 < 8) { float* o = (float*)(ws + WS_SHW) + (size_t)g * 8 * 4096 + (size_t)r16 * 4096 + row0 + q4 * 4; *(f32x4*)o = acc; }
    }
    __syncthreads();
}
DI void phase_modnorm(Ctx& c, const float* x, const float* gain, const float* sh, const float* sc, bf16_t* XN) {
    const int gw = c.bid * NW + c.wave, NGW = c.G * NW; constexpr int RB = 8;
    for (int m0 = gw; m0 < T; m0 += NGW * RB) {
        f32x4 v[RB][4]; float rs[RB];
#pragma unroll
        for (int t = 0; t < RB; ++t) { const int m = m0 + t * NGW; const f32x4* xr = (const f32x4*)(x + (size_t)(m < T ? m : 0) * D) + c.lane;
#pragma unroll
            for (int j = 0; j < 4; ++j) v[t][j] = xr[64 * j]; }
#pragma unroll
        for (int t = 0; t < RB; ++t) { float s = 0.f;
#pragma unroll
            for (int j = 0; j < 4; ++j) s += (v[t][j].x * v[t][j].x + v[t][j].y * v[t][j].y) + (v[t][j].z * v[t][j].z + v[t][j].w * v[t][j].w);
            rs[t] = s; }
#pragma unroll
        for (int t = 0; t < RB; ++t) rs[t] = rsqrtf(wave_sum(rs[t]) * (1.f / D) + EPS);
#pragma unroll
        for (int t = 0; t < RB; ++t) { const int m = m0 + t * NGW; if (m >= T) continue; const int b = m >> 11;
#pragma unroll
            for (int j = 0; j < 4; ++j) { const int n = 4 * c.lane + 256 * j; const f32x4 g = *(const f32x4*)(gain + n), sv = *(const f32x4*)(sc + b * 6144 + n), hv = *(const f32x4*)(sh + b * 6144 + n);
                f32x4 y; y.x = v[t][j].x * rs[t] * g.x * (1.f + sv.x) + hv.x; y.y = v[t][j].y * rs[t] * g.y * (1.f + sv.y) + hv.y; y.z = v[t][j].z * rs[t] * g.z * (1.f + sv.z) + hv.z; y.w = v[t][j].w * rs[t] * g.w * (1.f + sv.w) + hv.w;
                u32x2 o; o.x = pk2(y.x, y.y); o.y = pk2(y.z, y.w); *(u32x2*)(XN + (size_t)m * D + n) = o; } }
    }
}
constexpr int TB = 8;
constexpr int TBV = 4;
template <int TBV> DI void head64_vec(bf16_t* const (&p)[TBV], bool act, const float* gain, const float* const (&tab)[TBV], float scale, int lane) {
    const int sub = lane & 7; float x[TBV][8], ss[TBV];
#pragma unroll
    for (int t = 0; t < TBV; ++t) { u32x4 v = (u32x4){0u, 0u, 0u, 0u}; if (act) v = *(const u32x4*)p[t];
        x[t][0] = bflo(v.x); x[t][1] = bfhi(v.x); x[t][2] = bflo(v.y); x[t][3] = bfhi(v.y); x[t][4] = bflo(v.z); x[t][5] = bfhi(v.z); x[t][6] = bflo(v.w); x[t][7] = bfhi(v.w); }
#pragma unroll
    for (int t = 0; t < TBV; ++t) { float s = 0.f;
#pragma unroll
        for (int e = 0; e < 8; ++e) s += x[t][e] * x[t][e];
        ss[t] = s; }
#pragma unroll
    for (int t = 0; t < TBV; ++t) ss[t] += swz<1>(ss[t]);
#pragma unroll
    for (int t = 0; t < TBV; ++t) ss[t] += swz<2>(ss[t]);
#pragma unroll
    for (int t = 0; t < TBV; ++t) ss[t] += swz<4>(ss[t]);
    const f32x4 ga = *(const f32x4*)(gain + 8 * sub), gb = *(const f32x4*)(gain + 8 * sub + 4);
    const float g[8] = {ga.x, ga.y, ga.z, ga.w, gb.x, gb.y, gb.z, gb.w};
#pragma unroll
    for (int t = 0; t < TBV; ++t) { const float rs = rsqrtf(ss[t] * (1.f / 64.f) + EPS);
        float y[8], o[8];
#pragma unroll
        for (int e = 0; e < 8; ++e) { y[e] = x[t][e] * rs * g[e]; o[e] = swz<1>(y[e]); }
        if (sub < 2) {
            const f32x4 t0 = *(const f32x4*)(tab[t]), t1 = *(const f32x4*)(tab[t] + 4), t2 = *(const f32x4*)(tab[t] + 8), t3 = *(const f32x4*)(tab[t] + 12);
            const float cs[8] = {t0.x, t0.z, t1.x, t1.z, t2.x, t2.z, t3.x, t3.z}, sn[8] = {t0.y, t0.w, t1.y, t1.w, t2.y, t2.w, t3.y, t3.w};
#pragma unroll
            for (int e = 0; e < 8; ++e) y[e] = sub == 0 ? y[e] * cs[e] - o[e] * sn[e] : o[e] * sn[e] + y[e] * cs[e];
        }
        u32x4 w; w.x = pk2(y[0] * scale, y[1] * scale); w.y = pk2(y[2] * scale, y[3] * scale); w.z = pk2(y[4] * scale, y[5] * scale); w.w = pk2(y[6] * scale, y[7] * scale);
        if (act) *(u32x4*)p[t] = w; }
}
DI void nsa_finalize_rows(Ctx& c, bf16_t* U, int m0, int mstride, int j) {
    CArgs& a = *c.a; const float* qg = a.in[17] + j * 64; const float* kg = a.in[18] + j * 192; const int lane = c.lane; constexpr int RB = 8;
    bf16_t* p[RB]; const float* tab[RB];
#pragma unroll
    for (int t = 0; t < RB; ++t) { const int m = m0 + t * mstride; p[t] = U + (size_t)m * UW + 544 + 8 * lane; tab[t] = (const float*)(c.ws + WS_CS8) + (size_t)m * 16; }
    head64_vec<RB>(p, true, qg, tab, 0.125f * LOG2E, lane);
#pragma unroll
    for (int t = 0; t < RB; ++t) { const int m = m0 + t * mstride; p[t] = U + (size_t)m * UW + (lane < 16 ? 1312 + 8 * lane : 1568 + 8 * (lane & 15)); }
    head64_vec<RB>(p, lane < 32, lane < 16 ? kg + 64 : kg + 128, tab, 1.f, lane);
}
DI void diff_finalize_rows(Ctx& c, bf16_t* QKV, int m0, int mstride, int j) {
    CArgs& a = *c.a; const float* qg = a.in[24] + j * 64; const float* kg = a.in[25] + j * 64; const int lane = c.lane;
    bf16_t* p[TBV]; const float* tab[TBV];
#pragma unroll 1
    for (int ch = 0; ch < 4; ++ch) {
#pragma unroll
        for (int t = 0; t < TBV; ++t) { const int m = m0 + t * mstride; p[t] = QKV + (size_t)m * 3072 + 512 * ch + 8 * lane; tab[t] = (const float*)(c.ws + WS_CS8) + (size_t)m * 16; }
        head64_vec<TBV>(p, true, ch < 2 ? qg : kg, tab, ch < 2 ? 0.125f * LOG2E : 1.f, lane);
    }
}
DI void diff_finalize_tile(Ctx& c, bf16_t* QKV, int pm, int pn, int j) {
    CArgs& a = *c.a; const int lane = c.lane; const bool isq = pn < 4; constexpr int RB = 8;
    const float* g = isq ? a.in[24] + j * 64 : a.in[25] + j * 64; const float sc = isq ? 0.125f * LOG2E : 1.f;
    bf16_t* p[RB]; const float* tab[RB];
#pragma unroll 1
    for (int r0 = 0; r0 < 256; r0 += 16 * RB) {
#pragma unroll
        for (int t = 0; t < RB; ++t) { const int m = pm * 256 + r0 + t * 16 + 2 * c.wave + (lane >> 5); p[t] = QKV + (size_t)m * 3072 + pn * 256 + 8 * (lane & 31); tab[t] = (const float*)(c.ws + WS_CS8) + (size_t)m * 16; }
        head64_vec<RB>(p, true, g, tab, sc, lane);
    }
}
DI void unpack8(const u32x4 v, float (&x)[8]) { x[0] = bflo(v.x); x[1] = bfhi(v.x); x[2] = bflo(v.y); x[3] = bfhi(v.y); x[4] = bflo(v.z); x[5] = bfhi(v.z); x[6] = bflo(v.w); x[7] = bfhi(v.w); }
DI float sumsq8(const float (&x)[8]) { return ((x[0] * x[0] + x[1] * x[1]) + (x[2] * x[2] + x[3] * x[3])) + ((x[4] * x[4] + x[5] * x[5]) + (x[6] * x[6] + x[7] * x[7])); }
DI u32x4 mla_chunk(const float (&x)[8], float ss, const float* g96, const float* tab, int ci, float scale) {
    const float rs = rsqrtf(ss * (1.f / 96.f) + EPS);
    const f32x4 ga = *(const f32x4*)(g96 + 8 * ci), gb = *(const f32x4*)(g96 + 8 * ci + 4);
    float y[8] = {x[0] * rs * ga.x, x[1] * rs * ga.y, x[2] * rs * ga.z, x[3] * rs * ga.w, x[4] * rs * gb.x, x[5] * rs * gb.y, x[6] * rs * gb.z, x[7] * rs * gb.w};
    float o[8];
#pragma unroll
    for (int e = 0; e < 8; ++e) o[e] = swz<2>(y[e]);
    if (ci < 4) { const float* tp = tab + 16 * (ci & 1);
        const f32x4 t0 = *(const f32x4*)tp, t1 = *(const f32x4*)(tp + 4), t2 = *(const f32x4*)(tp + 8), t3 = *(const f32x4*)(tp + 12);
        const float cs[8] = {t0.x, t0.z, t1.x, t1.z, t2.x, t2.z, t3.x, t3.z}, sn[8] = {t0.y, t0.w, t1.y, t1.w, t2.y, t2.w, t3.y, t3.w};
#pragma unroll
        for (int e = 0; e < 8; ++e) y[e] = ci < 2 ? y[e] * cs[e] - o[e] * sn[e] : o[e] * sn[e] + y[e] * cs[e]; }
    u32x4 w; w.x = pk2(y[0] * scale, y[1] * scale); w.y = pk2(y[2] * scale, y[3] * scale); w.z = pk2(y[4] * scale, y[5] * scale); w.w = pk2(y[6] * scale, y[7] * scale);
    return w;
}
DI float head_ss(const LAS float* tbl, int h) { const f32x4 a = *(const LAS f32x4*)(tbl + 12 * h), b = *(const LAS f32x4*)(tbl + 12 * h + 4), cc = *(const LAS f32x4*)(tbl + 12 * h + 8); return ((a.x + a.y) + (a.z + a.w)) + ((b.x + b.y) + (b.z + b.w)) + ((cc.x + cc.y) + (cc.z + cc.w)); }
DI void mla_finalize_rows(Ctx& c, const bf16_t* U, bf16_t* QL, bf16_t* KVU, bf16_t* KF, int m0, int mstride, int j) {
    CArgs& a = *c.a; const int lane = c.lane;
    const float* qg = a.in[15] + j * 96; const float* kg = a.in[16] + j * 96;
    LAS float* tbl = (LAS float*)(c.lds + c.wave * 4096);
    const int cA = lane, hA = cA / 12, ciA = cA % 12, cB = 64 + (lane & 31), hB = cB / 12, ciB = cB % 12; const bool actB = lane < 32;
    const float qscale = 0.10206207261596577f * LOG2E;
    float xqA[TBV][8], xqB[TBV][8], xkA[TBV][8], xkB[TBV][8], rskv[TBV]; int mrow[TBV];
#pragma unroll
    for (int t = 0; t < TBV; ++t) { const int m = m0 + t * mstride; mrow[t] = m; const bf16_t* urow = U + (size_t)m * UW;
        float lx[8]; unpack8(*(const u32x4*)(urow + 8 * lane), lx); float sl = sumsq8(lx);
        sl += swz<1>(sl); sl += swz<2>(sl); sl += swz<4>(sl); sl += swz<8>(sl); sl += swz<16>(sl);
        const float rsq = rsqrtf(__builtin_bit_cast(float, __builtin_amdgcn_readlane(__builtin_bit_cast(int, sl), 0)) * (1.f / 256.f) + EPS);
        rskv[t] = rsqrtf(__builtin_bit_cast(float, __builtin_amdgcn_readlane(__builtin_bit_cast(int, sl), 32)) * (1.f / 256.f) + EPS);
        { const bf16_t* q = QL + (size_t)m * UPW; unpack8(*(const u32x4*)(q + 8 * cA), xqA[t]); u32x4 vb = (u32x4){0u, 0u, 0u, 0u}; if (actB) vb = *(const u32x4*)(q + 8 * cB); unpack8(vb, xqB[t]);
#pragma unroll
          for (int e = 0; e < 8; ++e) { xqA[t][e] *= rsq; xqB[t][e] *= rsq; }
          tbl[t * 192 + cA] = sumsq8(xqA[t]); if (actB) tbl[t * 192 + cB] = sumsq8(xqB[t]); }
        { const bf16_t* kn = KVU + (size_t)m * UPW;
          unpack8(*(const u32x4*)(ciA < 4 ? urow + 512 + 8 * ciA : kn + 128 * hA + 8 * (ciA - 4)), xkA[t]);
          u32x4 vb = (u32x4){0u, 0u, 0u, 0u}; if (actB) vb = *(const u32x4*)(ciB < 4 ? urow + 512 + 8 * ciB : kn + 128 * hB + 8 * (ciB - 4)); unpack8(vb, xkB[t]);
          const float fa = ciA < 4 ? 1.f : rskv[t], fb = ciB < 4 ? 1.f : rskv[t];
#pragma unroll
          for (int e = 0; e < 8; ++e) { xkA[t][e] *= fa; xkB[t][e] *= fb; }
          tbl[t * 192 + 96 + cA] = sumsq8(xkA[t]); if (actB) tbl[t * 192 + 96 + cB] = sumsq8(xkB[t]); }
    }
#pragma unroll
    for (int t = 0; t < TBV; ++t) { const int m = mrow[t]; const float* tab = (const float*)(c.ws + WS_CS16) + (size_t)m * 32;
        { bf16_t* q = QL + (size_t)m * UPW;
          const u32x4 wA = mla_chunk(xqA[t], head_ss(tbl + t * 192, hA), qg, tab, ciA, qscale); const u32x4 wB = mla_chunk(xqB[t], head_ss(tbl + t * 192, hB), qg, tab, ciB, qscale);
          *(u32x4*)(q + 8 * cA) = wA; if (actB) *(u32x4*)(q + 8 * cB) = wB; }
        { bf16_t* k = KF + (size_t)m * 768;
          const u32x4 wA = mla_chunk(xkA[t], head_ss(tbl + t * 192 + 96, hA), kg, tab, ciA, 1.f); const u32x4 wB = mla_chunk(xkB[t], head_ss(tbl + t * 192 + 96, hB), kg, tab, ciB, 1.f);
          *(u32x4*)(k + 8 * cA) = wA; if (actB) *(u32x4*)(k + 8 * cB) = wB; }
        { bf16_t* v = KVU + (size_t)m * UPW + 128 * (lane >> 3) + 64 + 8 * (lane & 7); float xv[8]; unpack8(*(const u32x4*)v, xv); const float f = rskv[t];
          u32x4 w; w.x = pk2(xv[0] * f, xv[1] * f); w.y = pk2(xv[2] * f, xv[3] * f); w.z = pk2(xv[4] * f, xv[5] * f); w.w = pk2(xv[6] * f, xv[7] * f); *(u32x4*)v = w; }
    }
}

DI float gelu_tanh(float x) { const float u = 0.7978845608028654f * (x + 0.044715f * x * x * x); const float e = __expf(2.f * u); const float t = 1.f - 2.f / (e + 1.f); return 0.5f * x * (1.f + t); }
DI void compress_item(Ctx& c, const bf16_t* U, int j, int it) {
    RELAUNDER(c);
    CArgs& a = *c.a; const int lane = c.lane, w = c.wave, tid = c.tid;
    const int jj = it >> 7, bg = (it >> 3) & 15, chunk = it & 7, b = bg >> 1, g = bg & 1, c0 = 16 * chunk;
    const bf16_t* W1t = (const bf16_t*)(c.ws + WS_WEVEN + j * W_EVEN + WE_C1) + (size_t)jj * 128 * 2048;
    const bf16_t* W2t = (const bf16_t*)(c.ws + WS_WEVEN + j * W_EVEN + WE_C2) + (size_t)jj * 64 * 128;
    const float* biasP = (const float*)(c.ws + WS_MISC) + (size_t)(j * 2 + jj) * 32 * 128;
    LAS float* part = (LAS float*)c.lds;
    LAS bf16_t* hid = (LAS bf16_t*)(c.lds + 65536);
    LAS float* outl = (LAS float*)(c.lds + 65536 + 8192);
    const int r16 = lane & 15, q4 = lane >> 4;
    f32x4 acc[8];
#pragma unroll
    for (int n = 0; n < 8; ++n) acc[n] = (f32x4){0.f, 0.f, 0.f, 0.f};
    const bf16_t* arow = U + ((size_t)b * S + 16 * (c0 + r16)) * UW + 1056 + jj * 128 + g * 64 + q4 * 8;
#pragma unroll 2
    for (int ks = 8 * w; ks < 8 * w + 8; ++ks) {
        const bf16x8 af = *(const bf16x8*)(arow + (size_t)(ks >> 1) * UW + (ks & 1) * 32);
#pragma unroll
        for (int n = 0; n < 8; ++n) { const bf16x8 bfr = *(const bf16x8*)(W1t + (size_t)(n * 16 + r16) * 2048 + 32 * ks + q4 * 8);
            acc[n] = __builtin_amdgcn_mfma_f32_16x16x32_bf16(af, bfr, acc[n], 0, 0, 0); }
    }
#pragma unroll
    for (int n = 0; n < 8; ++n)
#pragma unroll
        for (int i = 0; i < 4; ++i) part[(w * 16 + q4 * 4 + i) * 128 + n * 16 + r16] = acc[n][i];
    __syncthreads();
    { const int cc = tid >> 5, n0 = (tid & 31) * 4; float v[4];
#pragma unroll
      for (int e = 0; e < 4; ++e) { float s = 0.f;
#pragma unroll
          for (int ww = 0; ww < 8; ++ww) s += part[(ww * 16 + cc) * 128 + n0 + e];
          v[e] = s; }
      { f32x4 bs = (f32x4){0.f, 0.f, 0.f, 0.f};
#pragma unroll 8
        for (int kc = 0; kc < 32; ++kc) bs += *(const f32x4*)(biasP + kc * 128 + n0);
        v[0] = gelu_tanh(v[0] + bs.x); v[1] = gelu_tanh(v[1] + bs.y); v[2] = gelu_tanh(v[2] + bs.z); v[3] = gelu_tanh(v[3] + bs.w); }
      u32x2 o; o.x = pk2(v[0], v[1]); o.y = pk2(v[2], v[3]); *(LAS u32x2*)(hid + cc * 136 + n0) = o; }
    __syncthreads();
    if (w < 4) {
        f32x4 a2 = (f32x4){0.f, 0.f, 0.f, 0.f};
#pragma unroll
        for (int kst = 0; kst < 4; ++kst) { const bf16x8 af = *(const LAS bf16x8*)(hid + r16 * 136 + 32 * kst + q4 * 8);
            const bf16x8 bfr = *(const bf16x8*)(W2t + (size_t)(w * 16 + r16) * 128 + 32 * kst + q4 * 8);
            a2 = __builtin_amdgcn_mfma_f32_16x16x32_bf16(af, bfr, a2, 0, 0, 0); }
#pragma unroll
        for (int i = 0; i < 4; ++i) outl[(q4 * 4 + i) * 64 + w * 16 + r16] = a2[i];
    }
    __syncthreads();
    if (tid < 256) {
        const int cc = tid >> 4, d0 = (tid & 15) * 4; const int cg = c0 + cc;
        bf16_t* dst = (bf16_t*)(c.ws + WS_MISC + 65536 + (size_t)jj * 262144) + ((size_t)bg * 128 + cg) * 64 + d0;
        float v[4];
#pragma unroll
        for (int e = 0; e < 4; ++e) v[e] = outl[cc * 64 + d0 + e];
        if (jj == 0) {
            float s = (v[0] * v[0] + v[1] * v[1]) + (v[2] * v[2] + v[3] * v[3]);
            s += swz<1>(s); s += swz<2>(s); s += swz<4>(s); s += swz<8>(s);
            const float rs = rsqrtf(s * (1.f / 64.f) + EPS); const float* kg = a.in[18] + j * 192;
            int tok = b * S + 16 * cg + 31; if (tok >= T) tok = T - 1;
            const float* tab = (const float*)(c.ws + WS_CS8) + (size_t)tok * 16;
#pragma unroll
            for (int e = 0; e < 4; ++e) { const int d = d0 + e; float y = v[e] * rs * kg[d];
                if (d < 16) { const float o = outl[cc * 64 + (d ^ 8)] * rs * kg[d ^ 8]; const int i = d & 7; const float cs = tab[2 * i], sn = tab[2 * i + 1]; y = d < 8 ? y * cs - o * sn : o * sn + y * cs; }
                v[e] = y; }
        }
        if (cg == 127) { v[0] = v[1] = v[2] = v[3] = 0.f; }
        u32x2 o; o.x = pk2(v[0], v[1]); o.y = pk2(v[2], v[3]); *(u32x2*)dst = o;
    }
    __syncthreads();
}

DI void lds_add(LAS float* p, float v) { (void)__hip_atomic_fetch_add(p, v, __ATOMIC_RELAXED, __HIP_MEMORY_SCOPE_WORKGROUP); }
DI int crow(int r, int h) { return (r & 3) + 8 * (r >> 2) + 4 * h; }
DI unsigned cvtpk(float lo, float hi) { typedef float f2 __attribute__((ext_vector_type(2))); typedef __bf16 b2 __attribute__((ext_vector_type(2))); f2 v = {lo, hi}; b2 r = __builtin_convertvector(v, b2); return __builtin_bit_cast(unsigned, r); }
template <int DD> struct TileRegs { u32x4 r[(64 * DD / 8 + NT - 1) / NT]; };
template <int DD> DI void tile_load(TileRegs<DD>& t, const bf16_t* g, int ld, int tid) {
    constexpr int CPR = DD / 8, NCH = 64 * CPR, NI = (NCH + NT - 1) / NT;
#pragma unroll
    for (int i = 0; i < NI; ++i) { const int ch = tid + NT * i; if (NCH % NT == 0 || ch < NCH) { const int row = ch / CPR, c8 = ch % CPR; const unsigned eo = (unsigned)row * (unsigned)ld + (unsigned)c8 * 8u; t.r[i] = *(const u32x4*)(g + eo); } }
}
template <int DD> DI void tile_store(const TileRegs<DD>& t, LAS char* buf, int tid) {
    constexpr int CPR = DD / 8, NCH = 64 * CPR, NI = (NCH + NT - 1) / NT, STR = DD * 2 + 16;
#pragma unroll
    for (int i = 0; i < NI; ++i) { const int ch = tid + NT * i; if (NCH % NT == 0 || ch < NCH) { const int row = ch / CPR, c8 = ch % CPR; *(LAS u32x4*)(buf + row * STR + c8 * 16) = t.r[i]; } }
}
template <int DK> DI void qk_tile(const LAS char* Kb, const bf16x8* qf, f32x16& p0, f32x16& p1, int lane) {
    constexpr int KS = DK * 2 + 16, NG = DK / 32; const LAS char* kp = Kb + (lane & 31) * KS + (lane >> 5) * 16;
    bf16x8 kf[2][2][2];
#define QK_LOAD(G_, B_) do { _Pragma("unroll") for (int j_ = 0; j_ < 2; ++j_) { kf[B_][j_][0] = *(const LAS bf16x8*)(kp + (2 * (G_) + j_) * 32); kf[B_][j_][1] = *(const LAS bf16x8*)(kp + 32 * KS + (2 * (G_) + j_) * 32); } } while (0)
    constexpr bool DB = FX_QKDB || (DK > 64);
    QK_LOAD(0, 0);
#pragma unroll
    for (int r = 0; r < 16; ++r) { p0[r] = 0.f; p1[r] = 0.f; }
#pragma unroll
    for (int g = 0; g < NG; ++g) {
        const int bcur = DB ? (g & 1) : 0;
        if (DB && g + 1 < NG) { if ((g & 1) == 0) QK_LOAD(g + 1, 1); else QK_LOAD(g + 1, 0); }
        __builtin_amdgcn_sched_barrier(0);
        if (FX_PRIO) __builtin_amdgcn_s_setprio(1);
#pragma unroll
        for (int j = 0; j < 2; ++j) { p0 = __builtin_amdgcn_mfma_f32_32x32x16_bf16(kf[bcur][j][0], qf[2 * g + j], p0, 0, 0, 0); p1 = __builtin_amdgcn_mfma_f32_32x32x16_bf16(kf[bcur][j][1], qf[2 * g + j], p1, 0, 0, 0); }
        if (FX_PRIO) __builtin_amdgcn_s_setprio(0);
        __builtin_amdgcn_sched_barrier(0);
        if (!DB && g + 1 < NG) QK_LOAD(g + 1, 0);
    }
#undef QK_LOAD
}
template <int DV> DI void pv_tile(const LAS char* Vb, const f32x16& p0, const f32x16& p1, f32x16* o, int lane) {
    constexpr int VS = DV * 2 + 16;
    const int g = lane >> 4, h = lane >> 5, i16 = lane & 15, q = i16 >> 2, p = i16 & 3;
    const LAS char* base = Vb + (4 * h + q) * VS + (16 * (g & 1) + 4 * p) * 2;
    constexpr int NDB = DV / 32, GS = (DV == 64) ? 2 : 1;
    bf16x8 pf[4];
#pragma unroll
    for (int s = 0; s < 4; ++s) { u32x4 pw;
        if (s < 2) { pw.x = cvtpk(p0[8 * s], p0[8 * s + 1]); pw.y = cvtpk(p0[8 * s + 2], p0[8 * s + 3]); pw.z = cvtpk(p0[8 * s + 4], p0[8 * s + 5]); pw.w = cvtpk(p0[8 * s + 6], p0[8 * s + 7]); }
        else { const int s2 = s - 2; pw.x = cvtpk(p1[8 * s2], p1[8 * s2 + 1]); pw.y = cvtpk(p1[8 * s2 + 2], p1[8 * s2 + 3]); pw.z = cvtpk(p1[8 * s2 + 4], p1[8 * s2 + 5]); pw.w = cvtpk(p1[8 * s2 + 6], p1[8 * s2 + 7]); }
        pf[s] = __builtin_bit_cast(bf16x8, pw); }
#pragma unroll
    for (int s0 = 0; s0 < 4; s0 += GS) {
        s16x4 lo[GS][NDB], hi[GS][NDB];
#pragma unroll
        for (int s = 0; s < GS; ++s)
#pragma unroll
            for (int db = 0; db < NDB; ++db) { lo[s][db] = vtr(base + (16 * (s0 + s)) * VS + db * 64); hi[s][db] = vtr(base + (16 * (s0 + s) + 8) * VS + db * 64); }
        __builtin_amdgcn_sched_barrier(0);
#pragma unroll
        for (int s = 0; s < GS; ++s)
#pragma unroll
            for (int db = 0; db < NDB; ++db) o[db] = __builtin_amdgcn_mfma_f32_32x32x16_bf16(__builtin_shufflevector(lo[s][db], hi[s][db], 0, 1, 2, 3, 4, 5, 6, 7), pf[s0 + s], o[db], 0, 0, 0);
        __builtin_amdgcn_sched_barrier(0);
    }
}
DI float max3f(float a, float b, float c) { return __builtin_fmaxf(__builtin_fmaxf(a, b), c); }
DI float rowmax32(const f32x16& p0, const f32x16& p1) {
    float a = max3f(p0[0], p0[1], p0[2]), b = max3f(p0[3], p0[4], p0[5]), c = max3f(p1[0], p1[1], p1[2]), d = max3f(p1[3], p1[4], p1[5]);
    a = max3f(a, p0[6], p0[7]); b = max3f(b, p0[8], p0[9]); c = max3f(c, p1[6], p1[7]); d = max3f(d, p1[8], p1[9]);
    a = max3f(a, p0[10], p0[11]); b = max3f(b, p0[12], p0[13]); c = max3f(c, p1[10], p1[11]); d = max3f(d, p1[12], p1[13]);
    a = max3f(a, p0[14], p0[15]); c = max3f(c, p1[14], p1[15]);
    return max32(max3f(max3f(a, b, c), d, d));
}
template <int DV> DI void softmax_step(f32x16& p0, f32x16& p1, f32x16* o, float& m, float& l) {
    const float mx = rowmax32(p0, p1); const float mnew = fmaxf(m, mx); const float muse = (mnew == -INFINITY) ? 0.f : mnew;
    const float alpha = __builtin_amdgcn_exp2f(m - muse);
    float s = 0.f;
#pragma unroll
    for (int r = 0; r < 16; ++r) { p0[r] = __builtin_amdgcn_exp2f(p0[r] - muse); p1[r] = __builtin_amdgcn_exp2f(p1[r] - muse); s += p0[r] + p1[r]; }
    l = l * alpha + s; m = mnew;
#pragma unroll
    for (int db = 0; db < DV / 32; ++db)
#pragma unroll
        for (int r = 0; r < 16; ++r) o[db][r] *= alpha;
}
template <int DK> DI void load_qfrag(bf16x8* qf, const bf16_t* qrow  , int h) {
#pragma unroll
    for (int st = 0; st < DK / 16; ++st) qf[st] = *(const bf16x8*)(qrow + 16 * st + 8 * h);
}
template <int DK, int DV> struct SweepLds { static constexpr int KB = 64 * (DK * 2 + 16), VB = 64 * (DV * 2 + 16); };

template <int DV> DI void softmax_step_lazy(f32x16& p0, f32x16& p1, f32x16* o, float& m, float& l) {
    const float mx = rowmax32(p0, p1); const float mnew = fmaxf(m, mx); const float muse = (mnew == -INFINITY) ? 0.f : mnew;
    const float alpha = __builtin_amdgcn_exp2f(m - muse);
    float s0 = 0.f, s1 = 0.f, s2 = 0.f, s3 = 0.f;
#pragma unroll
    for (int r = 0; r < 16; ++r) { p0[r] = __builtin_amdgcn_exp2f(p0[r] - muse); p1[r] = __builtin_amdgcn_exp2f(p1[r] - muse); }
#pragma unroll
    for (int r = 0; r < 16; r += 2) { s0 += p0[r]; s1 += p0[r + 1]; s2 += p1[r]; s3 += p1[r + 1]; }
    l = l * alpha + ((s0 + s1) + (s2 + s3)); m = mnew;
    if (__builtin_amdgcn_ballot_w64(alpha != 1.f) != 0ull) {
#pragma unroll
        for (int db = 0; db < DV / 32; ++db)
#pragma unroll
            for (int r = 0; r < 16; ++r) o[db][r] *= alpha;
    }
}
template <int DK, int DV> struct SweepLds3 { static constexpr int KB = 64 * (DK * 2 + 16), VB = 64 * (DV * 2 + 16), TOTAL = 2 * KB + 3 * VB; };
template <int DK, int DV, bool late, class It, class F> DI void flash_sweep_impl(Ctx& c, const bf16x8* qf, const bf16_t* Kg, int ldk, const bf16_t* Vg, int ldv, It it, const F& f, f32x16* o, float& m, float& l) {
    typedef SweepLds3<DK, DV> L; LAS char* lds = (LAS char*)c.lds; const int lane = c.lane, tid = c.tid;
    TileRegs<DK> kA, kB; TileRegs<DV> vA, vB;
    int ta = it.next(); int tb = ta >= 0 ? it.next() : -1;
    if (ta < 0) return;
    tile_load<DK>(kA, Kg + (size_t)ta * 64 * ldk, ldk, tid); tile_load<DV>(vA, Vg + (size_t)ta * 64 * ldv, ldv, tid);
    if (tb >= 0) { tile_load<DK>(kB, Kg + (size_t)tb * 64 * ldk, ldk, tid); tile_load<DV>(vB, Vg + (size_t)tb * 64 * ldv, ldv, tid); }
    __syncthreads();
    tile_store<DK>(kA, lds, tid); tile_store<DV>(vA, lds + 2 * L::KB, tid);
    __syncthreads();
    int vprev = 2 * L::KB + 2 * L::VB, vcur = 2 * L::KB, vnext = 2 * L::KB + L::VB;
    f32x16 s0, s1; bool pend = false;
#pragma unroll
    for (int r = 0; r < 16; ++r) { s0[r] = 0.f; s1[r] = 0.f; }
#define FS_QK(P0_, P1_, KOFF_) do { if (c.var != 3) qk_tile<DK>(lds + (KOFF_), qf, P0_, P1_, lane); } while (0)
#define FS_SM(P0_, P1_) do { if (c.var != 2) softmax_step_lazy<DV>(P0_, P1_, o, m, l); } while (0)
#define FS_PV(VOFF_, P0_, P1_) do { if (c.var != 1) pv_tile<DV>(lds + (VOFF_), P0_, P1_, o, lane); } while (0)
#define FS_COMPUTE(T_, KOFF_) do { \
        if (!late) { if (!f.skip(T_)) { f32x16 p0, p1; if (c.var == 3) { p0 = s0; p1 = s1; } FS_QK(p0, p1, KOFF_); f.mask(p0, p1, T_); FS_SM(p0, p1); FS_PV(vcur, p0, p1); } } \
        else { if (pend) { FS_SM(s0, s1); FS_PV(vprev, s0, s1); pend = false; } \
               if (!f.skip(T_)) { FS_QK(s0, s1, KOFF_); f.mask(s0, s1, T_); pend = true; } } } while (0)
#define FS_ROTATE() do { const int t_ = vprev; vprev = vcur; vcur = vnext; vnext = t_; } while (0)
    for (;;) {
        const int tc = tb >= 0 ? it.next() : -1;
        if (tc >= 0) { tile_load<DK>(kA, Kg + (size_t)tc * 64 * ldk, ldk, tid); tile_load<DV>(vA, Vg + (size_t)tc * 64 * ldv, ldv, tid); }
        FS_COMPUTE(ta, 0);
        if (tb >= 0) { tile_store<DK>(kB, lds + L::KB, tid); tile_store<DV>(vB, lds + vnext, tid); }
        __syncthreads(); FS_ROTATE();
        if (tb < 0) break;
        const int td = tc >= 0 ? it.next() : -1;
        if (td >= 0) { tile_load<DK>(kB, Kg + (size_t)td * 64 * ldk, ldk, tid); tile_load<DV>(vB, Vg + (size_t)td * 64 * ldv, ldv, tid); }
        FS_COMPUTE(tb, L::KB);
        if (tc >= 0) { tile_store<DK>(kA, lds, tid); tile_store<DV>(vA, lds + vnext, tid); }
        __syncthreads(); FS_ROTATE();
        if (tc < 0) break;
        ta = tc; tb = td;
    }
    if (late && pend) { FS_SM(s0, s1); FS_PV(vprev, s0, s1); }
#undef FS_COMPUTE
#undef FS_ROTATE
#undef FS_QK
#undef FS_SM
#undef FS_PV
}
template <int DK, int DV, bool STG, class It, class F> DI void flash_sweep(Ctx& c, const bf16x8* qf, const bf16_t* Kg, int ldk, const bf16_t* Vg, int ldv, It it, const F& f, f32x16* o, float& m, float& l) {
#if FX_SWEEP2
    flash_sweep2<DK, DV>(c, qf, Kg, ldk, Vg, ldv, it, f, o, m, l); return;
#endif
    if (STG && FX_LATE(c.wave)) flash_sweep_impl<DK, DV, true>(c, qf, Kg, ldk, Vg, ldv, it, f, o, m, l);
    else flash_sweep_impl<DK, DV, false>(c, qf, Kg, ldk, Vg, ldv, it, f, o, m, l);
}
template <int DK, int DV, class It, class F> DI void flash_sweep2(Ctx& c, const bf16x8* qf, const bf16_t* Kg, int ldk, const bf16_t* Vg, int ldv, It it, const F& f, f32x16* o, float& m, float& l) {
    constexpr int KB = 64 * (DK * 2 + 16), VB = 64 * (DV * 2 + 16), VOFF = 4 * KB;
    LAS char* lds = (LAS char*)c.lds; const int lane = c.lane, tid = c.tid;
    TileRegs<DK> k0, k1; TileRegs<DV> v0, v1;
    int a = it.next(); if (a < 0) return; int b = it.next();
    tile_load<DK>(k0, Kg + (size_t)a * 64 * ldk, ldk, tid); tile_load<DV>(v0, Vg + (size_t)a * 64 * ldv, ldv, tid);
    if (b >= 0) { tile_load<DK>(k1, Kg + (size_t)b * 64 * ldk, ldk, tid); tile_load<DV>(v1, Vg + (size_t)b * 64 * ldv, ldv, tid); }
    __syncthreads();
    tile_store<DK>(k0, lds, tid); tile_store<DV>(v0, lds + VOFF, tid);
    if (b >= 0) { tile_store<DK>(k1, lds + KB, tid); tile_store<DV>(v1, lds + VOFF + VB, tid); }
    __syncthreads();
    int st = 0;
    for (;;) {
        const int na = b >= 0 ? it.next() : -1; const int nb = na >= 0 ? it.next() : -1;
        if (na >= 0) { tile_load<DK>(k0, Kg + (size_t)na * 64 * ldk, ldk, tid); tile_load<DV>(v0, Vg + (size_t)na * 64 * ldv, ldv, tid); }
        if (nb >= 0) { tile_load<DK>(k1, Kg + (size_t)nb * 64 * ldk, ldk, tid); tile_load<DV>(v1, Vg + (size_t)nb * 64 * ldv, ldv, tid); }
        const int ko = st * 2 * KB, vo = VOFF + st * 2 * VB;
        if (!f.skip(a)) { f32x16 p0, p1; qk_tile<DK>(lds + ko, qf, p0, p1, lane); f.mask(p0, p1, a); softmax_step_lazy<DV>(p0, p1, o, m, l); pv_tile<DV>(lds + vo, p0, p1, o, lane); }
        if (b >= 0 && !f.skip(b)) { f32x16 p0, p1; qk_tile<DK>(lds + ko + KB, qf, p0, p1, lane); f.mask(p0, p1, b); softmax_step_lazy<DV>(p0, p1, o, m, l); pv_tile<DV>(lds + vo + VB, p0, p1, o, lane); }
        const int kn = (st ^ 1) * 2 * KB, vn = VOFF + (st ^ 1) * 2 * VB;
        if (na >= 0) { tile_store<DK>(k0, lds + kn, tid); tile_store<DV>(v0, lds + vn, tid); }
        if (nb >= 0) { tile_store<DK>(k1, lds + kn + KB, tid); tile_store<DV>(v1, lds + vn + VB, tid); }
        __syncthreads();
        if (na < 0) break;
        a = na; b = nb; st ^= 1;
    }
}
struct RangeIt { int t, tend; DI int next() { return t <= tend ? t++ : -1; } };
struct BitsIt { unsigned rem; DI int next() { if (!rem) return -1; const int t = __builtin_ctz(rem); rem &= rem - 1; return t; } };
struct CausalF { int qrow, wfirst, wlast, h;
    DI bool skip(int t) const { return t > wlast; }
    DI void mask(f32x16& p0, f32x16& p1, int t) const { if (t * 64 + 63 > wfirst) {
#pragma unroll
        for (int r = 0; r < 16; ++r) { const int kv = t * 64 + crow(r, h); if (kv > qrow) p0[r] = -INFINITY; if (kv + 32 > qrow) p1[r] = -INFINITY; } } } };
template <int DK, int DV> DI void causal_sweep(Ctx& c, const bf16_t* Qg, int ldq, const bf16_t* Kg, int ldk, const bf16_t* Vg, int ldv, int q0, f32x16* o, float& lsum) {
    RELAUNDER(c);
    const int lane = c.lane, w = c.wave, r32 = lane & 31, h = lane >> 5;
    const int qrow = q0 + 32 * w + r32;
    bf16x8 qf[DK / 16]; load_qfrag<DK>(qf, Qg + (unsigned)qrow * (unsigned)ldq, h);
#pragma unroll
    for (int db = 0; db < DV / 32; ++db)
#pragma unroll
        for (int r = 0; r < 16; ++r) o[db][r] = 0.f;
    float m = -INFINITY, l = 0.f;
    RangeIt it{0, (q0 >> 6) + 3}; CausalF f{qrow, q0 + 32 * w, (q0 + 32 * w + 31) >> 6, h};
    flash_sweep<DK, DV, (DV == 64) && FX_STG>(c, qf, Kg, ldk, Vg, ldv, it, f, o, m, l);
    lsum = sum32(l);
}
template <int DV> DI void store_o(const f32x16* o, float scale, bf16_t* rowp, int h) {
#pragma unroll
    for (int db = 0; db < DV / 32; ++db)
#pragma unroll
        for (int k = 0; k < 4; ++k) { u32x2 v; v.x = cvtpk(o[db][4 * k] * scale, o[db][4 * k + 1] * scale); v.y = cvtpk(o[db][4 * k + 2] * scale, o[db][4 * k + 3] * scale);
            *(u32x2*)(rowp + 32 * db + 8 * k + 4 * h) = v; }
}

DI void mla_unit(Ctx& c, const bf16_t* QL, const bf16_t* KF, const bf16_t* KVU, bf16_t* YC, int b, int hd, int qt) {
    RELAUNDER(c);
    const int q0 = qt * 256; f32x16 o[2]; float l;
    const size_t rb = (size_t)b * S;
    causal_sweep<96, 64>(c, QL + rb * UPW + 96 * hd, UPW, KF + rb * 768 + 96 * hd, 768, KVU + rb * UPW + 128 * hd + 64, UPW, q0, o, l);
    const int qrow = q0 + 32 * c.wave + (c.lane & 31);
    store_o<64>(o, 1.f / l, YC + (rb + qrow) * 1024 + 64 * hd, c.lane >> 5);
}
DI void diff_unit(Ctx& c, const bf16_t* QKV, bf16_t* ON, int b, int hd, int qt, int j, int layer) {
    RELAUNDER(c);
    CArgs& a = *c.a; const int q0 = qt * 256, lane = c.lane, h = lane >> 5; const size_t rb = (size_t)b * S;
    f32x16 o1[4], o2[4]; float l1, l2;
    const bf16_t* base = QKV + rb * 3072;
    causal_sweep<64, 128>(c, base + 128 * hd, 3072, base + 1024 + 128 * hd, 3072, base + 2048 + 128 * hd, 3072, q0, o1, l1);
    { const float i1_ = 1.f / l1;
#pragma unroll
      for (int db = 0; db < 4; ++db)
#pragma unroll
          for (int r = 0; r < 16; ++r) o1[db][r] *= i1_; }
    causal_sweep<64, 128>(c, base + 128 * hd + 64, 3072, base + 1024 + 128 * hd + 64, 3072, base + 2048 + 128 * hd, 3072, q0, o2, l2);
    const float* lam = a.in[26] + j * 256; float s1 = lam[lane] * lam[64 + lane], s2 = lam[128 + lane] * lam[192 + lane];
    s1 = wave_sum(s1); s2 = wave_sum(s2);
    const float lam_init = 0.8f - 0.6f * __expf(-0.3f * (float)layer); const float lmb = __expf(s1) - __expf(s2) + lam_init;
    const float i1 = 1.f, i2 = lmb / l2; float ss = 0.f;
#pragma unroll
    for (int db = 0; db < 4; ++db)
#pragma unroll
        for (int r = 0; r < 16; ++r) { const float v = o1[db][r] * i1 - o2[db][r] * i2; o1[db][r] = v; ss += v * v; }
    ss = sum32(ss);
    const float rs = rsqrtf(ss * (1.f / 128.f) + EPS) * (1.f - lam_init);
    const float* sg = a.in[27] + j * 128;
#pragma unroll
    for (int db = 0; db < 4; ++db)
#pragma unroll
        for (int r = 0; r < 16; ++r) o1[db][r] *= rs * sg[32 * db + crow(r, h)];
    const int qrow = q0 + 32 * c.wave + (lane & 31);
    store_o<128>(o1, 1.f, ON + (rb + qrow) * 1024 + 128 * hd, h);
}

DI void nsa_unit(Ctx& c, const bf16_t* U, bf16_t* YC, int b, int g, int qt) {
    RELAUNDER(c);
    CArgs& a = *c.a; LAS char* lds = (LAS char*)c.lds; typedef SweepLds<64, 64> L;
    const int lane = c.lane, w = c.wave, tid = c.tid, r32 = lane & 31, h = lane >> 5;
    const int hg = w & 3, qsub = w >> 2, head = g * 4 + hg, q0 = qt * 64, jt = qt;
    const int qrow = q0 + 32 * qsub + r32; const size_t rb = (size_t)b * S; const size_t m = rb + qrow;
    LAS float* imp = (LAS float*)(lds + 8 * L::KB);
    LAS unsigned* selw = (LAS unsigned*)(lds + 8 * L::KB + 4 * 64 * 33 * 4);
    bf16x8 qf[4]; load_qfrag<64>(qf, U + m * UW + 544 + 64 * head, h);
    const bf16_t* urow = U + m * UW + 1824;
#ifdef NSA_ONLY
    const float g0 = NSA_ONLY == 0 ? 1.f : 0.f, g1 = NSA_ONLY == 1 ? 1.f : 0.f, g2 = NSA_ONLY == 2 ? 1.f : 0.f; (void)urow;
#else
    const float g0 = 1.f / (1.f + __expf(-bf2f(urow[head]))), g1 = 1.f / (1.f + __expf(-bf2f(urow[8 + head]))), g2 = 1.f / (1.f + __expf(-bf2f(urow[16 + head])));
#endif
    unsigned accp[2][8];
    const int bg = b * 2 + g;
    const bf16_t* KC = (const bf16_t*)(c.ws + WS_MISC + 65536) + (size_t)bg * 128 * 64; const bf16_t* VC = (const bf16_t*)(c.ws + WS_MISC + 65536 + 262144) + (size_t)bg * 128 * 64;
    __syncthreads();
    PSEC_B(1);
    PSEC_B(5);
    { TileRegs<64> k0, k1, v0, v1; tile_load<64>(k0, KC, 64, tid); tile_load<64>(k1, KC + 64 * 64, 64, tid); tile_load<64>(v0, VC, 64, tid); tile_load<64>(v1, VC + 64 * 64, 64, tid);
      tile_store<64>(k0, lds, tid); tile_store<64>(k1, lds + L::KB, tid); tile_store<64>(v0, lds + 2 * L::KB, tid); tile_store<64>(v1, lds + 2 * L::KB + L::VB, tid); }
    __syncthreads();
    PSEC_E(5); PSEC_B(6);
    {
        f32x16 p0, p1, p2, p3; qk_tile<64>(lds, qf, p0, p1, lane); qk_tile<64>(lds + L::KB, qf, p2, p3, lane);
        const int hi = qrow < 31 ? -1 : (qrow - 31) >> 4;
#pragma unroll
        for (int r = 0; r < 16; ++r) { const int cidx = crow(r, h); if (cidx > hi) p0[r] = -INFINITY; if (cidx + 32 > hi) p1[r] = -INFINITY; if (cidx + 64 > hi) p2[r] = -INFINITY; if (cidx + 96 > hi) p3[r] = -INFINITY; }
        float mx = fmaxf(rowmax32(p0, p1), rowmax32(p2, p3)); const float muse = (mx == -INFINITY) ? 0.f : mx; float s = 0.f;
#pragma unroll
        for (int r = 0; r < 16; ++r) { p0[r] = __builtin_amdgcn_exp2f(p0[r] - muse); p1[r] = __builtin_amdgcn_exp2f(p1[r] - muse); p2[r] = __builtin_amdgcn_exp2f(p2[r] - muse); p3[r] = __builtin_amdgcn_exp2f(p3[r] - muse); s += (p0[r] + p1[r]) + (p2[r] + p3[r]); }
        s = sum32(s); const float inv = s > 0.f ? 1.f / s : 0.f;
#pragma unroll
        for (int r = 0; r < 16; ++r) { p0[r] *= inv; p1[r] *= inv; p2[r] *= inv; p3[r] *= inv; }
        LAS float* ir = imp + hg * (64 * 33) + (32 * qsub + r32) * 33;
        float eo[4][4];
#define EDGE_X(P, PI) _Pragma("unroll") for (int k = 0; k < 4; ++k) { unsigned ua = __builtin_bit_cast(unsigned, P[4 * k + 3]), ub = ua; xchg32(ua, ub); eo[PI][k] = __builtin_bit_cast(float, h ? ua : ub); }
        EDGE_X(p0, 0) EDGE_X(p1, 1) EDGE_X(p2, 2) EDGE_X(p3, 3)
#undef EDGE_X
#define IMP_ST(P, PI) _Pragma("unroll") for (int k = 0; k < 4; ++k) { const float s4 = (P[4 * k] + P[4 * k + 1]) + (P[4 * k + 2] + P[4 * k + 3]); \
            const float prev0 = k >= 1 ? eo[PI][k >= 1 ? k - 1 : 0] : ((PI) >= 1 ? eo[(PI) >= 1 ? (PI) - 1 : 0][3] : 0.f); ir[8 * (PI) + 2 * k + h] = s4 + (h ? eo[PI][k] : prev0); }
        IMP_ST(p0, 0) IMP_ST(p1, 1) IMP_ST(p2, 2) IMP_ST(p3, 3)
#undef IMP_ST
        PSEC_E(7); PSEC_B(8);
        f32x16 oc[2];
#pragma unroll
        for (int db = 0; db < 2; ++db)
#pragma unroll
            for (int r = 0; r < 16; ++r) oc[db][r] = 0.f;
        pv_tile<64>(lds + 2 * L::KB, p0, p1, oc, lane); pv_tile<64>(lds + 2 * L::KB + L::VB, p2, p3, oc, lane);
#pragma unroll
        for (int db = 0; db < 2; ++db)
#pragma unroll
            for (int r = 0; r < 8; ++r) accp[db][r] = cvtpk(g0 * oc[db][2 * r], g0 * oc[db][2 * r + 1]);
    }
    __syncthreads();
    PSEC_E(8); PSEC_E(1); PSEC_B(2);
    LAS float* vsl = (LAS float*)(lds + 8 * L::KB + 4 * 64 * 33 * 4 + 256);
#pragma unroll 1
    for (int i = 0; i < 4; ++i) { const int id = tid + NT * i, qq = id >> 5, jb = id & 31;
        const bool allowed = jb <= jt, forced = allowed && (jb == 0 || jb >= jt - 1);
        const float iv = (imp[qq * 33 + jb] + imp[64 * 33 + qq * 33 + jb]) + (imp[2 * 64 * 33 + qq * 33 + jb] + imp[3 * 64 * 33 + qq * 33 + jb]);
        vsl[id] = forced ? 1e9f : (allowed ? iv : -1e30f); }
    __syncthreads();
#pragma unroll 1
    for (int i = 0; i < 4; ++i) { const int id = tid + NT * i, qq = id >> 5, jb = id & 31;
        const float v = vsl[id]; int rank = 0;
#pragma unroll
        for (int k4 = 0; k4 < 8; ++k4) { const f32x4 w = *(const LAS f32x4*)(vsl + qq * 32 + 4 * k4);
            rank += (w.x > v || (w.x == v && 4 * k4 + 0 < jb)) ? 1 : 0; rank += (w.y > v || (w.y == v && 4 * k4 + 1 < jb)) ? 1 : 0;
            rank += (w.z > v || (w.z == v && 4 * k4 + 2 < jb)) ? 1 : 0; rank += (w.w > v || (w.w == v && 4 * k4 + 3 < jb)) ? 1 : 0; }
        const unsigned long long bal = __ballot(jb <= jt && rank < 16);
        if (jb == 0) selw[qq] = (unsigned)(bal >> (lane & 32)); }
    __syncthreads();
    const unsigned mysel = selw[32 * qsub + r32];
    unsigned uni = selw[lane];
    uni |= swzu<1>(uni); uni |= swzu<2>(uni); uni |= swzu<4>(uni); uni |= swzu<8>(uni); uni |= swzu<16>(uni); uni = or32(uni);
    uni = __builtin_amdgcn_readfirstlane(uni);
    PSEC_E(2); PSEC_B(3);
    {
        struct SlcF { unsigned mysel; int qrow, h, jt; DI bool skip(int) const { return false; }
            DI void mask(f32x16& p0, f32x16& p1, int t) const { const float bias = ((mysel >> t) & 1u) ? 0.f : -INFINITY;
#pragma unroll
                for (int r = 0; r < 16; ++r) { p0[r] += bias; p1[r] += bias; }
                if (t == jt) {
#pragma unroll
                    for (int r = 0; r < 16; ++r) { const int kv = t * 64 + crow(r, h); if (kv > qrow) p0[r] = -INFINITY; if (kv + 32 > qrow) p1[r] = -INFINITY; } } } };
        f32x16 o[2];
#pragma unroll
        for (int db = 0; db < 2; ++db)
#pragma unroll
            for (int r = 0; r < 16; ++r) o[db][r] = 0.f;
        float mm = -INFINITY, l = 0.f;
        flash_sweep<64, 64, FX_STG>(c, qf, U + rb * UW + 1312 + 64 * g, UW, U + rb * UW + 1440 + 64 * g, UW, BitsIt{uni}, SlcF{mysel, qrow, h, jt}, o, mm, l);
        l = sum32(l); const float sc = g1 / l;
#pragma unroll
        for (int db = 0; db < 2; ++db)
#pragma unroll
            for (int r = 0; r < 8; ++r) accp[db][r] = cvtpk(bflo(accp[db][r]) + sc * o[db][2 * r], bfhi(accp[db][r]) + sc * o[db][2 * r + 1]);
    }
    PSEC_E(3); PSEC_B(4);
    {
        struct WinF { int qrow, h, jt; DI bool skip(int) const { return false; }
            DI void mask(f32x16& p0, f32x16& p1, int t) const { if (t == jt || t == jt - 8) {
#pragma unroll
                for (int r = 0; r < 16; ++r) { const int kv = t * 64 + crow(r, h); if (kv > qrow || kv <= qrow - 512) p0[r] = -INFINITY; if (kv + 32 > qrow || kv + 32 <= qrow - 512) p1[r] = -INFINITY; } } } };
        f32x16 o[2];
#pragma unroll
        for (int db = 0; db < 2; ++db)
#pragma unroll
            for (int r = 0; r < 16; ++r) o[db][r] = 0.f;
        float mm = -INFINITY, l = 0.f;
        flash_sweep<64, 64, FX_STG>(c, qf, U + rb * UW + 1568 + 64 * g, UW, U + rb * UW + 1696 + 64 * g, UW, RangeIt{jt - 8 > 0 ? jt - 8 : 0, jt}, WinF{qrow, h, jt}, o, mm, l);
        l = sum32(l); const float sc = g2 / l;
#pragma unroll
        for (int db = 0; db < 2; ++db)
#pragma unroll
            for (int r = 0; r < 8; ++r) accp[db][r] = cvtpk(bflo(accp[db][r]) + sc * o[db][2 * r], bfhi(accp[db][r]) + sc * o[db][2 * r + 1]);
    }
    PSEC_E(4);
    { bf16_t* rowp = YC + m * 1024 + 512 + 64 * head;
#pragma unroll
      for (int db = 0; db < 2; ++db)
#pragma unroll
          for (int k = 0; k < 4; ++k) { u32x2 v; v.x = accp[db][2 * k]; v.y = accp[db][2 * k + 1]; *(u32x2*)(rowp + 32 * db + 8 * k + 4 * h) = v; } }
}
}
#ifndef FX_MODE
#define FX_MODE 0
#endif
namespace fx {
template <int ACT  > struct EpiB16 {
    static constexpr bool PERM = true, AFTER_DRAIN = false;
    bf16_t* O; int ldc; const float* ss; const float* shw;
    __device__ __forceinline__ void operator()(const pg8::f32x4 (&acc)[2][2][4][2], const pg8::Unit& u, int wr, int wc, int fr, int fq) const {
        const int row0 = u.pm * 256 + wr * 64 + fr, col0 = u.pn * 256 + wc * 32 + 8 * fq;
        const bool FUSED = ss != nullptr; pg8::f32x4 sv[2][2];
        if (FUSED) { const float* sp = shw + (size_t)(u.pm >> 3) * 4096 + col0;
#pragma unroll
            for (int bj = 0; bj < 2; ++bj) { sv[bj][0] = *(const pg8::f32x4*)(sp + bj * 128); sv[bj][1] = *(const pg8::f32x4*)(sp + bj * 128 + 4); } }
#pragma unroll
        for (int ai = 0; ai < 2; ++ai)
#pragma unroll
            for (int m = 0; m < 4; ++m) { const int row = row0 + ai * 128 + m * 16; bf16_t* rowp = O + (size_t)row * ldc + col0;
                float rs = 1.f; if (FUSED) { const pg8::f32x4* sp4 = (const pg8::f32x4*)(ss + (size_t)row * 16); const pg8::f32x4 a0 = sp4[0], a1 = sp4[1], a2 = sp4[2], a3 = sp4[3];
                    const float tot = (((a0[0] + a0[1]) + (a0[2] + a0[3])) + ((a1[0] + a1[1]) + (a1[2] + a1[3]))) + (((a2[0] + a2[1]) + (a2[2] + a2[3])) + ((a3[0] + a3[1]) + (a3[2] + a3[3]))); rs = rsqrtf(tot * (1.f / 1024.f) + EPS); }
#pragma unroll
                for (int bj = 0; bj < 2; ++bj) { pg8::f32x4 v0 = acc[ai][bj][m][0], v1 = acc[ai][bj][m][1];
                    if (FUSED) { v0 = v0 * rs + sv[bj][0]; v1 = v1 * rs + sv[bj][1]; }
                    if (ACT == 1) {
#pragma unroll
                        for (int e = 0; e < 4; ++e) { float a = v0[e] > 0.f ? v0[e] : 0.f; v0[e] = a * a; float b = v1[e] > 0.f ? v1[e] : 0.f; v1[e] = b * b; } }
                    u32x4 w; w.x = pg8::cvt_pk_bf16(v0[0], v0[1]); w.y = pg8::cvt_pk_bf16(v0[2], v0[3]); w.z = pg8::cvt_pk_bf16(v1[0], v1[1]); w.w = pg8::cvt_pk_bf16(v1[2], v1[3]);
                    *(u32x4*)(rowp + bj * 128) = w; } }
    }
};
struct UpOrder : pg8::StaticOrder {
    __device__ bool next(int i, pg8::Unit& u) const { if (!pg8::StaticOrder::next(i, u)) return false; u.aoff = u.pn >= 3 ? 256 : 0; return true; }
};
struct EpiResid {
    static constexpr bool PERM = true, AFTER_DRAIN = false;
    const float* base32; const bf16_t* base16; float* out32; bf16_t* out16; const float* gate; bf16_t* xa; const float* ngain; const float* nsc; float* ss;
    __device__ __forceinline__ void operator()(const pg8::f32x4 (&acc)[2][2][4][2], const pg8::Unit& u, int wr, int wc, int fr, int fq) const {
        const int row0 = u.pm * 256 + wr * 64 + fr, col0 = u.pn * 256 + wc * 32 + 8 * fq; const int b = u.pm >> 3; const float* gp = gate + (size_t)b * 6144 + col0;
        pg8::f32x4 gv[2][2], av[2][2];
#pragma unroll
        for (int bj = 0; bj < 2; ++bj)
#pragma unroll
            for (int n = 0; n < 2; ++n) { gv[bj][n] = *(const pg8::f32x4*)(gp + bj * 128 + n * 4);
                if (xa) { const pg8::f32x4 g = *(const pg8::f32x4*)(ngain + col0 + bj * 128 + n * 4), sc = *(const pg8::f32x4*)(nsc + (size_t)b * 6144 + col0 + bj * 128 + n * 4); av[bj][n] = g * (sc + 1.f); } }
#pragma unroll
        for (int ai = 0; ai < 2; ++ai)
#pragma unroll
            for (int m = 0; m < 4; ++m) { const int row = row0 + ai * 128 + m * 16; const size_t off = (size_t)row * 1024 + col0; float sq = 0.f;
#pragma unroll
                for (int bj = 0; bj < 2; ++bj) { pg8::f32x4 xn[2];
                    if (base32) { xn[0] = *(const pg8::f32x4*)(base32 + off + bj * 128); xn[1] = *(const pg8::f32x4*)(base32 + off + bj * 128 + 4); }
                    else { const u32x4 bw = *(const u32x4*)(base16 + off + bj * 128); xn[0] = (pg8::f32x4){bflo(bw.x), bfhi(bw.x), bflo(bw.y), bfhi(bw.y)}; xn[1] = (pg8::f32x4){bflo(bw.z), bfhi(bw.z), bflo(bw.w), bfhi(bw.w)}; }
                    xn[0] = xn[0] + gv[bj][0] * acc[ai][bj][m][0]; xn[1] = xn[1] + gv[bj][1] * acc[ai][bj][m][1];
                    if (out32) { *(pg8::f32x4*)(out32 + off + bj * 128) = xn[0]; *(pg8::f32x4*)(out32 + off + bj * 128 + 4) = xn[1]; }
                    else { u32x4 w; w.x = pg8::cvt_pk_bf16(xn[0][0], xn[0][1]); w.y = pg8::cvt_pk_bf16(xn[0][2], xn[0][3]); w.z = pg8::cvt_pk_bf16(xn[1][0], xn[1][1]); w.w = pg8::cvt_pk_bf16(xn[1][2], xn[1][3]); *(u32x4*)(out16 + off + bj * 128) = w; }
                    if (xa) { sq += ((xn[0][0] * xn[0][0] + xn[0][1] * xn[0][1]) + (xn[0][2] * xn[0][2] + xn[0][3] * xn[0][3])) + ((xn[1][0] * xn[1][0] + xn[1][1] * xn[1][1]) + (xn[1][2] * xn[1][2] + xn[1][3] * xn[1][3]));
                        const pg8::f32x4 y0 = xn[0] * av[bj][0], y1 = xn[1] * av[bj][1];
                        u32x4 w; w.x = pg8::cvt_pk_bf16(y0[0], y0[1]); w.y = pg8::cvt_pk_bf16(y0[2], y0[3]); w.z = pg8::cvt_pk_bf16(y1[0], y1[1]); w.w = pg8::cvt_pk_bf16(y1[2], y1[3]);
                        *(u32x4*)(xa + off + bj * 128) = w; } }
                if (xa) { sq += swz<16>(sq); sq = sum32(sq); if (fq == 0) ss[(size_t)row * 16 + u.pn * 4 + wc] = sq; } }
    }
};

DI bool static_unit(int nM, int nN, int G, int c, int i, int& pm, int& pn) {
    const int nwg = nM * nN; const long L = (long)i * G + c; if (L >= nwg) return false;
    int wgid = (int)L; { const int q = nwg / pg8::NXCD, r = nwg % pg8::NXCD, xcd = wgid % pg8::NXCD, off = wgid / pg8::NXCD; wgid = (xcd < r ? xcd * (q + 1) : r * (q + 1) + (xcd - r) * q) + off; }
    const int nig = pg8::WGM * nN, gid = wgid / nig, fm = gid * pg8::WGM, gsz = (nM - fm) < pg8::WGM ? (nM - fm) : pg8::WGM;
    pm = fm + ((wgid % nig) % gsz); pn = (wgid % nig) / gsz; return true;
}
#ifndef FX_REPEAT_KIND
#define FX_REPEAT_KIND 0
#endif
#ifndef FX_VAR
#define FX_VAR 0
#endif
#define DUMMY_OUT ((float*)(ws + 344 * MiB))
#define DUMMY_XB ((bf16_t*)(ws + 344 * MiB))
__global__ void __launch_bounds__(NT, 2) mega(Args args) {
    extern __shared__ __attribute__((aligned(16))) unsigned char lds_raw[];
    Ctx c; c.lds = (LAS unsigned char*)lds_raw; c.tid = threadIdx.x; c.lane = c.tid & 63; c.wave = __builtin_amdgcn_readfirstlane(c.tid >> 6); c.G = gridDim.x; c.bid = blockIdx.x; c.a = nullptr; c.var = 0; c.pr_acc = 0u; c.pr_t = 0ull; (void)args;
#define KARGS() ({ CArgs* p_ = (CArgs*)__builtin_amdgcn_kernarg_segment_ptr(); asm volatile("" : "+s"(p_)); p_; })
    CArgs* pa0 = KARGS();
    volatile LAS unsigned* MISC = (volatile LAS unsigned*)(c.lds + LDS_MISC);
    for (int i = c.tid; i < 64; i += NT) MISC[i] = 0u;
    __syncthreads();
    XcdBarrier bar = xcd_barrier_post((unsigned*)(pa0->ws + WS_CTL) + 4096, MISC + 8);
    int ph = 0;
#ifdef PROBE_PHASE
    unsigned long long pr_t0 = 0ull; unsigned pr_dt = 0u;
    pr_t0 = __builtin_amdgcn_s_memrealtime();
#endif
#if FX_MODE == 0
    constexpr int lo = 0, hi = 26;
#else
    const int lo = pa0->ph_lo, hi = pa0->ph_hi;
#endif
#define SEAM() do { if (ph + 1 < hi) { xcd_barrier(bar); if (FX_REPEAT_KIND == 12) xcd_barrier(bar); } } while (0)
#ifdef PROBE_PHASE
#define PROBE_T0() do { if (ph == PROBE_PHASE) pr_t0 = __builtin_amdgcn_s_memrealtime(); } while (0)
#ifndef PROBE_WORK
#define PROBE_WORK 0
#endif
#define PROBE_T1() do { if (!PROBE_WORK && ph == PROBE_PHASE) pr_dt = (unsigned)(__builtin_amdgcn_s_memrealtime() - pr_t0); } while (0)
#define PROBE_T1W() do { if (PROBE_WORK && ph == PROBE_PHASE) { __syncthreads(); pr_dt = (unsigned)(__builtin_amdgcn_s_memrealtime() - pr_t0); } } while (0)
#else
#define PROBE_T1W() do {} while (0)
#define PROBE_T0() do {} while (0)
#define PROBE_T1() do {} while (0)
#endif
#define PHASE_BEGIN if (ph >= lo && ph < hi) { PROBE_T0(); CArgs* pa = KARGS(); c.a = pa; unsigned char* ws = pa->ws; c.ws = ws; RELAUNDER(c); const int gw = c.bid * NW + c.wave, NGW = c.G * NW; (void)gw; (void)NGW; \
    const float* MOD = (const float*)(ws + WS_MOD); const float* mod = MOD + (size_t)layer * 8 * 6144; (void)mod; \
    bf16_t* XN = (bf16_t*)(ws + WS_XN); bf16_t* YC = (bf16_t*)(ws + WS_YC); bf16_t* U = (bf16_t*)(ws + WS_BIG + BIG_U); bf16_t* QL = (bf16_t*)(ws + WS_BIG + BIG_UP); bf16_t* KVU = QL + 768; \
    bf16_t* KF = XN; bf16_t* HID = (bf16_t*)(ws + WS_BIG); bf16_t* QKV = (bf16_t*)(ws + WS_BIG); bf16_t* XB = (bf16_t*)(ws + WS_XB); (void)XB; float* SS = (float*)(ws + WS_SS); const float* SHW = (const float*)(ws + WS_SHW); (void)SS; (void)SHW; (void)XN; (void)YC; (void)U; (void)QL; (void)KVU; (void)KF; (void)HID; (void)QKV; \
    unsigned char* wb = ws + ((layer & 1) ? WS_WODD + (size_t)(layer >> 1) * W_ODD : WS_WEVEN + (size_t)(layer >> 1) * W_EVEN); unsigned char* wm = ws + WS_WMLP + (size_t)layer * W_MLP; (void)wb; (void)wm;
#define PHASE_END PROBE_T1W(); SEAM(); PROBE_T1(); } ++ph;
    int layer = 0;

    if (lo == 0) { CArgs* pa = KARGS(); c.a = pa; c.ws = pa->ws; RELAUNDER(c);
#if FX_REPEAT_KIND == 20
        {
          const u32x4* src = (const u32x4*)(pa->ws + 40 * MiB); u32x4 acc4 = (u32x4){0u, 0u, 0u, 0u}; const size_t n16 = (256 * MiB) / 16;
          for (size_t i = (size_t)c.bid * NT + c.tid; i < n16; i += (size_t)c.G * NT * 8) {
#pragma unroll
              for (int u = 0; u < 8; ++u) { const size_t k = i + (size_t)u * c.G * NT; if (k < n16) { const u32x4 v = src[k]; acc4.x ^= v.x; acc4.y ^= v.y; acc4.z ^= v.z; acc4.w ^= v.w; } } }
          if ((acc4.x ^ acc4.y ^ acc4.z ^ acc4.w) == 0x12345u) ((unsigned*)(pa->ws + 380 * MiB))[c.tid] = acc4.x; }
#endif
#ifndef SKIP_PRO
        REP(10) phase_prologue(c);
#endif
        if (hi > 1) { if (pa->use_cg != 0) cooperative_groups::this_grid().sync(); else xcd_barrier(bar); }
#ifdef PROBE_PHASE
        if (PROBE_PHASE == 0) pr_dt = (unsigned)(__builtin_amdgcn_s_memrealtime() - pr_t0);
#endif
    }
    ++ph;

#pragma clang loop unroll(full)
    for (layer = 0; layer < 4; ++layer) {
        const int j = layer >> 1;
        if (layer == 0) {
        PHASE_BEGIN
            PSEC_B(9); REP(8) phase_modnorm(c, pa->in[0], pa->in[5], mod + 0, mod + 1024, XN); PSEC_E(9);
            PSEC_B(10); REP(15) { shw_items(c, 0); if (FX_PRO_MATS >= 28) shw_items(c, 1); } PSEC_E(10);
        PHASE_END
        }
        if ((layer & 1) == 0) {
            PHASE_BEGIN { pg8::Gemm g{XN, (const bf16_t*)(wb + WE_IN), T, UW, D, D}; pg8::StaticOrder so; so.init(T, UW, c.G, c.bid); EpiB16<0> E{U, UW, layer == 0 ? nullptr : SS + (size_t)(2 * layer) * T * 16, SHW + (size_t)(2 * layer) * 8 * 4096};

#ifndef SKIP_G1
REP(6) pg8::gemm_phase<EpiB16<0>, pg8::StaticOrder, true, true>(c.lds, g, so, E);
#endif
 } PHASE_END
            PHASE_BEGIN { pg8::Gemm g{U, (const bf16_t*)(wb + WE_UP), T, 1792, 256, UW}; UpOrder so; so.init(T, 1792, c.G, c.bid); EpiB16<0> E{QL, UPW, nullptr, nullptr};

#ifndef SKIP_G2
PSEC_B(13); REP(13) pg8::gemm_phase<EpiB16<0>, UpOrder, false, true>(c.lds, g, so, E); PSEC_E(13);
#endif

                __syncthreads();

#ifndef SKIP_CMP
 PSEC_B(14); REP(14) for (int it = c.bid; it < 256; it += c.G) compress_item(c, U, j, it); PSEC_E(14);
#endif


#ifndef SKIP_FIN
 RELAUNDER(c); PSEC_B(15); for (int m0 = gw; m0 < T; m0 += NGW * 8) nsa_finalize_rows(c, U, m0, NGW, j); PSEC_E(15);
#endif
 } PHASE_END
            PHASE_BEGIN {
#ifndef SKIP_FIN
 for (int m0 = gw; m0 < T; m0 += NGW * TBV) mla_finalize_rows(c, U, QL, KVU, KF, m0, NGW, j);
                __syncthreads();
#endif

                REP(1) for (int p = c.bid; p < 256; p += c.G) { const int bg = p >> 4, s = p & 15;
#ifndef SKIP_NSA
 nsa_unit(c, U, YC, bg >> 1, bg & 1, 31 - s); nsa_unit(c, U, YC, bg >> 1, bg & 1, s);
#endif
 } } PHASE_END
            PHASE_BEGIN { REP(2) for (int p = c.bid; p < 256; p += c.G) { const int bh = p >> 2, s = p & 3;
#ifndef SKIP_MLA
 { bf16_t* yo_ = rep_ ? (bf16_t*)(ws + 344 * MiB) : YC; c.var = rep_ ? FX_VAR : 0; mla_unit(c, QL, KF, KVU, yo_, bh >> 3, bh & 7, 7 - s); mla_unit(c, QL, KF, KVU, yo_, bh >> 3, bh & 7, s); c.var = 0; }
#endif
 }
                if (layer == 0 && FX_PRO_MATS < 28) { __syncthreads(); RELAUNDER(c); convert_mats(c, FX_PRO_MATS, 28); } } PHASE_END
            PHASE_BEGIN { pg8::Gemm g{YC, (const bf16_t*)(wb + WE_OUT), T, D, D, D}; pg8::StaticOrder so; so.init(T, D, c.G, c.bid);
#ifndef SKIP_G3
REP(9) { EpiResid E{layer == 0 ? pa->in[0] : nullptr, XB, nullptr, rep_ ? DUMMY_XB : XB, mod + 2048, XN, pa->in[6] + layer * D, mod + 4096, SS + (size_t)(2 * layer + 1) * T * 16}; pg8::gemm_phase<EpiResid, pg8::StaticOrder, true, true>(c.lds, g, so, E); }
#endif
                if (layer == 0 && FX_PRO_MATS < 28) { RELAUNDER(c); shw_items(c, 1); }
 } PHASE_END
        } else {
            PHASE_BEGIN { pg8::Gemm g{XN, (const bf16_t*)(wb + WO_QKV), T, 3072, D, D}; pg8::StaticOrder so; so.init(T, 3072, c.G, c.bid); EpiB16<0> E{QKV, 3072, SS + (size_t)(2 * layer) * T * 16, SHW + (size_t)(2 * layer) * 8 * 4096};

#ifndef SKIP_G4
PSEC_B(11); REP(7) pg8::gemm_phase<EpiB16<0>, pg8::StaticOrder, true, true>(c.lds, g, so, E); PSEC_E(11); PSEC_B(12);
                asm volatile("s_waitcnt vmcnt(0)" ::: "memory"); __syncthreads(); RELAUNDER(c);
                for (int i = 0; i < 3; ++i) { int pm_, pn_; if (!static_unit(T / 256, 3072 / 256, c.G, c.bid, i, pm_, pn_)) break; if (pn_ < 8) diff_finalize_tile(c, QKV, pm_, pn_, j); } PSEC_E(12);
#endif
 } PHASE_END
            PHASE_BEGIN { REP(3) for (int p = c.bid; p < 256; p += c.G) { const int bh = p >> 2, s = p & 3;
#ifndef SKIP_DIFF
 diff_unit(c, QKV, YC, bh >> 3, bh & 7, 7 - s, j, layer); diff_unit(c, QKV, YC, bh >> 3, bh & 7, s, j, layer);
#endif
 } } PHASE_END
            PHASE_BEGIN { pg8::Gemm g{YC, (const bf16_t*)(wb + WO_O), T, D, D, D}; pg8::StaticOrder so; so.init(T, D, c.G, c.bid);
#ifndef SKIP_G5
REP(9) { EpiResid E{nullptr, XB, nullptr, rep_ ? DUMMY_XB : XB, mod + 2048, XN, pa->in[6] + layer * D, mod + 4096, SS + (size_t)(2 * layer + 1) * T * 16}; pg8::gemm_phase<EpiResid, pg8::StaticOrder, true, true>(c.lds, g, so, E); }
#endif
 } PHASE_END
        }
        PHASE_BEGIN { pg8::Gemm g{XN, (const bf16_t*)wm, T, FF, D, D}; pg8::StaticOrder so; so.init(T, FF, c.G, c.bid); EpiB16<1> E{HID, FF, SS + (size_t)(2 * layer + 1) * T * 16, SHW + (size_t)(2 * layer + 1) * 8 * 4096};

#ifndef SKIP_G6
REP(4) pg8::gemm_phase<EpiB16<1>, pg8::StaticOrder, true, true>(c.lds, g, so, E);
#endif
 } PHASE_END
        PHASE_BEGIN { pg8::Gemm g{HID, (const bf16_t*)(wm + 8 * MiB), T, D, FF, FF}; pg8::StaticOrder so; so.init(T, D, c.G, c.bid);
#ifndef SKIP_G7
REP(5) { EpiResid E{nullptr, XB, (layer == 3 && !rep_) ? pa->out : nullptr, rep_ ? DUMMY_XB : XB, mod + 5120, layer < 3 ? XN : nullptr, pa->in[5] + (layer + 1) * D, MOD + (size_t)(layer + 1) * 8 * 6144 + 1024, SS + (size_t)(2 * layer + 2) * T * 16}; pg8::gemm_phase<EpiResid, pg8::StaticOrder, true, true>(c.lds, g, so, E); }
#endif
 } PHASE_END
    }
#ifdef PROBE_PHASE
    { if (blockIdx.x == 0 && threadIdx.x == 0) {
#ifndef PROBE_MULT
#define PROBE_MULT 2u
#endif
          const unsigned long long t_end = __builtin_amdgcn_s_memrealtime();
#ifdef PROBE_SEC
          pr_dt = c.pr_acc;
#endif
          const unsigned long long wait = (unsigned long long)pr_dt * PROBE_MULT;
          while (__builtin_amdgcn_s_memrealtime() - t_end < wait) __builtin_amdgcn_s_sleep(8); } }
#endif
#undef PHASE_BEGIN
#undef PHASE_END
#undef SEAM
}
constexpr int N_PHASES = 1 + 1 + 2 * (5 + 2) + 2 * (3 + 2);
static_assert(N_PHASES == 26, "phase count");

inline void launch(const Args& base, int lo, int hi, int use_cg, hipStream_t st) {
    static int grid = 0;
    if (grid == 0) {
        int dev = 0, cus = 0, per_cu = 0;
        (void)hipGetDevice(&dev); (void)hipDeviceGetAttribute(&cus, hipDeviceAttributeMultiprocessorCount, dev);
        (void)hipFuncSetAttribute((const void*)mega, hipFuncAttributeMaxDynamicSharedMemorySize, LDS_BYTES);
        (void)hipOccupancyMaxActiveBlocksPerMultiprocessor(&per_cu, (const void*)mega, NT, LDS_BYTES);
        if (per_cu < 1) { fprintf(stderr, "occupancy query says %d blocks/CU\n", per_cu); per_cu = 1; }
        grid = cus;
        (void)hipGetLastError();
    }
    Args a = base; a.ph_lo = lo; a.ph_hi = hi; a.use_cg = use_cg; a.pad = 0;
    void* kargs[] = {&a};
#ifndef FX_COOP
#define FX_COOP 1
#endif
#if FX_COOP
    hipError_t e = hipLaunchCooperativeKernel((const void*)mega, dim3(grid), dim3(NT), kargs, LDS_BYTES, st);
    if (e != hipSuccess) fprintf(stderr, "cooperative launch failed: %s\n", hipGetErrorString(e));
#else
    (void)kargs; hipLaunchKernelGGL(mega, dim3(grid), dim3(NT), LDS_BYTES, st, a);
#endif
}
}
#ifndef FX_COOP
#define FX_COOP 1
#endif
#ifndef FX_MODE
#define FX_MODE 0
#endif
#ifndef DBG_LAYERS
#define DBG_LAYERS 1
#endif
#ifndef DBG_B0
#define DBG_B0 5
#endif
#ifndef DBG_STAGE
#define DBG_STAGE 0
#endif
#ifndef DBG_NPH
#define DBG_NPH -1
#endif
namespace dbg {
__global__ void k_cmp(const void* fast, int is_bf16, long fld, const float* ref, long rld, int nrows, int ncols, float fscale, float* acc2) {
    const long n = (long)nrows * ncols; float d2 = 0.f, r2 = 0.f;
    for (long i = (long)blockIdx.x * 256 + threadIdx.x; i < n; i += (long)gridDim.x * 256) { const long r = i / ncols, cidx = i % ncols;
        float a = is_bf16 ? fx::bf2f(((const unsigned short*)fast)[r * fld + cidx]) : ((const float*)fast)[r * fld + cidx]; a *= fscale;
        const float b = ref[r * rld + cidx]; if (!(a == a)) a = 1e6f; d2 += (a - b) * (a - b); r2 += b * b; }
    for (int o = 32; o > 0; o >>= 1) { d2 += __shfl_xor(d2, o); r2 += __shfl_xor(r2, o); }
    if ((threadIdx.x & 63) == 0) { atomicAdd(acc2, d2); atomicAdd(acc2 + 1, r2); }
}
#ifndef DBG_SEL
#define DBG_SEL -1
#endif
__global__ void k_finish(float* out, const float* acc, int nchk, long n) {
    float e = 0.f; int bad = -1; for (int i = 0; i < nchk; ++i) { float v = sqrtf(acc[2 * i] / fmaxf(acc[2 * i + 1], 1e-30f)); if (!(v == v)) v = 100.f; e = fmaxf(e, v); if (bad < 0 && v > 0.05f) bad = i; }
    if (DBG_SEL >= 0) { e = sqrtf(acc[2 * DBG_SEL] / fmaxf(acc[2 * DBG_SEL + 1], 1e-30f)); if (!(e == e)) e = 100.f; bad = -1; }
    if (blockIdx.x == 0 && threadIdx.x == 0 && bad >= 0) out[0] += 1000.f * (bad + 1);
    for (long i = (long)blockIdx.x * 256 + threadIdx.x; i < n; i += (long)gridDim.x * 256) out[i] *= (1.f + e);
}
}
extern "C" void kernel_launch(void* const* d_in, const int* in_sizes, int n_in, void* d_out, int out_size, void* d_ws, size_t ws_size, hipStream_t stream) {
    fx::Args a{};
    for (int i = 0; i < 28; ++i) a.in[i] = (const float*)d_in[i];
    a.pos = (const int*)d_in[2]; a.out = (float*)d_out; a.ws = (unsigned char*)d_ws;
    (void)hipMemsetAsync((char*)d_ws + fx::WS_CTL, 0, 65536, stream);
#if FX_MODE == 0
    fx::launch(a, 0, fx::N_PHASES, FX_COOP ? 1 : 0, stream);
#elif FX_MODE == 1
    for (int p = 0; p < fx::N_PHASES; ++p) fx::launch(a, p, p + 1, 0, stream);
#else
    nv::In in{}; for (int i = 0; i < 28; ++i) in.p[i] = (const float*)d_in[i]; in.pos = (const int*)d_in[2];
    float* errs = (float*)((char*)d_ws + 381 * fx::MiB);
    (void)hipMemsetAsync(errs, 0, 256, stream);
    const int nph = DBG_NPH >= 0 ? DBG_NPH : (DBG_LAYERS == 1 ? 9 : DBG_LAYERS == 2 ? 15 : DBG_LAYERS == 3 ? 22 : 28);
    for (int p = 0; p < nph; ++p) fx::launch(a, p, p + 1, 0, stream);
    float* nws = (float*)((char*)d_ws + fx::WS_NAIVE); float* nx = (float*)((char*)d_ws + fx::WS_NAIVE + 56 * fx::MiB);
    nv::forward(in, nx, nws, stream, DBG_LAYERS, DBG_B0, 1, DBG_STAGE == 8 ? 6 : DBG_STAGE);
    int nchk = 0;
    auto CMPR = [&](const void* f, int isb, long fld, const float* r, long rld, int nrows, int ncols, float fs) { hipLaunchKernelGGL(dbg::k_cmp, dim3(512), dim3(256), 0, stream, f, isb, fld, r, rld, nrows, ncols, fs, errs + 2 * nchk); ++nchk; };
    auto CMP = [&](const void* f, int isb, long fld, const float* r, long rld, int ncols, float fs) { CMPR(f, isb, fld, r, rld, 2048, ncols, fs); };
    const size_t r0 = (size_t)DBG_B0 * 2048;
    unsigned char* ws = (unsigned char*)d_ws;
    const size_t NMi = (size_t)(1u << 20) / 8;
    float* nU = nws + nv::R_U; float* nRA = nU + 29 * NMi; float* nRB = nRA + 12 * NMi; float* nRC = nRB + 16 * NMi; float* nRD = nRC + 12 * NMi; float* nH = nRD + 8 * NMi;
    (void)nRA; (void)nRB; (void)nRC; (void)nRD; (void)nH;
    const fx::bf16_t* fU = (const fx::bf16_t*)(ws + fx::WS_BIG + fx::BIG_U); const fx::bf16_t* fQL = (const fx::bf16_t*)(ws + fx::WS_BIG + fx::BIG_UP);
    const fx::bf16_t* fKVU = fQL + 768; const fx::bf16_t* fXN = (const fx::bf16_t*)(ws + fx::WS_XN); const fx::bf16_t* fYC = (const fx::bf16_t*)(ws + fx::WS_YC);
    (void)fU; (void)fQL; (void)fKVU; (void)fXN; (void)fYC;
#if DBG_STAGE == 0 || DBG_STAGE == 9
    CMP((const float*)d_out + r0 * 1024, 0, 1024, nx, 1024, 1024, 1.f);
#elif DBG_STAGE == 1
    if ((DBG_LAYERS & 1) == 1) { CMP(fU + r0 * 2048, 1, 2048, nU, 1848, 544, 1.f); CMP(fU + r0 * 2048 + 1056, 1, 2048, nU + 1056, 1848, 256, 1.f); CMP(fU + r0 * 2048 + 1824, 1, 2048, nU + 1824, 1848, 24, 1.f); }
    else { CMP(fU + r0 * 3072 + 2048, 1, 3072, nU + 2048, 3072, 1024, 1.f); }
#elif DBG_STAGE == 2
    if ((DBG_LAYERS & 1) == 1) { CMP(fQL + r0 * 1792, 1, 1792, nRC, 768, 768, 1.f / (0.10206207261596577f * 1.4426950408889634f)); CMP(fXN + r0 * 768, 1, 768, nRA, 768, 768, 1.f); }
    else { CMP(fU + r0 * 3072, 1, 3072, nU, 3072, 1024, 1.f / (0.125f * 1.4426950408889634f)); CMP(fU + r0 * 3072 + 1024, 1, 3072, nU + 1024, 3072, 1024, 1.f); }
#elif DBG_STAGE == 3
    CMP(fU + r0 * 2048, 1, 2048, nU, 1848, 544, 1.f); CMP(fU + r0 * 2048 + 1056, 1, 2048, nU + 1056, 1848, 256, 1.f); CMP(fU + r0 * 2048 + 1824, 1, 2048, nU + 1824, 1848, 24, 1.f);
    CMP(fQL + r0 * 1792, 1, 1792, nRC, 768, 768, 1.f / (0.10206207261596577f * 1.4426950408889634f)); CMP(fXN + r0 * 768, 1, 768, nRA, 768, 768, 1.f);
    CMP(fYC + r0 * 1024, 1, 1024, nH, 1024, 512, 1.f);
#elif DBG_STAGE == 4
    if ((DBG_LAYERS & 1) == 1) { CMP(fU + r0 * 2048 + 544, 1, 2048, nRD, 512, 512, 1.f / (0.125f * 1.4426950408889634f)); }
    else { CMP(fYC + r0 * 1024, 1, 1024, nU, 1024, 1024, 1.f); }
#elif DBG_STAGE == 6
    { const float* nSM = nws + nv::R_SMALL; const fx::bf16_t* fKC = (const fx::bf16_t*)(ws + fx::WS_MISC + 65536) + (size_t)DBG_B0 * 2 * 128 * 64; const fx::bf16_t* fVC = fKC + 16 * 128 * 64;
      CMP(fU + r0 * 2048 + 544, 1, 2048, nRD, 512, 512, 1.f / (0.125f * 1.4426950408889634f));
      CMPR(fKC, 1, 64, nSM, 64, 127, 64, 1.f); CMPR(fKC + 128 * 64, 1, 64, nSM + 128 * 64, 64, 127, 64, 1.f);
      CMPR(fVC, 1, 64, nSM + 16 * 128 * 64, 64, 127, 64, 1.f); CMPR(fVC + 128 * 64, 1, 64, nSM + 17 * 128 * 64, 64, 127, 64, 1.f);
      CMP(fU + r0 * 2048 + 1312, 1, 2048, nRA, 128, 128, 1.f); CMP(fU + r0 * 2048 + 1568, 1, 2048, nRA + 2 * NMi, 128, 128, 1.f); }
#elif DBG_STAGE == 8
    { const float* nb_ = NSA_ONLY == 0 ? nRC : NSA_ONLY == 1 ? nRA + 4 * NMi : nRB; CMP(fYC + r0 * 1024 + 512, 1, 1024, nb_, 512, 512, 1.f); }
#elif DBG_STAGE == 7
    CMP(fYC + r0 * 1024, 1, 1024, nH, 1024, 512, 1.f); CMP(fYC + r0 * 1024 + 512, 1, 1024, nH + 512, 1024, 512, 1.f);
#endif
    nv::forward(in, (float*)d_out, (float*)d_ws, stream, 4, 0, 8, 0);
    hipLaunchKernelGGL(dbg::k_finish, dim3(1024), dim3(256), 0, stream, (float*)d_out, errs, nchk, (long)16384 * 1024);
#endif
}
```

```cpp
#define FX_MODE 0

#include <hip/hip_runtime.h>
#include <hip/hip_bf16.h>
#include <cstdio>
#include <cstdint>
#include <cmath>
#include <hip/hip_cooperative_groups.h>
namespace pg8 {
#define PG8_LAS __attribute__((address_space(3)))
typedef unsigned short bf16_t;
typedef short bf16x8 __attribute__((ext_vector_type(8)));
typedef float f32x4 __attribute__((ext_vector_type(4)));
typedef unsigned u32x4 __attribute__((ext_vector_type(4)));
constexpr int BM = 256, BK = 64, HALF = 128, HTB = HALF * BK * 2  , STAGE_BYTES = 8 * HTB, NXCD = 8, WGM = 8;

__host__ __device__ __forceinline__ int lds_byte(int r, int c) { const int st = (r >> 4) * 2 + (c >> 5), rr = r & 15, cc = c & 31, ob = rr * 64 + cc * 2; return st * 1024 + (ob ^ (((ob >> 9) & 1) << 5)); }
__host__ __device__ __forceinline__ void stage_rc(int b, int& R, int& C) { const int st = b / 1024, sb = b % 1024, swz = sb ^ (((sb >> 9) & 1) << 5); R = (st >> 1) * 16 + swz / 64; C = (st & 1) * 32 + (swz % 64) / 2; }
__host__ __device__ __forceinline__ int perm32(int rho) { const int n = rho >> 4, i = rho & 15; return 8 * (i >> 2) + 4 * n + (i & 3); }

struct Unit { int pm, pn; int aoff; };
struct Gemm { const bf16_t* A; const bf16_t* Bt; int M, N, K, lda; };

struct StaticOrder {
    int nM, nN, nwg, G, c;
    __host__ __device__ void init(int M, int N, int G_, int c_) { nM = M / BM; nN = N / BM; nwg = nM * nN; G = G_; c = c_; }
    __host__ __device__ bool next(int i, Unit& u) const {
        const long L = (long)i * G + c; if (L >= nwg) return false;
        int wgid = (int)L; { const int q = nwg / NXCD, r = nwg % NXCD, xcd = wgid % NXCD, off = wgid / NXCD; wgid = (xcd < r ? xcd * (q + 1) : r * (q + 1) + (xcd - r) * q) + off; }
        const int nig = WGM * nN, gid = wgid / nig, fm = gid * WGM, gsz = (nM - fm) < WGM ? (nM - fm) : WGM;
        u.pm = fm + ((wgid % nig) % gsz); u.pn = (wgid % nig) / gsz; u.aoff = 0; return true;
    }
    __device__ __forceinline__ void a_ready(const Unit&) const {}
    __device__ __forceinline__ void done(const Unit&) const {}
};

__device__ __forceinline__ unsigned cvt_pk_bf16(float lo, float hi) { unsigned r; asm volatile("v_cvt_pk_bf16_f32 %0, %1, %2" : "=v"(r) : "v"(lo), "v"(hi)); return r; }
typedef float f32x2 __attribute__((ext_vector_type(2)));
__device__ __forceinline__ f32x2 gelu_pk(f32x2 v) {
    const f32x2 av = __builtin_elementwise_abs(v), d = av * 0.2316418882f + 1.0f;
    f32x2 t; t.x = __builtin_amdgcn_rcpf(d.x); t.y = __builtin_amdgcn_rcpf(d.y);
    f32x2 q = t * 0.5307027145f + (-0.7265760135f); q = q * t + 0.7107068705f; q = q * t + (-0.142248368f); q = q * t + 0.127414796f; q = q * t;
    const f32x2 s = (v * v) * (-0.72134752044f);
    f32x2 e; e.x = __builtin_amdgcn_exp2f(s.x); e.y = __builtin_amdgcn_exp2f(s.y);
    const f32x2 m = v * (q * e), r = v - m;
    f32x2 o; o.x = v.x < 0.f ? m.x : r.x; o.y = v.y < 0.f ? m.y : r.y; return o;
}

template <int ACT  > struct EpiBf16 {
    static constexpr bool PERM = true, AFTER_DRAIN = false; static_assert(ACT == 0 || ACT == 1, "EpiBf16: ACT is 0 (none) or 1 (gelu_pk)");
    bf16_t* O; int ldc; const float* bias; int split_cols; size_t split_stride; float scale0;
    __device__ __forceinline__ void operator()(const f32x4 (&acc)[2][2][4][2], const Unit& u, int wr, int wc, int fr, int fq) const {
        const int row0 = u.pm * BM + wr * 64 + fr; int colt = u.pn * BM; bf16_t* base = O;
        float sc = 1.f; if (split_cols) { const int t = colt / split_cols; base += (size_t)t * split_stride; colt -= t * split_cols; if (t == 0) sc = scale0; }
        const int col0 = colt + wc * 32 + 8 * fq, bcol0 = u.pn * BM + wc * 32 + 8 * fq;
        f32x4 bv[2][2];
#pragma unroll
        for (int bj = 0; bj < 2; ++bj)
#pragma unroll
            for (int n = 0; n < 2; ++n) bv[bj][n] = bias ? *(const f32x4*)(bias + bcol0 + bj * HALF + 4 * n) : (f32x4){0.f, 0.f, 0.f, 0.f};
#pragma unroll
        for (int ai = 0; ai < 2; ++ai)
#pragma unroll
            for (int m = 0; m < 4; ++m) { bf16_t* rowp = base + (size_t)(row0 + ai * HALF + m * 16) * ldc + col0;
#pragma unroll
                for (int bj = 0; bj < 2; ++bj) { f32x4 v0 = acc[ai][bj][m][0] + bv[bj][0], v1 = acc[ai][bj][m][1] + bv[bj][1];
                    if (ACT == 1) { f32x2 a = gelu_pk((f32x2){v0[0], v0[1]}), b = gelu_pk((f32x2){v0[2], v0[3]}), c = gelu_pk((f32x2){v1[0], v1[1]}), d = gelu_pk((f32x2){v1[2], v1[3]});
                        v0 = (f32x4){a.x, a.y, b.x, b.y}; v1 = (f32x4){c.x, c.y, d.x, d.y}; }
                    v0 = v0 * sc; v1 = v1 * sc; u32x4 w; w.x = cvt_pk_bf16(v0[0], v0[1]); w.y = cvt_pk_bf16(v0[2], v0[3]); w.z = cvt_pk_bf16(v1[0], v1[1]); w.w = cvt_pk_bf16(v1[2], v1[3]);
                    *(u32x4*)(rowp + bj * HALF) = w; } }
    }
};

template <class Epi, class Sched, bool ALIGN_EPI = false, bool SP2 = false>
__device__ __forceinline__ void gemm_phase(PG8_LAS unsigned char* lds, const Gemm g, const Sched& S, const Epi& E) {
    int tid_ = threadIdx.x; asm volatile("" : "+v"(tid_)); const int tid = tid_, wid = __builtin_amdgcn_readfirstlane(tid >> 6), lane = tid & 63, wr = wid >> 2, wc = wid & 3, fr = lane & 15, fq = lane >> 4;
    const int K = g.K, nt = K / BK;
    unsigned voffA[2], voffB[2];
#pragma unroll
    for (int i = 0; i < 2; ++i) { int R, C; stage_rc(tid * 16 + i * 8192, R, C); const int Rb = Epi::PERM ? ((R & ~31) + perm32(R & 31)) : R;
        voffA[i] = (unsigned)(R * g.lda + C) * 2u; voffB[i] = (unsigned)(Rb * K + C) * 2u; }
    const size_t kstep = (size_t)(BK * 2);
    const size_t hstep = (size_t)HALF * K * 2;
    const size_t hstepA = (size_t)HALF * g.lda * 2, tstepA = 2 * hstepA;
    const size_t tstep = 2 * hstep;
    const unsigned ldsw = (unsigned)wid * 1024u;
    const int aoff = lds_byte(wr * 64 + fr, fq * 8), boff = lds_byte(wc * 32 + fr, fq * 8);
#define PG8_SA(b, h) (((b) * 2 + (h)) * HTB)
#define PG8_SB(b, h) ((4 + (b) * 2 + (h)) * HTB)
#define PG8_STAGE(bufoff, gbase, voff) do { _Pragma("unroll") for (int _i = 0; _i < 2; ++_i) \
        __builtin_amdgcn_global_load_lds((const unsigned*)((const char*)(gbase) + (voff)[_i]), (PG8_LAS unsigned*)(lds + (bufoff) + ldsw + _i * 8192), 16, 0, 0); } while (0)
#define PG8_LDA(dst, b, h) do { _Pragma("unroll") for (int m = 0; m < 4; ++m) _Pragma("unroll") for (int k = 0; k < 2; ++k) dst[m][k] = *(const PG8_LAS bf16x8*)(lds + PG8_SA(b, h) + aoff + m * 2048 + k * 1024); } while (0)
#define PG8_LDB(dst, b, h) do { _Pragma("unroll") for (int n = 0; n < 2; ++n) _Pragma("unroll") for (int k = 0; k < 2; ++k) dst[n][k] = *(const PG8_LAS bf16x8*)(lds + PG8_SB(b, h) + boff + n * 2048 + k * 1024); } while (0)
#define PG8_MMA(ai, bj, At, Bt) do { __builtin_amdgcn_s_setprio(1); _Pragma("unroll") for (int m = 0; m < 4; ++m) _Pragma("unroll") for (int n = 0; n < 2; ++n) _Pragma("unroll") for (int k = 0; k < 2; ++k) \
        acc[ai][bj][m][n] = __builtin_amdgcn_mfma_f32_16x16x32_bf16(Bt[n][k], At[m][k], acc[ai][bj][m][n], 0, 0, 0); __builtin_amdgcn_s_setprio(0); } while (0)
#define PG8_WAIT_V(n) asm volatile("s_waitcnt vmcnt(" #n ")" ::: "memory")
#define PG8_WAIT_L(n) asm volatile("s_waitcnt lgkmcnt(" #n ")" ::: "memory")
#define PG8_BAR __builtin_amdgcn_s_barrier()
#define PG8_SCHED __builtin_amdgcn_sched_barrier(0)
    Unit cur, nxt; int ui = 0;
    if (!S.next(0, cur)) return;
    f32x4 acc[2][2][4][2];
#pragma unroll
    for (int a = 0; a < 2; ++a)
#pragma unroll
        for (int b = 0; b < 2; ++b)
#pragma unroll
            for (int m = 0; m < 4; ++m)
#pragma unroll
                for (int n = 0; n < 2; ++n) acc[a][b][m][n] = (f32x4){0.f, 0.f, 0.f, 0.f};
    bf16x8 At[4][2], B0[2][2], B1[2][2];
    const char* cA = (const char*)g.A + (size_t)cur.pm * tstepA + (size_t)cur.aoff * 2; const char* cB = (const char*)g.Bt + (size_t)cur.pn * tstep;
    S.a_ready(cur);
    if constexpr (SP2) {
        PG8_STAGE(PG8_SB(0, 0), cB, voffB); PG8_STAGE(PG8_SB(0, 1), cB + hstep, voffB); PG8_STAGE(PG8_SA(0, 0), cA, voffA); PG8_STAGE(PG8_SA(0, 1), cA + hstepA, voffA);
        if (wr == 1) PG8_BAR;
        PG8_WAIT_V(2); PG8_BAR;
        PG8_STAGE(PG8_SB(1, 0), cB + kstep, voffB); PG8_STAGE(PG8_SA(1, 0), cA + kstep, voffA); PG8_STAGE(PG8_SB(1, 1), cB + hstep + kstep, voffB);
        PG8_WAIT_V(6); PG8_BAR;
    } else {
        PG8_STAGE(PG8_SB(0, 0), cB, voffB); PG8_STAGE(PG8_SA(0, 0), cA, voffA); PG8_STAGE(PG8_SB(0, 1), cB + hstep, voffB); PG8_STAGE(PG8_SA(0, 1), cA + hstepA, voffA);
        if (wr == 1) PG8_BAR;
        PG8_WAIT_V(4); PG8_BAR;
        PG8_STAGE(PG8_SB(1, 0), cB + kstep, voffB); PG8_STAGE(PG8_SA(1, 0), cA + kstep, voffA); PG8_STAGE(PG8_SB(1, 1), cB + hstep + kstep, voffB);
        PG8_WAIT_V(6); PG8_BAR;
    }
    for (;;) {
        const bool has_next = S.next(ui + 1, nxt);
        const char* nA = has_next ? (const char*)g.A + (size_t)nxt.pm * tstepA + (size_t)nxt.aoff * 2 : cA; const char* nB = has_next ? (const char*)g.Bt + (size_t)nxt.pn * tstep : cB;
        for (int t = 0; t < nt; t += 2) {
            const bool last = (t == nt - 2);
            const char* a1 = cA + (size_t)(t + 1) * kstep;
            const char* a2 = last ? nA : cA + (size_t)(t + 2) * kstep; const char* b2 = last ? nB : cB + (size_t)(t + 2) * kstep;
            const char* a3 = a2 + kstep; const char* b3 = b2 + kstep;
            if (last && has_next) S.a_ready(nxt);
            if constexpr (SP2) {
            PG8_LDB(B0, 0, 0); PG8_LDB(B1, 0, 1); PG8_SCHED; PG8_LDA(At, 0, 0); PG8_STAGE(PG8_SA(1, 1), a1 + hstepA, voffA);
            PG8_WAIT_V(8); PG8_WAIT_L(0); PG8_BAR; PG8_MMA(0, 0, At, B0); PG8_MMA(0, 1, At, B1); PG8_BAR; PG8_SCHED;
            PG8_LDA(At, 0, 1); PG8_STAGE(PG8_SB(0, 0), b2, voffB); PG8_STAGE(PG8_SB(0, 1), b2 + hstep, voffB); PG8_STAGE(PG8_SA(0, 0), a2, voffA);
            PG8_WAIT_V(8); PG8_WAIT_L(0); PG8_BAR; PG8_MMA(1, 0, At, B0); PG8_MMA(1, 1, At, B1); PG8_BAR; PG8_SCHED;
            PG8_LDB(B0, 1, 0); PG8_LDB(B1, 1, 1); PG8_SCHED; PG8_LDA(At, 1, 0); PG8_STAGE(PG8_SA(0, 1), a2 + hstepA, voffA);
            PG8_WAIT_V(8); PG8_WAIT_L(0); PG8_BAR; PG8_MMA(0, 0, At, B0); PG8_MMA(0, 1, At, B1); PG8_BAR; PG8_SCHED;
            PG8_LDA(At, 1, 1); PG8_STAGE(PG8_SB(1, 0), b3, voffB); PG8_STAGE(PG8_SB(1, 1), b3 + hstep, voffB); PG8_STAGE(PG8_SA(1, 0), a3, voffA);
            PG8_WAIT_V(8); PG8_WAIT_L(0); PG8_BAR; PG8_MMA(1, 0, At, B0); PG8_MMA(1, 1, At, B1); PG8_BAR; PG8_SCHED;
            } else {
            PG8_LDB(B0, 0, 0); PG8_SCHED; PG8_LDA(At, 0, 0); PG8_STAGE(PG8_SA(1, 1), a1 + hstepA, voffA);
            PG8_WAIT_L(8); PG8_BAR; PG8_WAIT_L(0); PG8_MMA(0, 0, At, B0); PG8_BAR; PG8_SCHED;
            PG8_LDB(B1, 0, 1); PG8_STAGE(PG8_SB(0, 0), b2, voffB);
            PG8_BAR; PG8_WAIT_L(0); PG8_MMA(0, 1, At, B1); PG8_BAR;
            PG8_LDA(At, 0, 1); PG8_STAGE(PG8_SA(0, 0), a2, voffA);
            PG8_BAR; PG8_WAIT_L(0); PG8_MMA(1, 0, At, B0); PG8_BAR; PG8_SCHED;
            PG8_STAGE(PG8_SB(0, 1), b2 + hstep, voffB);
            PG8_WAIT_V(6); PG8_BAR; PG8_MMA(1, 1, At, B1); PG8_BAR;
            PG8_LDB(B0, 1, 0); PG8_SCHED; PG8_LDA(At, 1, 0); PG8_STAGE(PG8_SA(0, 1), a2 + hstepA, voffA);
            PG8_WAIT_L(8); PG8_BAR; PG8_WAIT_L(0); PG8_MMA(0, 0, At, B0); PG8_BAR; PG8_SCHED;
            PG8_LDB(B1, 1, 1); PG8_STAGE(PG8_SB(1, 0), b3, voffB);
            PG8_BAR; PG8_WAIT_L(0); PG8_MMA(0, 1, At, B1); PG8_BAR;
            PG8_LDA(At, 1, 1); PG8_STAGE(PG8_SA(1, 0), a3, voffA);
            PG8_BAR; PG8_WAIT_L(0); PG8_MMA(1, 0, At, B0); PG8_BAR; PG8_SCHED;
            PG8_STAGE(PG8_SB(1, 1), b3 + hstep, voffB);
            PG8_WAIT_V(6); PG8_BAR; PG8_MMA(1, 1, At, B1); PG8_BAR;
            }
        }
        if constexpr (ALIGN_EPI) { if (wr == 0) PG8_BAR; }
        if constexpr (!Epi::AFTER_DRAIN) { E(acc, cur, wr, wc, fr, fq); S.done(cur); }
        if (!has_next) break;
#pragma unroll
        for (int a = 0; a < 2; ++a)
#pragma unroll
            for (int b = 0; b < 2; ++b)
#pragma unroll
                for (int m = 0; m < 4; ++m)
#pragma unroll
                    for (int n = 0; n < 2; ++n) acc[a][b][m][n] = (f32x4){0.f, 0.f, 0.f, 0.f};
        cur = nxt; cA = nA; cB = nB; ++ui;
        if constexpr (ALIGN_EPI) { if (wr == 1) PG8_BAR; }
    }
    PG8_WAIT_V(0);
    if constexpr (!ALIGN_EPI) { if (wr == 0) PG8_BAR; }
    PG8_BAR;
    if constexpr (Epi::AFTER_DRAIN) { E.fused(acc, cur, wr, wc, fr, fq, lds, wid, lane); S.done(cur); }
#undef PG8_SA
#undef PG8_SB
#undef PG8_STAGE
#undef PG8_LDA
#undef PG8_LDB
#undef PG8_MMA
#undef PG8_WAIT_V
#undef PG8_WAIT_L
#undef PG8_BAR
#undef PG8_SCHED
}
}
#ifndef FX_REPEAT_KIND
#define FX_REPEAT_KIND 0
#endif
#ifndef FX_STG
#define FX_STG false
#endif
#ifndef FX_SWEEP2
#define FX_SWEEP2 0
#endif
#ifndef FX_QKDB
#define FX_QKDB false
#endif
#ifndef FX_VPRE
#define FX_VPRE 2
#endif
#ifndef FX_PRO_MATS
#define FX_PRO_MATS 28
#endif
#ifndef FX_PRIO
#define FX_PRIO 0
#endif
#ifndef FX_LATE
#define FX_LATE(w) ((w) >= 4)
#endif
#ifdef PROBE_SEC
#define PSEC_B(id) do { if ((id) == PROBE_SEC) { __syncthreads(); c.pr_t = __builtin_amdgcn_s_memrealtime(); } } while (0)
#define PSEC_E(id) do { if ((id) == PROBE_SEC) { __syncthreads(); c.pr_acc += (unsigned)(__builtin_amdgcn_s_memrealtime() - c.pr_t); } } while (0)
#else
#define PSEC_B(id) do {} while (0)
#define PSEC_E(id) do {} while (0)
#endif
#ifdef PROBE_SEC
#define PSW_B(id) do { if ((id) == PROBE_SEC) c.pr_t = __builtin_amdgcn_s_memrealtime(); } while (0)
#define PSW_DRAIN() do { if (PROBE_SEC == 23 || PROBE_SEC == 25) asm volatile("s_waitcnt vmcnt(0) lgkmcnt(0)" ::: "memory"); } while (0)
#define PSW_E(id) do { if ((id) == PROBE_SEC) c.pr_acc += (unsigned)(__builtin_amdgcn_s_memrealtime() - c.pr_t); } while (0)
#else
#define PSW_B(id) do {} while (0)
#define PSW_E(id) do {} while (0)
#define PSW_DRAIN() do {} while (0)
#endif
#define REP(kind) for (int rep_ = 0; rep_ < ((FX_REPEAT_KIND == (kind)) ? 2 : 1); ++rep_)
namespace fx {
#define DI __device__ __forceinline__
#define LAS __attribute__((address_space(3)))
typedef unsigned short bf16_t;
typedef short bf16x8 __attribute__((ext_vector_type(8)));
typedef short s16x4 __attribute__((ext_vector_type(4)));
typedef float f32x4 __attribute__((ext_vector_type(4)));
typedef float f32x16 __attribute__((ext_vector_type(16)));
typedef unsigned u32x4 __attribute__((ext_vector_type(4)));
typedef unsigned u32x2 __attribute__((ext_vector_type(2)));
constexpr int B = 8, S = 2048, D = 1024, T = B * S, FF = 4096, HYIN = 1848, UW = 2048;
constexpr float EPS = 1e-6f, LOG2E = 1.4426950408889634f;
constexpr int NW = 8, NT = 512;
constexpr size_t MiB = 1u << 20;
constexpr size_t WS_CTL = 0;
constexpr size_t WS_MOD = 1 * MiB;
constexpr size_t WS_CS8 = 2 * MiB;
constexpr size_t WS_CS16 = 3 * MiB;
constexpr size_t WS_MISC = 5 * MiB;
constexpr size_t WS_W = 6 * MiB;
constexpr size_t W_EVEN = 9 * MiB, W_ODD = 8 * MiB, W_MLP = 16 * MiB;
constexpr size_t WE_IN = 0, WE_OUT = 4 * MiB, WE_UP = 6 * MiB, WE_C1 = 7 * MiB, WE_C2 = 8 * MiB;
constexpr size_t WO_QKV = 0, WO_O = 6 * MiB;
constexpr size_t WS_WEVEN = WS_W, WS_WODD = WS_W + 2 * W_EVEN, WS_WMLP = WS_WODD + 2 * W_ODD;
constexpr size_t WS_XN = 104 * MiB;
constexpr size_t WS_YC = 136 * MiB;
constexpr size_t WS_BIG = 168 * MiB;
constexpr size_t BIG_U = 0, BIG_UP = 64 * MiB + 64 * 1024;
constexpr int UPW = 1792;
constexpr size_t WS_FAST_END = 296 * MiB;
constexpr size_t WS_SS = 332 * MiB;
constexpr size_t WS_SHW = 296 * MiB;
constexpr size_t WS_XB = 300 * MiB;
constexpr size_t WS_NAIVE = 300 * MiB;
constexpr int LDS_MISC = 131072, LDS_BYTES = 147456;

DI unsigned f2bf(float f) { unsigned u = __builtin_bit_cast(unsigned, f); return (u + 0x7fffu + ((u >> 16) & 1u)) >> 16; }
DI unsigned pk2(float lo, float hi) { return f2bf(lo) | (f2bf(hi) << 16); }
DI float bf2f(unsigned short b) { return __builtin_bit_cast(float, (unsigned)b << 16); }
DI float bflo(unsigned u) { return __builtin_bit_cast(float, u << 16); }
DI float bfhi(unsigned u) { return __builtin_bit_cast(float, u & 0xffff0000u); }
typedef short v4i16_t_ __attribute__((ext_vector_type(4)));
DI s16x4 vtr(const LAS char* p) { return __builtin_bit_cast(s16x4, __builtin_amdgcn_ds_read_tr16_b64_v4i16((LAS v4i16_t_*)p)); }
template <int O> DI float swz(float v) { static_assert(O < 32, "swz: xor mask < 32"); return __builtin_bit_cast(float, __builtin_amdgcn_ds_swizzle(__builtin_bit_cast(int, v), (O << 10) | 0x1f)); }
template <int O> DI unsigned swzu(unsigned v) { return (unsigned)__builtin_amdgcn_ds_swizzle((int)v, (O << 10) | 0x1f); }
DI void xchg32(unsigned& a, unsigned& b) { asm volatile("s_nop 1\n\tv_permlane32_swap_b32 %0, %1\n\ts_nop 1" : "+v"(a), "+v"(b)); }
DI float sum32(float v) { unsigned a = __builtin_bit_cast(unsigned, v), b = a; xchg32(a, b); return __builtin_bit_cast(float, a) + __builtin_bit_cast(float, b); }
DI float max32(float v) { unsigned a = __builtin_bit_cast(unsigned, v), b = a; xchg32(a, b); return fmaxf(__builtin_bit_cast(float, a), __builtin_bit_cast(float, b)); }
DI unsigned or32(unsigned v) { unsigned a = v, b = v; xchg32(a, b); return a | b; }
#ifdef DBG_SHFL
DI float wave_sum(float v) { for (int o = 1; o < 64; o <<= 1) v += __shfl_xor(v, o); return v; }
#else
DI float wave_sum(float v) { v += swz<1>(v); v += swz<2>(v); v += swz<4>(v); v += swz<8>(v); v += swz<16>(v); return sum32(v); }
#endif

struct Args { const float* in[28]; const int* pos; float* out; unsigned char* ws; int ph_lo, ph_hi; int use_cg; int pad; };
typedef const __attribute__((address_space(4))) Args CArgs;
#define XB_TMO      128
#define XB_XCNT(j)  (256  + 64 * (j))
#define XB_XSUB(j)  (1280 + 64 * (j))
#define XB_XGEN(j)  (2304 + 64 * (j))
#define XB_TOP      3328
#define XB_TOPGEN   3392
#define XCD_BAR_WORDS 3456
#define XB_SPIN_CAP (1u << 20)
DI unsigned xb_ld(unsigned* p)              { return __hip_atomic_load(p, __ATOMIC_RELAXED, __HIP_MEMORY_SCOPE_AGENT); }
DI unsigned xb_add(unsigned* p, unsigned v) { return __hip_atomic_fetch_add(p, v, __ATOMIC_RELAXED, __HIP_MEMORY_SCOPE_AGENT); }
DI unsigned xb_xcc_id() { return (unsigned)__builtin_amdgcn_s_getreg((3 << 11) | 20) & 0xFu; }
#define XB_SPIN(cond, bar) do { unsigned _sp = 0; while (cond) { __builtin_amdgcn_s_sleep(1); \
    if ((++_sp & 255u) == 0u) { if (xb_ld(&(bar)[XB_TMO])) break; if (_sp > XB_SPIN_CAP) { atomicAdd(&(bar)[XB_TMO], 1u); break; } } } } while (0)
struct XcdBarrier { unsigned* bar; unsigned x; volatile LAS unsigned* st; };
DI XcdBarrier xcd_barrier_post(unsigned* bar, volatile LAS unsigned* st) {
    XcdBarrier b; b.bar = bar; b.x = xb_xcc_id(); b.st = st;
    if (threadIdx.x == 0) (void)xb_add(&bar[XB_XCNT(b.x)], 1u);
    return b;
}
DI void xcd_barrier_complete(unsigned* bar, unsigned x, unsigned& nloc, unsigned& nx) {
    const unsigned G = gridDim.x * gridDim.y * gridDim.z;
    unsigned sum, cnt, mine, sp = 0u;
    for (;;) {
        sum = 0u; cnt = 0u; mine = 0u;
#pragma unroll
        for (unsigned j = 0; j < 16; ++j) { const unsigned c = xb_ld(&bar[XB_XCNT(j)]); sum += c; cnt += (c > 0u) ? 1u : 0u; mine = (j == x) ? c : mine; }
        if (sum == G) break;
        __builtin_amdgcn_s_sleep(1);
        if ((++sp & 255u) == 0u) { if (xb_ld(&bar[XB_TMO])) break; if (sp > XB_SPIN_CAP) { atomicAdd(&bar[XB_TMO], 1u); break; } }
    }
    nloc = mine > 0u ? mine : 1u; nx = cnt > 0u ? cnt : 1u;
}
DI void xcd_barrier(const XcdBarrier& b) {
    asm volatile("s_waitcnt vmcnt(0)" ::: "memory");
    __syncthreads();
    int t0_ = threadIdx.x; asm volatile("" : "+v"(t0_));
    if (t0_ == 0) {
        unsigned* bar; { CArgs* p_ = (CArgs*)__builtin_amdgcn_kernarg_segment_ptr(); asm volatile("" : "+s"(p_)); bar = (unsigned*)(p_->ws + WS_CTL) + 4096; }
        __builtin_amdgcn_s_waitcnt(0);
        unsigned nloc = b.st[0], nx = b.st[1];
        unsigned bx = b.x; asm volatile("" : "+s"(bx));
        if (nloc == 0u) { xcd_barrier_complete(bar, bx, nloc, nx); b.st[0] = nloc; b.st[1] = nx; }
        const unsigned old = xb_add(&bar[XB_XSUB(bx)], 1u);
        const unsigned gen = old / nloc;
        if (old + 1u == (gen + 1u) * nloc) {
            __builtin_amdgcn_fence(__ATOMIC_RELEASE, "agent");
            asm volatile("s_waitcnt vmcnt(0)" ::: "memory");
            const unsigned og = xb_add(&bar[XB_TOP], 1u);
            const unsigned tg = og / nx;
            if (og + 1u == (tg + 1u) * nx) xb_add(&bar[XB_TOPGEN], 1u);
            else XB_SPIN(xb_ld(&bar[XB_TOPGEN]) == tg, bar);
            __builtin_amdgcn_fence(__ATOMIC_ACQUIRE, "agent");
            xb_add(&bar[XB_XGEN(bx)], 1u);
            asm volatile("s_waitcnt vmcnt(0)" ::: "memory");
        } else {
            XB_SPIN(xb_ld(&bar[XB_XGEN(bx)]) == gen, bar);
            __builtin_amdgcn_fence(__ATOMIC_ACQUIRE, "agent");
            asm volatile("s_waitcnt vmcnt(0)" ::: "memory");
        }
    }
    __syncthreads();
}

struct Ctx {
    LAS unsigned char* lds; int tid, lane, wave, G, bid; unsigned char* ws; int var; unsigned pr_acc; unsigned long long pr_t; CArgs* a;
};
#define RELAUNDER(c) do { int t_ = threadIdx.x; asm volatile("" : "+v"(t_)); (c).tid = t_; (c).lane = t_ & 63; int b_ = blockIdx.x, g_ = gridDim.x; asm volatile("" : "+s"(b_), "+s"(g_)); (c).bid = b_; (c).G = g_; } while (0)

struct TrRegs { f32x4 tv[8]; };
constexpr int TRS = 544;
DI void transpose_load(TrRegs& r, const float* W, int ld, int N, int item, int nblk, int wave, int lane) {
    const int k0 = 64 * (item / nblk) + 8 * wave, n = 256 * (item % nblk) + 4 * lane;
#pragma unroll
    for (int i = 0; i < 8; ++i) { r.tv[i] = (f32x4){0.f, 0.f, 0.f, 0.f}; if (n < N) r.tv[i] = *(const f32x4*)(W + (size_t)(k0 + i) * ld + n); }
}
DI void transpose_finish(const TrRegs& r, int K, int Npad, bf16_t* WT, const float* kscale, LAS char* img, int item, int nblk, int wave, int lane) {
    const int k0 = 64 * (item / nblk), n0 = 256 * (item % nblk);
#pragma unroll
    for (int i = 0; i < 8; ++i) { f32x4 v = r.tv[i]; if (kscale) v = v * kscale[k0 + 8 * wave + i];
        u32x2 w; w.x = pk2(v.x, v.y); w.y = pk2(v.z, v.w); *(LAS u32x2*)(img + (8 * wave + i) * TRS + lane * 8) = w; }
    __syncthreads();
    const int g = lane >> 4, i16 = lane & 15, q = i16 >> 2, p = i16 & 3;
#pragma unroll
    for (int j = 0; j < 4; ++j) { const int kc = 4 * (j & 1) + g, nb = 2 * wave + (j >> 1);
        const LAS char* rb = img + (8 * kc + q) * TRS + (16 * nb + 4 * p) * 2;
        const s16x4 lo = vtr(rb), hi = vtr(rb + 4 * TRS);
        const int nn = n0 + 16 * nb + i16;
        if (nn < Npad) *(bf16x8*)(WT + (size_t)nn * K + k0 + 8 * kc) = __builtin_shufflevector(lo, hi, 0, 1, 2, 3, 4, 5, 6, 7); }
    __syncthreads();
}
struct MatDesc { const float* src; int ld, K, N, Npad; bf16_t* dst; const float* kscale; };
DI MatDesc get_mat(CArgs& a, unsigned char* ws, int idx) {
    MatDesc m; m.kscale = nullptr;
    if (idx < 16) { const int j = idx >> 3, t = idx & 7; unsigned char* base = ws + WS_WEVEN + j * W_EVEN;
        if (t == 0) { m.src = a.in[9] + (size_t)j * D * HYIN; m.ld = HYIN; m.K = D; m.N = HYIN; m.Npad = UW; m.dst = (bf16_t*)(base + WE_IN); }
        else if (t == 1) { m.src = a.in[10] + (size_t)j * D * D; m.ld = D; m.K = D; m.N = D; m.Npad = D; m.dst = (bf16_t*)(base + WE_OUT); }
        else if (t == 2) { m.src = a.in[12] + (size_t)j * 256 * 768; m.ld = 768; m.K = 256; m.N = 768; m.Npad = 768; m.dst = (bf16_t*)(base + WE_UP); m.kscale = a.in[11] + j * 256; }
        else if (t == 3) { m.src = a.in[14] + (size_t)j * 256 * 1024; m.ld = 1024; m.K = 256; m.N = 1024; m.Npad = 1024; m.dst = (bf16_t*)(base + WE_UP) + 768 * 256; m.kscale = a.in[13] + j * 256; }
        else if (t < 6) { const int jj = t - 4; m.src = a.in[20] + ((size_t)j * 2 + jj) * 2048 * 128; m.ld = 128; m.K = 2048; m.N = 128; m.Npad = 128; m.dst = (bf16_t*)(base + WE_C1) + (size_t)jj * 128 * 2048; }
        else { const int jj = t - 6; m.src = a.in[21] + ((size_t)j * 2 + jj) * 128 * 64; m.ld = 64; m.K = 128; m.N = 64; m.Npad = 64; m.dst = (bf16_t*)(base + WE_C2) + (size_t)jj * 64 * 128; }
    } else if (idx < 20) { const int j = (idx - 16) >> 1, t = idx & 1; unsigned char* base = ws + WS_WODD + j * W_ODD;
        if (t == 0) { m.src = a.in[22] + (size_t)j * D * 3072; m.ld = 3072; m.K = D; m.N = 3072; m.Npad = 3072; m.dst = (bf16_t*)(base + WO_QKV); }
        else { m.src = a.in[23] + (size_t)j * D * D; m.ld = D; m.K = D; m.N = D; m.Npad = D; m.dst = (bf16_t*)(base + WO_O); }
    } else { const int i = (idx - 20) >> 1, t = idx & 1; unsigned char* base = ws + WS_WMLP + i * W_MLP;
        if (t == 0) { m.src = a.in[7] + (size_t)i * D * FF; m.ld = FF; m.K = D; m.N = FF; m.Npad = FF; m.dst = (bf16_t*)base; }
        else { m.src = a.in[8] + (size_t)i * FF * D; m.ld = D; m.K = FF; m.N = D; m.Npad = D; m.dst = (bf16_t*)(base + 8 * MiB); }
    }
    return m;
}
DI void convert_mats(Ctx& c, int lo, int hi) {
    CArgs& a = *c.a; unsigned char* ws = c.ws; LAS char* img = (LAS char*)c.lds;
    int base = 0;
    for (int mi = lo; mi < hi; ++mi) {
        const MatDesc m = get_mat(a, ws, mi); const int nblk = (m.Npad + 255) / 256, nit = (m.K / 64) * nblk;
        for (int it = (c.bid + c.G - (base % c.G)) % c.G; it < nit; it += 2 * c.G) {
            TrRegs ra, rb2; const int it2 = it + c.G; transpose_load(ra, m.src, m.ld, m.N, it, nblk, c.wave, c.lane); if (it2 < nit) transpose_load(rb2, m.src, m.ld, m.N, it2, nblk, c.wave, c.lane);
            transpose_finish(ra, m.K, m.Npad, m.dst, m.kscale, img, it, nblk, c.wave, c.lane); if (it2 < nit) transpose_finish(rb2, m.K, m.Npad, m.dst, m.kscale, img, it2, nblk, c.wave, c.lane); }
        base += nit;
    }
}
DI void phase_prologue(Ctx& c) {
    CArgs& a = *c.a; unsigned char* ws = c.ws;
    const int gw = c.bid * NW + c.wave, NGW = c.G * NW;
    LAS float* cond = (LAS float*)(c.lds + 98304);
    for (int i = c.tid; i < 8192; i += NT) { float v = a.in[1][i]; cond[i] = v / (1.f + __expf(-v)); }
    __syncthreads();
    float* mod = (float*)(ws + WS_MOD);
    LAS float* red = (LAS float*)c.lds;
    REP(18) for (int it = c.bid; it < 384; it += c.G) {
        const int n = it * 64 + c.lane; const int li = n / 6144, nn = n % 6144;
        const float* w = a.in[3] + (size_t)li * D * 6144 + (size_t)(c.wave * 128) * 6144 + nn; float acc[8] = {0, 0, 0, 0, 0, 0, 0, 0};
#pragma unroll 32
        for (int k = 0; k < 128; ++k) { const float wv = w[(size_t)k * 6144];
#pragma unroll
            for (int b = 0; b < 8; ++b) acc[b] += cond[b * D + c.wave * 128 + k] * wv; }
#pragma unroll
        for (int b = 0; b < 8; ++b) red[(c.wave * 8 + b) * 64 + c.lane] = acc[b];
        __syncthreads();
        { const int b = c.wave; float s = 0.f;
#pragma unroll
          for (int ww = 0; ww < 8; ++ww) s += red[(ww * 8 + b) * 64 + c.lane];
          mod[((size_t)li * 8 + b) * 6144 + nn] = s + a.in[4][li * 6144 + nn]; }
        __syncthreads();
    }
    { float* P = (float*)(ws + WS_MISC);
      for (int it = gw; it < 256; it += NGW) { const int jj2 = it >> 6, kc = (it >> 1) & 31, n = (it & 1) * 64 + c.lane;
          const float* cp = a.in[19] + (size_t)jj2 * 2048 + kc * 64; const float* w = a.in[20] + (size_t)jj2 * 2048 * 128 + (size_t)(kc * 64) * 128 + n; float acc = 0.f;
#pragma unroll 16
          for (int k = 0; k < 64; ++k) acc += cp[k] * w[(size_t)k * 128];
          P[(jj2 * 32 + kc) * 128 + n] = acc; } }
    REP(16) convert_mats(c, 0, FX_PRO_MATS);
    { float* cs8 = (float*)(ws + WS_CS8); float* cs16 = (float*)(ws + WS_CS16);
      REP(17) for (int g = c.bid * NT + c.tid; g < T * 24; g += c.G * NT) { const int m = g / 24, i = g % 24; const double p = (double)a.pos[m];
          if (i < 8) { const double f = pow(500000.0, -(double)i / 8.0), an = p * f; cs8[(m * 8 + i) * 2] = (float)cos(an); cs8[(m * 8 + i) * 2 + 1] = (float)sin(an); }
          else { const int k = i - 8; const double f = pow(500000.0, -(double)k / 16.0), an = p * f; cs16[(m * 16 + k) * 2] = (float)cos(an); cs16[(m * 16 + k) * 2 + 1] = (float)sin(an); } } }
}

DI void shw_items(Ctx& c, int set) {
    unsigned char* ws = c.ws; const int lane = c.lane, r16 = lane & 15, q4 = lane >> 4;
    LAS bf16_t* shl = (LAS bf16_t*)c.lds;
    for (int it = c.bid; it < 96; it += c.G) {
        int g, r = it;
        if (set == 0) { if (r < 32) g = 1; else if ((r -= 32) < 24) g = 2; else if ((r -= 24) < 16) g = 4; else { r -= 16; g = 6; } }
        else { g = 3 + 2 * (r >> 5); r &= 31; }
        const int layer = g >> 1, sub = g & 1;
        const bf16_t* Wt = sub ? (const bf16_t*)(ws + WS_WMLP + (size_t)layer * W_MLP) : ((layer & 1) ? (const bf16_t*)(ws + WS_WODD + (size_t)(layer >> 1) * W_ODD + WO_QKV) : (const bf16_t*)(ws + WS_WEVEN + (size_t)(layer >> 1) * W_EVEN + WE_IN));
        const float* sh = (const float*)(ws + WS_MOD) + (size_t)layer * 8 * 6144 + (sub ? 3072 : 0);
        __syncthreads();
        { const int b = c.tid >> 6, k0 = (c.tid & 63) * 16; const float* sp = sh + (size_t)b * 6144 + k0;
          const f32x4 a0 = *(const f32x4*)sp, a1 = *(const f32x4*)(sp + 4), a2 = *(const f32x4*)(sp + 8), a3 = *(const f32x4*)(sp + 12);
          u32x4 w0, w1; w0.x = pk2(a0.x, a0.y); w0.y = pk2(a0.z, a0.w); w0.z = pk2(a1.x, a1.y); w0.w = pk2(a1.z, a1.w); w1.x = pk2(a2.x, a2.y); w1.y = pk2(a2.z, a2.w); w1.z = pk2(a3.x, a3.y); w1.w = pk2(a3.z, a3.w);
          *(LAS u32x4*)(shl + b * 1032 + k0) = w0; *(LAS u32x4*)(shl + b * 1032 + k0 + 8) = w1; }
        __syncthreads();
        const int row0 = r * 128 + c.wave * 16;
        const bf16_t* wr = Wt + (size_t)(row0 + r16) * D + 8 * q4;
        const LAS bf16_t* bp = shl + (r16 & 7) * 1032 + 8 * q4;
        f32x4 acc = (f32x4){0.f, 0.f, 0.f, 0.f};
#pragma unroll 1
        for (int k0 = 0; k0 < 32; k0 += 16) {
            bf16x8 af[16];
#pragma unroll
            for (int i = 0; i < 16; ++i) af[i] = *(const bf16x8*)(wr + 32 * (k0 + i));
#pragma unroll
            for (int i = 0; i < 16; ++i) { bf16x8 bfr = *(const LAS bf16x8*)(bp + 32 * (k0 + i)); if (r16 >= 8) bfr = (bf16x8){0, 0, 0, 0, 0, 0, 0, 0};
                acc = __builtin_amdgcn_mfma_f32_16x16x32_bf16(af[i], bfr, acc, 0, 0, 0); }
        }
        if (r16 < 8) { float* o = (float*)(ws + WS_SHW) + (size_t)g * 8 * 4096 + (size_t)r16 * 4096 + row0 + q4 * 4; *(f32x4*)o = acc; }
    }
    __syncthreads();
}
DI void phase_modnorm(Ctx& c, const float* x, const float* gain, const float* sh, const float* sc, bf16_t* XN) {
    const int gw = c.bid * NW + c.wave, NGW = c.G * NW; constexpr int RB = 8;
    for (int m0 = gw; m0 < T; m0 += NGW * RB) {
        f32x4 v[RB][4]; float rs[RB];
#pragma unroll
        for (int t = 0; t < RB; ++t) { const int m = m0 + t * NGW; const f32x4* xr = (const f32x4*)(x + (size_t)(m < T ? m : 0) * D) + c.lane;
#pragma unroll
            for (int j = 0; j < 4; ++j) v[t][j] = xr[64 * j]; }
#pragma unroll
        for (int t = 0; t < RB; ++t) { float s = 0.f;
#pragma unroll
            for (int j = 0; j < 4; ++j) s += (v[t][j].x * v[t][j].x + v[t][j].y * v[t][j].y) + (v[t][j].z * v[t][j].z + v[t][j].w * v[t][j].w);
            rs[t] = s; }
#pragma unroll
        for (int t = 0; t < RB; ++t) rs[t] = rsqrtf(wave_sum(rs[t]) * (1.f / D) + EPS);
#pragma unroll
        for (int t = 0; t < RB; ++t) { const int m = m0 + t * NGW; if (m >= T) continue; const int b = m >> 11;
#pragma unroll
            for (int j = 0; j < 4; ++j) { const int n = 4 * c.lane + 256 * j; const f32x4 g = *(const f32x4*)(gain + n), sv = *(const f32x4*)(sc + b * 6144 + n), hv = *(const f32x4*)(sh + b * 6144 + n);
                f32x4 y; y.x = v[t][j].x * rs[t] * g.x * (1.f + sv.x) + hv.x; y.y = v[t][j].y * rs[t] * g.y * (1.f + sv.y) + hv.y; y.z = v[t][j].z * rs[t] * g.z * (1.f + sv.z) + hv.z; y.w = v[t][j].w * rs[t] * g.w * (1.f + sv.w) + hv.w;
                u32x2 o; o.x = pk2(y.x, y.y); o.y = pk2(y.z, y.w); *(u32x2*)(XN + (size_t)m * D + n) = o; } }
    }
}
constexpr int TB = 8;
constexpr int TBV = 4;
template <int TBV> DI void head64_vec(bf16_t* const (&p)[TBV], bool act, const float* gain, const float* const (&tab)[TBV], float scale, int lane) {
    const int sub = lane & 7; float x[TBV][8], ss[TBV];
#pragma unroll
    for (int t = 0; t < TBV; ++t) { u32x4 v = (u32x4){0u, 0u, 0u, 0u}; if (act) v = *(const u32x4*)p[t];
        x[t][0] = bflo(v.x); x[t][1] = bfhi(v.x); x[t][2] = bflo(v.y); x[t][3] = bfhi(v.y); x[t][4] = bflo(v.z); x[t][5] = bfhi(v.z); x[t][6] = bflo(v.w); x[t][7] = bfhi(v.w); }
#pragma unroll
    for (int t = 0; t < TBV; ++t) { float s = 0.f;
#pragma unroll
        for (int e = 0; e < 8; ++e) s += x[t][e] * x[t][e];
        ss[t] = s; }
#pragma unroll
    for (int t = 0; t < TBV; ++t) ss[t] += swz<1>(ss[t]);
#pragma unroll
    for (int t = 0; t < TBV; ++t) ss[t] += swz<2>(ss[t]);
#pragma unroll
    for (int t = 0; t < TBV; ++t) ss[t] += swz<4>(ss[t]);
    const f32x4 ga = *(const f32x4*)(gain + 8 * sub), gb = *(const f32x4*)(gain + 8 * sub + 4);
    const float g[8] = {ga.x, ga.y, ga.z, ga.w, gb.x, gb.y, gb.z, gb.w};
#pragma unroll
    for (int t = 0; t < TBV; ++t) { const float rs = rsqrtf(ss[t] * (1.f / 64.f) + EPS);
        float y[8], o[8];
#pragma unroll
        for (int e = 0; e < 8; ++e) { y[e] = x[t][e] * rs * g[e]; o[e] = swz<1>(y[e]); }
        if (sub < 2) {
            const f32x4 t0 = *(const f32x4*)(tab[t]), t1 = *(const f32x4*)(tab[t] + 4), t2 = *(const f32x4*)(tab[t] + 8), t3 = *(const f32x4*)(tab[t] + 12);
            const float cs[8] = {t0.x, t0.z, t1.x, t1.z, t2.x, t2.z, t3.x, t3.z}, sn[8] = {t0.y, t0.w, t1.y, t1.w, t2.y, t2.w, t3.y, t3.w};
#pragma unroll
            for (int e = 0; e < 8; ++e) y[e] = sub == 0 ? y[e] * cs[e] - o[e] * sn[e] : o[e] * sn[e] + y[e] * cs[e];
        }
        u32x4 w; w.x = pk2(y[0] * scale, y[1] * scale); w.y = pk2(y[2] * scale, y[3] * scale); w.z = pk2(y[4] * scale, y[5] * scale); w.w = pk2(y[6] * scale, y[7] * scale);
        if (act) *(u32x4*)p[t] = w; }
}
DI void nsa_finalize_rows(Ctx& c, bf16_t* U, int m0, int mstride, int j) {
    CArgs& a = *c.a; const float* qg = a.in[17] + j * 64; const float* kg = a.in[18] + j * 192; const int lane = c.lane; constexpr int RB = 8;
    bf16_t* p[RB]; const float* tab[RB];
#pragma unroll
    for (int t = 0; t < RB; ++t) { const int m = m0 + t * mstride; p[t] = U + (size_t)m * UW + 544 + 8 * lane; tab[t] = (const float*)(c.ws + WS_CS8) + (size_t)m * 16; }
    head64_vec<RB>(p, true, qg, tab, 0.125f * LOG2E, lane);
#pragma unroll
    for (int t = 0; t < RB; ++t) { const int m = m0 + t * mstride; p[t] = U + (size_t)m * UW + (lane < 16 ? 1312 + 8 * lane : 1568 + 8 * (lane & 15)); }
    head64_vec<RB>(p, lane < 32, lane < 16 ? kg + 64 : kg + 128, tab, 1.f, lane);
}
DI void diff_finalize_rows(Ctx& c, bf16_t* QKV, int m0, int mstride, int j) {
    CArgs& a = *c.a; const float* qg = a.in[24] + j * 64; const float* kg = a.in[25] + j * 64; const int lane = c.lane;
    bf16_t* p[TBV]; const float* tab[TBV];
#pragma unroll 1
    for (int ch = 0; ch < 4; ++ch) {
#pragma unroll
        for (int t = 0; t < TBV; ++t) { const int m = m0 + t * mstride; p[t] = QKV + (size_t)m * 3072 + 512 * ch + 8 * lane; tab[t] = (const float*)(c.ws + WS_CS8) + (size_t)m * 16; }
        head64_vec<TBV>(p, true, ch < 2 ? qg : kg, tab, ch < 2 ? 0.125f * LOG2E : 1.f, lane);
    }
}
DI void diff_finalize_tile(Ctx& c, bf16_t* QKV, int pm, int pn, int j) {
    CArgs& a = *c.a; const int lane = c.lane; const bool isq = pn < 4; constexpr int RB = 8;
    const float* g = isq ? a.in[24] + j * 64 : a.in[25] + j * 64; const float sc = isq ? 0.125f * LOG2E : 1.f;
    bf16_t* p[RB]; const float* tab[RB];
#pragma unroll 1
    for (int r0 = 0; r0 < 256; r0 += 16 * RB) {
#pragma unroll
        for (int t = 0; t < RB; ++t) { const int m = pm * 256 + r0 + t * 16 + 2 * c.wave + (lane >> 5); p[t] = QKV + (size_t)m * 3072 + pn * 256 + 8 * (lane & 31); tab[t] = (const float*)(c.ws + WS_CS8) + (size_t)m * 16; }
        head64_vec<RB>(p, true, g, tab, sc, lane);
    }
}
DI void unpack8(const u32x4 v, float (&x)[8]) { x[0] = bflo(v.x); x[1] = bfhi(v.x); x[2] = bflo(v.y); x[3] = bfhi(v.y); x[4] = bflo(v.z); x[5] = bfhi(v.z); x[6] = bflo(v.w); x[7] = bfhi(v.w); }
DI float sumsq8(const float (&x)[8]) { return ((x[0] * x[0] + x[1] * x[1]) + (x[2] * x[2] + x[3] * x[3])) + ((x[4] * x[4] + x[5] * x[5]) + (x[6] * x[6] + x[7] * x[7])); }
DI u32x4 mla_chunk(const float (&x)[8], float ss, const float* g96, const float* tab, int ci, float scale) {
    const float rs = rsqrtf(ss * (1.f / 96.f) + EPS);
    const f32x4 ga = *(const f32x4*)(g96 + 8 * ci), gb = *(const f32x4*)(g96 + 8 * ci + 4);
    float y[8] = {x[0] * rs * ga.x, x[1] * rs * ga.y, x[2] * rs * ga.z, x[3] * rs * ga.w, x[4] * rs * gb.x, x[5] * rs * gb.y, x[6] * rs * gb.z, x[7] * rs * gb.w};
    float o[8];
#pragma unroll
    for (int e = 0; e < 8; ++e) o[e] = swz<2>(y[e]);
    if (ci < 4) { const float* tp = tab + 16 * (ci & 1);
        const f32x4 t0 = *(const f32x4*)tp, t1 = *(const f32x4*)(tp + 4), t2 = *(const f32x4*)(tp + 8), t3 = *(const f32x4*)(tp + 12);
        const float cs[8] = {t0.x, t0.z, t1.x, t1.z, t2.x, t2.z, t3.x, t3.z}, sn[8] = {t0.y, t0.w, t1.y, t1.w, t2.y, t2.w, t3.y, t3.w};
#pragma unroll
        for (int e = 0; e < 8; ++e) y[e] = ci < 2 ? y[e] * cs[e] - o[e] * sn[e] : o[e] * sn[e] + y[e] * cs[e]; }
    u32x4 w; w.x = pk2(y[0] * scale, y[1] * scale); w.y = pk2(y[2] * scale, y[3] * scale); w.z = pk2(y[4] * scale, y[5] * scale); w.w = pk2(y[6] * scale, y[7] * scale);
    return w;
}
DI float head_ss(const LAS float* tbl, int h) { const f32x4 a = *(const LAS f32x4*)(tbl + 12 * h), b = *(const LAS f32x4*)(tbl + 12 * h + 4), cc = *(const LAS f32x4*)(tbl + 12 * h + 8); return ((a.x + a.y) + (a.z + a.w)) + ((b.x + b.y) + (b.z + b.w)) + ((cc.x + cc.y) + (cc.z + cc.w)); }
DI void mla_finalize_rows(Ctx& c, const bf16_t* U, bf16_t* QL, bf16_t* KVU, bf16_t* KF, int m0, int mstride, int j) {
    CArgs& a = *c.a; const int lane = c.lane;
    const float* qg = a.in[15] + j * 96; const float* kg = a.in[16] + j * 96;
    LAS float* tbl = (LAS float*)(c.lds + c.wave * 4096);
    const int cA = lane, hA = cA / 12, ciA = cA % 12, cB = 64 + (lane & 31), hB = cB / 12, ciB = cB % 12; const bool actB = lane < 32;
    const float qscale = 0.10206207261596577f * LOG2E;
    float xqA[TBV][8], xqB[TBV][8], xkA[TBV][8], xkB[TBV][8], rskv[TBV]; int mrow[TBV];
#pragma unroll
    for (int t = 0; t < TBV; ++t) { const int m = m0 + t * mstride; mrow[t] = m; const bf16_t* urow = U + (size_t)m * UW;
        float lx[8]; unpack8(*(const u32x4*)(urow + 8 * lane), lx); float sl = sumsq8(lx);
        sl += swz<1>(sl); sl += swz<2>(sl); sl += swz<4>(sl); sl += swz<8>(sl); sl += swz<16>(sl);
        const float rsq = rsqrtf(__builtin_bit_cast(float, __builtin_amdgcn_readlane(__builtin_bit_cast(int, sl), 0)) * (1.f / 256.f) + EPS);
        rskv[t] = rsqrtf(__builtin_bit_cast(float, __builtin_amdgcn_readlane(__builtin_bit_cast(int, sl), 32)) * (1.f / 256.f) + EPS);
        { const bf16_t* q = QL + (size_t)m * UPW; unpack8(*(const u32x4*)(q + 8 * cA), xqA[t]); u32x4 vb = (u32x4){0u, 0u, 0u, 0u}; if (actB) vb = *(const u32x4*)(q + 8 * cB); unpack8(vb, xqB[t]);
#pragma unroll
          for (int e = 0; e < 8; ++e) { xqA[t][e] *= rsq; xqB[t][e] *= rsq; }
          tbl[t * 192 + cA] = sumsq8(xqA[t]); if (actB) tbl[t * 192 + cB] = sumsq8(xqB[t]); }
        { const bf16_t* kn = KVU + (size_t)m * UPW;
          unpack8(*(const u32x4*)(ciA < 4 ? urow + 512 + 8 * ciA : kn + 128 * hA + 8 * (ciA - 4)), xkA[t]);
          u32x4 vb = (u32x4){0u, 0u, 0u, 0u}; if (actB) vb = *(const u32x4*)(ciB < 4 ? urow + 512 + 8 * ciB : kn + 128 * hB + 8 * (ciB - 4)); unpack8(vb, xkB[t]);
          const float fa = ciA < 4 ? 1.f : rskv[t], fb = ciB < 4 ? 1.f : rskv[t];
#pragma unroll
          for (int e = 0; e < 8; ++e) { xkA[t][e] *= fa; xkB[t][e] *= fb; }
          tbl[t * 192 + 96 + cA] = sumsq8(xkA[t]); if (actB) tbl[t * 192 + 96 + cB] = sumsq8(xkB[t]); }
    }
#pragma unroll
    for (int t = 0; t < TBV; ++t) { const int m = mrow[t]; const float* tab = (const float*)(c.ws + WS_CS16) + (size_t)m * 32;
        { bf16_t* q = QL + (size_t)m * UPW;
          const u32x4 wA = mla_chunk(xqA[t], head_ss(tbl + t * 192, hA), qg, tab, ciA, qscale); const u32x4 wB = mla_chunk(xqB[t], head_ss(tbl + t * 192, hB), qg, tab, ciB, qscale);
          *(u32x4*)(q + 8 * cA) = wA; if (actB) *(u32x4*)(q + 8 * cB) = wB; }
        { bf16_t* k = KF + (size_t)m * 768;
          const u32x4 wA = mla_chunk(xkA[t], head_ss(tbl + t * 192 + 96, hA), kg, tab, ciA, 1.f); const u32x4 wB = mla_chunk(xkB[t], head_ss(tbl + t * 192 + 96, hB), kg, tab, ciB, 1.f);
          *(u32x4*)(k + 8 * cA) = wA; if (actB) *(u32x4*)(k + 8 * cB) = wB; }
        { bf16_t* v = KVU + (size_t)m * UPW + 128 * (lane >> 3) + 64 + 8 * (lane & 7); float xv[8]; unpack8(*(const u32x4*)v, xv); const float f = rskv[t];
          u32x4 w; w.x = pk2(xv[0] * f, xv[1] * f); w.y = pk2(xv[2] * f, xv[3] * f); w.z = pk2(xv[4] * f, xv[5] * f); w.w = pk2(xv[6] * f, xv[7] * f); *(u32x4*)v = w; }
    }
}

DI float gelu_tanh(float x) { const float u = 0.7978845608028654f * (x + 0.044715f * x * x * x); const float e = __expf(2.f * u); const float t = 1.f - 2.f / (e + 1.f); return 0.5f * x * (1.f + t); }
DI void compress_item(Ctx& c, const bf16_t* U, int j, int it) {
    RELAUNDER(c);
    CArgs& a = *c.a; const int lane = c.lane, w = c.wave, tid = c.tid;
    const int jj = it >> 7, bg = (it >> 3) & 15, chunk = it & 7, b = bg >> 1, g = bg & 1, c0 = 16 * chunk;
    const bf16_t* W1t = (const bf16_t*)(c.ws + WS_WEVEN + j * W_EVEN + WE_C1) + (size_t)jj * 128 * 2048;
    const bf16_t* W2t = (const bf16_t*)(c.ws + WS_WEVEN + j * W_EVEN + WE_C2) + (size_t)jj * 64 * 128;
    const float* biasP = (const float*)(c.ws + WS_MISC) + (size_t)(j * 2 + jj) * 32 * 128;
    LAS float* part = (LAS float*)c.lds;
    LAS bf16_t* hid = (LAS bf16_t*)(c.lds + 65536);
    LAS float* outl = (LAS float*)(c.lds + 65536 + 8192);
    const int r16 = lane & 15, q4 = lane >> 4;
    f32x4 acc[8];
#pragma unroll
    for (int n = 0; n < 8; ++n) acc[n] = (f32x4){0.f, 0.f, 0.f, 0.f};
    const bf16_t* arow = U + ((size_t)b * S + 16 * (c0 + r16)) * UW + 1056 + jj * 128 + g * 64 + q4 * 8;
#pragma unroll 2
    for (int ks = 8 * w; ks < 8 * w + 8; ++ks) {
        const bf16x8 af = *(const bf16x8*)(arow + (size_t)(ks >> 1) * UW + (ks & 1) * 32);
#pragma unroll
        for (int n = 0; n < 8; ++n) { const bf16x8 bfr = *(const bf16x8*)(W1t + (size_t)(n * 16 + r16) * 2048 + 32 * ks + q4 * 8);
            acc[n] = __builtin_amdgcn_mfma_f32_16x16x32_bf16(af, bfr, acc[n], 0, 0, 0); }
    }
#pragma unroll
    for (int n = 0; n < 8; ++n)
#pragma unroll
        for (int i = 0; i < 4; ++i) part[(w * 16 + q4 * 4 + i) * 128 + n * 16 + r16] = acc[n][i];
    __syncthreads();
    { const int cc = tid >> 5, n0 = (tid & 31) * 4; float v[4];
#pragma unroll
      for (int e = 0; e < 4; ++e) { float s = 0.f;
#pragma unroll
          for (int ww = 0; ww < 8; ++ww) s += part[(ww * 16 + cc) * 128 + n0 + e];
          v[e] = s; }
      { f32x4 bs = (f32x4){0.f, 0.f, 0.f, 0.f};
#pragma unroll 8
        for (int kc = 0; kc < 32; ++kc) bs += *(const f32x4*)(biasP + kc * 128 + n0);
        v[0] = gelu_tanh(v[0] + bs.x); v[1] = gelu_tanh(v[1] + bs.y); v[2] = gelu_tanh(v[2] + bs.z); v[3] = gelu_tanh(v[3] + bs.w); }
      u32x2 o; o.x = pk2(v[0], v[1]); o.y = pk2(v[2], v[3]); *(LAS u32x2*)(hid + cc * 136 + n0) = o; }
    __syncthreads();
    if (w < 4) {
        f32x4 a2 = (f32x4){0.f, 0.f, 0.f, 0.f};
#pragma unroll
        for (int kst = 0; kst < 4; ++kst) { const bf16x8 af = *(const LAS bf16x8*)(hid + r16 * 136 + 32 * kst + q4 * 8);
            const bf16x8 bfr = *(const bf16x8*)(W2t + (size_t)(w * 16 + r16) * 128 + 32 * kst + q4 * 8);
            a2 = __builtin_amdgcn_mfma_f32_16x16x32_bf16(af, bfr, a2, 0, 0, 0); }
#pragma unroll
        for (int i = 0; i < 4; ++i) outl[(q4 * 4 + i) * 64 + w * 16 + r16] = a2[i];
    }
    __syncthreads();
    if (tid < 256) {
        const int cc = tid >> 4, d0 = (tid & 15) * 4; const int cg = c0 + cc;
        bf16_t* dst = (bf16_t*)(c.ws + WS_MISC + 65536 + (size_t)jj * 262144) + ((size_t)bg * 128 + cg) * 64 + d0;
        float v[4];
#pragma unroll
        for (int e = 0; e < 4; ++e) v[e] = outl[cc * 64 + d0 + e];
        if (jj == 0) {
            float s = (v[0] * v[0] + v[1] * v[1]) + (v[2] * v[2] + v[3] * v[3]);
            s += swz<1>(s); s += swz<2>(s); s += swz<4>(s); s += swz<8>(s);
            const float rs = rsqrtf(s * (1.f / 64.f) + EPS); const float* kg = a.in[18] + j * 192;
            int tok = b * S + 16 * cg + 31; if (tok >= T) tok = T - 1;
            const float* tab = (const float*)(c.ws + WS_CS8) + (size_t)tok * 16;
#pragma unroll
            for (int e = 0; e < 4; ++e) { const int d = d0 + e; float y = v[e] * rs * kg[d];
                if (d < 16) { const float o = outl[cc * 64 + (d ^ 8)] * rs * kg[d ^ 8]; const int i = d & 7; const float cs = tab[2 * i], sn = tab[2 * i + 1]; y = d < 8 ? y * cs - o * sn : o * sn + y * cs; }
                v[e] = y; }
        }
        if (cg == 127) { v[0] = v[1] = v[2] = v[3] = 0.f; }
        u32x2 o; o.x = pk2(v[0], v[1]); o.y = pk2(v[2], v[3]); *(u32x2*)dst = o;
    }
    __syncthreads();
}

DI void lds_add(LAS float* p, float v) { (void)__hip_atomic_fetch_add(p, v, __ATOMIC_RELAXED, __HIP_MEMORY_SCOPE_WORKGROUP); }
DI int crow(int r, int h) { return (r & 3) + 8 * (r >> 2) + 4 * h; }
DI unsigned cvtpk(float lo, float hi) { typedef float f2 __attribute__((ext_vector_type(2))); typedef __bf16 b2 __attribute__((ext_vector_type(2))); f2 v = {lo, hi}; b2 r = __builtin_convertvector(v, b2); return __builtin_bit_cast(unsigned, r); }
template <int DD> struct TileRegs { u32x4 r[(64 * DD / 8 + NT - 1) / NT]; };
template <int DD> DI void tile_load(TileRegs<DD>& t, const bf16_t* g, int ld, int tid) {
    constexpr int CPR = DD / 8, NCH = 64 * CPR, NI = (NCH + NT - 1) / NT;
#pragma unroll
    for (int i = 0; i < NI; ++i) { const int ch = tid + NT * i; if (NCH % NT == 0 || ch < NCH) { const int row = ch / CPR, c8 = ch % CPR; const unsigned eo = (unsigned)row * (unsigned)ld + (unsigned)c8 * 8u; t.r[i] = *(const u32x4*)(g + eo); } }
}
template <int DD> DI void tile_store(const TileRegs<DD>& t, LAS char* buf, int tid) {
    constexpr int CPR = DD / 8, NCH = 64 * CPR, NI = (NCH + NT - 1) / NT, STR = DD * 2 + 16;
#pragma unroll
    for (int i = 0; i < NI; ++i) { const int ch = tid + NT * i; if (NCH % NT == 0 || ch < NCH) { const int row = ch / CPR, c8 = ch % CPR; *(LAS u32x4*)(buf + row * STR + c8 * 16) = t.r[i]; } }
}
template <int DK> DI void qk_tile(const LAS char* Kb, const bf16x8* qf, f32x16& p0, f32x16& p1, int lane) {
    constexpr int KS = DK * 2 + 16, NG = DK / 32; const LAS char* kp = Kb + (lane & 31) * KS + (lane >> 5) * 16;
    bf16x8 kf[2][2][2];
#define QK_LOAD(G_, B_) do { _Pragma("unroll") for (int j_ = 0; j_ < 2; ++j_) { kf[B_][j_][0] = *(const LAS bf16x8*)(kp + (2 * (G_) + j_) * 32); kf[B_][j_][1] = *(const LAS bf16x8*)(kp + 32 * KS + (2 * (G_) + j_) * 32); } } while (0)
    constexpr bool DB = FX_QKDB || (DK > 64);
    QK_LOAD(0, 0);
#pragma unroll
    for (int r = 0; r < 16; ++r) { p0[r] = 0.f; p1[r] = 0.f; }
#pragma unroll
    for (int g = 0; g < NG; ++g) {
        const int bcur = DB ? (g & 1) : 0;
        if (DB && g + 1 < NG) { if ((g & 1) == 0) QK_LOAD(g + 1, 1); else QK_LOAD(g + 1, 0); }
        __builtin_amdgcn_sched_barrier(0);
        if (FX_PRIO) __builtin_amdgcn_s_setprio(1);
#pragma unroll
        for (int j = 0; j < 2; ++j) { p0 = __builtin_amdgcn_mfma_f32_32x32x16_bf16(kf[bcur][j][0], qf[2 * g + j], p0, 0, 0, 0); p1 = __builtin_amdgcn_mfma_f32_32x32x16_bf16(kf[bcur][j][1], qf[2 * g + j], p1, 0, 0, 0); }
        if (FX_PRIO) __builtin_amdgcn_s_setprio(0);
        __builtin_amdgcn_sched_barrier(0);
        if (!DB && g + 1 < NG) QK_LOAD(g + 1, 0);
    }
#undef QK_LOAD
}
template <int DV> DI void pv_tile(const LAS char* Vb, const f32x16& p0, const f32x16& p1, f32x16* o, int lane) {
    constexpr int VS = DV * 2 + 16;
    const int g = lane >> 4, h = lane >> 5, i16 = lane & 15, q = i16 >> 2, p = i16 & 3;
    const LAS char* base = Vb + (4 * h + q) * VS + (16 * (g & 1) + 4 * p) * 2;
    constexpr int NDB = DV / 32, GS = (DV == 64) ? 2 : 1;
    bf16x8 pf[4];
#pragma unroll
    for (int s = 0; s < 4; ++s) { u32x4 pw;
        if (s < 2) { pw.x = cvtpk(p0[8 * s], p0[8 * s + 1]); pw.y = cvtpk(p0[8 * s + 2], p0[8 * s + 3]); pw.z = cvtpk(p0[8 * s + 4], p0[8 * s + 5]); pw.w = cvtpk(p0[8 * s + 6], p0[8 * s + 7]); }
        else { const int s2 = s - 2; pw.x = cvtpk(p1[8 * s2], p1[8 * s2 + 1]); pw.y = cvtpk(p1[8 * s2 + 2], p1[8 * s2 + 3]); pw.z = cvtpk(p1[8 * s2 + 4], p1[8 * s2 + 5]); pw.w = cvtpk(p1[8 * s2 + 6], p1[8 * s2 + 7]); }
        pf[s] = __builtin_bit_cast(bf16x8, pw); }
#pragma unroll
    for (int s0 = 0; s0 < 4; s0 += GS) {
        s16x4 lo[GS][NDB], hi[GS][NDB];
#pragma unroll
        for (int s = 0; s < GS; ++s)
#pragma unroll
            for (int db = 0; db < NDB; ++db) { lo[s][db] = vtr(base + (16 * (s0 + s)) * VS + db * 64); hi[s][db] = vtr(base + (16 * (s0 + s) + 8) * VS + db * 64); }
        __builtin_amdgcn_sched_barrier(0);
#pragma unroll
        for (int s = 0; s < GS; ++s)
#pragma unroll
            for (int db = 0; db < NDB; ++db) o[db] = __builtin_amdgcn_mfma_f32_32x32x16_bf16(__builtin_shufflevector(lo[s][db], hi[s][db], 0, 1, 2, 3, 4, 5, 6, 7), pf[s0 + s], o[db], 0, 0, 0);
        __builtin_amdgcn_sched_barrier(0);
    }
}
struct VPre { s16x4 lo[2][2], hi[2][2]; };
DI void pv_prefetch64(const LAS char* Vb, VPre& v, int lane) {
    constexpr int VS = 64 * 2 + 16; const int g = lane >> 4, h = lane >> 5, i16 = lane & 15, q = i16 >> 2, p = i16 & 3;
    const LAS char* base = Vb + (4 * h + q) * VS + (16 * (g & 1) + 4 * p) * 2;
#pragma unroll
    for (int s = 0; s < 2; ++s)
#pragma unroll
        for (int db = 0; db < 2; ++db) { v.lo[s][db] = vtr(base + (16 * s) * VS + db * 64); v.hi[s][db] = vtr(base + (16 * s + 8) * VS + db * 64); }
}
DI void pv_tile64_pre(const LAS char* Vb, const f32x16& p0, const f32x16& p1, f32x16* o, const VPre& v, int lane) {
    constexpr int VS = 64 * 2 + 16; const int g = lane >> 4, h = lane >> 5, i16 = lane & 15, q = i16 >> 2, p = i16 & 3;
    const LAS char* base = Vb + (4 * h + q) * VS + (16 * (g & 1) + 4 * p) * 2;
    bf16x8 pf[4];
#pragma unroll
    for (int s = 0; s < 4; ++s) { u32x4 pw;
        if (s < 2) { pw.x = cvtpk(p0[8 * s], p0[8 * s + 1]); pw.y = cvtpk(p0[8 * s + 2], p0[8 * s + 3]); pw.z = cvtpk(p0[8 * s + 4], p0[8 * s + 5]); pw.w = cvtpk(p0[8 * s + 6], p0[8 * s + 7]); }
        else { const int s2 = s - 2; pw.x = cvtpk(p1[8 * s2], p1[8 * s2 + 1]); pw.y = cvtpk(p1[8 * s2 + 2], p1[8 * s2 + 3]); pw.z = cvtpk(p1[8 * s2 + 4], p1[8 * s2 + 5]); pw.w = cvtpk(p1[8 * s2 + 6], p1[8 * s2 + 7]); }
        pf[s] = __builtin_bit_cast(bf16x8, pw); }
    s16x4 lo2[2][2], hi2[2][2];
#pragma unroll
    for (int s = 0; s < 2; ++s)
#pragma unroll
        for (int db = 0; db < 2; ++db) { lo2[s][db] = vtr(base + (16 * (2 + s)) * VS + db * 64); hi2[s][db] = vtr(base + (16 * (2 + s) + 8) * VS + db * 64); }
    __builtin_amdgcn_sched_barrier(0);
#pragma unroll
    for (int s = 0; s < 2; ++s)
#pragma unroll
        for (int db = 0; db < 2; ++db) o[db] = __builtin_amdgcn_mfma_f32_32x32x16_bf16(__builtin_shufflevector(v.lo[s][db], v.hi[s][db], 0, 1, 2, 3, 4, 5, 6, 7), pf[s], o[db], 0, 0, 0);
    __builtin_amdgcn_sched_barrier(0);
#pragma unroll
    for (int s = 0; s < 2; ++s)
#pragma unroll
        for (int db = 0; db < 2; ++db) o[db] = __builtin_amdgcn_mfma_f32_32x32x16_bf16(__builtin_shufflevector(lo2[s][db], hi2[s][db], 0, 1, 2, 3, 4, 5, 6, 7), pf[2 + s], o[db], 0, 0, 0);
    __builtin_amdgcn_sched_barrier(0);
}
struct VPre128 { s16x4 lo[4], hi[4]; };
DI void pv_prefetch128(const LAS char* Vb, VPre128& v, int lane) {
    constexpr int VS = 128 * 2 + 16; const int g = lane >> 4, h = lane >> 5, i16 = lane & 15, q = i16 >> 2, p = i16 & 3;
    const LAS char* base = Vb + (4 * h + q) * VS + (16 * (g & 1) + 4 * p) * 2;
#pragma unroll
    for (int db = 0; db < 4; ++db) { v.lo[db] = vtr(base + db * 64); v.hi[db] = vtr(base + 8 * VS + db * 64); }
}
DI void pv_tile128_pre(const LAS char* Vb, const f32x16& p0, const f32x16& p1, f32x16* o, const VPre128& v, int lane) {
    constexpr int VS = 128 * 2 + 16; const int g = lane >> 4, h = lane >> 5, i16 = lane & 15, q = i16 >> 2, p = i16 & 3;
    const LAS char* base = Vb + (4 * h + q) * VS + (16 * (g & 1) + 4 * p) * 2;
    bf16x8 pf[4];
#pragma unroll
    for (int s = 0; s < 4; ++s) { u32x4 pw;
        if (s < 2) { pw.x = cvtpk(p0[8 * s], p0[8 * s + 1]); pw.y = cvtpk(p0[8 * s + 2], p0[8 * s + 3]); pw.z = cvtpk(p0[8 * s + 4], p0[8 * s + 5]); pw.w = cvtpk(p0[8 * s + 6], p0[8 * s + 7]); }
        else { const int s2 = s - 2; pw.x = cvtpk(p1[8 * s2], p1[8 * s2 + 1]); pw.y = cvtpk(p1[8 * s2 + 2], p1[8 * s2 + 3]); pw.z = cvtpk(p1[8 * s2 + 4], p1[8 * s2 + 5]); pw.w = cvtpk(p1[8 * s2 + 6], p1[8 * s2 + 7]); }
        pf[s] = __builtin_bit_cast(bf16x8, pw); }
#pragma unroll
    for (int db = 0; db < 4; ++db) o[db] = __builtin_amdgcn_mfma_f32_32x32x16_bf16(__builtin_shufflevector(v.lo[db], v.hi[db], 0, 1, 2, 3, 4, 5, 6, 7), pf[0], o[db], 0, 0, 0);
    __builtin_amdgcn_sched_barrier(0);
#pragma unroll
    for (int s = 1; s < 4; ++s) { s16x4 lo[4], hi[4];
#pragma unroll
        for (int db = 0; db < 4; ++db) { lo[db] = vtr(base + (16 * s) * VS + db * 64); hi[db] = vtr(base + (16 * s + 8) * VS + db * 64); }
        __builtin_amdgcn_sched_barrier(0);
#pragma unroll
        for (int db = 0; db < 4; ++db) o[db] = __builtin_amdgcn_mfma_f32_32x32x16_bf16(__builtin_shufflevector(lo[db], hi[db], 0, 1, 2, 3, 4, 5, 6, 7), pf[s], o[db], 0, 0, 0);
        __builtin_amdgcn_sched_barrier(0); }
}
DI float max3f(float a, float b, float c) { return __builtin_fmaxf(__builtin_fmaxf(a, b), c); }
DI float rowmax32(const f32x16& p0, const f32x16& p1) {
    float a = max3f(p0[0], p0[1], p0[2]), b = max3f(p0[3], p0[4], p0[5]), c = max3f(p1[0], p1[1], p1[2]), d = max3f(p1[3], p1[4], p1[5]);
    a = max3f(a, p0[6], p0[7]); b = max3f(b, p0[8], p0[9]); c = max3f(c, p1[6], p1[7]); d = max3f(d, p1[8], p1[9]);
    a = max3f(a, p0[10], p0[11]); b = max3f(b, p0[12], p0[13]); c = max3f(c, p1[10], p1[11]); d = max3f(d, p1[12], p1[13]);
    a = max3f(a, p0[14], p0[15]); c = max3f(c, p1[14], p1[15]);
    return max32(max3f(max3f(a, b, c), d, d));
}
template <int DV> DI void softmax_step(f32x16& p0, f32x16& p1, f32x16* o, float& m, float& l) {
    const float mx = rowmax32(p0, p1); const float mnew = fmaxf(m, mx); const float muse = (mnew == -INFINITY) ? 0.f : mnew;
    const float alpha = __builtin_amdgcn_exp2f(m - muse);
    float s = 0.f;
#pragma unroll
    for (int r = 0; r < 16; ++r) { p0[r] = __builtin_amdgcn_exp2f(p0[r] - muse); p1[r] = __builtin_amdgcn_exp2f(p1[r] - muse); s += p0[r] + p1[r]; }
    l = l * alpha + s; m = mnew;
#pragma unroll
    for (int db = 0; db < DV / 32; ++db)
#pragma unroll
        for (int r = 0; r < 16; ++r) o[db][r] *= alpha;
}
template <int DK> DI void load_qfrag(bf16x8* qf, const bf16_t* qrow  , int h) {
#pragma unroll
    for (int st = 0; st < DK / 16; ++st) qf[st] = *(const bf16x8*)(qrow + 16 * st + 8 * h);
}
template <int DK, int DV> struct SweepLds { static constexpr int KB = 64 * (DK * 2 + 16), VB = 64 * (DV * 2 + 16); };

template <int DV> DI void softmax_step_lazy(f32x16& p0, f32x16& p1, f32x16* o, float& m, float& l) {
    const float mx = rowmax32(p0, p1); const float mnew = fmaxf(m, mx); const float muse = (mnew == -INFINITY) ? 0.f : mnew;
    const float alpha = __builtin_amdgcn_exp2f(m - muse);
    float s0 = 0.f, s1 = 0.f, s2 = 0.f, s3 = 0.f;
#pragma unroll
    for (int r = 0; r < 16; ++r) { p0[r] = __builtin_amdgcn_exp2f(p0[r] - muse); p1[r] = __builtin_amdgcn_exp2f(p1[r] - muse); }
#pragma unroll
    for (int r = 0; r < 16; r += 2) { s0 += p0[r]; s1 += p0[r + 1]; s2 += p1[r]; s3 += p1[r + 1]; }
    l = l * alpha + ((s0 + s1) + (s2 + s3)); m = mnew;
    if (__builtin_amdgcn_ballot_w64(alpha != 1.f) != 0ull) {
#pragma unroll
        for (int db = 0; db < DV / 32; ++db)
#pragma unroll
            for (int r = 0; r < 16; ++r) o[db][r] *= alpha;
    }
}
template <int DK, int DV> struct SweepLds3 { static constexpr int KB = 64 * (DK * 2 + 16), VB = 64 * (DV * 2 + 16), TOTAL = 2 * KB + 3 * VB; };
template <int DK, int DV, bool late, class It, class F> DI void flash_sweep_impl(Ctx& c, const bf16x8* qf, const bf16_t* Kg, int ldk, const bf16_t* Vg, int ldv, It it, const F& f, f32x16* o, float& m, float& l) {
    typedef SweepLds3<DK, DV> L; LAS char* lds = (LAS char*)c.lds; const int lane = c.lane, tid = c.tid;
    TileRegs<DK> kA, kB; TileRegs<DV> vA, vB;
    int ta = it.next(); int tb = ta >= 0 ? it.next() : -1;
    if (ta < 0) return;
    tile_load<DK>(kA, Kg + (size_t)ta * 64 * ldk, ldk, tid); tile_load<DV>(vA, Vg + (size_t)ta * 64 * ldv, ldv, tid);
    if (tb >= 0) { tile_load<DK>(kB, Kg + (size_t)tb * 64 * ldk, ldk, tid); tile_load<DV>(vB, Vg + (size_t)tb * 64 * ldv, ldv, tid); }
    __syncthreads();
    tile_store<DK>(kA, lds, tid); tile_store<DV>(vA, lds + 2 * L::KB, tid);
    __syncthreads();
    int vprev = 2 * L::KB + 2 * L::VB, vcur = 2 * L::KB, vnext = 2 * L::KB + L::VB;
    f32x16 s0, s1; bool pend = false;
#pragma unroll
    for (int r = 0; r < 16; ++r) { s0[r] = 0.f; s1[r] = 0.f; }
#define FS_QK(P0_, P1_, KOFF_) do { PSW_B(20); if (c.var != 3) qk_tile<DK>(lds + (KOFF_), qf, P0_, P1_, lane); PSW_E(20); } while (0)
#define FS_SM(P0_, P1_) do { PSW_B(21); if (c.var != 2) softmax_step_lazy<DV>(P0_, P1_, o, m, l); PSW_E(21); } while (0)
#define FS_PV(VOFF_, P0_, P1_) do { PSW_B(22); if (c.var != 1) pv_tile<DV>(lds + (VOFF_), P0_, P1_, o, lane); PSW_E(22); } while (0)
#define FS_COMPUTE(T_, KOFF_) do { \
        if (!late) { if (!f.skip(T_)) { f32x16 p0, p1; if (c.var == 3) { p0 = s0; p1 = s1; } FS_QK(p0, p1, KOFF_); f.mask(p0, p1, T_); \
            if constexpr (DV == 64 && (DK == 96 || FX_VPRE >= 2)) { VPre vp; pv_prefetch64(lds + vcur, vp, lane); __builtin_amdgcn_sched_barrier(0); FS_SM(p0, p1); pv_tile64_pre(lds + vcur, p0, p1, o, vp, lane); } else if constexpr (DV == 128 && FX_VPRE >= 3) { VPre128 vp; pv_prefetch128(lds + vcur, vp, lane); __builtin_amdgcn_sched_barrier(0); FS_SM(p0, p1); pv_tile128_pre(lds + vcur, p0, p1, o, vp, lane); } else { FS_SM(p0, p1); FS_PV(vcur, p0, p1); } } } \
        else { if (pend) { FS_SM(s0, s1); FS_PV(vprev, s0, s1); pend = false; } \
               if (!f.skip(T_)) { FS_QK(s0, s1, KOFF_); f.mask(s0, s1, T_); pend = true; } } } while (0)
#define FS_ROTATE() do { const int t_ = vprev; vprev = vcur; vcur = vnext; vnext = t_; } while (0)
    for (;;) {
        const int tc = tb >= 0 ? it.next() : -1;
        if (tc >= 0) { tile_load<DK>(kA, Kg + (size_t)tc * 64 * ldk, ldk, tid); tile_load<DV>(vA, Vg + (size_t)tc * 64 * ldv, ldv, tid); }
        FS_COMPUTE(ta, 0);
        PSW_B(23); if (tb >= 0) { tile_store<DK>(kB, lds + L::KB, tid); tile_store<DV>(vB, lds + vnext, tid); } PSW_DRAIN(); PSW_E(23);
        PSW_B(25); __syncthreads(); PSW_E(25); FS_ROTATE();
        if (tb < 0) break;
        const int td = tc >= 0 ? it.next() : -1;
        if (td >= 0) { tile_load<DK>(kB, Kg + (size_t)td * 64 * ldk, ldk, tid); tile_load<DV>(vB, Vg + (size_t)td * 64 * ldv, ldv, tid); }
        FS_COMPUTE(tb, L::KB);
        PSW_B(23); if (tc >= 0) { tile_store<DK>(kA, lds, tid); tile_store<DV>(vA, lds + vnext, tid); } PSW_DRAIN(); PSW_E(23);
        PSW_B(25); __syncthreads(); PSW_E(25); FS_ROTATE();
        if (tc < 0) break;
        ta = tc; tb = td;
    }
    if (late && pend) { FS_SM(s0, s1); FS_PV(vprev, s0, s1); }
#undef FS_COMPUTE
#undef FS_ROTATE
#undef FS_QK
#undef FS_SM
#undef FS_PV
}
template <int DK, int DV, bool STG, class It, class F> DI void flash_sweep(Ctx& c, const bf16x8* qf, const bf16_t* Kg, int ldk, const bf16_t* Vg, int ldv, It it, const F& f, f32x16* o, float& m, float& l) {
#if FX_SWEEP2
    flash_sweep2<DK, DV>(c, qf, Kg, ldk, Vg, ldv, it, f, o, m, l); return;
#endif
    PSW_B(24);
    if (STG && FX_LATE(c.wave)) flash_sweep_impl<DK, DV, true>(c, qf, Kg, ldk, Vg, ldv, it, f, o, m, l);
    else flash_sweep_impl<DK, DV, false>(c, qf, Kg, ldk, Vg, ldv, it, f, o, m, l);
    PSW_E(24);
}
template <int DK, int DV, class It, class F> DI void flash_sweep2(Ctx& c, const bf16x8* qf, const bf16_t* Kg, int ldk, const bf16_t* Vg, int ldv, It it, const F& f, f32x16* o, float& m, float& l) {
    constexpr int KB = 64 * (DK * 2 + 16), VB = 64 * (DV * 2 + 16), VOFF = 4 * KB;
    LAS char* lds = (LAS char*)c.lds; const int lane = c.lane, tid = c.tid;
    TileRegs<DK> k0, k1; TileRegs<DV> v0, v1;
    int a = it.next(); if (a < 0) return; int b = it.next();
    tile_load<DK>(k0, Kg + (size_t)a * 64 * ldk, ldk, tid); tile_load<DV>(v0, Vg + (size_t)a * 64 * ldv, ldv, tid);
    if (b >= 0) { tile_load<DK>(k1, Kg + (size_t)b * 64 * ldk, ldk, tid); tile_load<DV>(v1, Vg + (size_t)b * 64 * ldv, ldv, tid); }
    __syncthreads();
    tile_store<DK>(k0, lds, tid); tile_store<DV>(v0, lds + VOFF, tid);
    if (b >= 0) { tile_store<DK>(k1, lds + KB, tid); tile_store<DV>(v1, lds + VOFF + VB, tid); }
    __syncthreads();
    int st = 0;
    for (;;) {
        const int na = b >= 0 ? it.next() : -1; const int nb = na >= 0 ? it.next() : -1;
        if (na >= 0) { tile_load<DK>(k0, Kg + (size_t)na * 64 * ldk, ldk, tid); tile_load<DV>(v0, Vg + (size_t)na * 64 * ldv, ldv, tid); }
        if (nb >= 0) { tile_load<DK>(k1, Kg + (size_t)nb * 64 * ldk, ldk, tid); tile_load<DV>(v1, Vg + (size_t)nb * 64 * ldv, ldv, tid); }
        const int ko = st * 2 * KB, vo = VOFF + st * 2 * VB;
        if (!f.skip(a)) { f32x16 p0, p1; qk_tile<DK>(lds + ko, qf, p0, p1, lane); f.mask(p0, p1, a); softmax_step_lazy<DV>(p0, p1, o, m, l); pv_tile<DV>(lds + vo, p0, p1, o, lane); }
        if (b >= 0 && !f.skip(b)) { f32x16 p0, p1; qk_tile<DK>(lds + ko + KB, qf, p0, p1, lane); f.mask(p0, p1, b); softmax_step_lazy<DV>(p0, p1, o, m, l); pv_tile<DV>(lds + vo + VB, p0, p1, o, lane); }
        const int kn = (st ^ 1) * 2 * KB, vn = VOFF + (st ^ 1) * 2 * VB;
        if (na >= 0) { tile_store<DK>(k0, lds + kn, tid); tile_store<DV>(v0, lds + vn, tid); }
        if (nb >= 0) { tile_store<DK>(k1, lds + kn + KB, tid); tile_store<DV>(v1, lds + vn + VB, tid); }
        __syncthreads();
        if (na < 0) break;
        a = na; b = nb; st ^= 1;
    }
}
struct RangeIt { int t, tend; DI int next() { return t <= tend ? t++ : -1; } };
struct BitsIt { unsigned rem; DI int next() { if (!rem) return -1; const int t = __builtin_ctz(rem); rem &= rem - 1; return t; } };
struct CausalF { int qrow, wfirst, wlast, h;
    DI bool skip(int t) const { return t > wlast; }
    DI void mask(f32x16& p0, f32x16& p1, int t) const { if (t * 64 + 63 > wfirst) {
#pragma unroll
        for (int r = 0; r < 16; ++r) { const int kv = t * 64 + crow(r, h); if (kv > qrow) p0[r] = -INFINITY; if (kv + 32 > qrow) p1[r] = -INFINITY; } } } };
template <int DK, int DV> DI void causal_sweep(Ctx& c, const bf16_t* Qg, int ldq, const bf16_t* Kg, int ldk, const bf16_t* Vg, int ldv, int q0, f32x16* o, float& lsum) {
    RELAUNDER(c);
    const int lane = c.lane, w = c.wave, r32 = lane & 31, h = lane >> 5;
    const int qrow = q0 + 32 * w + r32;
    bf16x8 qf[DK / 16]; load_qfrag<DK>(qf, Qg + (unsigned)qrow * (unsigned)ldq, h);
#pragma unroll
    for (int db = 0; db < DV / 32; ++db)
#pragma unroll
        for (int r = 0; r < 16; ++r) o[db][r] = 0.f;
    float m = -INFINITY, l = 0.f;
    RangeIt it{0, (q0 >> 6) + 3}; CausalF f{qrow, q0 + 32 * w, (q0 + 32 * w + 31) >> 6, h};
    flash_sweep<DK, DV, (DV == 64) && FX_STG>(c, qf, Kg, ldk, Vg, ldv, it, f, o, m, l);
    lsum = sum32(l);
}
template <int DV> DI void store_o(const f32x16* o, float scale, bf16_t* rowp, int h) {
#pragma unroll
    for (int db = 0; db < DV / 32; ++db)
#pragma unroll
        for (int k = 0; k < 4; ++k) { u32x2 v; v.x = cvtpk(o[db][4 * k] * scale, o[db][4 * k + 1] * scale); v.y = cvtpk(o[db][4 * k + 2] * scale, o[db][4 * k + 3] * scale);
            *(u32x2*)(rowp + 32 * db + 8 * k + 4 * h) = v; }
}

DI void mla_unit(Ctx& c, const bf16_t* QL, const bf16_t* KF, const bf16_t* KVU, bf16_t* YC, int b, int hd, int qt) {
    RELAUNDER(c);
    const int q0 = qt * 256; f32x16 o[2]; float l;
    const size_t rb = (size_t)b * S;
    causal_sweep<96, 64>(c, QL + rb * UPW + 96 * hd, UPW, KF + rb * 768 + 96 * hd, 768, KVU + rb * UPW + 128 * hd + 64, UPW, q0, o, l);
    const int qrow = q0 + 32 * c.wave + (c.lane & 31);
    store_o<64>(o, 1.f / l, YC + (rb + qrow) * 1024 + 64 * hd, c.lane >> 5);
}
DI void diff_unit(Ctx& c, const bf16_t* QKV, bf16_t* ON, int b, int hd, int qt, int j, int layer) {
    RELAUNDER(c);
    CArgs& a = *c.a; const int q0 = qt * 256, lane = c.lane, h = lane >> 5; const size_t rb = (size_t)b * S;
    f32x16 o1[4], o2[4]; float l1, l2;
    const bf16_t* base = QKV + rb * 3072;
    causal_sweep<64, 128>(c, base + 128 * hd, 3072, base + 1024 + 128 * hd, 3072, base + 2048 + 128 * hd, 3072, q0, o1, l1);
    { const float i1_ = 1.f / l1;
#pragma unroll
      for (int db = 0; db < 4; ++db)
#pragma unroll
          for (int r = 0; r < 16; ++r) o1[db][r] *= i1_; }
    causal_sweep<64, 128>(c, base + 128 * hd + 64, 3072, base + 1024 + 128 * hd + 64, 3072, base + 2048 + 128 * hd, 3072, q0, o2, l2);
    const float* lam = a.in[26] + j * 256; float s1 = lam[lane] * lam[64 + lane], s2 = lam[128 + lane] * lam[192 + lane];
    s1 = wave_sum(s1); s2 = wave_sum(s2);
    const float lam_init = 0.8f - 0.6f * __expf(-0.3f * (float)layer); const float lmb = __expf(s1) - __expf(s2) + lam_init;
    const float i1 = 1.f, i2 = lmb / l2; float ss = 0.f;
#pragma unroll
    for (int db = 0; db < 4; ++db)
#pragma unroll
        for (int r = 0; r < 16; ++r) { const float v = o1[db][r] * i1 - o2[db][r] * i2; o1[db][r] = v; ss += v * v; }
    ss = sum32(ss);
    const float rs = rsqrtf(ss * (1.f / 128.f) + EPS) * (1.f - lam_init);
    const float* sg = a.in[27] + j * 128;
#pragma unroll
    for (int db = 0; db < 4; ++db)
#pragma unroll
        for (int r = 0; r < 16; ++r) o1[db][r] *= rs * sg[32 * db + crow(r, h)];
    const int qrow = q0 + 32 * c.wave + (lane & 31);
    store_o<128>(o1, 1.f, ON + (rb + qrow) * 1024 + 128 * hd, h);
}

DI void nsa_unit(Ctx& c, const bf16_t* U, bf16_t* YC, int b, int g, int qt) {
    RELAUNDER(c);
    CArgs& a = *c.a; LAS char* lds = (LAS char*)c.lds; typedef SweepLds<64, 64> L;
    const int lane = c.lane, w = c.wave, tid = c.tid, r32 = lane & 31, h = lane >> 5;
    const int hg = w & 3, qsub = w >> 2, head = g * 4 + hg, q0 = qt * 64, jt = qt;
    const int qrow = q0 + 32 * qsub + r32; const size_t rb = (size_t)b * S; const size_t m = rb + qrow;
    LAS float* imp = (LAS float*)(lds + 8 * L::KB);
    LAS unsigned* selw = (LAS unsigned*)(lds + 8 * L::KB + 4 * 64 * 33 * 4);
    bf16x8 qf[4]; load_qfrag<64>(qf, U + m * UW + 544 + 64 * head, h);
    const bf16_t* urow = U + m * UW + 1824;
#ifdef NSA_ONLY
    const float g0 = NSA_ONLY == 0 ? 1.f : 0.f, g1 = NSA_ONLY == 1 ? 1.f : 0.f, g2 = NSA_ONLY == 2 ? 1.f : 0.f; (void)urow;
#else
    const float g0 = 1.f / (1.f + __expf(-bf2f(urow[head]))), g1 = 1.f / (1.f + __expf(-bf2f(urow[8 + head]))), g2 = 1.f / (1.f + __expf(-bf2f(urow[16 + head])));
#endif
    unsigned accp[2][8];
    const int bg = b * 2 + g;
    const bf16_t* KC = (const bf16_t*)(c.ws + WS_MISC + 65536) + (size_t)bg * 128 * 64; const bf16_t* VC = (const bf16_t*)(c.ws + WS_MISC + 65536 + 262144) + (size_t)bg * 128 * 64;
    __syncthreads();
    PSEC_B(1);
    PSEC_B(5);
    { TileRegs<64> k0, k1, v0, v1; tile_load<64>(k0, KC, 64, tid); tile_load<64>(k1, KC + 64 * 64, 64, tid); tile_load<64>(v0, VC, 64, tid); tile_load<64>(v1, VC + 64 * 64, 64, tid);
      tile_store<64>(k0, lds, tid); tile_store<64>(k1, lds + L::KB, tid); tile_store<64>(v0, lds + 2 * L::KB, tid); tile_store<64>(v1, lds + 2 * L::KB + L::VB, tid); }
    __syncthreads();
    PSEC_E(5); PSEC_B(6);
    {
        f32x16 p0, p1, p2, p3; qk_tile<64>(lds, qf, p0, p1, lane); qk_tile<64>(lds + L::KB, qf, p2, p3, lane);
        const int hi = qrow < 31 ? -1 : (qrow - 31) >> 4;
#pragma unroll
        for (int r = 0; r < 16; ++r) { const int cidx = crow(r, h); if (cidx > hi) p0[r] = -INFINITY; if (cidx + 32 > hi) p1[r] = -INFINITY; if (cidx + 64 > hi) p2[r] = -INFINITY; if (cidx + 96 > hi) p3[r] = -INFINITY; }
        float mx = fmaxf(rowmax32(p0, p1), rowmax32(p2, p3)); const float muse = (mx == -INFINITY) ? 0.f : mx; float s = 0.f;
#pragma unroll
        for (int r = 0; r < 16; ++r) { p0[r] = __builtin_amdgcn_exp2f(p0[r] - muse); p1[r] = __builtin_amdgcn_exp2f(p1[r] - muse); p2[r] = __builtin_amdgcn_exp2f(p2[r] - muse); p3[r] = __builtin_amdgcn_exp2f(p3[r] - muse); s += (p0[r] + p1[r]) + (p2[r] + p3[r]); }
        s = sum32(s); const float inv = s > 0.f ? 1.f / s : 0.f;
#pragma unroll
        for (int r = 0; r < 16; ++r) { p0[r] *= inv; p1[r] *= inv; p2[r] *= inv; p3[r] *= inv; }
        LAS float* ir = imp + hg * (64 * 33) + (32 * qsub + r32) * 33;
        float eo[4][4];
#define EDGE_X(P, PI) _Pragma("unroll") for (int k = 0; k < 4; ++k) { unsigned ua = __builtin_bit_cast(unsigned, P[4 * k + 3]), ub = ua; xchg32(ua, ub); eo[PI][k] = __builtin_bit_cast(float, h ? ua : ub); }
        EDGE_X(p0, 0) EDGE_X(p1, 1) EDGE_X(p2, 2) EDGE_X(p3, 3)
#undef EDGE_X
#define IMP_ST(P, PI) _Pragma("unroll") for (int k = 0; k < 4; ++k) { const float s4 = (P[4 * k] + P[4 * k + 1]) + (P[4 * k + 2] + P[4 * k + 3]); \
            const float prev0 = k >= 1 ? eo[PI][k >= 1 ? k - 1 : 0] : ((PI) >= 1 ? eo[(PI) >= 1 ? (PI) - 1 : 0][3] : 0.f); ir[8 * (PI) + 2 * k + h] = s4 + (h ? eo[PI][k] : prev0); }
        IMP_ST(p0, 0) IMP_ST(p1, 1) IMP_ST(p2, 2) IMP_ST(p3, 3)
#undef IMP_ST
        PSEC_E(7); PSEC_B(8);
        f32x16 oc[2];
#pragma unroll
        for (int db = 0; db < 2; ++db)
#pragma unroll
            for (int r = 0; r < 16; ++r) oc[db][r] = 0.f;
        pv_tile<64>(lds + 2 * L::KB, p0, p1, oc, lane); pv_tile<64>(lds + 2 * L::KB + L::VB, p2, p3, oc, lane);
#pragma unroll
        for (int db = 0; db < 2; ++db)
#pragma unroll
            for (int r = 0; r < 8; ++r) accp[db][r] = cvtpk(g0 * oc[db][2 * r], g0 * oc[db][2 * r + 1]);
    }
    __syncthreads();
    PSEC_E(8); PSEC_E(1); PSEC_B(2);
    LAS float* vsl = (LAS float*)(lds + 8 * L::KB + 4 * 64 * 33 * 4 + 256);
#pragma unroll 1
    for (int i = 0; i < 4; ++i) { const int id = tid + NT * i, qq = id >> 5, jb = id & 31;
        const bool allowed = jb <= jt, forced = allowed && (jb == 0 || jb >= jt - 1);
        const float iv = (imp[qq * 33 + jb] + imp[64 * 33 + qq * 33 + jb]) + (imp[2 * 64 * 33 + qq * 33 + jb] + imp[3 * 64 * 33 + qq * 33 + jb]);
        vsl[id] = forced ? 1e9f : (allowed ? iv : -1e30f); }
    __syncthreads();
#pragma unroll 1
    for (int i = 0; i < 4; ++i) { const int id = tid + NT * i, qq = id >> 5, jb = id & 31;
        const float v = vsl[id]; int rank = 0;
#pragma unroll
        for (int k4 = 0; k4 < 8; ++k4) { const f32x4 w = *(const LAS f32x4*)(vsl + qq * 32 + 4 * k4);
            rank += (w.x > v || (w.x == v && 4 * k4 + 0 < jb)) ? 1 : 0; rank += (w.y > v || (w.y == v && 4 * k4 + 1 < jb)) ? 1 : 0;
            rank += (w.z > v || (w.z == v && 4 * k4 + 2 < jb)) ? 1 : 0; rank += (w.w > v || (w.w == v && 4 * k4 + 3 < jb)) ? 1 : 0; }
        const unsigned long long bal = __ballot(jb <= jt && rank < 16);
        if (jb == 0) selw[qq] = (unsigned)(bal >> (lane & 32)); }
    __syncthreads();
    const unsigned mysel = selw[32 * qsub + r32];
    unsigned uni = selw[lane];
    uni |= swzu<1>(uni); uni |= swzu<2>(uni); uni |= swzu<4>(uni); uni |= swzu<8>(uni); uni |= swzu<16>(uni); uni = or32(uni);
    uni = __builtin_amdgcn_readfirstlane(uni);
    PSEC_E(2); PSEC_B(3);
    {
        struct SlcF { unsigned mysel; int qrow, h, jt; DI bool skip(int) const { return false; }
            DI void mask(f32x16& p0, f32x16& p1, int t) const { const float bias = ((mysel >> t) & 1u) ? 0.f : -INFINITY;
#pragma unroll
                for (int r = 0; r < 16; ++r) { p0[r] += bias; p1[r] += bias; }
                if (t == jt) {
#pragma unroll
                    for (int r = 0; r < 16; ++r) { const int kv = t * 64 + crow(r, h); if (kv > qrow) p0[r] = -INFINITY; if (kv + 32 > qrow) p1[r] = -INFINITY; } } } };
        f32x16 o[2];
#pragma unroll
        for (int db = 0; db < 2; ++db)
#pragma unroll
            for (int r = 0; r < 16; ++r) o[db][r] = 0.f;
        float mm = -INFINITY, l = 0.f;
        flash_sweep<64, 64, FX_STG>(c, qf, U + rb * UW + 1312 + 64 * g, UW, U + rb * UW + 1440 + 64 * g, UW, BitsIt{uni}, SlcF{mysel, qrow, h, jt}, o, mm, l);
        l = sum32(l); const float sc = g1 / l;
#pragma unroll
        for (int db = 0; db < 2; ++db)
#pragma unroll
            for (int r = 0; r < 8; ++r) accp[db][r] = cvtpk(bflo(accp[db][r]) + sc * o[db][2 * r], bfhi(accp[db][r]) + sc * o[db][2 * r + 1]);
    }
    PSEC_E(3); PSEC_B(4);
    {
        struct WinF { int qrow, h, jt; DI bool skip(int) const { return false; }
            DI void mask(f32x16& p0, f32x16& p1, int t) const { if (t == jt || t == jt - 8) {
#pragma unroll
                for (int r = 0; r < 16; ++r) { const int kv = t * 64 + crow(r, h); if (kv > qrow || kv <= qrow - 512) p0[r] = -INFINITY; if (kv + 32 > qrow || kv + 32 <= qrow - 512) p1[r] = -INFINITY; } } } };
        f32x16 o[2];
#pragma unroll
        for (int db = 0; db < 2; ++db)
#pragma unroll
            for (int r = 0; r < 16; ++r) o[db][r] = 0.f;
        float mm = -INFINITY, l = 0.f;
        flash_sweep<64, 64, FX_STG>(c, qf, U + rb * UW + 1568 + 64 * g, UW, U + rb * UW + 1696 + 64 * g, UW, RangeIt{jt - 8 > 0 ? jt - 8 : 0, jt}, WinF{qrow, h, jt}, o, mm, l);
        l = sum32(l); const float sc = g2 / l;
#pragma unroll
        for (int db = 0; db < 2; ++db)
#pragma unroll
            for (int r = 0; r < 8; ++r) accp[db][r] = cvtpk(bflo(accp[db][r]) + sc * o[db][2 * r], bfhi(accp[db][r]) + sc * o[db][2 * r + 1]);
    }
    PSEC_E(4);
    { bf16_t* rowp = YC + m * 1024 + 512 + 64 * head;
#pragma unroll
      for (int db = 0; db < 2; ++db)
#pragma unroll
          for (int k = 0; k < 4; ++k) { u32x2 v; v.x = accp[db][2 * k]; v.y = accp[db][2 * k + 1]; *(u32x2*)(rowp + 32 * db + 8 * k + 4 * h) = v; } }
}
}
#ifndef FX_MODE
#define FX_MODE 0
#endif
namespace fx {
template <int ACT  > struct EpiB16 {
    static constexpr bool PERM = true, AFTER_DRAIN = false;
    bf16_t* O; int ldc; const float* ss; const float* shw;
    __device__ __forceinline__ void operator()(const pg8::f32x4 (&acc)[2][2][4][2], const pg8::Unit& u, int wr, int wc, int fr, int fq) const {
        const int row0 = u.pm * 256 + wr * 64 + fr, col0 = u.pn * 256 + wc * 32 + 8 * fq;
        const bool FUSED = ss != nullptr; pg8::f32x4 sv[2][2];
        if (FUSED) { const float* sp = shw + (size_t)(u.pm >> 3) * 4096 + col0;
#pragma unroll
            for (int bj = 0; bj < 2; ++bj) { sv[bj][0] = *(const pg8::f32x4*)(sp + bj * 128); sv[bj][1] = *(const pg8::f32x4*)(sp + bj * 128 + 4); } }
#pragma unroll
        for (int ai = 0; ai < 2; ++ai)
#pragma unroll
            for (int m = 0; m < 4; ++m) { const int row = row0 + ai * 128 + m * 16; bf16_t* rowp = O + (size_t)row * ldc + col0;
                float rs = 1.f; if (FUSED) { const pg8::f32x4* sp4 = (const pg8::f32x4*)(ss + (size_t)row * 16); const pg8::f32x4 a0 = sp4[0], a1 = sp4[1], a2 = sp4[2], a3 = sp4[3];
                    const float tot = (((a0[0] + a0[1]) + (a0[2] + a0[3])) + ((a1[0] + a1[1]) + (a1[2] + a1[3]))) + (((a2[0] + a2[1]) + (a2[2] + a2[3])) + ((a3[0] + a3[1]) + (a3[2] + a3[3]))); rs = rsqrtf(tot * (1.f / 1024.f) + EPS); }
#pragma unroll
                for (int bj = 0; bj < 2; ++bj) { pg8::f32x4 v0 = acc[ai][bj][m][0], v1 = acc[ai][bj][m][1];
                    if (FUSED) { v0 = v0 * rs + sv[bj][0]; v1 = v1 * rs + sv[bj][1]; }
                    if (ACT == 1) {
#pragma unroll
                        for (int e = 0; e < 4; ++e) { float a = v0[e] > 0.f ? v0[e] : 0.f; v0[e] = a * a; float b = v1[e] > 0.f ? v1[e] : 0.f; v1[e] = b * b; } }
                    u32x4 w; w.x = pg8::cvt_pk_bf16(v0[0], v0[1]); w.y = pg8::cvt_pk_bf16(v0[2], v0[3]); w.z = pg8::cvt_pk_bf16(v1[0], v1[1]); w.w = pg8::cvt_pk_bf16(v1[2], v1[3]);
                    *(u32x4*)(rowp + bj * 128) = w; } }
    }
};
struct UpOrder : pg8::StaticOrder {
    __device__ bool next(int i, pg8::Unit& u) const { if (!pg8::StaticOrder::next(i, u)) return false; u.aoff = u.pn >= 3 ? 256 : 0; return true; }
};
struct EpiResid {
    static constexpr bool PERM = true, AFTER_DRAIN = false;
    const float* base32; const bf16_t* base16; float* out32; bf16_t* out16; const float* gate; bf16_t* xa; const float* ngain; const float* nsc; float* ss;
    __device__ __forceinline__ void operator()(const pg8::f32x4 (&acc)[2][2][4][2], const pg8::Unit& u, int wr, int wc, int fr, int fq) const {
        const int row0 = u.pm * 256 + wr * 64 + fr, col0 = u.pn * 256 + wc * 32 + 8 * fq; const int b = u.pm >> 3; const float* gp = gate + (size_t)b * 6144 + col0;
        pg8::f32x4 gv[2][2], av[2][2];
#pragma unroll
        for (int bj = 0; bj < 2; ++bj)
#pragma unroll
            for (int n = 0; n < 2; ++n) { gv[bj][n] = *(const pg8::f32x4*)(gp + bj * 128 + n * 4);
                if (xa) { const pg8::f32x4 g = *(const pg8::f32x4*)(ngain + col0 + bj * 128 + n * 4), sc = *(const pg8::f32x4*)(nsc + (size_t)b * 6144 + col0 + bj * 128 + n * 4); av[bj][n] = g * (sc + 1.f); } }
#pragma unroll
        for (int ai = 0; ai < 2; ++ai)
#pragma unroll
            for (int m = 0; m < 4; ++m) { const int row = row0 + ai * 128 + m * 16; const size_t off = (size_t)row * 1024 + col0; float sq = 0.f;
#pragma unroll
                for (int bj = 0; bj < 2; ++bj) { pg8::f32x4 xn[2];
                    if (base32) { xn[0] = *(const pg8::f32x4*)(base32 + off + bj * 128); xn[1] = *(const pg8::f32x4*)(base32 + off + bj * 128 + 4); }
                    else { const u32x4 bw = *(const u32x4*)(base16 + off + bj * 128); xn[0] = (pg8::f32x4){bflo(bw.x), bfhi(bw.x), bflo(bw.y), bfhi(bw.y)}; xn[1] = (pg8::f32x4){bflo(bw.z), bfhi(bw.z), bflo(bw.w), bfhi(bw.w)}; }
                    xn[0] = xn[0] + gv[bj][0] * acc[ai][bj][m][0]; xn[1] = xn[1] + gv[bj][1] * acc[ai][bj][m][1];
                    if (out32) { *(pg8::f32x4*)(out32 + off + bj * 128) = xn[0]; *(pg8::f32x4*)(out32 + off + bj * 128 + 4) = xn[1]; }
                    else { u32x4 w; w.x = pg8::cvt_pk_bf16(xn[0][0], xn[0][1]); w.y = pg8::cvt_pk_bf16(xn[0][2], xn[0][3]); w.z = pg8::cvt_pk_bf16(xn[1][0], xn[1][1]); w.w = pg8::cvt_pk_bf16(xn[1][2], xn[1][3]); *(u32x4*)(out16 + off + bj * 128) = w; }
                    if (xa) { sq += ((xn[0][0] * xn[0][0] + xn[0][1] * xn[0][1]) + (xn[0][2] * xn[0][2] + xn[0][3] * xn[0][3])) + ((xn[1][0] * xn[1][0] + xn[1][1] * xn[1][1]) + (xn[1][2] * xn[1][2] + xn[1][3] * xn[1][3]));
                        const pg8::f32x4 y0 = xn[0] * av[bj][0], y1 = xn[1] * av[bj][1];
                        u32x4 w; w.x = pg8::cvt_pk_bf16(y0[0], y0[1]); w.y = pg8::cvt_pk_bf16(y0[2], y0[3]); w.z = pg8::cvt_pk_bf16(y1[0], y1[1]); w.w = pg8::cvt_pk_bf16(y1[2], y1[3]);
                        *(u32x4*)(xa + off + bj * 128) = w; } }
                if (xa) { sq += swz<16>(sq); sq = sum32(sq); if (fq == 0) ss[(size_t)row * 16 + u.pn * 4 + wc] = sq; } }
    }
};

DI bool static_unit(int nM, int nN, int G, int c, int i, int& pm, int& pn) {
    const int nwg = nM * nN; const long L = (long)i * G + c; if (L >= nwg) return false;
    int wgid = (int)L; { const int q = nwg / pg8::NXCD, r = nwg % pg8::NXCD, xcd = wgid % pg8::NXCD, off = wgid / pg8::NXCD; wgid = (xcd < r ? xcd * (q + 1) : r * (q + 1) + (xcd - r) * q) + off; }
    const int nig = pg8::WGM * nN, gid = wgid / nig, fm = gid * pg8::WGM, gsz = (nM - fm) < pg8::WGM ? (nM - fm) : pg8::WGM;
    pm = fm + ((wgid % nig) % gsz); pn = (wgid % nig) / gsz; return true;
}
#ifndef FX_REPEAT_KIND
#define FX_REPEAT_KIND 0
#endif
#ifndef FX_VAR
#define FX_VAR 0
#endif
#define DUMMY_OUT ((float*)(ws + 344 * MiB))
#define DUMMY_XB ((bf16_t*)(ws + 344 * MiB))
__global__ void __launch_bounds__(NT, 2) mega(Args args) {
    extern __shared__ __attribute__((aligned(16))) unsigned char lds_raw[];
    Ctx c; c.lds = (LAS unsigned char*)lds_raw; c.tid = threadIdx.x; c.lane = c.tid & 63; c.wave = __builtin_amdgcn_readfirstlane(c.tid >> 6); c.G = gridDim.x; c.bid = blockIdx.x; c.a = nullptr; c.var = 0; c.pr_acc = 0u; c.pr_t = 0ull; (void)args;
#define KARGS() ({ CArgs* p_ = (CArgs*)__builtin_amdgcn_kernarg_segment_ptr(); asm volatile("" : "+s"(p_)); p_; })
    CArgs* pa0 = KARGS();
    volatile LAS unsigned* MISC = (volatile LAS unsigned*)(c.lds + LDS_MISC);
    for (int i = c.tid; i < 64; i += NT) MISC[i] = 0u;
    __syncthreads();
    XcdBarrier bar = xcd_barrier_post((unsigned*)(pa0->ws + WS_CTL) + 4096, MISC + 8);
    int ph = 0;
#ifdef PROBE_PHASE
    unsigned long long pr_t0 = 0ull; unsigned pr_dt = 0u;
    pr_t0 = __builtin_amdgcn_s_memrealtime();
#endif
#if FX_MODE == 0
    constexpr int lo = 0, hi = 26;
#else
    const int lo = pa0->ph_lo, hi = pa0->ph_hi;
#endif
#define SEAM() do { if (ph + 1 < hi) { xcd_barrier(bar); if (FX_REPEAT_KIND == 12) xcd_barrier(bar); } } while (0)
#ifdef PROBE_PHASE
#define PROBE_T0() do { if (ph == PROBE_PHASE) pr_t0 = __builtin_amdgcn_s_memrealtime(); } while (0)
#ifndef PROBE_WORK
#define PROBE_WORK 0
#endif
#define PROBE_T1() do { if (!PROBE_WORK && ph == PROBE_PHASE) pr_dt = (unsigned)(__builtin_amdgcn_s_memrealtime() - pr_t0); } while (0)
#define PROBE_T1W() do { if (PROBE_WORK && ph == PROBE_PHASE) { __syncthreads(); pr_dt = (unsigned)(__builtin_amdgcn_s_memrealtime() - pr_t0); } } while (0)
#else
#define PROBE_T1W() do {} while (0)
#define PROBE_T0() do {} while (0)
#define PROBE_T1() do {} while (0)
#endif
#define PHASE_BEGIN if (ph >= lo && ph < hi) { PROBE_T0(); CArgs* pa = KARGS(); c.a = pa; unsigned char* ws = pa->ws; c.ws = ws; RELAUNDER(c); const int gw = c.bid * NW + c.wave, NGW = c.G * NW; (void)gw; (void)NGW; \
    const float* MOD = (const float*)(ws + WS_MOD); const float* mod = MOD + (size_t)layer * 8 * 6144; (void)mod; \
    bf16_t* XN = (bf16_t*)(ws + WS_XN); bf16_t* YC = (bf16_t*)(ws + WS_YC); bf16_t* U = (bf16_t*)(ws + WS_BIG + BIG_U); bf16_t* QL = (bf16_t*)(ws + WS_BIG + BIG_UP); bf16_t* KVU = QL + 768; \
    bf16_t* KF = XN; bf16_t* HID = (bf16_t*)(ws + WS_BIG); bf16_t* QKV = (bf16_t*)(ws + WS_BIG); bf16_t* XB = (bf16_t*)(ws + WS_XB); (void)XB; float* SS = (float*)(ws + WS_SS); const float* SHW = (const float*)(ws + WS_SHW); (void)SS; (void)SHW; (void)XN; (void)YC; (void)U; (void)QL; (void)KVU; (void)KF; (void)HID; (void)QKV; \
    unsigned char* wb = ws + ((layer & 1) ? WS_WODD + (size_t)(layer >> 1) * W_ODD : WS_WEVEN + (size_t)(layer >> 1) * W_EVEN); unsigned char* wm = ws + WS_WMLP + (size_t)layer * W_MLP; (void)wb; (void)wm;
#define PHASE_END PROBE_T1W(); SEAM(); PROBE_T1(); } ++ph;
    int layer = 0;

    if (lo == 0) { CArgs* pa = KARGS(); c.a = pa; c.ws = pa->ws; RELAUNDER(c);
#if FX_REPEAT_KIND == 20
        {
          const u32x4* src = (const u32x4*)(pa->ws + 40 * MiB); u32x4 acc4 = (u32x4){0u, 0u, 0u, 0u}; const size_t n16 = (256 * MiB) / 16;
          for (size_t i = (size_t)c.bid * NT + c.tid; i < n16; i += (size_t)c.G * NT * 8) {
#pragma unroll
              for (int u = 0; u < 8; ++u) { const size_t k = i + (size_t)u * c.G * NT; if (k < n16) { const u32x4 v = src[k]; acc4.x ^= v.x; acc4.y ^= v.y; acc4.z ^= v.z; acc4.w ^= v.w; } } }
          if ((acc4.x ^ acc4.y ^ acc4.z ^ acc4.w) == 0x12345u) ((unsigned*)(pa->ws + 380 * MiB))[c.tid] = acc4.x; }
#endif
#ifndef SKIP_PRO
        REP(10) phase_prologue(c);
#endif
        if (hi > 1) { if (pa->use_cg != 0) cooperative_groups::this_grid().sync(); else xcd_barrier(bar); }
#ifdef PROBE_PHASE
        if (PROBE_PHASE == 0) pr_dt = (unsigned)(__builtin_amdgcn_s_memrealtime() - pr_t0);
#endif
    }
    ++ph;

#pragma clang loop unroll(full)
    for (layer = 0; layer < 4; ++layer) {
        const int j = layer >> 1;
        if (layer == 0) {
        PHASE_BEGIN
            PSEC_B(9); REP(8) phase_modnorm(c, pa->in[0], pa->in[5], mod + 0, mod + 1024, XN); PSEC_E(9);
            PSEC_B(10); REP(15) { shw_items(c, 0); if (FX_PRO_MATS >= 28) shw_items(c, 1); } PSEC_E(10);
        PHASE_END
        }
        if ((layer & 1) == 0) {
            PHASE_BEGIN { pg8::Gemm g{XN, (const bf16_t*)(wb + WE_IN), T, UW, D, D}; pg8::StaticOrder so; so.init(T, UW, c.G, c.bid); EpiB16<0> E{U, UW, layer == 0 ? nullptr : SS + (size_t)(2 * layer) * T * 16, SHW + (size_t)(2 * layer) * 8 * 4096};

#ifndef SKIP_G1
REP(6) pg8::gemm_phase<EpiB16<0>, pg8::StaticOrder, true, true>(c.lds, g, so, E);
#endif
 } PHASE_END
            PHASE_BEGIN { pg8::Gemm g{U, (const bf16_t*)(wb + WE_UP), T, 1792, 256, UW}; UpOrder so; so.init(T, 1792, c.G, c.bid); EpiB16<0> E{QL, UPW, nullptr, nullptr};

#ifndef SKIP_G2
PSEC_B(13); REP(13) pg8::gemm_phase<EpiB16<0>, UpOrder, false, true>(c.lds, g, so, E); PSEC_E(13);
#endif

                __syncthreads();

#ifndef SKIP_CMP
 PSEC_B(14); REP(14) for (int it = c.bid; it < 256; it += c.G) compress_item(c, U, j, it); PSEC_E(14);
#endif


#ifndef SKIP_FIN
 RELAUNDER(c); PSEC_B(15); for (int m0 = gw; m0 < T; m0 += NGW * 8) nsa_finalize_rows(c, U, m0, NGW, j); PSEC_E(15);
#endif
 } PHASE_END
            PHASE_BEGIN {
#ifndef SKIP_FIN
 for (int m0 = gw; m0 < T; m0 += NGW * TBV) mla_finalize_rows(c, U, QL, KVU, KF, m0, NGW, j);
                __syncthreads();
#endif

                REP(1) for (int p = c.bid; p < 256; p += c.G) { const int bg = p >> 4, s = p & 15;
#ifndef SKIP_NSA
 nsa_unit(c, U, YC, bg >> 1, bg & 1, 31 - s); nsa_unit(c, U, YC, bg >> 1, bg & 1, s);
#endif
 } } PHASE_END
            PHASE_BEGIN { REP(2) for (int p = c.bid; p < 256; p += c.G) { const int bh = p >> 2, s = p & 3;
#ifndef SKIP_MLA
 { bf16_t* yo_ = rep_ ? (bf16_t*)(ws + 344 * MiB) : YC; c.var = rep_ ? FX_VAR : 0; mla_unit(c, QL, KF, KVU, yo_, bh >> 3, bh & 7, 7 - s); mla_unit(c, QL, KF, KVU, yo_, bh >> 3, bh & 7, s); c.var = 0; }
#endif
 }
                if (layer == 0 && FX_PRO_MATS < 28) { __syncthreads(); RELAUNDER(c); convert_mats(c, FX_PRO_MATS, 28); } } PHASE_END
            PHASE_BEGIN { pg8::Gemm g{YC, (const bf16_t*)(wb + WE_OUT), T, D, D, D}; pg8::StaticOrder so; so.init(T, D, c.G, c.bid);
#ifndef SKIP_G3
REP(9) { EpiResid E{layer == 0 ? pa->in[0] : nullptr, XB, nullptr, rep_ ? DUMMY_XB : XB, mod + 2048, XN, pa->in[6] + layer * D, mod + 4096, SS + (size_t)(2 * layer + 1) * T * 16}; pg8::gemm_phase<EpiResid, pg8::StaticOrder, true, true>(c.lds, g, so, E); }
#endif
                if (layer == 0 && FX_PRO_MATS < 28) { RELAUNDER(c); shw_items(c, 1); }
 } PHASE_END
        } else {
            PHASE_BEGIN { pg8::Gemm g{XN, (const bf16_t*)(wb + WO_QKV), T, 3072, D, D}; pg8::StaticOrder so; so.init(T, 3072, c.G, c.bid); EpiB16<0> E{QKV, 3072, SS + (size_t)(2 * layer) * T * 16, SHW + (size_t)(2 * layer) * 8 * 4096};

#ifndef SKIP_G4
PSEC_B(11); REP(7) pg8::gemm_phase<EpiB16<0>, pg8::StaticOrder, true, true>(c.lds, g, so, E); PSEC_E(11); PSEC_B(12);
                asm volatile("s_waitcnt vmcnt(0)" ::: "memory"); __syncthreads(); RELAUNDER(c);
                for (int i = 0; i < 3; ++i) { int pm_, pn_; if (!static_unit(T / 256, 3072 / 256, c.G, c.bid, i, pm_, pn_)) break; if (pn_ < 8) diff_finalize_tile(c, QKV, pm_, pn_, j); } PSEC_E(12);
#endif
 } PHASE_END
            PHASE_BEGIN { REP(3) for (int p = c.bid; p < 256; p += c.G) { const int bh = p >> 2, s = p & 3;
#ifndef SKIP_DIFF
 diff_unit(c, QKV, YC, bh >> 3, bh & 7, 7 - s, j, layer); diff_unit(c, QKV, YC, bh >> 3, bh & 7, s, j, layer);
#endif
 } } PHASE_END
            PHASE_BEGIN { pg8::Gemm g{YC, (const bf16_t*)(wb + WO_O), T, D, D, D}; pg8::StaticOrder so; so.init(T, D, c.G, c.bid);
#ifndef SKIP_G5
REP(9) { EpiResid E{nullptr, XB, nullptr, rep_ ? DUMMY_XB : XB, mod + 2048, XN, pa->in[6] + layer * D, mod + 4096, SS + (size_t)(2 * layer + 1) * T * 16}; pg8::gemm_phase<EpiResid, pg8::StaticOrder, true, true>(c.lds, g, so, E); }
#endif
 } PHASE_END
        }
        PHASE_BEGIN { pg8::Gemm g{XN, (const bf16_t*)wm, T, FF, D, D}; pg8::StaticOrder so; so.init(T, FF, c.G, c.bid); EpiB16<1> E{HID, FF, SS + (size_t)(2 * layer + 1) * T * 16, SHW + (size_t)(2 * layer + 1) * 8 * 4096};

#ifndef SKIP_G6
REP(4) pg8::gemm_phase<EpiB16<1>, pg8::StaticOrder, true, true>(c.lds, g, so, E);
#endif
 } PHASE_END
        PHASE_BEGIN { pg8::Gemm g{HID, (const bf16_t*)(wm + 8 * MiB), T, D, FF, FF}; pg8::StaticOrder so; so.init(T, D, c.G, c.bid);
#ifndef SKIP_G7
REP(5) { EpiResid E{nullptr, XB, (layer == 3 && !rep_) ? pa->out : nullptr, rep_ ? DUMMY_XB : XB, mod + 5120, layer < 3 ? XN : nullptr, pa->in[5] + (layer + 1) * D, MOD + (size_t)(layer + 1) * 8 * 6144 + 1024, SS + (size_t)(2 * layer + 2) * T * 16}; pg8::gemm_phase<EpiResid, pg8::StaticOrder, true, true>(c.lds, g, so, E); }
#endif
 } PHASE_END
    }
#ifdef PROBE_SEC
#ifndef PROBE_WAVE
#define PROBE_WAVE 0
#endif
    if (blockIdx.x == 0 && threadIdx.x == PROBE_WAVE * 64) MISC[16] = c.pr_acc;
    __syncthreads();
#endif
#ifdef PROBE_PHASE
    { if (blockIdx.x == 0 && threadIdx.x == 0) {
#ifndef PROBE_MULT
#define PROBE_MULT 2u
#endif
          const unsigned long long t_end = __builtin_amdgcn_s_memrealtime();
#ifdef PROBE_SEC
          pr_dt = MISC[16];
#endif
          const unsigned long long wait = (unsigned long long)pr_dt * PROBE_MULT;
          while (__builtin_amdgcn_s_memrealtime() - t_end < wait) __builtin_amdgcn_s_sleep(8); } }
#endif
#undef PHASE_BEGIN
#undef PHASE_END
#undef SEAM
}
constexpr int N_PHASES = 1 + 1 + 2 * (5 + 2) + 2 * (3 + 2);
static_assert(N_PHASES == 26, "phase count");

inline void launch(const Args& base, int lo, int hi, int use_cg, hipStream_t st) {
    static int grid = 0;
    if (grid == 0) {
        int dev = 0, cus = 0, per_cu = 0;
        (void)hipGetDevice(&dev); (void)hipDeviceGetAttribute(&cus, hipDeviceAttributeMultiprocessorCount, dev);
        (void)hipFuncSetAttribute((const void*)mega, hipFuncAttributeMaxDynamicSharedMemorySize, LDS_BYTES);
        (void)hipOccupancyMaxActiveBlocksPerMultiprocessor(&per_cu, (const void*)mega, NT, LDS_BYTES);
        if (per_cu < 1) { fprintf(stderr, "occupancy query says %d blocks/CU\n", per_cu); per_cu = 1; }
        grid = cus;
        (void)hipGetLastError();
    }
    Args a = base; a.ph_lo = lo; a.ph_hi = hi; a.use_cg = use_cg; a.pad = 0;
    void* kargs[] = {&a};
#ifndef FX_COOP
#define FX_COOP 1
#endif
#if FX_COOP
    hipError_t e = hipLaunchCooperativeKernel((const void*)mega, dim3(grid), dim3(NT), kargs, LDS_BYTES, st);
    if (e != hipSuccess) fprintf(stderr, "cooperative launch failed: %s\n", hipGetErrorString(e));
#else
    (void)kargs; hipLaunchKernelGGL(mega, dim3(grid), dim3(NT), LDS_BYTES, st, a);
#endif
}
}
#ifndef FX_COOP
#define FX_COOP 1
#endif
#ifndef FX_MODE
#define FX_MODE 0
#endif
#ifndef DBG_LAYERS
#define DBG_LAYERS 1
#endif
#ifndef DBG_B0
#define DBG_B0 5
#endif
#ifndef DBG_STAGE
#define DBG_STAGE 0
#endif
#ifndef DBG_NPH
#define DBG_NPH -1
#endif
namespace dbg {
__global__ void k_cmp(const void* fast, int is_bf16, long fld, const float* ref, long rld, int nrows, int ncols, float fscale, float* acc2) {
    const long n = (long)nrows * ncols; float d2 = 0.f, r2 = 0.f;
    for (long i = (long)blockIdx.x * 256 + threadIdx.x; i < n; i += (long)gridDim.x * 256) { const long r = i / ncols, cidx = i % ncols;
        float a = is_bf16 ? fx::bf2f(((const unsigned short*)fast)[r * fld + cidx]) : ((const float*)fast)[r * fld + cidx]; a *= fscale;
        const float b = ref[r * rld + cidx]; if (!(a == a)) a = 1e6f; d2 += (a - b) * (a - b); r2 += b * b; }
    for (int o = 32; o > 0; o >>= 1) { d2 += __shfl_xor(d2, o); r2 += __shfl_xor(r2, o); }
    if ((threadIdx.x & 63) == 0) { atomicAdd(acc2, d2); atomicAdd(acc2 + 1, r2); }
}
#ifndef DBG_SEL
#define DBG_SEL -1
#endif
__global__ void k_finish(float* out, const float* acc, int nchk, long n) {
    float e = 0.f; int bad = -1; for (int i = 0; i < nchk; ++i) { float v = sqrtf(acc[2 * i] / fmaxf(acc[2 * i + 1], 1e-30f)); if (!(v == v)) v = 100.f; e = fmaxf(e, v); if (bad < 0 && v > 0.05f) bad = i; }
    if (DBG_SEL >= 0) { e = sqrtf(acc[2 * DBG_SEL] / fmaxf(acc[2 * DBG_SEL + 1], 1e-30f)); if (!(e == e)) e = 100.f; bad = -1; }
    if (blockIdx.x == 0 && threadIdx.x == 0 && bad >= 0) out[0] += 1000.f * (bad + 1);
    for (long i = (long)blockIdx.x * 256 + threadIdx.x; i < n; i += (long)gridDim.x * 256) out[i] *= (1.f + e);
}
}
extern "C" void kernel_launch(void* const* d_in, const int* in_sizes, int n_in, void* d_out, int out_size, void* d_ws, size_t ws_size, hipStream_t stream) {
    fx::Args a{};
    for (int i = 0; i < 28; ++i) a.in[i] = (const float*)d_in[i];
    a.pos = (const int*)d_in[2]; a.out = (float*)d_out; a.ws = (unsigned char*)d_ws;
    (void)hipMemsetAsync((char*)d_ws + fx::WS_CTL, 0, 65536, stream);
#if FX_MODE == 0
    fx::launch(a, 0, fx::N_PHASES, FX_COOP ? 1 : 0, stream);
#elif FX_MODE == 1
    for (int p = 0; p < fx::N_PHASES; ++p) fx::launch(a, p, p + 1, 0, stream);
#else
    nv::In in{}; for (int i = 0; i < 28; ++i) in.p[i] = (const float*)d_in[i]; in.pos = (const int*)d_in[2];
    float* errs = (float*)((char*)d_ws + 381 * fx::MiB);
    (void)hipMemsetAsync(errs, 0, 256, stream);
    const int nph = DBG_NPH >= 0 ? DBG_NPH : (DBG_LAYERS == 1 ? 9 : DBG_LAYERS == 2 ? 15 : DBG_LAYERS == 3 ? 22 : 28);
    for (int p = 0; p < nph; ++p) fx::launch(a, p, p + 1, 0, stream);
    float* nws = (float*)((char*)d_ws + fx::WS_NAIVE); float* nx = (float*)((char*)d_ws + fx::WS_NAIVE + 56 * fx::MiB);
    nv::forward(in, nx, nws, stream, DBG_LAYERS, DBG_B0, 1, DBG_STAGE == 8 ? 6 : DBG_STAGE);
    int nchk = 0;
    auto CMPR = [&](const void* f, int isb, long fld, const float* r, long rld, int nrows, int ncols, float fs) { hipLaunchKernelGGL(dbg::k_cmp, dim3(512), dim3(256), 0, stream, f, isb, fld, r, rld, nrows, ncols, fs, errs + 2 * nchk); ++nchk; };
    auto CMP = [&](const void* f, int isb, long fld, const float* r, long rld, int ncols, float fs) { CMPR(f, isb, fld, r, rld, 2048, ncols, fs); };
    const size_t r0 = (size_t)DBG_B0 * 2048;
    unsigned char* ws = (unsigned char*)d_ws;
    const size_t NMi = (size_t)(1u << 20) / 8;
    float* nU = nws + nv::R_U; float* nRA = nU + 29 * NMi; float* nRB = nRA + 12 * NMi; float* nRC = nRB + 16 * NMi; float* nRD = nRC + 12 * NMi; float* nH = nRD + 8 * NMi;
    (void)nRA; (void)nRB; (void)nRC; (void)nRD; (void)nH;
    const fx::bf16_t* fU = (const fx::bf16_t*)(ws + fx::WS_BIG + fx::BIG_U); const fx::bf16_t* fQL = (const fx::bf16_t*)(ws + fx::WS_BIG + fx::BIG_UP);
    const fx::bf16_t* fKVU = fQL + 768; const fx::bf16_t* fXN = (const fx::bf16_t*)(ws + fx::WS_XN); const fx::bf16_t* fYC = (const fx::bf16_t*)(ws + fx::WS_YC);
    (void)fU; (void)fQL; (void)fKVU; (void)fXN; (void)fYC;
#if DBG_STAGE == 0 || DBG_STAGE == 9
    CMP((const float*)d_out + r0 * 1024, 0, 1024, nx, 1024, 1024, 1.f);
#elif DBG_STAGE == 1
    if ((DBG_LAYERS & 1) == 1) { CMP(fU + r0 * 2048, 1, 2048, nU, 1848, 544, 1.f); CMP(fU + r0 * 2048 + 1056, 1, 2048, nU + 1056, 1848, 256, 1.f); CMP(fU + r0 * 2048 + 1824, 1, 2048, nU + 1824, 1848, 24, 1.f); }
    else { CMP(fU + r0 * 3072 + 2048, 1, 3072, nU + 2048, 3072, 1024, 1.f); }
#elif DBG_STAGE == 2
    if ((DBG_LAYERS & 1) == 1) { CMP(fQL + r0 * 1792, 1, 1792, nRC, 768, 768, 1.f / (0.10206207261596577f * 1.4426950408889634f)); CMP(fXN + r0 * 768, 1, 768, nRA, 768, 768, 1.f); }
    else { CMP(fU + r0 * 3072, 1, 3072, nU, 3072, 1024, 1.f / (0.125f * 1.4426950408889634f)); CMP(fU + r0 * 3072 + 1024, 1, 3072, nU + 1024, 3072, 1024, 1.f); }
#elif DBG_STAGE == 3
    CMP(fU + r0 * 2048, 1, 2048, nU, 1848, 544, 1.f); CMP(fU + r0 * 2048 + 1056, 1, 2048, nU + 1056, 1848, 256, 1.f); CMP(fU + r0 * 2048 + 1824, 1, 2048, nU + 1824, 1848, 24, 1.f);
    CMP(fQL + r0 * 1792, 1, 1792, nRC, 768, 768, 1.f / (0.10206207261596577f * 1.4426950408889634f)); CMP(fXN + r0 * 768, 1, 768, nRA, 768, 768, 1.f);
    CMP(fYC + r0 * 1024, 1, 1024, nH, 1024, 512, 1.f);
#elif DBG_STAGE == 4
    if ((DBG_LAYERS & 1) == 1) { CMP(fU + r0 * 2048 + 544, 1, 2048, nRD, 512, 512, 1.f / (0.125f * 1.4426950408889634f)); }
    else { CMP(fYC + r0 * 1024, 1, 1024, nU, 1024, 1024, 1.f); }
#elif DBG_STAGE == 6
    { const float* nSM = nws + nv::R_SMALL; const fx::bf16_t* fKC = (const fx::bf16_t*)(ws + fx::WS_MISC + 65536) + (size_t)DBG_B0 * 2 * 128 * 64; const fx::bf16_t* fVC = fKC + 16 * 128 * 64;
      CMP(fU + r0 * 2048 + 544, 1, 2048, nRD, 512, 512, 1.f / (0.125f * 1.4426950408889634f));
      CMPR(fKC, 1, 64, nSM, 64, 127, 64, 1.f); CMPR(fKC + 128 * 64, 1, 64, nSM + 128 * 64, 64, 127, 64, 1.f);
      CMPR(fVC, 1, 64, nSM + 16 * 128 * 64, 64, 127, 64, 1.f); CMPR(fVC + 128 * 64, 1, 64, nSM + 17 * 128 * 64, 64, 127, 64, 1.f);
      CMP(fU + r0 * 2048 + 1312, 1, 2048, nRA, 128, 128, 1.f); CMP(fU + r0 * 2048 + 1568, 1, 2048, nRA + 2 * NMi, 128, 128, 1.f); }
#elif DBG_STAGE == 8
    { const float* nb_ = NSA_ONLY == 0 ? nRC : NSA_ONLY == 1 ? nRA + 4 * NMi : nRB; CMP(fYC + r0 * 1024 + 512, 1, 1024, nb_, 512, 512, 1.f); }
#elif DBG_STAGE == 7
    CMP(fYC + r0 * 1024, 1, 1024, nH, 1024, 512, 1.f); CMP(fYC + r0 * 1024 + 512, 1, 1024, nH + 512, 1024, 512, 1.f);
#endif
    nv::forward(in, (float*)d_out, (float*)d_ws, stream, 4, 0, 8, 0);
    hipLaunchKernelGGL(dbg::k_finish, dim3(1024), dim3(256), 0, stream, (float*)d_out, errs, nchk, (long)16384 * 1024);
#endif
}
```

```cpp
#define FX_MODE 0
#define FX_RESPF 0

#include <hip/hip_runtime.h>
#include <hip/hip_bf16.h>
#include <cstdio>
#include <cstdint>
#include <cmath>
#include <hip/hip_cooperative_groups.h>
namespace pg8 {
#define PG8_LAS __attribute__((address_space(3)))
typedef unsigned short bf16_t;
typedef short bf16x8 __attribute__((ext_vector_type(8)));
typedef float f32x4 __attribute__((ext_vector_type(4)));
typedef unsigned u32x4 __attribute__((ext_vector_type(4)));
constexpr int BM = 256, BK = 64, HALF = 128, HTB = HALF * BK * 2  , STAGE_BYTES = 8 * HTB, NXCD = 8, WGM = 8;

__host__ __device__ __forceinline__ int lds_byte(int r, int c) { const int st = (r >> 4) * 2 + (c >> 5), rr = r & 15, cc = c & 31, ob = rr * 64 + cc * 2; return st * 1024 + (ob ^ (((ob >> 9) & 1) << 5)); }
__host__ __device__ __forceinline__ void stage_rc(int b, int& R, int& C) { const int st = b / 1024, sb = b % 1024, swz = sb ^ (((sb >> 9) & 1) << 5); R = (st >> 1) * 16 + swz / 64; C = (st & 1) * 32 + (swz % 64) / 2; }
__host__ __device__ __forceinline__ int perm32(int rho) { const int n = rho >> 4, i = rho & 15; return 8 * (i >> 2) + 4 * n + (i & 3); }

struct Unit { int pm, pn; int aoff; };
struct Gemm { const bf16_t* A; const bf16_t* Bt; int M, N, K, lda; };

struct StaticOrder {
    int nM, nN, nwg, G, c;
    __host__ __device__ void init(int M, int N, int G_, int c_) { nM = M / BM; nN = N / BM; nwg = nM * nN; G = G_; c = c_; }
    __host__ __device__ bool next(int i, Unit& u) const {
        const long L = (long)i * G + c; if (L >= nwg) return false;
        int wgid = (int)L; { const int q = nwg / NXCD, r = nwg % NXCD, xcd = wgid % NXCD, off = wgid / NXCD; wgid = (xcd < r ? xcd * (q + 1) : r * (q + 1) + (xcd - r) * q) + off; }
        const int nig = WGM * nN, gid = wgid / nig, fm = gid * WGM, gsz = (nM - fm) < WGM ? (nM - fm) : WGM;
        u.pm = fm + ((wgid % nig) % gsz); u.pn = (wgid % nig) / gsz; u.aoff = 0; return true;
    }
    __device__ __forceinline__ void a_ready(const Unit&) const {}
    __device__ __forceinline__ void done(const Unit&) const {}
};

__device__ __forceinline__ unsigned cvt_pk_bf16(float lo, float hi) { unsigned r; asm volatile("v_cvt_pk_bf16_f32 %0, %1, %2" : "=v"(r) : "v"(lo), "v"(hi)); return r; }
typedef float f32x2 __attribute__((ext_vector_type(2)));
__device__ __forceinline__ f32x2 gelu_pk(f32x2 v) {
    const f32x2 av = __builtin_elementwise_abs(v), d = av * 0.2316418882f + 1.0f;
    f32x2 t; t.x = __builtin_amdgcn_rcpf(d.x); t.y = __builtin_amdgcn_rcpf(d.y);
    f32x2 q = t * 0.5307027145f + (-0.7265760135f); q = q * t + 0.7107068705f; q = q * t + (-0.142248368f); q = q * t + 0.127414796f; q = q * t;
    const f32x2 s = (v * v) * (-0.72134752044f);
    f32x2 e; e.x = __builtin_amdgcn_exp2f(s.x); e.y = __builtin_amdgcn_exp2f(s.y);
    const f32x2 m = v * (q * e), r = v - m;
    f32x2 o; o.x = v.x < 0.f ? m.x : r.x; o.y = v.y < 0.f ? m.y : r.y; return o;
}

template <int ACT  > struct EpiBf16 {
    static constexpr bool PERM = true, AFTER_DRAIN = false; static_assert(ACT == 0 || ACT == 1, "EpiBf16: ACT is 0 (none) or 1 (gelu_pk)");
    bf16_t* O; int ldc; const float* bias; int split_cols; size_t split_stride; float scale0;
    __device__ __forceinline__ void operator()(const f32x4 (&acc)[2][2][4][2], const Unit& u, int wr, int wc, int fr, int fq) const {
        const int row0 = u.pm * BM + wr * 64 + fr; int colt = u.pn * BM; bf16_t* base = O;
        float sc = 1.f; if (split_cols) { const int t = colt / split_cols; base += (size_t)t * split_stride; colt -= t * split_cols; if (t == 0) sc = scale0; }
        const int col0 = colt + wc * 32 + 8 * fq, bcol0 = u.pn * BM + wc * 32 + 8 * fq;
        f32x4 bv[2][2];
#pragma unroll
        for (int bj = 0; bj < 2; ++bj)
#pragma unroll
            for (int n = 0; n < 2; ++n) bv[bj][n] = bias ? *(const f32x4*)(bias + bcol0 + bj * HALF + 4 * n) : (f32x4){0.f, 0.f, 0.f, 0.f};
#pragma unroll
        for (int ai = 0; ai < 2; ++ai)
#pragma unroll
            for (int m = 0; m < 4; ++m) { bf16_t* rowp = base + (size_t)(row0 + ai * HALF + m * 16) * ldc + col0;
#pragma unroll
                for (int bj = 0; bj < 2; ++bj) { f32x4 v0 = acc[ai][bj][m][0] + bv[bj][0], v1 = acc[ai][bj][m][1] + bv[bj][1];
                    if (ACT == 1) { f32x2 a = gelu_pk((f32x2){v0[0], v0[1]}), b = gelu_pk((f32x2){v0[2], v0[3]}), c = gelu_pk((f32x2){v1[0], v1[1]}), d = gelu_pk((f32x2){v1[2], v1[3]});
                        v0 = (f32x4){a.x, a.y, b.x, b.y}; v1 = (f32x4){c.x, c.y, d.x, d.y}; }
                    v0 = v0 * sc; v1 = v1 * sc; u32x4 w; w.x = cvt_pk_bf16(v0[0], v0[1]); w.y = cvt_pk_bf16(v0[2], v0[3]); w.z = cvt_pk_bf16(v1[0], v1[1]); w.w = cvt_pk_bf16(v1[2], v1[3]);
                    *(u32x4*)(rowp + bj * HALF) = w; } }
    }
};

template <class Epi, class Sched, bool ALIGN_EPI = false, bool SP2 = false>
__device__ __forceinline__ void gemm_phase(PG8_LAS unsigned char* lds, const Gemm g, const Sched& S, const Epi& E) {
    int tid_ = threadIdx.x; asm volatile("" : "+v"(tid_)); const int tid = tid_, wid = __builtin_amdgcn_readfirstlane(tid >> 6), lane = tid & 63, wr = wid >> 2, wc = wid & 3, fr = lane & 15, fq = lane >> 4;
    const int K = g.K, nt = K / BK;
    unsigned voffA[2], voffB[2];
#pragma unroll
    for (int i = 0; i < 2; ++i) { int R, C; stage_rc(tid * 16 + i * 8192, R, C); const int Rb = Epi::PERM ? ((R & ~31) + perm32(R & 31)) : R;
        voffA[i] = (unsigned)(R * g.lda + C) * 2u; voffB[i] = (unsigned)(Rb * K + C) * 2u; }
    const size_t kstep = (size_t)(BK * 2);
    const size_t hstep = (size_t)HALF * K * 2;
    const size_t hstepA = (size_t)HALF * g.lda * 2, tstepA = 2 * hstepA;
    const size_t tstep = 2 * hstep;
    const unsigned ldsw = (unsigned)wid * 1024u;
    const int aoff = lds_byte(wr * 64 + fr, fq * 8), boff = lds_byte(wc * 32 + fr, fq * 8);
#define PG8_SA(b, h) (((b) * 2 + (h)) * HTB)
#define PG8_SB(b, h) ((4 + (b) * 2 + (h)) * HTB)
#define PG8_STAGE(bufoff, gbase, voff) do { _Pragma("unroll") for (int _i = 0; _i < 2; ++_i) \
        __builtin_amdgcn_global_load_lds((const unsigned*)((const char*)(gbase) + (voff)[_i]), (PG8_LAS unsigned*)(lds + (bufoff) + ldsw + _i * 8192), 16, 0, 0); } while (0)
#define PG8_LDA(dst, b, h) do { _Pragma("unroll") for (int m = 0; m < 4; ++m) _Pragma("unroll") for (int k = 0; k < 2; ++k) dst[m][k] = *(const PG8_LAS bf16x8*)(lds + PG8_SA(b, h) + aoff + m * 2048 + k * 1024); } while (0)
#define PG8_LDB(dst, b, h) do { _Pragma("unroll") for (int n = 0; n < 2; ++n) _Pragma("unroll") for (int k = 0; k < 2; ++k) dst[n][k] = *(const PG8_LAS bf16x8*)(lds + PG8_SB(b, h) + boff + n * 2048 + k * 1024); } while (0)
#define PG8_MMA(ai, bj, At, Bt) do { __builtin_amdgcn_s_setprio(1); _Pragma("unroll") for (int m = 0; m < 4; ++m) _Pragma("unroll") for (int n = 0; n < 2; ++n) _Pragma("unroll") for (int k = 0; k < 2; ++k) \
        acc[ai][bj][m][n] = __builtin_amdgcn_mfma_f32_16x16x32_bf16(Bt[n][k], At[m][k], acc[ai][bj][m][n], 0, 0, 0); __builtin_amdgcn_s_setprio(0); } while (0)
#define PG8_WAIT_V(n) asm volatile("s_waitcnt vmcnt(" #n ")" ::: "memory")
#define PG8_WAIT_L(n) asm volatile("s_waitcnt lgkmcnt(" #n ")" ::: "memory")
#define PG8_BAR __builtin_amdgcn_s_barrier()
#define PG8_SCHED __builtin_amdgcn_sched_barrier(0)
    Unit cur, nxt; int ui = 0;
    if (!S.next(0, cur)) return;
    f32x4 acc[2][2][4][2];
#pragma unroll
    for (int a = 0; a < 2; ++a)
#pragma unroll
        for (int b = 0; b < 2; ++b)
#pragma unroll
            for (int m = 0; m < 4; ++m)
#pragma unroll
                for (int n = 0; n < 2; ++n) acc[a][b][m][n] = (f32x4){0.f, 0.f, 0.f, 0.f};
    bf16x8 At[4][2], B0[2][2], B1[2][2];
    const char* cA = (const char*)g.A + (size_t)cur.pm * tstepA + (size_t)cur.aoff * 2; const char* cB = (const char*)g.Bt + (size_t)cur.pn * tstep;
    S.a_ready(cur);
    if constexpr (SP2) {
        PG8_STAGE(PG8_SB(0, 0), cB, voffB); PG8_STAGE(PG8_SB(0, 1), cB + hstep, voffB); PG8_STAGE(PG8_SA(0, 0), cA, voffA); PG8_STAGE(PG8_SA(0, 1), cA + hstepA, voffA);
        if (wr == 1) PG8_BAR;
        PG8_WAIT_V(2); PG8_BAR;
        PG8_STAGE(PG8_SB(1, 0), cB + kstep, voffB); PG8_STAGE(PG8_SA(1, 0), cA + kstep, voffA); PG8_STAGE(PG8_SB(1, 1), cB + hstep + kstep, voffB);
        PG8_WAIT_V(6); PG8_BAR;
    } else {
        PG8_STAGE(PG8_SB(0, 0), cB, voffB); PG8_STAGE(PG8_SA(0, 0), cA, voffA); PG8_STAGE(PG8_SB(0, 1), cB + hstep, voffB); PG8_STAGE(PG8_SA(0, 1), cA + hstepA, voffA);
        if (wr == 1) PG8_BAR;
        PG8_WAIT_V(4); PG8_BAR;
        PG8_STAGE(PG8_SB(1, 0), cB + kstep, voffB); PG8_STAGE(PG8_SA(1, 0), cA + kstep, voffA); PG8_STAGE(PG8_SB(1, 1), cB + hstep + kstep, voffB);
        PG8_WAIT_V(6); PG8_BAR;
    }
    for (;;) {
        const bool has_next = S.next(ui + 1, nxt);
        const char* nA = has_next ? (const char*)g.A + (size_t)nxt.pm * tstepA + (size_t)nxt.aoff * 2 : cA; const char* nB = has_next ? (const char*)g.Bt + (size_t)nxt.pn * tstep : cB;
        for (int t = 0; t < nt; t += 2) {
            const bool last = (t == nt - 2);
            const char* a1 = cA + (size_t)(t + 1) * kstep;
            const char* a2 = last ? nA : cA + (size_t)(t + 2) * kstep; const char* b2 = last ? nB : cB + (size_t)(t + 2) * kstep;
            const char* a3 = a2 + kstep; const char* b3 = b2 + kstep;
            if (last && has_next) S.a_ready(nxt);
            if constexpr (SP2) {
            PG8_LDB(B0, 0, 0); PG8_LDB(B1, 0, 1); PG8_SCHED; PG8_LDA(At, 0, 0); PG8_STAGE(PG8_SA(1, 1), a1 + hstepA, voffA);
            PG8_WAIT_V(8); PG8_WAIT_L(0); PG8_BAR; PG8_MMA(0, 0, At, B0); PG8_MMA(0, 1, At, B1); PG8_BAR; PG8_SCHED;
            PG8_LDA(At, 0, 1); PG8_STAGE(PG8_SB(0, 0), b2, voffB); PG8_STAGE(PG8_SB(0, 1), b2 + hstep, voffB); PG8_STAGE(PG8_SA(0, 0), a2, voffA);
            PG8_WAIT_V(8); PG8_WAIT_L(0); PG8_BAR; PG8_MMA(1, 0, At, B0); PG8_MMA(1, 1, At, B1); PG8_BAR; PG8_SCHED;
            PG8_LDB(B0, 1, 0); PG8_LDB(B1, 1, 1); PG8_SCHED; PG8_LDA(At, 1, 0); PG8_STAGE(PG8_SA(0, 1), a2 + hstepA, voffA);
            PG8_WAIT_V(8); PG8_WAIT_L(0); PG8_BAR; PG8_MMA(0, 0, At, B0); PG8_MMA(0, 1, At, B1); PG8_BAR; PG8_SCHED;
            PG8_LDA(At, 1, 1); PG8_STAGE(PG8_SB(1, 0), b3, voffB); PG8_STAGE(PG8_SB(1, 1), b3 + hstep, voffB); PG8_STAGE(PG8_SA(1, 0), a3, voffA);
            PG8_WAIT_V(8); PG8_WAIT_L(0); PG8_BAR; PG8_MMA(1, 0, At, B0); PG8_MMA(1, 1, At, B1); PG8_BAR; PG8_SCHED;
            } else {
            PG8_LDB(B0, 0, 0); PG8_SCHED; PG8_LDA(At, 0, 0); PG8_STAGE(PG8_SA(1, 1), a1 + hstepA, voffA);
            PG8_WAIT_L(8); PG8_BAR; PG8_WAIT_L(0); PG8_MMA(0, 0, At, B0); PG8_BAR; PG8_SCHED;
            PG8_LDB(B1, 0, 1); PG8_STAGE(PG8_SB(0, 0), b2, voffB);
            PG8_BAR; PG8_WAIT_L(0); PG8_MMA(0, 1, At, B1); PG8_BAR;
            PG8_LDA(At, 0, 1); PG8_STAGE(PG8_SA(0, 0), a2, voffA);
            PG8_BAR; PG8_WAIT_L(0); PG8_MMA(1, 0, At, B0); PG8_BAR; PG8_SCHED;
            PG8_STAGE(PG8_SB(0, 1), b2 + hstep, voffB);
            PG8_WAIT_V(6); PG8_BAR; PG8_MMA(1, 1, At, B1); PG8_BAR;
            PG8_LDB(B0, 1, 0); PG8_SCHED; PG8_LDA(At, 1, 0); PG8_STAGE(PG8_SA(0, 1), a2 + hstepA, voffA);
            PG8_WAIT_L(8); PG8_BAR; PG8_WAIT_L(0); PG8_MMA(0, 0, At, B0); PG8_BAR; PG8_SCHED;
            PG8_LDB(B1, 1, 1); PG8_STAGE(PG8_SB(1, 0), b3, voffB);
            PG8_BAR; PG8_WAIT_L(0); PG8_MMA(0, 1, At, B1); PG8_BAR;
            PG8_LDA(At, 1, 1); PG8_STAGE(PG8_SA(1, 0), a3, voffA);
            PG8_BAR; PG8_WAIT_L(0); PG8_MMA(1, 0, At, B0); PG8_BAR; PG8_SCHED;
            PG8_STAGE(PG8_SB(1, 1), b3 + hstep, voffB);
            PG8_WAIT_V(6); PG8_BAR; PG8_MMA(1, 1, At, B1); PG8_BAR;
            }
        }
        if constexpr (ALIGN_EPI) { if (wr == 0) PG8_BAR; }
#ifdef PROBE_EPI
        const unsigned long long pe_t0 = __builtin_amdgcn_s_memrealtime();
#endif
        if constexpr (!Epi::AFTER_DRAIN) { E(acc, cur, wr, wc, fr, fq); S.done(cur); }
#ifdef PROBE_EPI
        asm volatile("s_waitcnt vmcnt(0)" ::: "memory");
        if (tid == 0 && blockIdx.x == 0) *(PG8_LAS unsigned*)(lds + 131072 + 68) += (unsigned)(__builtin_amdgcn_s_memrealtime() - pe_t0);
#endif
        if (!has_next) break;
#pragma unroll
        for (int a = 0; a < 2; ++a)
#pragma unroll
            for (int b = 0; b < 2; ++b)
#pragma unroll
                for (int m = 0; m < 4; ++m)
#pragma unroll
                    for (int n = 0; n < 2; ++n) acc[a][b][m][n] = (f32x4){0.f, 0.f, 0.f, 0.f};
        cur = nxt; cA = nA; cB = nB; ++ui;
        if constexpr (ALIGN_EPI) { if (wr == 1) PG8_BAR; }
    }
    PG8_WAIT_V(0);
    if constexpr (!ALIGN_EPI) { if (wr == 0) PG8_BAR; }
    PG8_BAR;
    if constexpr (Epi::AFTER_DRAIN) { E.fused(acc, cur, wr, wc, fr, fq, lds, wid, lane); S.done(cur); }
#undef PG8_SA
#undef PG8_SB
#undef PG8_STAGE
#undef PG8_LDA
#undef PG8_LDB
#undef PG8_MMA
#undef PG8_WAIT_V
#undef PG8_WAIT_L
#undef PG8_BAR
#undef PG8_SCHED
}
}
#ifndef FX_REPEAT_KIND
#define FX_REPEAT_KIND 0
#endif
#ifndef FX_STG
#define FX_STG false
#endif
#ifndef FX_SWEEP2
#define FX_SWEEP2 0
#endif
#ifndef FX_QKDB
#define FX_QKDB false
#endif
#ifndef FX_VPRE
#define FX_VPRE 2
#endif
#ifndef FX_T13
#define FX_T13 1
#endif
#ifndef FX_DIFFPARK
#define FX_DIFFPARK 0
#endif
#ifndef FX_GS128
#define FX_GS128 1
#endif
#ifndef FX_PRO_MATS
#define FX_PRO_MATS 28
#endif
#ifndef FX_PRIO
#define FX_PRIO 0
#endif
#ifndef FX_LATE
#define FX_LATE(w) ((w) >= 4)
#endif
#ifdef PROBE_SEC
#define PSEC_B(id) do { if ((id) == PROBE_SEC) { __syncthreads(); c.pr_t = __builtin_amdgcn_s_memrealtime(); } } while (0)
#define PSEC_E(id) do { if ((id) == PROBE_SEC) { __syncthreads(); c.pr_acc += (unsigned)(__builtin_amdgcn_s_memrealtime() - c.pr_t); } } while (0)
#else
#define PSEC_B(id) do {} while (0)
#define PSEC_E(id) do {} while (0)
#endif
#ifdef PROBE_SEC
#define PSW_B(id) do { if ((id) == PROBE_SEC) c.pr_t = __builtin_amdgcn_s_memrealtime(); } while (0)
#define PSW_DRAIN() do { if (PROBE_SEC == 23 || PROBE_SEC == 25) asm volatile("s_waitcnt vmcnt(0) lgkmcnt(0)" ::: "memory"); } while (0)
#define PSW_E(id) do { if ((id) == PROBE_SEC) c.pr_acc += (unsigned)(__builtin_amdgcn_s_memrealtime() - c.pr_t); } while (0)
#else
#define PSW_B(id) do {} while (0)
#define PSW_E(id) do {} while (0)
#define PSW_DRAIN() do {} while (0)
#endif
#define REP(kind) for (int rep_ = 0; rep_ < ((FX_REPEAT_KIND == (kind)) ? 2 : 1); ++rep_)
namespace fx {
#define DI __device__ __forceinline__
#define LAS __attribute__((address_space(3)))
typedef unsigned short bf16_t;
typedef short bf16x8 __attribute__((ext_vector_type(8)));
typedef short s16x4 __attribute__((ext_vector_type(4)));
typedef float f32x4 __attribute__((ext_vector_type(4)));
typedef float f32x16 __attribute__((ext_vector_type(16)));
typedef unsigned u32x4 __attribute__((ext_vector_type(4)));
typedef unsigned u32x2 __attribute__((ext_vector_type(2)));
constexpr int B = 8, S = 2048, D = 1024, T = B * S, FF = 4096, HYIN = 1848, UW = 2048;
constexpr float EPS = 1e-6f, LOG2E = 1.4426950408889634f;
constexpr int NW = 8, NT = 512;
constexpr size_t MiB = 1u << 20;
constexpr size_t WS_CTL = 0;
constexpr size_t WS_MOD = 1 * MiB;
constexpr size_t WS_CS8 = 2 * MiB;
constexpr size_t WS_CS16 = 3 * MiB;
constexpr size_t WS_MISC = 5 * MiB;
constexpr size_t WS_W = 6 * MiB;
constexpr size_t W_EVEN = 9 * MiB, W_ODD = 8 * MiB, W_MLP = 16 * MiB;
constexpr size_t WE_IN = 0, WE_OUT = 4 * MiB, WE_UP = 6 * MiB, WE_C1 = 7 * MiB, WE_C2 = 8 * MiB;
constexpr size_t WO_QKV = 0, WO_O = 6 * MiB;
constexpr size_t WS_WEVEN = WS_W, WS_WODD = WS_W + 2 * W_EVEN, WS_WMLP = WS_WODD + 2 * W_ODD;
constexpr size_t WS_XN = 104 * MiB;
constexpr size_t WS_YC = 136 * MiB;
constexpr size_t WS_BIG = 168 * MiB;
constexpr size_t BIG_U = 0, BIG_UP = 64 * MiB + 64 * 1024;
constexpr int UPW = 1792;
constexpr size_t WS_FAST_END = 296 * MiB;
constexpr size_t WS_SS = 332 * MiB;
constexpr size_t WS_SHW = 296 * MiB;
constexpr size_t WS_XB = 300 * MiB;
constexpr size_t WS_NAIVE = 300 * MiB;
constexpr int LDS_MISC = 131072, LDS_BYTES = 147456;

DI unsigned f2bf(float f) { unsigned u = __builtin_bit_cast(unsigned, f); return (u + 0x7fffu + ((u >> 16) & 1u)) >> 16; }
DI unsigned pk2(float lo, float hi) { return f2bf(lo) | (f2bf(hi) << 16); }
DI float bf2f(unsigned short b) { return __builtin_bit_cast(float, (unsigned)b << 16); }
DI float bflo(unsigned u) { return __builtin_bit_cast(float, u << 16); }
DI float bfhi(unsigned u) { return __builtin_bit_cast(float, u & 0xffff0000u); }
typedef short v4i16_t_ __attribute__((ext_vector_type(4)));
DI s16x4 vtr(const LAS char* p) { return __builtin_bit_cast(s16x4, __builtin_amdgcn_ds_read_tr16_b64_v4i16((LAS v4i16_t_*)p)); }
template <int O> DI float swz(float v) { static_assert(O < 32, "swz: xor mask < 32"); return __builtin_bit_cast(float, __builtin_amdgcn_ds_swizzle(__builtin_bit_cast(int, v), (O << 10) | 0x1f)); }
template <int O> DI unsigned swzu(unsigned v) { return (unsigned)__builtin_amdgcn_ds_swizzle((int)v, (O << 10) | 0x1f); }
DI void xchg32(unsigned& a, unsigned& b) { asm volatile("s_nop 1\n\tv_permlane32_swap_b32 %0, %1\n\ts_nop 1" : "+v"(a), "+v"(b)); }
DI float sum32(float v) { unsigned a = __builtin_bit_cast(unsigned, v), b = a; xchg32(a, b); return __builtin_bit_cast(float, a) + __builtin_bit_cast(float, b); }
DI float max32(float v) { unsigned a = __builtin_bit_cast(unsigned, v), b = a; xchg32(a, b); return fmaxf(__builtin_bit_cast(float, a), __builtin_bit_cast(float, b)); }
DI unsigned or32(unsigned v) { unsigned a = v, b = v; xchg32(a, b); return a | b; }
#ifdef DBG_SHFL
DI float wave_sum(float v) { for (int o = 1; o < 64; o <<= 1) v += __shfl_xor(v, o); return v; }
#else
DI float wave_sum(float v) { v += swz<1>(v); v += swz<2>(v); v += swz<4>(v); v += swz<8>(v); v += swz<16>(v); return sum32(v); }
#endif

struct Args { const float* in[28]; const int* pos; float* out; unsigned char* ws; int ph_lo, ph_hi; int use_cg; int pad; };
typedef const __attribute__((address_space(4))) Args CArgs;
#define XB_TMO      128
#define XB_XCNT(j)  (256  + 64 * (j))
#define XB_XSUB(j)  (1280 + 64 * (j))
#define XB_XGEN(j)  (2304 + 64 * (j))
#define XB_TOP      3328
#define XB_TOPGEN   3392
#define XCD_BAR_WORDS 3456
#define XB_SPIN_CAP (1u << 20)
DI unsigned xb_ld(unsigned* p)              { return __hip_atomic_load(p, __ATOMIC_RELAXED, __HIP_MEMORY_SCOPE_AGENT); }
DI unsigned xb_add(unsigned* p, unsigned v) { return __hip_atomic_fetch_add(p, v, __ATOMIC_RELAXED, __HIP_MEMORY_SCOPE_AGENT); }
DI unsigned xb_xcc_id() { return (unsigned)__builtin_amdgcn_s_getreg((3 << 11) | 20) & 0xFu; }
#define XB_SPIN(cond, bar) do { unsigned _sp = 0; while (cond) { __builtin_amdgcn_s_sleep(1); \
    if ((++_sp & 255u) == 0u) { if (xb_ld(&(bar)[XB_TMO])) break; if (_sp > XB_SPIN_CAP) { atomicAdd(&(bar)[XB_TMO], 1u); break; } } } } while (0)
#ifndef FX_EARLYWB
#define FX_EARLYWB 0
#endif
#ifndef FX_BARFAST
#define FX_BARFAST 0
#endif
#ifndef FX_BARREL
#define FX_BARREL 1
#endif
struct XcdBarrier { unsigned* bar; unsigned x; volatile LAS unsigned* st; };
DI XcdBarrier xcd_barrier_post(unsigned* bar, volatile LAS unsigned* st) {
    XcdBarrier b; b.bar = bar; b.x = xb_xcc_id(); b.st = st;
    if (threadIdx.x == 0) (void)xb_add(&bar[XB_XCNT(b.x)], 1u);
    return b;
}
DI void xcd_barrier_complete(unsigned* bar, unsigned x, unsigned& nloc, unsigned& nx) {
    const unsigned G = gridDim.x * gridDim.y * gridDim.z;
    unsigned sum, cnt, mine, sp = 0u;
    for (;;) {
        sum = 0u; cnt = 0u; mine = 0u;
#pragma unroll
        for (unsigned j = 0; j < 16; ++j) { const unsigned c = xb_ld(&bar[XB_XCNT(j)]); sum += c; cnt += (c > 0u) ? 1u : 0u; mine = (j == x) ? c : mine; }
        if (sum == G) break;
        __builtin_amdgcn_s_sleep(1);
        if ((++sp & 255u) == 0u) { if (xb_ld(&bar[XB_TMO])) break; if (sp > XB_SPIN_CAP) { atomicAdd(&bar[XB_TMO], 1u); break; } }
    }
    nloc = mine > 0u ? mine : 1u; nx = cnt > 0u ? cnt : 1u;
}
DI void xcd_barrier(const XcdBarrier& b) {
    asm volatile("s_waitcnt vmcnt(0)" ::: "memory");
    __syncthreads();
    int t0_ = threadIdx.x; asm volatile("" : "+v"(t0_));
    if (t0_ == 0) {
        unsigned* bar; { CArgs* p_ = (CArgs*)__builtin_amdgcn_kernarg_segment_ptr(); asm volatile("" : "+s"(p_)); bar = (unsigned*)(p_->ws + WS_CTL) + 4096; }
        __builtin_amdgcn_s_waitcnt(0);
        unsigned nloc = b.st[0], nx = b.st[1];
        unsigned bx = b.x; asm volatile("" : "+s"(bx));
        if (nloc == 0u) { xcd_barrier_complete(bar, bx, nloc, nx); b.st[0] = nloc; b.st[1] = nx; }
#if FX_EARLYWB
        __builtin_amdgcn_fence(__ATOMIC_RELEASE, "agent");
#endif
        const unsigned old = xb_add(&bar[XB_XSUB(bx)], 1u);
        const unsigned gen = old / nloc;
        if (old + 1u == (gen + 1u) * nloc) {
            __builtin_amdgcn_fence(__ATOMIC_RELEASE, "agent");
            asm volatile("s_waitcnt vmcnt(0)" ::: "memory");
            const unsigned og = xb_add(&bar[XB_TOP], 1u);
            const unsigned tg = og / nx;
            if (og + 1u == (tg + 1u) * nx) xb_add(&bar[XB_TOPGEN], 1u);
            else XB_SPIN(xb_ld(&bar[XB_TOPGEN]) == tg, bar);
#if FX_BARREL
            xb_add(&bar[XB_XGEN(bx)], 1u);
            __builtin_amdgcn_fence(__ATOMIC_ACQUIRE, "agent");
            asm volatile("s_waitcnt vmcnt(0)" ::: "memory");
#else
            __builtin_amdgcn_fence(__ATOMIC_ACQUIRE, "agent");
            xb_add(&bar[XB_XGEN(bx)], 1u);
#if !FX_BARFAST
            asm volatile("s_waitcnt vmcnt(0)" ::: "memory");
#endif
#endif
        } else {
            XB_SPIN(xb_ld(&bar[XB_XGEN(bx)]) == gen, bar);
            __builtin_amdgcn_fence(__ATOMIC_ACQUIRE, "agent");
            asm volatile("s_waitcnt vmcnt(0)" ::: "memory");
        }
    }
    __syncthreads();
}

struct Ctx {
    LAS unsigned char* lds; int tid, lane, wave, G, bid; unsigned char* ws; int var; unsigned pr_acc; unsigned long long pr_t; CArgs* a;
};
#define RELAUNDER(c) do { int t_ = threadIdx.x; asm volatile("" : "+v"(t_)); (c).tid = t_; (c).lane = t_ & 63; int b_ = blockIdx.x, g_ = gridDim.x; asm volatile("" : "+s"(b_), "+s"(g_)); (c).bid = b_; (c).G = g_; } while (0)

struct TrRegs { f32x4 tv[8]; };
constexpr int TRS = 544;
DI void transpose_load(TrRegs& r, const float* W, int ld, int N, int item, int nblk, int wave, int lane) {
    const int k0 = 64 * (item / nblk) + 8 * wave, n = 256 * (item % nblk) + 4 * lane;
#pragma unroll
    for (int i = 0; i < 8; ++i) { r.tv[i] = (f32x4){0.f, 0.f, 0.f, 0.f}; if (n < N) r.tv[i] = *(const f32x4*)(W + (size_t)(k0 + i) * ld + n); }
}
DI void transpose_finish(const TrRegs& r, int K, int Npad, bf16_t* WT, const float* kscale, LAS char* img, int item, int nblk, int wave, int lane) {
    const int k0 = 64 * (item / nblk), n0 = 256 * (item % nblk);
#pragma unroll
    for (int i = 0; i < 8; ++i) { f32x4 v = r.tv[i]; if (kscale) v = v * kscale[k0 + 8 * wave + i];
        u32x2 w; w.x = pk2(v.x, v.y); w.y = pk2(v.z, v.w); *(LAS u32x2*)(img + (8 * wave + i) * TRS + lane * 8) = w; }
    __syncthreads();
    const int g = lane >> 4, i16 = lane & 15, q = i16 >> 2, p = i16 & 3;
#pragma unroll
    for (int j = 0; j < 4; ++j) { const int kc = 4 * (j & 1) + g, nb = 2 * wave + (j >> 1);
        const LAS char* rb = img + (8 * kc + q) * TRS + (16 * nb + 4 * p) * 2;
        const s16x4 lo = vtr(rb), hi = vtr(rb + 4 * TRS);
        const int nn = n0 + 16 * nb + i16;
        if (nn < Npad) *(bf16x8*)(WT + (size_t)nn * K + k0 + 8 * kc) = __builtin_shufflevector(lo, hi, 0, 1, 2, 3, 4, 5, 6, 7); }
    __syncthreads();
}
struct MatDesc { const float* src; int ld, K, N, Npad; bf16_t* dst; const float* kscale; };
DI MatDesc get_mat(CArgs& a, unsigned char* ws, int idx) {
    MatDesc m; m.kscale = nullptr;
    if (idx < 16) { const int j = idx >> 3, t = idx & 7; unsigned char* base = ws + WS_WEVEN + j * W_EVEN;
        if (t == 0) { m.src = a.in[9] + (size_t)j * D * HYIN; m.ld = HYIN; m.K = D; m.N = HYIN; m.Npad = UW; m.dst = (bf16_t*)(base + WE_IN); }
        else if (t == 1) { m.src = a.in[10] + (size_t)j * D * D; m.ld = D; m.K = D; m.N = D; m.Npad = D; m.dst = (bf16_t*)(base + WE_OUT); }
        else if (t == 2) { m.src = a.in[12] + (size_t)j * 256 * 768; m.ld = 768; m.K = 256; m.N = 768; m.Npad = 768; m.dst = (bf16_t*)(base + WE_UP); m.kscale = a.in[11] + j * 256; }
        else if (t == 3) { m.src = a.in[14] + (size_t)j * 256 * 1024; m.ld = 1024; m.K = 256; m.N = 1024; m.Npad = 1024; m.dst = (bf16_t*)(base + WE_UP) + 768 * 256; m.kscale = a.in[13] + j * 256; }
        else if (t < 6) { const int jj = t - 4; m.src = a.in[20] + ((size_t)j * 2 + jj) * 2048 * 128; m.ld = 128; m.K = 2048; m.N = 128; m.Npad = 128; m.dst = (bf16_t*)(base + WE_C1) + (size_t)jj * 128 * 2048; }
        else { const int jj = t - 6; m.src = a.in[21] + ((size_t)j * 2 + jj) * 128 * 64; m.ld = 64; m.K = 128; m.N = 64; m.Npad = 64; m.dst = (bf16_t*)(base + WE_C2) + (size_t)jj * 64 * 128; }
    } else if (idx < 20) { const int j = (idx - 16) >> 1, t = idx & 1; unsigned char* base = ws + WS_WODD + j * W_ODD;
        if (t == 0) { m.src = a.in[22] + (size_t)j * D * 3072; m.ld = 3072; m.K = D; m.N = 3072; m.Npad = 3072; m.dst = (bf16_t*)(base + WO_QKV); }
        else { m.src = a.in[23] + (size_t)j * D * D; m.ld = D; m.K = D; m.N = D; m.Npad = D; m.dst = (bf16_t*)(base + WO_O); }
    } else { const int i = (idx - 20) >> 1, t = idx & 1; unsigned char* base = ws + WS_WMLP + i * W_MLP;
        if (t == 0) { m.src = a.in[7] + (size_t)i * D * FF; m.ld = FF; m.K = D; m.N = FF; m.Npad = FF; m.dst = (bf16_t*)base; }
        else { m.src = a.in[8] + (size_t)i * FF * D; m.ld = D; m.K = FF; m.N = D; m.Npad = D; m.dst = (bf16_t*)(base + 8 * MiB); }
    }
    return m;
}
struct ConvIt {
    int mi, hi, it, nit, nblk, base, bid, G; MatDesc m;
    DI void open(CArgs& a, unsigned char* ws) { for (;;) { if (mi >= hi) { it = -1; return; } m = get_mat(a, ws, mi); nblk = (m.Npad + 255) / 256; nit = (m.K / 64) * nblk; it = (bid + G - (base % G)) % G; if (it < nit) return; base += nit; ++mi; } }
    DI void next(CArgs& a, unsigned char* ws) { if (it < 0) return; it += G; if (it >= nit) { base += nit; ++mi; open(a, ws); } }
    DI bool valid() const { return it >= 0; }
};
struct ConvSlot { TrRegs r; MatDesc m; int it, nblk; bool v; };
DI void conv_fetch(ConvSlot& sl, ConvIt& ci, CArgs& a, unsigned char* ws, int wave, int lane) {
    sl.v = ci.valid(); if (sl.v) { sl.m = ci.m; sl.it = ci.it; sl.nblk = ci.nblk; transpose_load(sl.r, sl.m.src, sl.m.ld, sl.m.N, sl.it, sl.nblk, wave, lane); ci.next(a, ws); }
}
DI void convert_mats(Ctx& c, int lo, int hi) {
    CArgs& a = *c.a; unsigned char* ws = c.ws; LAS char* img = (LAS char*)c.lds;
    ConvIt ci; ci.mi = lo; ci.hi = hi; ci.base = 0; ci.bid = c.bid; ci.G = c.G; ci.it = -1; ci.open(a, ws);
    ConvSlot sA, sB, sC;
    conv_fetch(sA, ci, a, ws, c.wave, c.lane); conv_fetch(sB, ci, a, ws, c.wave, c.lane);
    for (;;) {
        if (!sA.v) break;
        conv_fetch(sC, ci, a, ws, c.wave, c.lane); transpose_finish(sA.r, sA.m.K, sA.m.Npad, sA.m.dst, sA.m.kscale, img, sA.it, sA.nblk, c.wave, c.lane);
        if (!sB.v) break;
        conv_fetch(sA, ci, a, ws, c.wave, c.lane); transpose_finish(sB.r, sB.m.K, sB.m.Npad, sB.m.dst, sB.m.kscale, img, sB.it, sB.nblk, c.wave, c.lane);
        if (!sC.v) break;
        conv_fetch(sB, ci, a, ws, c.wave, c.lane); transpose_finish(sC.r, sC.m.K, sC.m.Npad, sC.m.dst, sC.m.kscale, img, sC.it, sC.nblk, c.wave, c.lane);
    }
}
DI void phase_prologue(Ctx& c) {
    CArgs& a = *c.a; unsigned char* ws = c.ws;
    const int gw = c.bid * NW + c.wave, NGW = c.G * NW;
    PSEC_B(30);
    LAS float* cond = (LAS float*)(c.lds + 98304);
    for (int i = c.tid; i < 8192; i += NT) { float v = a.in[1][i]; cond[i] = v / (1.f + __expf(-v)); }
    __syncthreads();
    PSEC_E(30); PSEC_B(31);
    float* mod = (float*)(ws + WS_MOD);
    LAS float* red = (LAS float*)c.lds;
    REP(18) for (int it = c.bid; it < 256; it += c.G) {
        const int l48 = c.lane < 48 ? c.lane : 47, kpar = l48 / 24, c4 = l48 % 24; const int n0 = it * 96, li = n0 / 6144, nn0 = n0 % 6144;
        const float* w = a.in[3] + (size_t)li * D * 6144 + (size_t)(c.wave * 128 + kpar) * 6144 + nn0 + 4 * c4;
        f32x4 acc[8];
#pragma unroll
        for (int b = 0; b < 8; ++b) acc[b] = (f32x4){0.f, 0.f, 0.f, 0.f};
#pragma unroll 8
        for (int k = 0; k < 64; ++k) { const f32x4 wv = *(const f32x4*)(w + (size_t)(2 * k) * 6144);
#pragma unroll
            for (int b = 0; b < 8; ++b) acc[b] += wv * cond[b * D + c.wave * 128 + 2 * k + kpar]; }
        if (c.lane < 48) {
#pragma unroll
            for (int b = 0; b < 8; ++b) *(LAS f32x4*)(red + ((c.wave * 2 + kpar) * 8 + b) * 96 + 4 * c4) = acc[b]; }
        __syncthreads();
        for (int e = c.tid; e < 8 * 96; e += NT) { const int b = e / 96, col = e % 96; float sacc = 0.f;
#pragma unroll
            for (int ww = 0; ww < 16; ++ww) sacc += red[(ww * 8 + b) * 96 + col];
            mod[((size_t)li * 8 + b) * 6144 + nn0 + col] = sacc + a.in[4][li * 6144 + nn0 + col]; }
        __syncthreads();
    }
    PSEC_E(31); PSEC_B(32);
    { float* P = (float*)(ws + WS_MISC);
      for (int it = gw; it < 256; it += NGW) { const int jj2 = it >> 6, kc = (it >> 1) & 31, n = (it & 1) * 64 + c.lane;
          const float* cp = a.in[19] + (size_t)jj2 * 2048 + kc * 64; const float* w = a.in[20] + (size_t)jj2 * 2048 * 128 + (size_t)(kc * 64) * 128 + n; float acc = 0.f;
#pragma unroll 16
          for (int k = 0; k < 64; ++k) acc += cp[k] * w[(size_t)k * 128];
          P[(jj2 * 32 + kc) * 128 + n] = acc; } }
    PSEC_E(32); PSEC_B(33);
    REP(16) convert_mats(c, 0, FX_PRO_MATS);
    PSEC_E(33); PSEC_B(34);
    { float* cs8 = (float*)(ws + WS_CS8); float* cs16 = (float*)(ws + WS_CS16);
      REP(17) for (int g = c.bid * NT + c.tid; g < T * 24; g += c.G * NT) { const int m = g / 24, i = g % 24; const double p = (double)a.pos[m];
          if (i < 8) { const double f = pow(500000.0, -(double)i / 8.0), an = p * f; cs8[(m * 8 + i) * 2] = (float)cos(an); cs8[(m * 8 + i) * 2 + 1] = (float)sin(an); }
          else { const int k = i - 8; const double f = pow(500000.0, -(double)k / 16.0), an = p * f; cs16[(m * 16 + k) * 2] = (float)cos(an); cs16[(m * 16 + k) * 2 + 1] = (float)sin(an); } } }
    PSEC_E(34);
}

DI void shw_items(Ctx& c, int set) {
    unsigned char* ws = c.ws; const int lane = c.lane, r16 = lane & 15, q4 = lane >> 4;
    LAS bf16_t* shl = (LAS bf16_t*)c.lds;
    for (int it = (set == 0 || c.G < 192) ? c.bid : (c.bid >= 96 ? c.bid - 96 : 96 + c.bid + c.G); it < 96; it += c.G) {
        int g, r = it;
        if (set == 0) { if (r < 32) g = 1; else if ((r -= 32) < 24) g = 2; else if ((r -= 24) < 16) g = 4; else { r -= 16; g = 6; } }
        else { g = 3 + 2 * (r >> 5); r &= 31; }
        const int layer = g >> 1, sub = g & 1;
        const bf16_t* Wt = sub ? (const bf16_t*)(ws + WS_WMLP + (size_t)layer * W_MLP) : ((layer & 1) ? (const bf16_t*)(ws + WS_WODD + (size_t)(layer >> 1) * W_ODD + WO_QKV) : (const bf16_t*)(ws + WS_WEVEN + (size_t)(layer >> 1) * W_EVEN + WE_IN));
        const float* sh = (const float*)(ws + WS_MOD) + (size_t)layer * 8 * 6144 + (sub ? 3072 : 0);
        __syncthreads();
        { const int b = c.tid >> 6, k0 = (c.tid & 63) * 16; const float* sp = sh + (size_t)b * 6144 + k0;
          const f32x4 a0 = *(const f32x4*)sp, a1 = *(const f32x4*)(sp + 4), a2 = *(const f32x4*)(sp + 8), a3 = *(const f32x4*)(sp + 12);
          u32x4 w0, w1; w0.x = pk2(a0.x, a0.y); w0.y = pk2(a0.z, a0.w); w0.z = pk2(a1.x, a1.y); w0.w = pk2(a1.z, a1.w); w1.x = pk2(a2.x, a2.y); w1.y = pk2(a2.z, a2.w); w1.z = pk2(a3.x, a3.y); w1.w = pk2(a3.z, a3.w);
          *(LAS u32x4*)(shl + b * 1032 + k0) = w0; *(LAS u32x4*)(shl + b * 1032 + k0 + 8) = w1; }
        __syncthreads();
        const int row0 = r * 128 + c.wave * 16;
        const bf16_t* wr = Wt + (size_t)(row0 + r16) * D + 8 * q4;
        const LAS bf16_t* bp = shl + (r16 & 7) * 1032 + 8 * q4;
        f32x4 acc = (f32x4){0.f, 0.f, 0.f, 0.f};
#pragma unroll 1
        for (int k0 = 0; k0 < 32; k0 += 16) {
            bf16x8 af[16];
#pragma unroll
            for (int i = 0; i < 16; ++i) af[i] = *(const bf16x8*)(wr + 32 * (k0 + i));
#pragma unroll
            for (int i = 0; i < 16; ++i) { bf16x8 bfr = *(const LAS bf16x8*)(bp + 32 * (k0 + i)); if (r16 >= 8) bfr = (bf16x8){0, 0, 0, 0, 0, 0, 0, 0};
                acc = __builtin_amdgcn_mfma_f32_16x16x32_bf16(af[i], bfr, acc, 0, 0, 0); }
        }
        if (r16 < 8) { float* o = (float*)(ws + WS_SHW) + (size_t)g * 8 * 4096 + (size_t)r16 * 4096 + row0 + q4 * 4; *(f32x4*)o = acc; }
    }
    __syncthreads();
}
DI void phase_modnorm(Ctx& c, const float* x, const float* gain, const float* sh, const float* sc, bf16_t* XN) {
    const int gw = c.bid * NW + c.wave, NGW = c.G * NW; constexpr int RB = 8;
    for (int m0 = gw; m0 < T; m0 += NGW * RB) {
        f32x4 v[RB][4]; float rs[RB];
#pragma unroll
        for (int t = 0; t < RB; ++t) { const int m = m0 + t * NGW; const f32x4* xr = (const f32x4*)(x + (size_t)(m < T ? m : 0) * D) + c.lane;
#pragma unroll
            for (int j = 0; j < 4; ++j) v[t][j] = xr[64 * j]; }
#pragma unroll
        for (int t = 0; t < RB; ++t) { float s = 0.f;
#pragma unroll
            for (int j = 0; j < 4; ++j) s += (v[t][j].x * v[t][j].x + v[t][j].y * v[t][j].y) + (v[t][j].z * v[t][j].z + v[t][j].w * v[t][j].w);
            rs[t] = s; }
#pragma unroll
        for (int t = 0; t < RB; ++t) rs[t] = rsqrtf(wave_sum(rs[t]) * (1.f / D) + EPS);
#pragma unroll
        for (int t = 0; t < RB; ++t) { const int m = m0 + t * NGW; if (m >= T) continue; const int b = m >> 11;
#pragma unroll
            for (int j = 0; j < 4; ++j) { const int n = 4 * c.lane + 256 * j; const f32x4 g = *(const f32x4*)(gain + n), sv = *(const f32x4*)(sc + b * 6144 + n), hv = *(const f32x4*)(sh + b * 6144 + n);
                f32x4 y; y.x = v[t][j].x * rs[t] * g.x * (1.f + sv.x) + hv.x; y.y = v[t][j].y * rs[t] * g.y * (1.f + sv.y) + hv.y; y.z = v[t][j].z * rs[t] * g.z * (1.f + sv.z) + hv.z; y.w = v[t][j].w * rs[t] * g.w * (1.f + sv.w) + hv.w;
                u32x2 o; o.x = pk2(y.x, y.y); o.y = pk2(y.z, y.w); *(u32x2*)(XN + (size_t)m * D + n) = o; } }
    }
}
constexpr int TB = 8;
constexpr int TBV = 4;
template <int N> struct H64In { u32x4 v[N]; };
template <int N> struct H64Tab { f32x4 tb[N][4]; };
template <int N> DI void head64_load(H64In<N>& in, bf16_t* const (&p)[N]) {
#pragma unroll
    for (int t = 0; t < N; ++t) in.v[t] = *(const u32x4*)p[t]; }
template <int N> DI void head64_tab(H64Tab<N>& tb, const float* const (&tab)[N]) {
#pragma unroll
    for (int t = 0; t < N; ++t) { tb.tb[t][0] = *(const f32x4*)(tab[t]); tb.tb[t][1] = *(const f32x4*)(tab[t] + 4); tb.tb[t][2] = *(const f32x4*)(tab[t] + 8); tb.tb[t][3] = *(const f32x4*)(tab[t] + 12); } }
template <int TBV> DI void head64_apply(const H64In<TBV>& in, const H64Tab<TBV>& tbs, bf16_t* const (&p)[TBV], bool act, const f32x4 ga, const f32x4 gb, float scale, int lane) {
    const int sub = lane & 7; float x[TBV][8], ss[TBV];
#pragma unroll
    for (int t = 0; t < TBV; ++t) { const u32x4 v = in.v[t];
        x[t][0] = bflo(v.x); x[t][1] = bfhi(v.x); x[t][2] = bflo(v.y); x[t][3] = bfhi(v.y); x[t][4] = bflo(v.z); x[t][5] = bfhi(v.z); x[t][6] = bflo(v.w); x[t][7] = bfhi(v.w); }
#pragma unroll
    for (int t = 0; t < TBV; ++t) { float s = 0.f;
#pragma unroll
        for (int e = 0; e < 8; ++e) s += x[t][e] * x[t][e];
        ss[t] = s; }
#pragma unroll
    for (int t = 0; t < TBV; ++t) ss[t] += swz<1>(ss[t]);
#pragma unroll
    for (int t = 0; t < TBV; ++t) ss[t] += swz<2>(ss[t]);
#pragma unroll
    for (int t = 0; t < TBV; ++t) ss[t] += swz<4>(ss[t]);
    const float g[8] = {ga.x, ga.y, ga.z, ga.w, gb.x, gb.y, gb.z, gb.w};
#pragma unroll
    for (int t = 0; t < TBV; ++t) { const float rs = rsqrtf(ss[t] * (1.f / 64.f) + EPS);
        float y[8], o[8];
#pragma unroll
        for (int e = 0; e < 8; ++e) { y[e] = x[t][e] * rs * g[e]; o[e] = swz<1>(y[e]); }
        if (sub < 2) {
            const f32x4 t0 = tbs.tb[t][0], t1 = tbs.tb[t][1], t2 = tbs.tb[t][2], t3 = tbs.tb[t][3];
            const float cs[8] = {t0.x, t0.z, t1.x, t1.z, t2.x, t2.z, t3.x, t3.z}, sn[8] = {t0.y, t0.w, t1.y, t1.w, t2.y, t2.w, t3.y, t3.w};
#pragma unroll
            for (int e = 0; e < 8; ++e) y[e] = sub == 0 ? y[e] * cs[e] - o[e] * sn[e] : o[e] * sn[e] + y[e] * cs[e];
        }
        u32x4 w; w.x = pk2(y[0] * scale, y[1] * scale); w.y = pk2(y[2] * scale, y[3] * scale); w.z = pk2(y[4] * scale, y[5] * scale); w.w = pk2(y[6] * scale, y[7] * scale);
        if (act) *(u32x4*)p[t] = w; }
}
template <int TBV> DI void head64_vec(bf16_t* const (&p)[TBV], bool act, const float* gain, const float* const (&tab)[TBV], float scale, int lane) {
    H64In<TBV> in; H64Tab<TBV> tb; head64_tab<TBV>(tb, tab); head64_load<TBV>(in, p);
    const f32x4 ga = *(const f32x4*)(gain + 8 * (lane & 7)), gb = *(const f32x4*)(gain + 8 * (lane & 7) + 4);
    head64_apply<TBV>(in, tb, p, act, ga, gb, scale, lane);
}
DI void nsa_finalize_rows(Ctx& c, bf16_t* U, int m0, int mstride, int j) {
    CArgs& a = *c.a; const float* qg = a.in[17] + j * 64; const float* kg = a.in[18] + j * 192; const int lane = c.lane; constexpr int RB = 4;
    bf16_t* pq[RB]; bf16_t* pk[RB]; const float* tab[RB];
#pragma unroll
    for (int t = 0; t < RB; ++t) { const int m = m0 + t * mstride; pq[t] = U + (size_t)m * UW + 544 + 8 * lane; pk[t] = U + (size_t)m * UW + ((lane & 31) < 16 ? 1312 + 8 * (lane & 15) : 1568 + 8 * (lane & 15));
        tab[t] = (const float*)(c.ws + WS_CS8) + (size_t)m * 16; }
    H64Tab<RB> tb; H64In<RB> inq, ink; head64_tab<RB>(tb, tab); head64_load<RB>(inq, pq); head64_load<RB>(ink, pk);
    const float* kgl = (lane & 31) < 16 ? kg + 64 : kg + 128; const int sub = lane & 7;
    const f32x4 gqa = *(const f32x4*)(qg + 8 * sub), gqb = *(const f32x4*)(qg + 8 * sub + 4), gka = *(const f32x4*)(kgl + 8 * sub), gkb = *(const f32x4*)(kgl + 8 * sub + 4);
    head64_apply<RB>(inq, tb, pq, true, gqa, gqb, 0.125f * LOG2E, lane);
    head64_apply<RB>(ink, tb, pk, lane < 32, gka, gkb, 1.f, lane);
}
DI void diff_finalize_rows(Ctx& c, bf16_t* QKV, int m0, int mstride, int j) {
    CArgs& a = *c.a; const float* qg = a.in[24] + j * 64; const float* kg = a.in[25] + j * 64; const int lane = c.lane;
    bf16_t* p[TBV]; const float* tab[TBV];
#pragma unroll 1
    for (int ch = 0; ch < 4; ++ch) {
#pragma unroll
        for (int t = 0; t < TBV; ++t) { const int m = m0 + t * mstride; p[t] = QKV + (size_t)m * 3072 + 512 * ch + 8 * lane; tab[t] = (const float*)(c.ws + WS_CS8) + (size_t)m * 16; }
        head64_vec<TBV>(p, true, ch < 2 ? qg : kg, tab, ch < 2 ? 0.125f * LOG2E : 1.f, lane);
    }
}
DI void diff_finalize_tile(Ctx& c, bf16_t* QKV, int pm, int pn, int j) {
    CArgs& a = *c.a; const int lane = c.lane; const bool isq = pn < 4; constexpr int RB = 2;
    const float* g = isq ? a.in[24] + j * 64 : a.in[25] + j * 64; const float sc = isq ? 0.125f * LOG2E : 1.f;
    const f32x4 ga = *(const f32x4*)(g + 8 * (lane & 7)), gb = *(const f32x4*)(g + 8 * (lane & 7) + 4);
    bf16_t* pc[RB]; bf16_t* pnx[RB]; const float* tab[RB]; H64In<RB> cur, nxt; H64Tab<RB> tbc, tbn;
#pragma unroll
    for (int t = 0; t < RB; ++t) { const int m = pm * 256 + t * 16 + 2 * c.wave + (lane >> 5); pc[t] = QKV + (size_t)m * 3072 + pn * 256 + 8 * (lane & 31); tab[t] = (const float*)(c.ws + WS_CS8) + (size_t)m * 16; }
    head64_tab<RB>(tbc, tab); head64_load<RB>(cur, pc);
#pragma unroll 1
    for (int r0 = 0; r0 < 256; r0 += 16 * RB) {
        const bool more = r0 + 16 * RB < 256;
        if (more) {
#pragma unroll
            for (int t = 0; t < RB; ++t) { const int m = pm * 256 + r0 + 16 * RB + t * 16 + 2 * c.wave + (lane >> 5); pnx[t] = QKV + (size_t)m * 3072 + pn * 256 + 8 * (lane & 31); tab[t] = (const float*)(c.ws + WS_CS8) + (size_t)m * 16; }
            head64_tab<RB>(tbn, tab); head64_load<RB>(nxt, pnx); }
        head64_apply<RB>(cur, tbc, pc, true, ga, gb, sc, lane);
        if (more) { cur = nxt; tbc = tbn;
#pragma unroll
            for (int t = 0; t < RB; ++t) pc[t] = pnx[t]; }
    }
}
DI void unpack8(const u32x4 v, float (&x)[8]) { x[0] = bflo(v.x); x[1] = bfhi(v.x); x[2] = bflo(v.y); x[3] = bfhi(v.y); x[4] = bflo(v.z); x[5] = bfhi(v.z); x[6] = bflo(v.w); x[7] = bfhi(v.w); }
DI float sumsq8(const float (&x)[8]) { return ((x[0] * x[0] + x[1] * x[1]) + (x[2] * x[2] + x[3] * x[3])) + ((x[4] * x[4] + x[5] * x[5]) + (x[6] * x[6] + x[7] * x[7])); }
DI u32x4 mla_chunk(const float (&x)[8], float ss, const LAS float* g96, const LAS float* tab, int ci, float scale) {
    const float rs = rsqrtf(ss * (1.f / 96.f) + EPS);
    const f32x4 ga = *(const LAS f32x4*)(g96 + 8 * ci), gb = *(const LAS f32x4*)(g96 + 8 * ci + 4);
    float y[8] = {x[0] * rs * ga.x, x[1] * rs * ga.y, x[2] * rs * ga.z, x[3] * rs * ga.w, x[4] * rs * gb.x, x[5] * rs * gb.y, x[6] * rs * gb.z, x[7] * rs * gb.w};
    float o[8];
#pragma unroll
    for (int e = 0; e < 8; ++e) o[e] = swz<2>(y[e]);
    { const LAS float* tp = tab + 16 * (ci & 1);
        const f32x4 t0 = *(const LAS f32x4*)tp, t1 = *(const LAS f32x4*)(tp + 4), t2 = *(const LAS f32x4*)(tp + 8), t3 = *(const LAS f32x4*)(tp + 12);
        const float cs[8] = {t0.x, t0.z, t1.x, t1.z, t2.x, t2.z, t3.x, t3.z}, sn[8] = {t0.y, t0.w, t1.y, t1.w, t2.y, t2.w, t3.y, t3.w};
        const float sg = ci < 2 ? -1.f : 1.f; const bool rot = ci < 4;
#pragma unroll
        for (int e = 0; e < 8; ++e) { const float r = y[e] * cs[e] + sg * (o[e] * sn[e]); y[e] = rot ? r : y[e]; } }
    u32x4 w; w.x = pk2(y[0] * scale, y[1] * scale); w.y = pk2(y[2] * scale, y[3] * scale); w.z = pk2(y[4] * scale, y[5] * scale); w.w = pk2(y[6] * scale, y[7] * scale);
    return w;
}
DI float head_ss(const LAS float* tbl, int h) { const f32x4 a = *(const LAS f32x4*)(tbl + 12 * h), b = *(const LAS f32x4*)(tbl + 12 * h + 4), cc = *(const LAS f32x4*)(tbl + 12 * h + 8); return ((a.x + a.y) + (a.z + a.w)) + ((b.x + b.y) + (b.z + b.w)) + ((cc.x + cc.y) + (cc.z + cc.w)); }
#ifndef FX_MTB
#define FX_MTB 2
#endif
constexpr int MTB = FX_MTB;
DI void mla_finalize_rows(Ctx& c, const bf16_t* U, bf16_t* QL, bf16_t* KVU, bf16_t* KF, int m0, int mstride, int j) {
    CArgs& a = *c.a; const int lane = c.lane;
    const float* qg = a.in[15] + j * 96; const float* kg = a.in[16] + j * 96;
    LAS float* tbl = (LAS float*)(c.lds + c.wave * 8192);
    LAS float* ropel = tbl + 768; LAS float* qgl = tbl + 896; LAS float* kgl = tbl + 992;
    f32x4 rp[MTB]; u32x4 xvp[MTB];
    { const int l24 = lane < 24 ? lane : 23; const f32x4 gq = *(const f32x4*)(qg + 4 * l24), gk = *(const f32x4*)(kg + 4 * l24);
#pragma unroll
      for (int t = 0; t < MTB; ++t) { const int m = m0 + t * mstride; rp[t] = *(const f32x4*)((const float*)(c.ws + WS_CS16) + (size_t)m * 32 + 4 * (lane & 7));
          xvp[t] = *(const u32x4*)(KVU + (size_t)m * UPW + 128 * (lane >> 3) + 64 + 8 * (lane & 7)); }
      if (lane < 24) { *(LAS f32x4*)(qgl + 4 * lane) = gq; *(LAS f32x4*)(kgl + 4 * lane) = gk; }
      if (lane < 8) {
#pragma unroll
          for (int t = 0; t < MTB; ++t) *(LAS f32x4*)(ropel + t * 32 + 4 * lane) = rp[t]; } }
    const int cA = lane, hA = cA / 12, ciA = cA % 12, cB = 64 + (lane & 31), hB = cB / 12, ciB = cB % 12; const bool actB = lane < 32;
    const float qscale = 0.10206207261596577f * LOG2E;
    float xqA[MTB][8], xqB[MTB][8], xkA[MTB][8], xkB[MTB][8], rskv[MTB]; int mrow[MTB];
#pragma unroll
    for (int t = 0; t < MTB; ++t) { const int m = m0 + t * mstride; mrow[t] = m; const bf16_t* urow = U + (size_t)m * UW;
        float lx[8]; unpack8(*(const u32x4*)(urow + 8 * lane), lx); float sl = sumsq8(lx);
        sl += swz<1>(sl); sl += swz<2>(sl); sl += swz<4>(sl); sl += swz<8>(sl); sl += swz<16>(sl);
        const float rsq = rsqrtf(__builtin_bit_cast(float, __builtin_amdgcn_readlane(__builtin_bit_cast(int, sl), 0)) * (1.f / 256.f) + EPS);
        rskv[t] = rsqrtf(__builtin_bit_cast(float, __builtin_amdgcn_readlane(__builtin_bit_cast(int, sl), 32)) * (1.f / 256.f) + EPS);
        { const bf16_t* q = QL + (size_t)m * UPW; unpack8(*(const u32x4*)(q + 8 * cA), xqA[t]); const u32x4 vb = *(const u32x4*)(q + 8 * cB); unpack8(vb, xqB[t]);
#pragma unroll
          for (int e = 0; e < 8; ++e) { xqA[t][e] *= rsq; xqB[t][e] *= rsq; }
          tbl[t * 192 + cA] = sumsq8(xqA[t]); if (actB) tbl[t * 192 + cB] = sumsq8(xqB[t]); }
        { const bf16_t* kn = KVU + (size_t)m * UPW;
          unpack8(*(const u32x4*)(ciA < 4 ? urow + 512 + 8 * ciA : kn + 128 * hA + 8 * (ciA - 4)), xkA[t]);
          u32x4 vb = (u32x4){0u, 0u, 0u, 0u}; if (actB) vb = *(const u32x4*)(ciB < 4 ? urow + 512 + 8 * ciB : kn + 128 * hB + 8 * (ciB - 4)); unpack8(vb, xkB[t]);
          const float fa = ciA < 4 ? 1.f : rskv[t], fb = ciB < 4 ? 1.f : rskv[t];
#pragma unroll
          for (int e = 0; e < 8; ++e) { xkA[t][e] *= fa; xkB[t][e] *= fb; }
          tbl[t * 192 + 96 + cA] = sumsq8(xkA[t]); if (actB) tbl[t * 192 + 96 + cB] = sumsq8(xkB[t]); }
    }
#pragma unroll
    for (int t = 0; t < MTB; ++t) { const int m = mrow[t]; const LAS float* tab = ropel + t * 32;
        { bf16_t* q = QL + (size_t)m * UPW;
          const u32x4 wA = mla_chunk(xqA[t], head_ss(tbl + t * 192, hA), qgl, tab, ciA, qscale); const u32x4 wB = mla_chunk(xqB[t], head_ss(tbl + t * 192, hB), qgl, tab, ciB, qscale);
          *(u32x4*)(q + 8 * cA) = wA; if (actB) *(u32x4*)(q + 8 * cB) = wB; }
        { bf16_t* k = KF + (size_t)m * 768;
          const u32x4 wA = mla_chunk(xkA[t], head_ss(tbl + t * 192 + 96, hA), kgl, tab, ciA, 1.f); const u32x4 wB = mla_chunk(xkB[t], head_ss(tbl + t * 192 + 96, hB), kgl, tab, ciB, 1.f);
          *(u32x4*)(k + 8 * cA) = wA; if (actB) *(u32x4*)(k + 8 * cB) = wB; }
        { bf16_t* v = KVU + (size_t)m * UPW + 128 * (lane >> 3) + 64 + 8 * (lane & 7); float xv[8]; unpack8(xvp[t], xv); const float f = rskv[t];
          u32x4 w; w.x = pk2(xv[0] * f, xv[1] * f); w.y = pk2(xv[2] * f, xv[3] * f); w.z = pk2(xv[4] * f, xv[5] * f); w.w = pk2(xv[6] * f, xv[7] * f); *(u32x4*)v = w; }
    }
}

DI float gelu_tanh(float x) { const float u = 0.7978845608028654f * (x + 0.044715f * x * x * x); const float e = __expf(2.f * u); const float t = 1.f - 2.f / (e + 1.f); return 0.5f * x * (1.f + t); }
constexpr size_t CBIAS_OFF = 640 * 1024;
DI void cbias_reduce(Ctx& c) {
    const float* P = (const float*)(c.ws + WS_MISC); float* F = (float*)(c.ws + WS_MISC + CBIAS_OFF);
    const int jj2 = c.tid >> 7, n = c.tid & 127; float s = 0.f;
#pragma unroll 8
    for (int kc = 0; kc < 32; ++kc) s += P[(jj2 * 32 + kc) * 128 + n];
    F[jj2 * 128 + n] = s;
}
DI void compress_item(Ctx& c, const bf16_t* U, int j, int it) {
    RELAUNDER(c);
    CArgs& a = *c.a; const int lane = c.lane, w = c.wave, tid = c.tid;
    const int jj = it >> 7, bg = (it >> 3) & 15, chunk = it & 7, b = bg >> 1, g = bg & 1, c0 = 16 * chunk;
    const bf16_t* W1t = (const bf16_t*)(c.ws + WS_WEVEN + j * W_EVEN + WE_C1) + (size_t)jj * 128 * 2048;
    const bf16_t* W2t = (const bf16_t*)(c.ws + WS_WEVEN + j * W_EVEN + WE_C2) + (size_t)jj * 64 * 128;
    LAS float* part = (LAS float*)c.lds;
    LAS bf16_t* hid = (LAS bf16_t*)(c.lds + 65536);
    LAS float* outl = (LAS float*)(c.lds + 65536 + 8192);
    const int r16 = lane & 15, q4 = lane >> 4;
    const f32x4 bsum = *(const f32x4*)((const float*)(c.ws + WS_MISC + CBIAS_OFF) + (size_t)(j * 2 + jj) * 128 + (tid & 31) * 4);
    f32x4 kgv = (f32x4){0.f, 0.f, 0.f, 0.f}, kgo = kgv, tb0 = kgv, tb1 = kgv;
    if (jj == 0) { const int d0_ = (tid & 15) * 4; const float* kg_ = a.in[18] + j * 192; int tok_ = b * S + 16 * (c0 + (tid >> 4)) + 31; if (tok_ >= T) tok_ = T - 1;
        const float* tab_ = (const float*)(c.ws + WS_CS8) + (size_t)tok_ * 16 + 2 * (d0_ & 7);
        kgv = *(const f32x4*)(kg_ + d0_); kgo = *(const f32x4*)(kg_ + (d0_ ^ 8)); tb0 = *(const f32x4*)tab_; tb1 = *(const f32x4*)(tab_ + 4); }
    f32x4 acc[8];
#pragma unroll
    for (int n = 0; n < 8; ++n) acc[n] = (f32x4){0.f, 0.f, 0.f, 0.f};
    const bf16_t* arow = U + ((size_t)b * S + 16 * (c0 + r16)) * UW + 1056 + jj * 128 + g * 64 + q4 * 8;
#pragma unroll 4
    for (int ks = 8 * w; ks < 8 * w + 8; ++ks) {
        const bf16x8 af = *(const bf16x8*)(arow + (size_t)(ks >> 1) * UW + (ks & 1) * 32);
#pragma unroll
        for (int n = 0; n < 8; ++n) { const bf16x8 bfr = *(const bf16x8*)(W1t + (size_t)(n * 16 + r16) * 2048 + 32 * ks + q4 * 8);
            acc[n] = __builtin_amdgcn_mfma_f32_16x16x32_bf16(af, bfr, acc[n], 0, 0, 0); }
    }
#pragma unroll
    for (int n = 0; n < 8; ++n)
#pragma unroll
        for (int i = 0; i < 4; ++i) part[(w * 16 + q4 * 4 + i) * 128 + n * 16 + r16] = acc[n][i];
    __syncthreads();
    { const int cc = tid >> 5, n0 = (tid & 31) * 4; float v[4];
#pragma unroll
      for (int e = 0; e < 4; ++e) { float s = 0.f;
#pragma unroll
          for (int ww = 0; ww < 8; ++ww) s += part[(ww * 16 + cc) * 128 + n0 + e];
          v[e] = s; }
      { const f32x4 bs = bsum;
        v[0] = gelu_tanh(v[0] + bs.x); v[1] = gelu_tanh(v[1] + bs.y); v[2] = gelu_tanh(v[2] + bs.z); v[3] = gelu_tanh(v[3] + bs.w); }
      u32x2 o; o.x = pk2(v[0], v[1]); o.y = pk2(v[2], v[3]); *(LAS u32x2*)(hid + cc * 136 + n0) = o; }
    __syncthreads();
    if (w < 4) {
        f32x4 a2 = (f32x4){0.f, 0.f, 0.f, 0.f};
#pragma unroll
        for (int kst = 0; kst < 4; ++kst) { const bf16x8 af = *(const LAS bf16x8*)(hid + r16 * 136 + 32 * kst + q4 * 8);
            const bf16x8 bfr = *(const bf16x8*)(W2t + (size_t)(w * 16 + r16) * 128 + 32 * kst + q4 * 8);
            a2 = __builtin_amdgcn_mfma_f32_16x16x32_bf16(af, bfr, a2, 0, 0, 0); }
#pragma unroll
        for (int i = 0; i < 4; ++i) outl[(q4 * 4 + i) * 64 + w * 16 + r16] = a2[i];
    }
    __syncthreads();
    if (tid < 256) {
        const int cc = tid >> 4, d0 = (tid & 15) * 4; const int cg = c0 + cc;
        bf16_t* dst = (bf16_t*)(c.ws + WS_MISC + 65536 + (size_t)jj * 262144) + ((size_t)bg * 128 + cg) * 64 + d0;
        float v[4];
#pragma unroll
        for (int e = 0; e < 4; ++e) v[e] = outl[cc * 64 + d0 + e];
        if (jj == 0) {
            float s = (v[0] * v[0] + v[1] * v[1]) + (v[2] * v[2] + v[3] * v[3]);
            s += swz<1>(s); s += swz<2>(s); s += swz<4>(s); s += swz<8>(s);
            const float rs = rsqrtf(s * (1.f / 64.f) + EPS);
            const float csv[4] = {tb0.x, tb0.z, tb1.x, tb1.z}, snv[4] = {tb0.y, tb0.w, tb1.y, tb1.w};
#pragma unroll
            for (int e = 0; e < 4; ++e) { const int d = d0 + e; float y = v[e] * rs * kgv[e];
                if (d < 16) { const float o = outl[cc * 64 + (d ^ 8)] * rs * kgo[e]; const float cs = csv[e], sn = snv[e]; y = d < 8 ? y * cs - o * sn : o * sn + y * cs; }
                v[e] = y; }
        }
        if (cg == 127) { v[0] = v[1] = v[2] = v[3] = 0.f; }
        u32x2 o; o.x = pk2(v[0], v[1]); o.y = pk2(v[2], v[3]); *(u32x2*)dst = o;
    }
    __syncthreads();
}

DI void lds_add(LAS float* p, float v) { (void)__hip_atomic_fetch_add(p, v, __ATOMIC_RELAXED, __HIP_MEMORY_SCOPE_WORKGROUP); }
DI int crow(int r, int h) { return (r & 3) + 8 * (r >> 2) + 4 * h; }
DI unsigned cvtpk(float lo, float hi) { typedef float f2 __attribute__((ext_vector_type(2))); typedef __bf16 b2 __attribute__((ext_vector_type(2))); f2 v = {lo, hi}; b2 r = __builtin_convertvector(v, b2); return __builtin_bit_cast(unsigned, r); }
#ifndef FX_VPAD
#define FX_VPAD 64
#endif
template <int DD> struct TileRegs { u32x4 r[(64 * DD / 8 + NT - 1) / NT]; };
template <int DD> DI void tile_load(TileRegs<DD>& t, const bf16_t* g, int ld, int tid) {
    constexpr int CPR = DD / 8, NCH = 64 * CPR, NI = (NCH + NT - 1) / NT;
#pragma unroll
    for (int i = 0; i < NI; ++i) { const int ch = tid + NT * i; if (NCH % NT == 0 || ch < NCH) { const int row = ch / CPR, c8 = ch % CPR; const unsigned eo = (unsigned)row * (unsigned)ld + (unsigned)c8 * 8u; t.r[i] = *(const u32x4*)(g + eo); } }
}
template <int DD, int PAD = 16> DI void tile_store(const TileRegs<DD>& t, LAS char* buf, int tid) {
    constexpr int CPR = DD / 8, NCH = 64 * CPR, NI = (NCH + NT - 1) / NT, STR = DD * 2 + PAD;
#pragma unroll
    for (int i = 0; i < NI; ++i) { const int ch = tid + NT * i; if (NCH % NT == 0 || ch < NCH) { const int row = ch / CPR, c8 = ch % CPR; *(LAS u32x4*)(buf + row * STR + c8 * 16) = t.r[i]; } }
}
template <int DK> DI void qk_tile(const LAS char* Kb, const bf16x8* qf, f32x16& p0, f32x16& p1, int lane, float negm = 0.f) {
    constexpr int KS = DK * 2 + 16, NG = DK / 32; const LAS char* kp = Kb + (lane & 31) * KS + (lane >> 5) * 16;
    bf16x8 kf[2][2][2];
#define QK_LOAD(G_, B_) do { _Pragma("unroll") for (int j_ = 0; j_ < 2; ++j_) { kf[B_][j_][0] = *(const LAS bf16x8*)(kp + (2 * (G_) + j_) * 32); kf[B_][j_][1] = *(const LAS bf16x8*)(kp + 32 * KS + (2 * (G_) + j_) * 32); } } while (0)
    constexpr bool DB = FX_QKDB || (DK > 64);
    QK_LOAD(0, 0);
#pragma unroll
    for (int r = 0; r < 16; ++r) { p0[r] = negm; p1[r] = negm; }
#pragma unroll
    for (int g = 0; g < NG; ++g) {
        const int bcur = DB ? (g & 1) : 0;
        if (DB && g + 1 < NG) { if ((g & 1) == 0) QK_LOAD(g + 1, 1); else QK_LOAD(g + 1, 0); }
        __builtin_amdgcn_sched_barrier(0);
        if (FX_PRIO) __builtin_amdgcn_s_setprio(1);
#pragma unroll
        for (int j = 0; j < 2; ++j) { p0 = __builtin_amdgcn_mfma_f32_32x32x16_bf16(kf[bcur][j][0], qf[2 * g + j], p0, 0, 0, 0); p1 = __builtin_amdgcn_mfma_f32_32x32x16_bf16(kf[bcur][j][1], qf[2 * g + j], p1, 0, 0, 0); }
        if (FX_PRIO) __builtin_amdgcn_s_setprio(0);
        __builtin_amdgcn_sched_barrier(0);
        if (!DB && g + 1 < NG) QK_LOAD(g + 1, 0);
    }
#undef QK_LOAD
}
template <int DV> DI void pv_tile(const LAS char* Vb, const f32x16& p0, const f32x16& p1, f32x16* o, int lane) {
    constexpr int VS = DV * 2 + FX_VPAD;
    const int g = lane >> 4, h = lane >> 5, i16 = lane & 15, q = i16 >> 2, p = i16 & 3;
    const LAS char* base = Vb + (4 * h + q) * VS + (16 * (g & 1) + 4 * p) * 2;
    constexpr int NDB = DV / 32, GS = (DV == 64) ? 2 : FX_GS128;
    bf16x8 pf[4];
#pragma unroll
    for (int s = 0; s < 4; ++s) { u32x4 pw;
        if (s < 2) { pw.x = cvtpk(p0[8 * s], p0[8 * s + 1]); pw.y = cvtpk(p0[8 * s + 2], p0[8 * s + 3]); pw.z = cvtpk(p0[8 * s + 4], p0[8 * s + 5]); pw.w = cvtpk(p0[8 * s + 6], p0[8 * s + 7]); }
        else { const int s2 = s - 2; pw.x = cvtpk(p1[8 * s2], p1[8 * s2 + 1]); pw.y = cvtpk(p1[8 * s2 + 2], p1[8 * s2 + 3]); pw.z = cvtpk(p1[8 * s2 + 4], p1[8 * s2 + 5]); pw.w = cvtpk(p1[8 * s2 + 6], p1[8 * s2 + 7]); }
        pf[s] = __builtin_bit_cast(bf16x8, pw); }
#pragma unroll
    for (int s0 = 0; s0 < 4; s0 += GS) {
        s16x4 lo[GS][NDB], hi[GS][NDB];
#pragma unroll
        for (int s = 0; s < GS; ++s)
#pragma unroll
            for (int db = 0; db < NDB; ++db) { lo[s][db] = vtr(base + (16 * (s0 + s)) * VS + db * 64); hi[s][db] = vtr(base + (16 * (s0 + s) + 8) * VS + db * 64); }
        __builtin_amdgcn_sched_barrier(0);
#pragma unroll
        for (int s = 0; s < GS; ++s)
#pragma unroll
            for (int db = 0; db < NDB; ++db) o[db] = __builtin_amdgcn_mfma_f32_32x32x16_bf16(__builtin_shufflevector(lo[s][db], hi[s][db], 0, 1, 2, 3, 4, 5, 6, 7), pf[s0 + s], o[db], 0, 0, 0);
        __builtin_amdgcn_sched_barrier(0);
    }
}
struct VPre { s16x4 lo[2][2], hi[2][2]; };
DI void pv_prefetch64(const LAS char* Vb, VPre& v, int lane) {
    constexpr int VS = 64 * 2 + FX_VPAD; const int g = lane >> 4, h = lane >> 5, i16 = lane & 15, q = i16 >> 2, p = i16 & 3;
    const LAS char* base = Vb + (4 * h + q) * VS + (16 * (g & 1) + 4 * p) * 2;
#pragma unroll
    for (int s = 0; s < 2; ++s)
#pragma unroll
        for (int db = 0; db < 2; ++db) { v.lo[s][db] = vtr(base + (16 * s) * VS + db * 64); v.hi[s][db] = vtr(base + (16 * s + 8) * VS + db * 64); }
}
DI void pv_tile64_pre(const LAS char* Vb, const f32x16& p0, const f32x16& p1, f32x16* o, const VPre& v, int lane) {
    constexpr int VS = 64 * 2 + FX_VPAD; const int g = lane >> 4, h = lane >> 5, i16 = lane & 15, q = i16 >> 2, p = i16 & 3;
    const LAS char* base = Vb + (4 * h + q) * VS + (16 * (g & 1) + 4 * p) * 2;
    bf16x8 pf[4];
#pragma unroll
    for (int s = 0; s < 4; ++s) { u32x4 pw;
        if (s < 2) { pw.x = cvtpk(p0[8 * s], p0[8 * s + 1]); pw.y = cvtpk(p0[8 * s + 2], p0[8 * s + 3]); pw.z = cvtpk(p0[8 * s + 4], p0[8 * s + 5]); pw.w = cvtpk(p0[8 * s + 6], p0[8 * s + 7]); }
        else { const int s2 = s - 2; pw.x = cvtpk(p1[8 * s2], p1[8 * s2 + 1]); pw.y = cvtpk(p1[8 * s2 + 2], p1[8 * s2 + 3]); pw.z = cvtpk(p1[8 * s2 + 4], p1[8 * s2 + 5]); pw.w = cvtpk(p1[8 * s2 + 6], p1[8 * s2 + 7]); }
        pf[s] = __builtin_bit_cast(bf16x8, pw); }
    s16x4 lo2[2][2], hi2[2][2];
#pragma unroll
    for (int s = 0; s < 2; ++s)
#pragma unroll
        for (int db = 0; db < 2; ++db) { lo2[s][db] = vtr(base + (16 * (2 + s)) * VS + db * 64); hi2[s][db] = vtr(base + (16 * (2 + s) + 8) * VS + db * 64); }
    __builtin_amdgcn_sched_barrier(0);
#pragma unroll
    for (int s = 0; s < 2; ++s)
#pragma unroll
        for (int db = 0; db < 2; ++db) o[db] = __builtin_amdgcn_mfma_f32_32x32x16_bf16(__builtin_shufflevector(v.lo[s][db], v.hi[s][db], 0, 1, 2, 3, 4, 5, 6, 7), pf[s], o[db], 0, 0, 0);
    __builtin_amdgcn_sched_barrier(0);
#pragma unroll
    for (int s = 0; s < 2; ++s)
#pragma unroll
        for (int db = 0; db < 2; ++db) o[db] = __builtin_amdgcn_mfma_f32_32x32x16_bf16(__builtin_shufflevector(lo2[s][db], hi2[s][db], 0, 1, 2, 3, 4, 5, 6, 7), pf[2 + s], o[db], 0, 0, 0);
    __builtin_amdgcn_sched_barrier(0);
}
struct VPre128 { s16x4 lo[4], hi[4]; };
DI void pv_prefetch128(const LAS char* Vb, VPre128& v, int lane) {
    constexpr int VS = 128 * 2 + FX_VPAD; const int g = lane >> 4, h = lane >> 5, i16 = lane & 15, q = i16 >> 2, p = i16 & 3;
    const LAS char* base = Vb + (4 * h + q) * VS + (16 * (g & 1) + 4 * p) * 2;
#pragma unroll
    for (int db = 0; db < 4; ++db) { v.lo[db] = vtr(base + db * 64); v.hi[db] = vtr(base + 8 * VS + db * 64); }
}
DI void pv_tile128_pre(const LAS char* Vb, const f32x16& p0, const f32x16& p1, f32x16* o, const VPre128& v, int lane) {
    constexpr int VS = 128 * 2 + FX_VPAD; const int g = lane >> 4, h = lane >> 5, i16 = lane & 15, q = i16 >> 2, p = i16 & 3;
    const LAS char* base = Vb + (4 * h + q) * VS + (16 * (g & 1) + 4 * p) * 2;
    bf16x8 pf[4];
#pragma unroll
    for (int s = 0; s < 4; ++s) { u32x4 pw;
        if (s < 2) { pw.x = cvtpk(p0[8 * s], p0[8 * s + 1]); pw.y = cvtpk(p0[8 * s + 2], p0[8 * s + 3]); pw.z = cvtpk(p0[8 * s + 4], p0[8 * s + 5]); pw.w = cvtpk(p0[8 * s + 6], p0[8 * s + 7]); }
        else { const int s2 = s - 2; pw.x = cvtpk(p1[8 * s2], p1[8 * s2 + 1]); pw.y = cvtpk(p1[8 * s2 + 2], p1[8 * s2 + 3]); pw.z = cvtpk(p1[8 * s2 + 4], p1[8 * s2 + 5]); pw.w = cvtpk(p1[8 * s2 + 6], p1[8 * s2 + 7]); }
        pf[s] = __builtin_bit_cast(bf16x8, pw); }
#pragma unroll
    for (int db = 0; db < 4; ++db) o[db] = __builtin_amdgcn_mfma_f32_32x32x16_bf16(__builtin_shufflevector(v.lo[db], v.hi[db], 0, 1, 2, 3, 4, 5, 6, 7), pf[0], o[db], 0, 0, 0);
    __builtin_amdgcn_sched_barrier(0);
#pragma unroll
    for (int s = 1; s < 4; ++s) { s16x4 lo[4], hi[4];
#pragma unroll
        for (int db = 0; db < 4; ++db) { lo[db] = vtr(base + (16 * s) * VS + db * 64); hi[db] = vtr(base + (16 * s + 8) * VS + db * 64); }
        __builtin_amdgcn_sched_barrier(0);
#pragma unroll
        for (int db = 0; db < 4; ++db) o[db] = __builtin_amdgcn_mfma_f32_32x32x16_bf16(__builtin_shufflevector(lo[db], hi[db], 0, 1, 2, 3, 4, 5, 6, 7), pf[s], o[db], 0, 0, 0);
        __builtin_amdgcn_sched_barrier(0); }
}
DI float max3f(float a, float b, float c) { return __builtin_fmaxf(__builtin_fmaxf(a, b), c); }
DI float rowmax32(const f32x16& p0, const f32x16& p1) {
    float a = max3f(p0[0], p0[1], p0[2]), b = max3f(p0[3], p0[4], p0[5]), c = max3f(p1[0], p1[1], p1[2]), d = max3f(p1[3], p1[4], p1[5]);
    a = max3f(a, p0[6], p0[7]); b = max3f(b, p0[8], p0[9]); c = max3f(c, p1[6], p1[7]); d = max3f(d, p1[8], p1[9]);
    a = max3f(a, p0[10], p0[11]); b = max3f(b, p0[12], p0[13]); c = max3f(c, p1[10], p1[11]); d = max3f(d, p1[12], p1[13]);
    a = max3f(a, p0[14], p0[15]); c = max3f(c, p1[14], p1[15]);
    return max32(max3f(max3f(a, b, c), d, d));
}
template <int DV> DI void softmax_step(f32x16& p0, f32x16& p1, f32x16* o, float& m, float& l) {
    const float mx = rowmax32(p0, p1); const float mnew = fmaxf(m, mx); const float muse = (mnew == -INFINITY) ? 0.f : mnew;
    const float alpha = __builtin_amdgcn_exp2f(m - muse);
    float s = 0.f;
#pragma unroll
    for (int r = 0; r < 16; ++r) { p0[r] = __builtin_amdgcn_exp2f(p0[r] - muse); p1[r] = __builtin_amdgcn_exp2f(p1[r] - muse); s += p0[r] + p1[r]; }
    l = l * alpha + s; m = mnew;
#pragma unroll
    for (int db = 0; db < DV / 32; ++db)
#pragma unroll
        for (int r = 0; r < 16; ++r) o[db][r] *= alpha;
}
template <int DK> DI void load_qfrag(bf16x8* qf, const bf16_t* qrow  , int h) {
#pragma unroll
    for (int st = 0; st < DK / 16; ++st) qf[st] = *(const bf16x8*)(qrow + 16 * st + 8 * h);
}
template <int DK, int DV> struct SweepLds { static constexpr int KB = 64 * (DK * 2 + 16), VB = 64 * (DV * 2 + FX_VPAD); };

#ifndef FX_THRL
#define FX_THRL 8.0f
#endif
template <int DV> DI void softmax_step_thr(f32x16& p0, f32x16& p1, f32x16* o, float& m, float& l) {
    const float rm = rowmax32(p0, p1);
    if (__builtin_amdgcn_ballot_w64(rm > FX_THRL) != 0ull) {
        const float dl = fmaxf(rm, 0.f);
        m += dl;
#pragma unroll
        for (int r = 0; r < 16; ++r) { p0[r] -= dl; p1[r] -= dl; }
        const float fsc = __builtin_amdgcn_exp2f(-dl); l *= fsc;
#pragma unroll
        for (int db = 0; db < DV / 32; ++db)
#pragma unroll
            for (int r = 0; r < 16; ++r) o[db][r] *= fsc;
    }
    float s0 = 0.f, s1 = 0.f, s2 = 0.f, s3 = 0.f;
#pragma unroll
    for (int r = 0; r < 16; ++r) { p0[r] = __builtin_amdgcn_exp2f(p0[r]); p1[r] = __builtin_amdgcn_exp2f(p1[r]); }
#pragma unroll
    for (int r = 0; r < 16; r += 2) { s0 += p0[r]; s1 += p0[r + 1]; s2 += p1[r]; s3 += p1[r + 1]; }
    l += (s0 + s1) + (s2 + s3);
}
template <int DV> DI void softmax_step_lazy(f32x16& p0, f32x16& p1, f32x16* o, float& m, float& l) {
    const float mx = rowmax32(p0, p1); const float mnew = fmaxf(m, mx); const float muse = (mnew == -INFINITY) ? 0.f : mnew;
    const float alpha = __builtin_amdgcn_exp2f(m - muse);
    float s0 = 0.f, s1 = 0.f, s2 = 0.f, s3 = 0.f;
#pragma unroll
    for (int r = 0; r < 16; ++r) { p0[r] = __builtin_amdgcn_exp2f(p0[r] - muse); p1[r] = __builtin_amdgcn_exp2f(p1[r] - muse); }
#pragma unroll
    for (int r = 0; r < 16; r += 2) { s0 += p0[r]; s1 += p0[r + 1]; s2 += p1[r]; s3 += p1[r + 1]; }
    l = l * alpha + ((s0 + s1) + (s2 + s3)); m = mnew;
    if (__builtin_amdgcn_ballot_w64(alpha != 1.f) != 0ull) {
#pragma unroll
        for (int db = 0; db < DV / 32; ++db)
#pragma unroll
            for (int r = 0; r < 16; ++r) o[db][r] *= alpha;
    }
}
template <int DK, int DV> struct SweepLds3 { static constexpr int KB = 64 * (DK * 2 + 16), VB = 64 * (DV * 2 + FX_VPAD), TOTAL = 2 * KB + 3 * VB; };
template <int DK, int DV, bool late, bool RING3, class It, class F> DI void flash_sweep_impl(Ctx& c, const bf16x8* qf, const bf16_t* Kg, int ldk, const bf16_t* Vg, int ldv, It it, const F& f, f32x16* o, float& m, float& l, const TileRegs<DK>* preK = nullptr, const TileRegs<DV>* preV = nullptr, int pre_t = -1) {
    typedef SweepLds3<DK, DV> L; LAS char* lds = (LAS char*)c.lds; const int lane = c.lane, tid = c.tid;
    TileRegs<DK> kA, kB; TileRegs<DV> vA, vB;
    int ta = it.next(); int tb = ta >= 0 ? it.next() : -1;
    if (ta < 0) return;
    if (preK && ta == pre_t) { kA = *preK; vA = *preV; }
    else { tile_load<DK>(kA, Kg + (size_t)ta * 64 * ldk, ldk, tid); tile_load<DV>(vA, Vg + (size_t)ta * 64 * ldv, ldv, tid); }
    if (tb >= 0) { tile_load<DK>(kB, Kg + (size_t)tb * 64 * ldk, ldk, tid); tile_load<DV>(vB, Vg + (size_t)tb * 64 * ldv, ldv, tid); }
    __syncthreads();
    tile_store<DK>(kA, lds, tid); tile_store<DV, FX_VPAD>(vA, lds + 2 * L::KB, tid);
    __syncthreads();
    int vprev = RING3 ? 2 * L::KB + 2 * L::VB : 2 * L::KB + L::VB, vcur = 2 * L::KB, vnext = 2 * L::KB + L::VB;
    f32x16 s0, s1; bool pend = false;
#pragma unroll
    for (int r = 0; r < 16; ++r) { s0[r] = 0.f; s1[r] = 0.f; }
#define FS_QK(P0_, P1_, KOFF_) do { PSW_B(20); if (c.var != 3) qk_tile<DK>(lds + (KOFF_), qf, P0_, P1_, lane, FX_T13 ? -m : 0.f); PSW_E(20); } while (0)
#define FS_SM(P0_, P1_) do { PSW_B(21); if (c.var != 2) { if (FX_T13) softmax_step_thr<DV>(P0_, P1_, o, m, l); else softmax_step_lazy<DV>(P0_, P1_, o, m, l); } PSW_E(21); } while (0)
#define FS_PV(VOFF_, P0_, P1_) do { PSW_B(22); if (c.var != 1) pv_tile<DV>(lds + (VOFF_), P0_, P1_, o, lane); PSW_E(22); } while (0)
#define FS_COMPUTE(T_, KOFF_) do { \
        if (!late) { if (!f.skip(T_)) { f32x16 p0, p1; if (c.var == 3) { p0 = s0; p1 = s1; } FS_QK(p0, p1, KOFF_); f.mask(p0, p1, T_); \
            if constexpr (DV == 64 && (DK == 96 || FX_VPRE >= 2)) { VPre vp; pv_prefetch64(lds + vcur, vp, lane); __builtin_amdgcn_sched_barrier(0); FS_SM(p0, p1); pv_tile64_pre(lds + vcur, p0, p1, o, vp, lane); } else if constexpr (DV == 128 && FX_VPRE >= 3) { VPre128 vp; pv_prefetch128(lds + vcur, vp, lane); __builtin_amdgcn_sched_barrier(0); FS_SM(p0, p1); pv_tile128_pre(lds + vcur, p0, p1, o, vp, lane); } else { FS_SM(p0, p1); FS_PV(vcur, p0, p1); } } } \
        else { if (pend) { FS_SM(s0, s1); FS_PV(vprev, s0, s1); pend = false; } \
               if (!f.skip(T_)) { FS_QK(s0, s1, KOFF_); f.mask(s0, s1, T_); pend = true; } } } while (0)
#define FS_ROTATE() do { if (RING3) { const int t_ = vprev; vprev = vcur; vcur = vnext; vnext = t_; } else { const int t_ = vcur; vcur = vnext; vnext = t_; vprev = t_; } } while (0)
    for (;;) {
        const int tc = tb >= 0 ? it.next() : -1;
        if (tc >= 0) { tile_load<DK>(kA, Kg + (size_t)tc * 64 * ldk, ldk, tid); tile_load<DV>(vA, Vg + (size_t)tc * 64 * ldv, ldv, tid); }
        FS_COMPUTE(ta, 0);
        PSW_B(23); if (tb >= 0) { tile_store<DK>(kB, lds + L::KB, tid); tile_store<DV, FX_VPAD>(vB, lds + vnext, tid); } PSW_DRAIN(); PSW_E(23);
        PSW_B(25); __syncthreads(); PSW_E(25); FS_ROTATE();
        if (tb < 0) break;
        const int td = tc >= 0 ? it.next() : -1;
        if (td >= 0) { tile_load<DK>(kB, Kg + (size_t)td * 64 * ldk, ldk, tid); tile_load<DV>(vB, Vg + (size_t)td * 64 * ldv, ldv, tid); }
        FS_COMPUTE(tb, L::KB);
        PSW_B(23); if (tc >= 0) { tile_store<DK>(kA, lds, tid); tile_store<DV, FX_VPAD>(vA, lds + vnext, tid); } PSW_DRAIN(); PSW_E(23);
        PSW_B(25); __syncthreads(); PSW_E(25); FS_ROTATE();
        if (tc < 0) break;
        ta = tc; tb = td;
    }
    if (late && pend) { FS_SM(s0, s1); FS_PV(vprev, s0, s1); }
#undef FS_COMPUTE
#undef FS_ROTATE
#undef FS_QK
#undef FS_SM
#undef FS_PV
}
template <int DK, int DV, bool STG, class It, class F> DI void flash_sweep(Ctx& c, const bf16x8* qf, const bf16_t* Kg, int ldk, const bf16_t* Vg, int ldv, It it, const F& f, f32x16* o, float& m, float& l, const TileRegs<DK>* preK = nullptr, const TileRegs<DV>* preV = nullptr, int pre_t = -1) {
#if FX_SWEEP2
    flash_sweep2<DK, DV>(c, qf, Kg, ldk, Vg, ldv, it, f, o, m, l); return;
#endif
    PSW_B(24);
    if (STG && FX_LATE(c.wave)) flash_sweep_impl<DK, DV, true, true>(c, qf, Kg, ldk, Vg, ldv, it, f, o, m, l, preK, preV, pre_t);
    else flash_sweep_impl<DK, DV, false, STG>(c, qf, Kg, ldk, Vg, ldv, it, f, o, m, l, preK, preV, pre_t);
    PSW_E(24);
}
template <int DK, int DV, class It, class F> DI void flash_sweep2(Ctx& c, const bf16x8* qf, const bf16_t* Kg, int ldk, const bf16_t* Vg, int ldv, It it, const F& f, f32x16* o, float& m, float& l) {
    constexpr int KB = 64 * (DK * 2 + 16), VB = 64 * (DV * 2 + FX_VPAD), VOFF = 4 * KB;
    LAS char* lds = (LAS char*)c.lds; const int lane = c.lane, tid = c.tid;
    TileRegs<DK> k0, k1; TileRegs<DV> v0, v1;
    int a = it.next(); if (a < 0) return; int b = it.next();
    tile_load<DK>(k0, Kg + (size_t)a * 64 * ldk, ldk, tid); tile_load<DV>(v0, Vg + (size_t)a * 64 * ldv, ldv, tid);
    if (b >= 0) { tile_load<DK>(k1, Kg + (size_t)b * 64 * ldk, ldk, tid); tile_load<DV>(v1, Vg + (size_t)b * 64 * ldv, ldv, tid); }
    __syncthreads();
    tile_store<DK>(k0, lds, tid); tile_store<DV, FX_VPAD>(v0, lds + VOFF, tid);
    if (b >= 0) { tile_store<DK>(k1, lds + KB, tid); tile_store<DV, FX_VPAD>(v1, lds + VOFF + VB, tid); }
    __syncthreads();
    int st = 0;
    for (;;) {
        const int na = b >= 0 ? it.next() : -1; const int nb = na >= 0 ? it.next() : -1;
        if (na >= 0) { tile_load<DK>(k0, Kg + (size_t)na * 64 * ldk, ldk, tid); tile_load<DV>(v0, Vg + (size_t)na * 64 * ldv, ldv, tid); }
        if (nb >= 0) { tile_load<DK>(k1, Kg + (size_t)nb * 64 * ldk, ldk, tid); tile_load<DV>(v1, Vg + (size_t)nb * 64 * ldv, ldv, tid); }
        const int ko = st * 2 * KB, vo = VOFF + st * 2 * VB;
        if (!f.skip(a)) { f32x16 p0, p1; qk_tile<DK>(lds + ko, qf, p0, p1, lane, FX_T13 ? -m : 0.f); f.mask(p0, p1, a); if (FX_T13) softmax_step_thr<DV>(p0, p1, o, m, l); else softmax_step_lazy<DV>(p0, p1, o, m, l); pv_tile<DV>(lds + vo, p0, p1, o, lane); }
        if (b >= 0 && !f.skip(b)) { f32x16 p0, p1; qk_tile<DK>(lds + ko + KB, qf, p0, p1, lane, FX_T13 ? -m : 0.f); f.mask(p0, p1, b); if (FX_T13) softmax_step_thr<DV>(p0, p1, o, m, l); else softmax_step_lazy<DV>(p0, p1, o, m, l); pv_tile<DV>(lds + vo + VB, p0, p1, o, lane); }
        const int kn = (st ^ 1) * 2 * KB, vn = VOFF + (st ^ 1) * 2 * VB;
        if (na >= 0) { tile_store<DK>(k0, lds + kn, tid); tile_store<DV, FX_VPAD>(v0, lds + vn, tid); }
        if (nb >= 0) { tile_store<DK>(k1, lds + kn + KB, tid); tile_store<DV, FX_VPAD>(v1, lds + vn + VB, tid); }
        __syncthreads();
        if (na < 0) break;
        a = na; b = nb; st ^= 1;
    }
}
struct RangeIt { int t, tend; DI int next() { return t <= tend ? t++ : -1; } };
struct BitsIt { unsigned rem; DI int next() { if (!rem) return -1; const int t = __builtin_ctz(rem); rem &= rem - 1; return t; } };
struct CausalF { int qrow, wfirst, wlast, h;
    DI bool skip(int t) const { return t > wlast; }
    DI void mask(f32x16& p0, f32x16& p1, int t) const { if (t * 64 + 63 > wfirst) {
#pragma unroll
        for (int r = 0; r < 16; ++r) { const int kv = t * 64 + crow(r, h); if (kv > qrow) p0[r] = -INFINITY; if (kv + 32 > qrow) p1[r] = -INFINITY; } } } };
template <int DK, int DV> DI void causal_sweep(Ctx& c, const bf16_t* Qg, int ldq, const bf16_t* Kg, int ldk, const bf16_t* Vg, int ldv, int q0, f32x16* o, float& lsum) {
    RELAUNDER(c);
    const int lane = c.lane, w = c.wave, r32 = lane & 31, h = lane >> 5;
    const int qrow = q0 + 32 * w + r32;
    bf16x8 qf[DK / 16]; load_qfrag<DK>(qf, Qg + (unsigned)qrow * (unsigned)ldq, h);
#pragma unroll
    for (int db = 0; db < DV / 32; ++db)
#pragma unroll
        for (int r = 0; r < 16; ++r) o[db][r] = 0.f;
    float m = FX_T13 ? 0.f : -INFINITY, l = 0.f;
    RangeIt it{0, (q0 >> 6) + 3}; CausalF f{qrow, q0 + 32 * w, (q0 + 32 * w + 31) >> 6, h};
    flash_sweep<DK, DV, (DV == 64) && FX_STG>(c, qf, Kg, ldk, Vg, ldv, it, f, o, m, l);
    lsum = sum32(l);
}
template <int DV> DI void store_o(const f32x16* o, float scale, bf16_t* rowp, int h) {
#pragma unroll
    for (int db = 0; db < DV / 32; ++db)
#pragma unroll
        for (int k = 0; k < 4; ++k) { u32x2 v; v.x = cvtpk(o[db][4 * k] * scale, o[db][4 * k + 1] * scale); v.y = cvtpk(o[db][4 * k + 2] * scale, o[db][4 * k + 3] * scale);
            *(u32x2*)(rowp + 32 * db + 8 * k + 4 * h) = v; }
}

DI void mla_unit(Ctx& c, const bf16_t* QL, const bf16_t* KF, const bf16_t* KVU, bf16_t* YC, int b, int hd, int qt) {
    RELAUNDER(c);
    const int q0 = qt * 256; f32x16 o[2]; float l;
    const size_t rb = (size_t)b * S;
    causal_sweep<96, 64>(c, QL + rb * UPW + 96 * hd, UPW, KF + rb * 768 + 96 * hd, 768, KVU + rb * UPW + 128 * hd + 64, UPW, q0, o, l);
    const int qrow = q0 + 32 * c.wave + (c.lane & 31);
    store_o<64>(o, 1.f / l, YC + (rb + qrow) * 1024 + 64 * hd, c.lane >> 5);
}
DI void diff_unit(Ctx& c, const bf16_t* QKV, bf16_t* ON, int b, int hd, int qt, int j, int layer) {
    RELAUNDER(c);
    CArgs& a = *c.a; const int q0 = qt * 256, lane = c.lane, h = lane >> 5; const size_t rb = (size_t)b * S;
    const bf16_t* base = QKV + rb * 3072;
#if FX_DIFFPARK
    static_assert(!FX_STG, "the park slab sits where the third V slot of a staggered sweep would be");
    LAS unsigned* park = (LAS unsigned*)(c.lds + 2 * 64 * (64 * 2 + 16) + 2 * 64 * (128 * 2 + FX_VPAD) + c.wave * 8192) + lane;
    f32x16 o1[4]; float l1, l2;
    causal_sweep<64, 128>(c, base + 128 * hd, 3072, base + 1024 + 128 * hd, 3072, base + 2048 + 128 * hd, 3072, q0, o1, l1);
    { const float i1_ = 1.f / l1;
#pragma unroll
      for (int db = 0; db < 4; ++db)
#pragma unroll
          for (int r = 0; r < 8; ++r) park[(db * 8 + r) * 64] = cvtpk(o1[db][2 * r] * i1_, o1[db][2 * r + 1] * i1_); }
    f32x16 o2[4];
    causal_sweep<64, 128>(c, base + 128 * hd + 64, 3072, base + 1024 + 128 * hd + 64, 3072, base + 2048 + 128 * hd, 3072, q0, o2, l2);
#pragma unroll
    for (int db = 0; db < 4; ++db)
#pragma unroll
        for (int r = 0; r < 8; ++r) { const unsigned w = park[(db * 8 + r) * 64]; o1[db][2 * r] = bflo(w); o1[db][2 * r + 1] = bfhi(w); }
#else
    f32x16 o1[4], o2[4]; float l1, l2;
    causal_sweep<64, 128>(c, base + 128 * hd, 3072, base + 1024 + 128 * hd, 3072, base + 2048 + 128 * hd, 3072, q0, o1, l1);
    { const float i1_ = 1.f / l1;
#pragma unroll
      for (int db = 0; db < 4; ++db)
#pragma unroll
          for (int r = 0; r < 16; ++r) o1[db][r] *= i1_; }
    causal_sweep<64, 128>(c, base + 128 * hd + 64, 3072, base + 1024 + 128 * hd + 64, 3072, base + 2048 + 128 * hd, 3072, q0, o2, l2);
#endif
    const float* lam = a.in[26] + j * 256; float s1 = lam[lane] * lam[64 + lane], s2 = lam[128 + lane] * lam[192 + lane];
    s1 = wave_sum(s1); s2 = wave_sum(s2);
    const float lam_init = 0.8f - 0.6f * __expf(-0.3f * (float)layer); const float lmb = __expf(s1) - __expf(s2) + lam_init;
    const float i2 = lmb / l2; float ss = 0.f;
#pragma unroll
    for (int db = 0; db < 4; ++db)
#pragma unroll
        for (int r = 0; r < 16; ++r) { const float v = o1[db][r] - o2[db][r] * i2; o1[db][r] = v; ss += v * v; }
    ss = sum32(ss);
    const float rs = rsqrtf(ss * (1.f / 128.f) + EPS) * (1.f - lam_init);
    const float* sg = a.in[27] + j * 128;
#pragma unroll
    for (int db = 0; db < 4; ++db)
#pragma unroll
        for (int r = 0; r < 16; ++r) o1[db][r] *= rs * sg[32 * db + crow(r, h)];
    const int qrow = q0 + 32 * c.wave + (lane & 31);
    store_o<128>(o1, 1.f, ON + (rb + qrow) * 1024 + 128 * hd, h);
}

#ifndef FX_NSAPRE
#define FX_NSAPRE 2
#endif
DI void nsa_unit(Ctx& c, const bf16_t* U, bf16_t* YC, int b, int g, int qt) {
    RELAUNDER(c);
    CArgs& a = *c.a; LAS char* lds = (LAS char*)c.lds; typedef SweepLds<64, 64> L;
    const int lane = c.lane, w = c.wave, tid = c.tid, r32 = lane & 31, h = lane >> 5;
    const int hg = w & 3, qsub = w >> 2, head = g * 4 + hg, q0 = qt * 64, jt = qt;
    const int qrow = q0 + 32 * qsub + r32; const size_t rb = (size_t)b * S; const size_t m = rb + qrow;
    LAS float* imp = (LAS float*)(lds + 8 * L::KB);
    LAS unsigned* selw = (LAS unsigned*)(lds + 8 * L::KB + 4 * 64 * 33 * 4);
    bf16x8 qf[4]; load_qfrag<64>(qf, U + m * UW + 544 + 64 * head, h);
    const bf16_t* urow = U + m * UW + 1824;
#ifdef NSA_ONLY
    const float g0 = NSA_ONLY == 0 ? 1.f : 0.f, g1 = NSA_ONLY == 1 ? 1.f : 0.f, g2 = NSA_ONLY == 2 ? 1.f : 0.f; (void)urow;
#else
    const bf16_t gr0 = urow[head], gr1 = urow[8 + head], gr2 = urow[16 + head];
#endif
    unsigned accp[2][8];
    const int bg = b * 2 + g;
    const bf16_t* KC = (const bf16_t*)(c.ws + WS_MISC + 65536) + (size_t)bg * 128 * 64; const bf16_t* VC = (const bf16_t*)(c.ws + WS_MISC + 65536 + 262144) + (size_t)bg * 128 * 64;
    TileRegs<64> sk0, sv0, wk0, wv0; const int wt0 = jt - 8 > 0 ? jt - 8 : 0; (void)wt0;
    __syncthreads();
    PSEC_B(1);
    PSEC_B(5);
    { TileRegs<64> k0, k1, v0, v1; tile_load<64>(k0, KC, 64, tid); tile_load<64>(k1, KC + 64 * 64, 64, tid); tile_load<64>(v0, VC, 64, tid); tile_load<64>(v1, VC + 64 * 64, 64, tid);
#if FX_NSAPRE >= 1
      tile_load<64>(sk0, U + rb * UW + 1312 + 64 * g, UW, tid); tile_load<64>(sv0, U + rb * UW + 1440 + 64 * g, UW, tid);
#endif
#if FX_NSAPRE >= 2
      tile_load<64>(wk0, U + (rb + (size_t)wt0 * 64) * UW + 1568 + 64 * g, UW, tid); tile_load<64>(wv0, U + (rb + (size_t)wt0 * 64) * UW + 1696 + 64 * g, UW, tid);
#endif
      tile_store<64>(k0, lds, tid); tile_store<64>(k1, lds + L::KB, tid); tile_store<64, FX_VPAD>(v0, lds + 2 * L::KB, tid); tile_store<64, FX_VPAD>(v1, lds + 2 * L::KB + L::VB, tid); }
    __syncthreads();
#ifndef NSA_ONLY
    const float g0 = 1.f / (1.f + __expf(-bf2f(gr0))), g1 = 1.f / (1.f + __expf(-bf2f(gr1))), g2 = 1.f / (1.f + __expf(-bf2f(gr2)));
#endif
    PSEC_E(5); PSEC_B(6);
    {
        f32x16 p0, p1, p2, p3; qk_tile<64>(lds, qf, p0, p1, lane); qk_tile<64>(lds + L::KB, qf, p2, p3, lane);
        const int hi = qrow < 31 ? -1 : (qrow - 31) >> 4;
#pragma unroll
        for (int r = 0; r < 16; ++r) { const int cidx = crow(r, h); if (cidx > hi) p0[r] = -INFINITY; if (cidx + 32 > hi) p1[r] = -INFINITY; if (cidx + 64 > hi) p2[r] = -INFINITY; if (cidx + 96 > hi) p3[r] = -INFINITY; }
        float mx = fmaxf(rowmax32(p0, p1), rowmax32(p2, p3)); const float muse = (mx == -INFINITY) ? 0.f : mx; float s = 0.f;
#pragma unroll
        for (int r = 0; r < 16; ++r) { p0[r] = __builtin_amdgcn_exp2f(p0[r] - muse); p1[r] = __builtin_amdgcn_exp2f(p1[r] - muse); p2[r] = __builtin_amdgcn_exp2f(p2[r] - muse); p3[r] = __builtin_amdgcn_exp2f(p3[r] - muse); s += (p0[r] + p1[r]) + (p2[r] + p3[r]); }
        s = sum32(s); const float inv = s > 0.f ? 1.f / s : 0.f;
#pragma unroll
        for (int r = 0; r < 16; ++r) { p0[r] *= inv; p1[r] *= inv; p2[r] *= inv; p3[r] *= inv; }
        LAS float* ir = imp + hg * (64 * 33) + (32 * qsub + r32) * 33;
        float eo[4][4];
#define EDGE_X(P, PI) _Pragma("unroll") for (int k = 0; k < 4; ++k) { unsigned ua = __builtin_bit_cast(unsigned, P[4 * k + 3]), ub = ua; xchg32(ua, ub); eo[PI][k] = __builtin_bit_cast(float, h ? ua : ub); }
        EDGE_X(p0, 0) EDGE_X(p1, 1) EDGE_X(p2, 2) EDGE_X(p3, 3)
#undef EDGE_X
#define IMP_ST(P, PI) _Pragma("unroll") for (int k = 0; k < 4; ++k) { const float s4 = (P[4 * k] + P[4 * k + 1]) + (P[4 * k + 2] + P[4 * k + 3]); \
            const float prev0 = k >= 1 ? eo[PI][k >= 1 ? k - 1 : 0] : ((PI) >= 1 ? eo[(PI) >= 1 ? (PI) - 1 : 0][3] : 0.f); ir[8 * (PI) + 2 * k + h] = s4 + (h ? eo[PI][k] : prev0); }
        IMP_ST(p0, 0) IMP_ST(p1, 1) IMP_ST(p2, 2) IMP_ST(p3, 3)
#undef IMP_ST
        PSEC_E(7); PSEC_B(8);
        f32x16 oc[2];
#pragma unroll
        for (int db = 0; db < 2; ++db)
#pragma unroll
            for (int r = 0; r < 16; ++r) oc[db][r] = 0.f;
        pv_tile<64>(lds + 2 * L::KB, p0, p1, oc, lane); pv_tile<64>(lds + 2 * L::KB + L::VB, p2, p3, oc, lane);
#pragma unroll
        for (int db = 0; db < 2; ++db)
#pragma unroll
            for (int r = 0; r < 8; ++r) accp[db][r] = cvtpk(g0 * oc[db][2 * r], g0 * oc[db][2 * r + 1]);
    }
    __syncthreads();
    PSEC_E(8); PSEC_E(1); PSEC_B(2);
    LAS float* vsl = (LAS float*)(lds + 8 * L::KB + 4 * 64 * 33 * 4 + 256);
    if (jt < 16) {
        if (tid < 64) selw[tid] = (jt >= 31) ? 0xffffffffu : ((2u << jt) - 1u);
        __syncthreads();
    } else {
#pragma unroll 1
    for (int i = 0; i < 4; ++i) { const int id = tid + NT * i, qq = id >> 5, jb = id & 31;
        const bool allowed = jb <= jt, forced = allowed && (jb == 0 || jb >= jt - 1);
        const float iv = (imp[qq * 33 + jb] + imp[64 * 33 + qq * 33 + jb]) + (imp[2 * 64 * 33 + qq * 33 + jb] + imp[3 * 64 * 33 + qq * 33 + jb]);
        vsl[id] = forced ? 1e9f : (allowed ? iv : -1e30f); }
    __syncthreads();
#pragma unroll 1
    for (int i = 0; i < 4; ++i) { const int id = tid + NT * i, qq = id >> 5, jb = id & 31;
        const float v = vsl[id]; int rank = 0;
#pragma unroll
        for (int k4 = 0; k4 < 8; ++k4) { const f32x4 w = *(const LAS f32x4*)(vsl + qq * 32 + 4 * k4);
            rank += (w.x > v || (w.x == v && 4 * k4 + 0 < jb)) ? 1 : 0; rank += (w.y > v || (w.y == v && 4 * k4 + 1 < jb)) ? 1 : 0;
            rank += (w.z > v || (w.z == v && 4 * k4 + 2 < jb)) ? 1 : 0; rank += (w.w > v || (w.w == v && 4 * k4 + 3 < jb)) ? 1 : 0; }
        const unsigned long long bal = __ballot(jb <= jt && rank < 16);
        if (jb == 0) selw[qq] = (unsigned)(bal >> (lane & 32)); }
    __syncthreads();
    }
    const unsigned mysel = selw[32 * qsub + r32];
    unsigned uni = selw[lane];
    uni |= swzu<1>(uni); uni |= swzu<2>(uni); uni |= swzu<4>(uni); uni |= swzu<8>(uni); uni |= swzu<16>(uni); uni = or32(uni);
    uni = __builtin_amdgcn_readfirstlane(uni);
    PSEC_E(2); PSEC_B(3);
    {
        struct SlcF { unsigned mysel; int qrow, h, jt; DI bool skip(int) const { return false; }
            DI void mask(f32x16& p0, f32x16& p1, int t) const { const float bias = ((mysel >> t) & 1u) ? 0.f : -INFINITY;
#pragma unroll
                for (int r = 0; r < 16; ++r) { p0[r] += bias; p1[r] += bias; }
                if (t == jt) {
#pragma unroll
                    for (int r = 0; r < 16; ++r) { const int kv = t * 64 + crow(r, h); if (kv > qrow) p0[r] = -INFINITY; if (kv + 32 > qrow) p1[r] = -INFINITY; } } } };
        f32x16 o[2];
#pragma unroll
        for (int db = 0; db < 2; ++db)
#pragma unroll
            for (int r = 0; r < 16; ++r) o[db][r] = 0.f;
        float mm = FX_T13 ? 0.f : -INFINITY, l = 0.f;
        flash_sweep<64, 64, FX_STG>(c, qf, U + rb * UW + 1312 + 64 * g, UW, U + rb * UW + 1440 + 64 * g, UW, BitsIt{uni}, SlcF{mysel, qrow, h, jt}, o, mm, l, FX_NSAPRE >= 1 ? &sk0 : nullptr, &sv0, 0);
        l = sum32(l); const float sc = g1 / l;
#pragma unroll
        for (int db = 0; db < 2; ++db)
#pragma unroll
            for (int r = 0; r < 8; ++r) accp[db][r] = cvtpk(bflo(accp[db][r]) + sc * o[db][2 * r], bfhi(accp[db][r]) + sc * o[db][2 * r + 1]);
    }
    PSEC_E(3); PSEC_B(4);
    {
        struct WinF { int qrow, h, jt; DI bool skip(int) const { return false; }
            DI void mask(f32x16& p0, f32x16& p1, int t) const { if (t == jt || t == jt - 8) {
#pragma unroll
                for (int r = 0; r < 16; ++r) { const int kv = t * 64 + crow(r, h); if (kv > qrow || kv <= qrow - 512) p0[r] = -INFINITY; if (kv + 32 > qrow || kv + 32 <= qrow - 512) p1[r] = -INFINITY; } } } };
        f32x16 o[2];
#pragma unroll
        for (int db = 0; db < 2; ++db)
#pragma unroll
            for (int r = 0; r < 16; ++r) o[db][r] = 0.f;
        float mm = FX_T13 ? 0.f : -INFINITY, l = 0.f;
        flash_sweep<64, 64, FX_STG>(c, qf, U + rb * UW + 1568 + 64 * g, UW, U + rb * UW + 1696 + 64 * g, UW, RangeIt{jt - 8 > 0 ? jt - 8 : 0, jt}, WinF{qrow, h, jt}, o, mm, l, FX_NSAPRE >= 2 ? &wk0 : nullptr, &wv0, wt0);
        l = sum32(l); const float sc = g2 / l;
#pragma unroll
        for (int db = 0; db < 2; ++db)
#pragma unroll
            for (int r = 0; r < 8; ++r) accp[db][r] = cvtpk(bflo(accp[db][r]) + sc * o[db][2 * r], bfhi(accp[db][r]) + sc * o[db][2 * r + 1]);
    }
    PSEC_E(4);
    { bf16_t* rowp = YC + m * 1024 + 512 + 64 * head;
#pragma unroll
      for (int db = 0; db < 2; ++db)
#pragma unroll
          for (int k = 0; k < 4; ++k) { u32x2 v; v.x = accp[db][2 * k]; v.y = accp[db][2 * k + 1]; *(u32x2*)(rowp + 32 * db + 8 * k + 4 * h) = v; } }
}
}
#ifndef FX_MODE
#define FX_MODE 0
#endif
#ifndef FX_RSLDS
#define FX_RSLDS 1
#endif
#ifndef FX_NTSTORE
#define FX_NTSTORE 0
#endif
namespace fx {
template <int ACT  > struct EpiB16 {
    static constexpr bool PERM = true, AFTER_DRAIN = false;
    bf16_t* O; int ldc; const float* ss; const float* shw; const LAS float* rsl; int pm0, pm1, pm2;
    __device__ __forceinline__ void operator()(const pg8::f32x4 (&acc)[2][2][4][2], const pg8::Unit& u, int wr, int wc, int fr, int fq) const {
        const int row0 = u.pm * 256 + wr * 64 + fr, col0 = u.pn * 256 + wc * 32 + 8 * fq;
        const bool FUSED = ss != nullptr; pg8::f32x4 sv[2][2];
        if (FUSED) { const float* sp = shw + (size_t)(u.pm >> 3) * 4096 + col0;
#pragma unroll
            for (int bj = 0; bj < 2; ++bj) { sv[bj][0] = *(const pg8::f32x4*)(sp + bj * 128); sv[bj][1] = *(const pg8::f32x4*)(sp + bj * 128 + 4); } }
#pragma unroll
        for (int ai = 0; ai < 2; ++ai)
#pragma unroll
            for (int m = 0; m < 4; ++m) { const int row = row0 + ai * 128 + m * 16; bf16_t* rowp = O + (size_t)row * ldc + col0;
                float rs = 1.f; if (FUSED && rsl) { const int slot = u.pm == pm0 ? 0 : (u.pm == pm1 ? 1 : (u.pm == pm2 ? 2 : 3)); rs = rsl[slot * 256 + wr * 64 + fr + ai * 128 + m * 16]; }
                else if (FUSED) { const pg8::f32x4* sp4 = (const pg8::f32x4*)(ss + (size_t)row * 16); const pg8::f32x4 a0 = sp4[0], a1 = sp4[1], a2 = sp4[2], a3 = sp4[3];
                    const float tot = (((a0[0] + a0[1]) + (a0[2] + a0[3])) + ((a1[0] + a1[1]) + (a1[2] + a1[3]))) + (((a2[0] + a2[1]) + (a2[2] + a2[3])) + ((a3[0] + a3[1]) + (a3[2] + a3[3]))); rs = rsqrtf(tot * (1.f / 1024.f) + EPS); }
#pragma unroll
                for (int bj = 0; bj < 2; ++bj) { pg8::f32x4 v0 = acc[ai][bj][m][0], v1 = acc[ai][bj][m][1];
                    if (FUSED) { v0 = v0 * rs + sv[bj][0]; v1 = v1 * rs + sv[bj][1]; }
                    if (ACT == 1) {
#pragma unroll
                        for (int e = 0; e < 4; ++e) { float a = v0[e] > 0.f ? v0[e] : 0.f; v0[e] = a * a; float b = v1[e] > 0.f ? v1[e] : 0.f; v1[e] = b * b; } }
                    u32x4 w; w.x = pg8::cvt_pk_bf16(v0[0], v0[1]); w.y = pg8::cvt_pk_bf16(v0[2], v0[3]); w.z = pg8::cvt_pk_bf16(v1[0], v1[1]); w.w = pg8::cvt_pk_bf16(v1[2], v1[3]);
                    if (FX_NTSTORE) __builtin_nontemporal_store(w, (u32x4*)(rowp + bj * 128)); else *(u32x4*)(rowp + bj * 128) = w; } }
    }
};
struct UpOrder : pg8::StaticOrder {
    __device__ bool next(int i, pg8::Unit& u) const { if (!pg8::StaticOrder::next(i, u)) return false; u.aoff = u.pn >= 3 ? 256 : 0; return true; }
};
#ifndef FX_M1STAG
#define FX_M1STAG 0
#endif
#ifndef FX_M1GROUPS
#define FX_M1GROUPS 2
#endif
#ifndef FX_O1STAG
#define FX_O1STAG 0
#endif
#ifndef FX_E1STAG
#define FX_E1STAG 0
#endif
#define FX_STAGGER(SL_) do { if ((SL_) > 0) { int grp_ = (c.bid >> 3) & (FX_M1GROUPS - 1); asm volatile("" : "+s"(grp_)); for (int d_ = 0; d_ < grp_; ++d_) __builtin_amdgcn_s_sleep(SL_); } } while (0)
#ifndef FX_NSAQ
#define FX_NSAQ 0
#endif
#ifndef FX_INKINIT
#define FX_INKINIT 1
#endif
#ifndef FX_RESPF
#define FX_RESPF 4
#endif
#if FX_RESPF > 0
struct EpiResid {
    static constexpr bool PERM = true, AFTER_DRAIN = false;
    const float* base32; const bf16_t* base16; float* out32; bf16_t* out16; const float* gate; bf16_t* xa; const float* ngain; const float* nsc; float* ss;
    __device__ __forceinline__ void operator()(const pg8::f32x4 (&acc)[2][2][4][2], const pg8::Unit& u, int wr, int wc, int fr, int fq) const {
        const int row0 = u.pm * 256 + wr * 64 + fr, col0 = u.pn * 256 + wc * 32 + 8 * fq; const int b = u.pm >> 3; const float* gp = gate + (size_t)b * 6144 + col0;
        u32x4 bw[FX_RESPF][2];
        if (!base32) {
#pragma unroll
            for (int s_ = 0; s_ < FX_RESPF; ++s_)
#pragma unroll
                for (int bj = 0; bj < 2; ++bj) bw[s_][bj] = *(const u32x4*)(base16 + (size_t)(row0 + (s_ >> 2) * 128 + (s_ & 3) * 16) * 1024 + col0 + bj * 128); }
        pg8::f32x4 gv[2][2], av[2][2];
#pragma unroll
        for (int bj = 0; bj < 2; ++bj)
#pragma unroll
            for (int n = 0; n < 2; ++n) { gv[bj][n] = *(const pg8::f32x4*)(gp + bj * 128 + n * 4);
                if (xa) { const pg8::f32x4 g = *(const pg8::f32x4*)(ngain + col0 + bj * 128 + n * 4), sc = *(const pg8::f32x4*)(nsc + (size_t)b * 6144 + col0 + bj * 128 + n * 4); av[bj][n] = g * (sc + 1.f); } }
#pragma unroll
        for (int it = 0; it < 8; ++it) { const int ai = it >> 2, m = it & 3; const int row = row0 + ai * 128 + m * 16; const size_t off = (size_t)row * 1024 + col0; float sq = 0.f;
                pg8::f32x4 xn[2][2];
#pragma unroll
                for (int bj = 0; bj < 2; ++bj) {
                    if (base32) { xn[bj][0] = *(const pg8::f32x4*)(base32 + off + bj * 128); xn[bj][1] = *(const pg8::f32x4*)(base32 + off + bj * 128 + 4); }
                    else { const u32x4 w_ = bw[it % FX_RESPF][bj]; xn[bj][0] = (pg8::f32x4){bflo(w_.x), bfhi(w_.x), bflo(w_.y), bfhi(w_.y)}; xn[bj][1] = (pg8::f32x4){bflo(w_.z), bfhi(w_.z), bflo(w_.w), bfhi(w_.w)}; }
                    xn[bj][0] = xn[bj][0] + gv[bj][0] * acc[ai][bj][m][0]; xn[bj][1] = xn[bj][1] + gv[bj][1] * acc[ai][bj][m][1]; }
                if (!base32 && it + FX_RESPF < 8) { const int i2 = it + FX_RESPF;
#pragma unroll
                    for (int bj = 0; bj < 2; ++bj) bw[it % FX_RESPF][bj] = *(const u32x4*)(base16 + (size_t)(row0 + (i2 >> 2) * 128 + (i2 & 3) * 16) * 1024 + col0 + bj * 128); }
#pragma unroll
                for (int bj = 0; bj < 2; ++bj) {
                    if (out32) { *(pg8::f32x4*)(out32 + off + bj * 128) = xn[bj][0]; *(pg8::f32x4*)(out32 + off + bj * 128 + 4) = xn[bj][1]; }
                    else { u32x4 w; w.x = pg8::cvt_pk_bf16(xn[bj][0][0], xn[bj][0][1]); w.y = pg8::cvt_pk_bf16(xn[bj][0][2], xn[bj][0][3]); w.z = pg8::cvt_pk_bf16(xn[bj][1][0], xn[bj][1][1]); w.w = pg8::cvt_pk_bf16(xn[bj][1][2], xn[bj][1][3]); *(u32x4*)(out16 + off + bj * 128) = w; }
                    if (xa) { sq += ((xn[bj][0][0] * xn[bj][0][0] + xn[bj][0][1] * xn[bj][0][1]) + (xn[bj][0][2] * xn[bj][0][2] + xn[bj][0][3] * xn[bj][0][3])) + ((xn[bj][1][0] * xn[bj][1][0] + xn[bj][1][1] * xn[bj][1][1]) + (xn[bj][1][2] * xn[bj][1][2] + xn[bj][1][3] * xn[bj][1][3]));
                        const pg8::f32x4 y0 = xn[bj][0] * av[bj][0], y1 = xn[bj][1] * av[bj][1];
                        u32x4 w; w.x = pg8::cvt_pk_bf16(y0[0], y0[1]); w.y = pg8::cvt_pk_bf16(y0[2], y0[3]); w.z = pg8::cvt_pk_bf16(y1[0], y1[1]); w.w = pg8::cvt_pk_bf16(y1[2], y1[3]);
                        *(u32x4*)(xa + off + bj * 128) = w; } }
                if (xa) { sq += swz<16>(sq); sq = sum32(sq); if (fq == 0) ss[(size_t)row * 16 + u.pn * 4 + wc] = sq; } }
    }
};
#else
struct EpiResid {
    static constexpr bool PERM = true, AFTER_DRAIN = false;
    const float* base32; const bf16_t* base16; float* out32; bf16_t* out16; const float* gate; bf16_t* xa; const float* ngain; const float* nsc; float* ss;
    __device__ __forceinline__ void operator()(const pg8::f32x4 (&acc)[2][2][4][2], const pg8::Unit& u, int wr, int wc, int fr, int fq) const {
        const int row0 = u.pm * 256 + wr * 64 + fr, col0 = u.pn * 256 + wc * 32 + 8 * fq; const int b = u.pm >> 3; const float* gp = gate + (size_t)b * 6144 + col0;
        pg8::f32x4 gv[2][2], av[2][2];
#pragma unroll
        for (int bj = 0; bj < 2; ++bj)
#pragma unroll
            for (int n = 0; n < 2; ++n) { gv[bj][n] = *(const pg8::f32x4*)(gp + bj * 128 + n * 4);
                if (xa) { const pg8::f32x4 g = *(const pg8::f32x4*)(ngain + col0 + bj * 128 + n * 4), sc = *(const pg8::f32x4*)(nsc + (size_t)b * 6144 + col0 + bj * 128 + n * 4); av[bj][n] = g * (sc + 1.f); } }
#pragma unroll
        for (int ai = 0; ai < 2; ++ai)
#pragma unroll
            for (int m = 0; m < 4; ++m) { const int row = row0 + ai * 128 + m * 16; const size_t off = (size_t)row * 1024 + col0; float sq = 0.f;
#pragma unroll
                for (int bj = 0; bj < 2; ++bj) { pg8::f32x4 xn[2];
                    if (base32) { xn[0] = *(const pg8::f32x4*)(base32 + off + bj * 128); xn[1] = *(const pg8::f32x4*)(base32 + off + bj * 128 + 4); }
                    else { const u32x4 bw = *(const u32x4*)(base16 + off + bj * 128); xn[0] = (pg8::f32x4){bflo(bw.x), bfhi(bw.x), bflo(bw.y), bfhi(bw.y)}; xn[1] = (pg8::f32x4){bflo(bw.z), bfhi(bw.z), bflo(bw.w), bfhi(bw.w)}; }
                    xn[0] = xn[0] + gv[bj][0] * acc[ai][bj][m][0]; xn[1] = xn[1] + gv[bj][1] * acc[ai][bj][m][1];
                    if (out32) { *(pg8::f32x4*)(out32 + off + bj * 128) = xn[0]; *(pg8::f32x4*)(out32 + off + bj * 128 + 4) = xn[1]; }
                    else { u32x4 w; w.x = pg8::cvt_pk_bf16(xn[0][0], xn[0][1]); w.y = pg8::cvt_pk_bf16(xn[0][2], xn[0][3]); w.z = pg8::cvt_pk_bf16(xn[1][0], xn[1][1]); w.w = pg8::cvt_pk_bf16(xn[1][2], xn[1][3]); *(u32x4*)(out16 + off + bj * 128) = w; }
                    if (xa) { sq += ((xn[0][0] * xn[0][0] + xn[0][1] * xn[0][1]) + (xn[0][2] * xn[0][2] + xn[0][3] * xn[0][3])) + ((xn[1][0] * xn[1][0] + xn[1][1] * xn[1][1]) + (xn[1][2] * xn[1][2] + xn[1][3] * xn[1][3]));
                        const pg8::f32x4 y0 = xn[0] * av[bj][0], y1 = xn[1] * av[bj][1];
                        u32x4 w; w.x = pg8::cvt_pk_bf16(y0[0], y0[1]); w.y = pg8::cvt_pk_bf16(y0[2], y0[3]); w.z = pg8::cvt_pk_bf16(y1[0], y1[1]); w.w = pg8::cvt_pk_bf16(y1[2], y1[3]);
                        *(u32x4*)(xa + off + bj * 128) = w; } }
                if (xa) { sq += swz<16>(sq); sq = sum32(sq); if (fq == 0) ss[(size_t)row * 16 + u.pn * 4 + wc] = sq; } }
    }
};
#endif

DI bool static_unit(int nM, int nN, int G, int c, int i, int& pm, int& pn) {
    const int nwg = nM * nN; const long L = (long)i * G + c; if (L >= nwg) return false;
    int wgid = (int)L; { const int q = nwg / pg8::NXCD, r = nwg % pg8::NXCD, xcd = wgid % pg8::NXCD, off = wgid / pg8::NXCD; wgid = (xcd < r ? xcd * (q + 1) : r * (q + 1) + (xcd - r) * q) + off; }
    const int nig = pg8::WGM * nN, gid = wgid / nig, fm = gid * pg8::WGM, gsz = (nM - fm) < pg8::WGM ? (nM - fm) : pg8::WGM;
    pm = fm + ((wgid % nig) % gsz); pn = (wgid % nig) / gsz; return true;
}
DI void rs_prepass(Ctx& c, const float* ss, int nM, int nN, LAS float* rsl, int (&pmv)[4]) {
#pragma unroll
    for (int i = 0; i < 4; ++i) { int pm_ = -1, pn_ = 0; if (!static_unit(nM, nN, c.G, c.bid, i, pm_, pn_)) pm_ = -1; pmv[i] = pm_; }
#pragma unroll
    for (int i2 = 0; i2 < 4; i2 += 2) { const int i = i2 + (c.tid >> 8), pm_ = (c.tid >> 8) ? pmv[i2 + 1] : pmv[i2];
        if (pm_ >= 0) { const int row = pm_ * 256 + (c.tid & 255); const pg8::f32x4* sp4 = (const pg8::f32x4*)(ss + (size_t)row * 16); const pg8::f32x4 a0 = sp4[0], a1 = sp4[1], a2 = sp4[2], a3 = sp4[3];
            const float tot = (((a0[0] + a0[1]) + (a0[2] + a0[3])) + ((a1[0] + a1[1]) + (a1[2] + a1[3]))) + (((a2[0] + a2[1]) + (a2[2] + a2[3])) + ((a3[0] + a3[1]) + (a3[2] + a3[3])));
            rsl[i * 256 + (c.tid & 255)] = rsqrtf(tot * (1.f / 1024.f) + EPS); } }
    __syncthreads();
}
#ifndef FX_XCDSWZ
#define FX_XCDSWZ 1
#endif
#ifndef FX_REPEAT_KIND
#define FX_REPEAT_KIND 0
#endif
#ifndef FX_VAR
#define FX_VAR 0
#endif
#define DUMMY_OUT ((float*)(ws + 344 * MiB))
#define DUMMY_XB ((bf16_t*)(ws + 344 * MiB))
__global__ void __launch_bounds__(NT, 2) mega(Args args) {
    extern __shared__ __attribute__((aligned(16))) unsigned char lds_raw[];
    Ctx c; c.lds = (LAS unsigned char*)lds_raw; c.tid = threadIdx.x; c.lane = c.tid & 63; c.wave = __builtin_amdgcn_readfirstlane(c.tid >> 6); c.G = gridDim.x; c.bid = blockIdx.x; c.a = nullptr; c.var = 0; c.pr_acc = 0u; c.pr_t = 0ull; (void)args;
#define KARGS() ({ CArgs* p_ = (CArgs*)__builtin_amdgcn_kernarg_segment_ptr(); asm volatile("" : "+s"(p_)); p_; })
    CArgs* pa0 = KARGS();
    volatile LAS unsigned* MISC = (volatile LAS unsigned*)(c.lds + LDS_MISC);
    for (int i = c.tid; i < 64; i += NT) MISC[i] = 0u;
    __syncthreads();
#if FX_INKINIT && FX_MODE == 0
    XcdBarrier bar; bar.bar = (unsigned*)(pa0->ws + WS_CTL) + 4096; bar.x = xb_xcc_id(); bar.st = MISC + 8;
    if (blockIdx.x == 0) for (int i = threadIdx.x; i < 4096; i += NT) bar.bar[i] = 0u;
#else
    XcdBarrier bar = xcd_barrier_post((unsigned*)(pa0->ws + WS_CTL) + 4096, MISC + 8);
#endif
    int ph = 0;
#ifdef PROBE_PHASE
    unsigned long long pr_t0 = 0ull; unsigned pr_dt = 0u;
    pr_t0 = __builtin_amdgcn_s_memrealtime();
#endif
#if FX_MODE == 0
    constexpr int lo = 0, hi = 26;
#else
    const int lo = pa0->ph_lo, hi = pa0->ph_hi;
#endif
#define SEAM() do { if (ph + 1 < hi) { xcd_barrier(bar); if (FX_REPEAT_KIND == 12) xcd_barrier(bar); } } while (0)
#ifdef PROBE_PHASE
#define PROBE_T0() do { if (ph == PROBE_PHASE) pr_t0 = __builtin_amdgcn_s_memrealtime(); } while (0)
#ifndef PROBE_WORK
#define PROBE_WORK 0
#endif
#define PROBE_T1() do { if (!PROBE_WORK && ph == PROBE_PHASE) pr_dt = (unsigned)(__builtin_amdgcn_s_memrealtime() - pr_t0); } while (0)
#define PROBE_T1W() do { if (PROBE_WORK && ph == PROBE_PHASE) { __syncthreads(); pr_dt = (unsigned)(__builtin_amdgcn_s_memrealtime() - pr_t0); } } while (0)
#else
#define PROBE_T1W() do {} while (0)
#define PROBE_T0() do {} while (0)
#define PROBE_T1() do {} while (0)
#endif
#define PHASE_BEGIN if (ph >= lo && ph < hi) { PROBE_T0(); CArgs* pa = KARGS(); c.a = pa; unsigned char* ws = pa->ws; c.ws = ws; RELAUNDER(c); const int gw = c.bid * NW + c.wave, NGW = c.G * NW; (void)gw; (void)NGW; \
    const float* MOD = (const float*)(ws + WS_MOD); const float* mod = MOD + (size_t)layer * 8 * 6144; (void)mod; \
    bf16_t* XN = (bf16_t*)(ws + WS_XN); bf16_t* YC = (bf16_t*)(ws + WS_YC); bf16_t* U = (bf16_t*)(ws + WS_BIG + BIG_U); bf16_t* QL = (bf16_t*)(ws + WS_BIG + BIG_UP); bf16_t* KVU = QL + 768; \
    bf16_t* KF = XN; bf16_t* HID = (bf16_t*)(ws + WS_BIG); bf16_t* QKV = (bf16_t*)(ws + WS_BIG); bf16_t* XB = (bf16_t*)(ws + WS_XB); (void)XB; float* SS = (float*)(ws + WS_SS); const float* SHW = (const float*)(ws + WS_SHW); (void)SS; (void)SHW; (void)XN; (void)YC; (void)U; (void)QL; (void)KVU; (void)KF; (void)HID; (void)QKV; \
    unsigned char* wb = ws + ((layer & 1) ? WS_WODD + (size_t)(layer >> 1) * W_ODD : WS_WEVEN + (size_t)(layer >> 1) * W_EVEN); unsigned char* wm = ws + WS_WMLP + (size_t)layer * W_MLP; (void)wb; (void)wm;
#define PHASE_END PROBE_T1W(); SEAM(); PROBE_T1(); } ++ph;
    int layer = 0;

    if (lo == 0) { CArgs* pa = KARGS(); c.a = pa; c.ws = pa->ws; RELAUNDER(c);
#if FX_REPEAT_KIND == 20
        {
          const u32x4* src = (const u32x4*)(pa->ws + 40 * MiB); u32x4 acc4 = (u32x4){0u, 0u, 0u, 0u}; const size_t n16 = (256 * MiB) / 16;
          for (size_t i = (size_t)c.bid * NT + c.tid; i < n16; i += (size_t)c.G * NT * 8) {
#pragma unroll
              for (int u = 0; u < 8; ++u) { const size_t k = i + (size_t)u * c.G * NT; if (k < n16) { const u32x4 v = src[k]; acc4.x ^= v.x; acc4.y ^= v.y; acc4.z ^= v.z; acc4.w ^= v.w; } } }
          if ((acc4.x ^ acc4.y ^ acc4.z ^ acc4.w) == 0x12345u) ((unsigned*)(pa->ws + 380 * MiB))[c.tid] = acc4.x; }
#endif
#ifndef SKIP_PRO
        REP(10) phase_prologue(c);
#endif
#ifdef PROBE_PHASE
        if (PROBE_PHASE == 0 && PROBE_WORK) { __syncthreads(); pr_dt = (unsigned)(__builtin_amdgcn_s_memrealtime() - pr_t0); }
#endif
#if FX_INKINIT && FX_MODE == 0
        cooperative_groups::this_grid().sync();
        { int t0_ = threadIdx.x; asm volatile("" : "+v"(t0_)); if (t0_ == 0) { unsigned* b_ = (unsigned*)(KARGS()->ws + WS_CTL) + 4096; (void)xb_add(&b_[XB_XCNT(xb_xcc_id())], 1u); } }
#else
        if (hi > 1) { if (pa->use_cg != 0) cooperative_groups::this_grid().sync(); else xcd_barrier(bar); }
#endif
#ifdef PROBE_PHASE
        if (PROBE_PHASE == 0 && !PROBE_WORK) pr_dt = (unsigned)(__builtin_amdgcn_s_memrealtime() - pr_t0);
#endif
    }
    ++ph;

#pragma clang loop unroll(full)
    for (layer = 0; layer < 4; ++layer) {
        const int j = layer >> 1;
        if (layer == 0) {
        PHASE_BEGIN
            PSEC_B(9); REP(8) phase_modnorm(c, pa->in[0], pa->in[5], mod + 0, mod + 1024, XN); PSEC_E(9);
            PSEC_B(10); REP(15) { shw_items(c, 0); if (FX_PRO_MATS >= 28) shw_items(c, 1); } PSEC_E(10);
            if (c.bid == c.G - 1) cbias_reduce(c);
        PHASE_END
        }
        if ((layer & 1) == 0) {
            PHASE_BEGIN { pg8::Gemm g{XN, (const bf16_t*)(wb + WE_IN), T, UW, D, D}; pg8::StaticOrder so; so.init(T, UW, c.G, c.bid); int pmv[4] = {-1, -1, -1, -1}; if (FX_RSLDS && layer != 0) rs_prepass(c, SS + (size_t)(2 * layer) * T * 16, T / 256, UW / 256, (LAS float*)(c.lds + LDS_MISC + 1024), pmv);
                EpiB16<0> E{U, UW, layer == 0 ? nullptr : SS + (size_t)(2 * layer) * T * 16, SHW + (size_t)(2 * layer) * 8 * 4096, (FX_RSLDS && layer != 0) ? (const LAS float*)(c.lds + LDS_MISC + 1024) : nullptr, pmv[0], pmv[1], pmv[2]};

#ifndef SKIP_G1
FX_STAGGER(FX_E1STAG);
REP(6) pg8::gemm_phase<EpiB16<0>, pg8::StaticOrder, true, true>(c.lds, g, so, E);
#endif
 } PHASE_END
            PHASE_BEGIN { pg8::Gemm g{U, (const bf16_t*)(wb + WE_UP), T, 1792, 256, UW}; UpOrder so; so.init(T, 1792, c.G, c.bid); EpiB16<0> E{QL, UPW, nullptr, nullptr, nullptr, -1, -1, -1};

#ifndef SKIP_G2
PSEC_B(13); REP(13) pg8::gemm_phase<EpiB16<0>, UpOrder, false, true>(c.lds, g, so, E); PSEC_E(13);
#endif

                __syncthreads();

#ifndef SKIP_CMP
 PSEC_B(14); REP(14) for (int it = c.bid; it < 256; it += c.G) compress_item(c, U, j, it); PSEC_E(14);
#endif


#ifndef SKIP_FIN
 RELAUNDER(c); PSEC_B(15); for (int m0 = gw; m0 < T; m0 += NGW * 4) nsa_finalize_rows(c, U, m0, NGW, j); PSEC_E(15);
#endif
 } PHASE_END
            PHASE_BEGIN {
#ifndef SKIP_FIN
 PSEC_B(16); for (int m0 = gw; m0 < T; m0 += NGW * MTB) mla_finalize_rows(c, U, QL, KVU, KF, m0, NGW, j);
                __syncthreads(); PSEC_E(16);
#endif

#if FX_NSAQ
                PSEC_B(17); { unsigned* qc = (unsigned*)(ws + WS_CTL) + 12288 + j * 256; unsigned xq = fx::xb_xcc_id() & 7u; asm volatile("" : "+s"(xq));
                  volatile LAS unsigned* bc = (volatile LAS unsigned*)(c.lds + LDS_MISC + 128);
                  for (unsigned k = 0; k < 8u; ++k) { const unsigned q = (xq + k) & 7u;
                      for (;;) { int t0_ = threadIdx.x; asm volatile("" : "+v"(t0_));
                          if (t0_ == 0) bc[0] = fx::xb_add(qc + q * 32, 1u);
                          __syncthreads();
                          const unsigned idx = (unsigned)__builtin_amdgcn_readfirstlane((int)bc[0]);
                          __syncthreads();
                          if (idx >= 64u) break;
#ifndef SKIP_NSA
                          nsa_unit(c, U, YC, (int)q, (int)(idx & 1u), 31 - (int)(idx >> 1));
#endif
                      } } }
#else
                PSEC_B(17); REP(1) for (int p = FX_XCDSWZ ? ((c.bid & 7) * (c.G >> 3) + (c.bid >> 3)) : c.bid; p < 256; p += c.G) { const int bg = p >> 4, s = p & 15;
#ifndef SKIP_NSA
 nsa_unit(c, U, YC, bg >> 1, bg & 1, 31 - s); nsa_unit(c, U, YC, bg >> 1, bg & 1, s);
#endif
 }
#endif
                PSEC_E(17); } PHASE_END
            PHASE_BEGIN { REP(2) for (int p = FX_XCDSWZ ? ((c.bid & 7) * (c.G >> 3) + (c.bid >> 3)) : c.bid; p < 256; p += c.G) { const int bh = p >> 2, s = p & 3;
#ifndef SKIP_MLA
 { bf16_t* yo_ = rep_ ? (bf16_t*)(ws + 344 * MiB) : YC; c.var = rep_ ? FX_VAR : 0; mla_unit(c, QL, KF, KVU, yo_, bh >> 3, bh & 7, 7 - s); mla_unit(c, QL, KF, KVU, yo_, bh >> 3, bh & 7, s); c.var = 0; }
#endif
 }
                if (layer == 0 && FX_PRO_MATS < 28) { __syncthreads(); RELAUNDER(c); convert_mats(c, FX_PRO_MATS, 28); } } PHASE_END
            PHASE_BEGIN { pg8::Gemm g{YC, (const bf16_t*)(wb + WE_OUT), T, D, D, D}; pg8::StaticOrder so; so.init(T, D, c.G, c.bid);
#ifndef SKIP_G3
REP(9) { EpiResid E{layer == 0 ? pa->in[0] : nullptr, XB, nullptr, rep_ ? DUMMY_XB : XB, mod + 2048, XN, pa->in[6] + layer * D, mod + 4096, SS + (size_t)(2 * layer + 1) * T * 16}; pg8::gemm_phase<EpiResid, pg8::StaticOrder, true, true>(c.lds, g, so, E); }
#endif
                if (layer == 0 && FX_PRO_MATS < 28) { RELAUNDER(c); shw_items(c, 1); }
 } PHASE_END
        } else {
            PHASE_BEGIN { pg8::Gemm g{XN, (const bf16_t*)(wb + WO_QKV), T, 3072, D, D}; pg8::StaticOrder so; so.init(T, 3072, c.G, c.bid); int pmv[4] = {-1, -1, -1, -1}; if (FX_RSLDS) rs_prepass(c, SS + (size_t)(2 * layer) * T * 16, T / 256, 3072 / 256, (LAS float*)(c.lds + LDS_MISC + 1024), pmv);
                EpiB16<0> E{QKV, 3072, SS + (size_t)(2 * layer) * T * 16, SHW + (size_t)(2 * layer) * 8 * 4096, FX_RSLDS ? (const LAS float*)(c.lds + LDS_MISC + 1024) : nullptr, pmv[0], pmv[1], pmv[2]};

#ifndef SKIP_G4
FX_STAGGER(FX_O1STAG);
PSEC_B(11); REP(7) pg8::gemm_phase<EpiB16<0>, pg8::StaticOrder, true, true>(c.lds, g, so, E); PSEC_E(11); PSEC_B(12);
                asm volatile("s_waitcnt vmcnt(0)" ::: "memory"); __syncthreads(); RELAUNDER(c);
                for (int i = 0; i < 3; ++i) { int pm_, pn_; if (!static_unit(T / 256, 3072 / 256, c.G, c.bid, i, pm_, pn_)) break; if (pn_ < 8) diff_finalize_tile(c, QKV, pm_, pn_, j); } PSEC_E(12);
#endif
 } PHASE_END
            PHASE_BEGIN { REP(3) for (int p = FX_XCDSWZ ? ((c.bid & 7) * (c.G >> 3) + (c.bid >> 3)) : c.bid; p < 256; p += c.G) { const int bh = p >> 2, s = p & 3;
#ifndef SKIP_DIFF
 diff_unit(c, QKV, YC, bh >> 3, bh & 7, 7 - s, j, layer); diff_unit(c, QKV, YC, bh >> 3, bh & 7, s, j, layer);
#endif
 } } PHASE_END
            PHASE_BEGIN { pg8::Gemm g{YC, (const bf16_t*)(wb + WO_O), T, D, D, D}; pg8::StaticOrder so; so.init(T, D, c.G, c.bid);
#ifndef SKIP_G5
REP(9) { EpiResid E{nullptr, XB, nullptr, rep_ ? DUMMY_XB : XB, mod + 2048, XN, pa->in[6] + layer * D, mod + 4096, SS + (size_t)(2 * layer + 1) * T * 16}; pg8::gemm_phase<EpiResid, pg8::StaticOrder, true, true>(c.lds, g, so, E); }
#endif
 } PHASE_END
        }
        PHASE_BEGIN { pg8::Gemm g{XN, (const bf16_t*)wm, T, FF, D, D}; pg8::StaticOrder so; so.init(T, FF, c.G, c.bid); int pmv[4] = {-1, -1, -1, -1}; if (FX_RSLDS) rs_prepass(c, SS + (size_t)(2 * layer + 1) * T * 16, T / 256, FF / 256, (LAS float*)(c.lds + LDS_MISC + 1024), pmv);
            EpiB16<1> E{HID, FF, SS + (size_t)(2 * layer + 1) * T * 16, SHW + (size_t)(2 * layer + 1) * 8 * 4096, FX_RSLDS ? (const LAS float*)(c.lds + LDS_MISC + 1024) : nullptr, pmv[0], pmv[1], pmv[2]};

#ifndef SKIP_G6
#if FX_M1STAG
            FX_STAGGER(FX_M1STAG);
#endif
REP(4) pg8::gemm_phase<EpiB16<1>, pg8::StaticOrder, true, true>(c.lds, g, so, E);
#endif
 } PHASE_END
        PHASE_BEGIN { pg8::Gemm g{HID, (const bf16_t*)(wm + 8 * MiB), T, D, FF, FF}; pg8::StaticOrder so; so.init(T, D, c.G, c.bid);
#ifndef SKIP_G7
REP(5) { EpiResid E{nullptr, XB, (layer == 3 && !rep_) ? pa->out : nullptr, rep_ ? DUMMY_XB : XB, mod + 5120, layer < 3 ? XN : nullptr, pa->in[5] + (layer + 1) * D, MOD + (size_t)(layer + 1) * 8 * 6144 + 1024, SS + (size_t)(2 * layer + 2) * T * 16}; pg8::gemm_phase<EpiResid, pg8::StaticOrder, true, true>(c.lds, g, so, E); }
#endif
 } PHASE_END
    }
#ifdef PROBE_SEC
#ifndef PROBE_WAVE
#define PROBE_WAVE 0
#endif
    if (blockIdx.x == 0 && threadIdx.x == PROBE_WAVE * 64) MISC[16] = c.pr_acc;
    __syncthreads();
#endif
#ifdef PROBE_PHASE
    { if (blockIdx.x == 0 && threadIdx.x == 0) {
#ifndef PROBE_MULT
#define PROBE_MULT 2u
#endif
          const unsigned long long t_end = __builtin_amdgcn_s_memrealtime();
#ifdef PROBE_SEC
          pr_dt = MISC[16];
#endif
#ifdef PROBE_EPI
          pr_dt = MISC[17];
#endif
          const unsigned long long wait = (unsigned long long)pr_dt * PROBE_MULT;
          while (__builtin_amdgcn_s_memrealtime() - t_end < wait) __builtin_amdgcn_s_sleep(8); } }
#endif
#undef PHASE_BEGIN
#undef PHASE_END
#undef SEAM
}
constexpr int N_PHASES = 1 + 1 + 2 * (5 + 2) + 2 * (3 + 2);
static_assert(N_PHASES == 26, "phase count");

inline void launch(const Args& base, int lo, int hi, int use_cg, hipStream_t st) {
    static int grid = 0;
    if (grid == 0) {
        int dev = 0, cus = 0, per_cu = 0;
        (void)hipGetDevice(&dev); (void)hipDeviceGetAttribute(&cus, hipDeviceAttributeMultiprocessorCount, dev);
        (void)hipFuncSetAttribute((const void*)mega, hipFuncAttributeMaxDynamicSharedMemorySize, LDS_BYTES);
        (void)hipOccupancyMaxActiveBlocksPerMultiprocessor(&per_cu, (const void*)mega, NT, LDS_BYTES);
        if (per_cu < 1) { fprintf(stderr, "occupancy query says %d blocks/CU\n", per_cu); per_cu = 1; }
        grid = 256;
        if (cus != 256) fprintf(stderr, "note: device reports %d CUs; this kernel is built for 256\n", cus);
        (void)hipGetLastError();
    }
    Args a = base; a.ph_lo = lo; a.ph_hi = hi; a.use_cg = use_cg; a.pad = 0;
    void* kargs[] = {&a};
#ifndef FX_COOP
#define FX_COOP 1
#endif
#if FX_COOP
    hipError_t e = hipLaunchCooperativeKernel((const void*)mega, dim3(grid), dim3(NT), kargs, LDS_BYTES, st);
    if (e != hipSuccess) fprintf(stderr, "cooperative launch failed: %s\n", hipGetErrorString(e));
#else
    (void)kargs; hipLaunchKernelGGL(mega, dim3(grid), dim3(NT), LDS_BYTES, st, a);
#endif
}
}
#ifndef FX_COOP
#define FX_COOP 1
#endif
#ifndef FX_MODE
#define FX_MODE 0
#endif
#ifndef DBG_LAYERS
#define DBG_LAYERS 1
#endif
#ifndef DBG_B0
#define DBG_B0 5
#endif
#ifndef DBG_STAGE
#define DBG_STAGE 0
#endif
#ifndef DBG_NPH
#define DBG_NPH -1
#endif
namespace dbg {
__global__ void k_cmp(const void* fast, int is_bf16, long fld, const float* ref, long rld, int nrows, int ncols, float fscale, float* acc2) {
    const long n = (long)nrows * ncols; float d2 = 0.f, r2 = 0.f;
    for (long i = (long)blockIdx.x * 256 + threadIdx.x; i < n; i += (long)gridDim.x * 256) { const long r = i / ncols, cidx = i % ncols;
        float a = is_bf16 ? fx::bf2f(((const unsigned short*)fast)[r * fld + cidx]) : ((const float*)fast)[r * fld + cidx]; a *= fscale;
        const float b = ref[r * rld + cidx]; if (!(a == a)) a = 1e6f; d2 += (a - b) * (a - b); r2 += b * b; }
    for (int o = 32; o > 0; o >>= 1) { d2 += __shfl_xor(d2, o); r2 += __shfl_xor(r2, o); }
    if ((threadIdx.x & 63) == 0) { atomicAdd(acc2, d2); atomicAdd(acc2 + 1, r2); }
}
#ifndef DBG_SEL
#define DBG_SEL -1
#endif
__global__ void k_finish(float* out, const float* acc, int nchk, long n) {
    float e = 0.f; int bad = -1; for (int i = 0; i < nchk; ++i) { float v = sqrtf(acc[2 * i] / fmaxf(acc[2 * i + 1], 1e-30f)); if (!(v == v)) v = 100.f; e = fmaxf(e, v); if (bad < 0 && v > 0.05f) bad = i; }
    if (DBG_SEL >= 0) { e = sqrtf(acc[2 * DBG_SEL] / fmaxf(acc[2 * DBG_SEL + 1], 1e-30f)); if (!(e == e)) e = 100.f; bad = -1; }
    if (blockIdx.x == 0 && threadIdx.x == 0 && bad >= 0) out[0] += 1000.f * (bad + 1);
    for (long i = (long)blockIdx.x * 256 + threadIdx.x; i < n; i += (long)gridDim.x * 256) out[i] *= (1.f + e);
}
}
extern "C" void kernel_launch(void* const* d_in, const int* in_sizes, int n_in, void* d_out, int out_size, void* d_ws, size_t ws_size, hipStream_t stream) {
    if (ws_size < (size_t)340 * fx::MiB || n_in < 28) { fprintf(stderr, "kernel_launch: needs 28 inputs and >= 340 MiB of workspace (got %d, %zu)\n", n_in, ws_size); return; }
    fx::Args a{};
    for (int i = 0; i < 28; ++i) a.in[i] = (const float*)d_in[i];
    a.pos = (const int*)d_in[2]; a.out = (float*)d_out; a.ws = (unsigned char*)d_ws;
#if !(FX_INKINIT && FX_MODE == 0 && FX_COOP)
    (void)hipMemsetAsync((char*)d_ws + fx::WS_CTL, 0, 65536, stream);
#endif
#if FX_MODE == 0
    fx::launch(a, 0, fx::N_PHASES, FX_COOP ? 1 : 0, stream);
#elif FX_MODE == 1
    for (int p = 0; p < fx::N_PHASES; ++p) fx::launch(a, p, p + 1, 0, stream);
#else
    nv::In in{}; for (int i = 0; i < 28; ++i) in.p[i] = (const float*)d_in[i]; in.pos = (const int*)d_in[2];
    float* errs = (float*)((char*)d_ws + 381 * fx::MiB);
    (void)hipMemsetAsync(errs, 0, 256, stream);
    const int nph = DBG_NPH >= 0 ? DBG_NPH : (DBG_LAYERS == 1 ? 9 : DBG_LAYERS == 2 ? 15 : DBG_LAYERS == 3 ? 22 : 28);
    for (int p = 0; p < nph; ++p) fx::launch(a, p, p + 1, 0, stream);
    float* nws = (float*)((char*)d_ws + fx::WS_NAIVE); float* nx = (float*)((char*)d_ws + fx::WS_NAIVE + 56 * fx::MiB);
    nv::forward(in, nx, nws, stream, DBG_LAYERS, DBG_B0, 1, DBG_STAGE == 8 ? 6 : DBG_STAGE);
    int nchk = 0;
    auto CMPR = [&](const void* f, int isb, long fld, const float* r, long rld, int nrows, int ncols, float fs) { hipLaunchKernelGGL(dbg::k_cmp, dim3(512), dim3(256), 0, stream, f, isb, fld, r, rld, nrows, ncols, fs, errs + 2 * nchk); ++nchk; };
    auto CMP = [&](const void* f, int isb, long fld, const float* r, long rld, int ncols, float fs) { CMPR(f, isb, fld, r, rld, 2048, ncols, fs); };
    const size_t r0 = (size_t)DBG_B0 * 2048;
    unsigned char* ws = (unsigned char*)d_ws;
    const size_t NMi = (size_t)(1u << 20) / 8;
    float* nU = nws + nv::R_U; float* nRA = nU + 29 * NMi; float* nRB = nRA + 12 * NMi; float* nRC = nRB + 16 * NMi; float* nRD = nRC + 12 * NMi; float* nH = nRD + 8 * NMi;
    (void)nRA; (void)nRB; (void)nRC; (void)nRD; (void)nH;
    const fx::bf16_t* fU = (const fx::bf16_t*)(ws + fx::WS_BIG + fx::BIG_U); const fx::bf16_t* fQL = (const fx::bf16_t*)(ws + fx::WS_BIG + fx::BIG_UP);
    const fx::bf16_t* fKVU = fQL + 768; const fx::bf16_t* fXN = (const fx::bf16_t*)(ws + fx::WS_XN); const fx::bf16_t* fYC = (const fx::bf16_t*)(ws + fx::WS_YC);
    (void)fU; (void)fQL; (void)fKVU; (void)fXN; (void)fYC;
#if DBG_STAGE == 0 || DBG_STAGE == 9
    CMP((const float*)d_out + r0 * 1024, 0, 1024, nx, 1024, 1024, 1.f);
#elif DBG_STAGE == 1
    if ((DBG_LAYERS & 1) == 1) { CMP(fU + r0 * 2048, 1, 2048, nU, 1848, 544, 1.f); CMP(fU + r0 * 2048 + 1056, 1, 2048, nU + 1056, 1848, 256, 1.f); CMP(fU + r0 * 2048 + 1824, 1, 2048, nU + 1824, 1848, 24, 1.f); }
    else { CMP(fU + r0 * 3072 + 2048, 1, 3072, nU + 2048, 3072, 1024, 1.f); }
#elif DBG_STAGE == 2
    if ((DBG_LAYERS & 1) == 1) { CMP(fQL + r0 * 1792, 1, 1792, nRC, 768, 768, 1.f / (0.10206207261596577f * 1.4426950408889634f)); CMP(fXN + r0 * 768, 1, 768, nRA, 768, 768, 1.f); }
    else { CMP(fU + r0 * 3072, 1, 3072, nU, 3072, 1024, 1.f / (0.125f * 1.4426950408889634f)); CMP(fU + r0 * 3072 + 1024, 1, 3072, nU + 1024, 3072, 1024, 1.f); }
#elif DBG_STAGE == 3
    CMP(fU + r0 * 2048, 1, 2048, nU, 1848, 544, 1.f); CMP(fU + r0 * 2048 + 1056, 1, 2048, nU + 1056, 1848, 256, 1.f); CMP(fU + r0 * 2048 + 1824, 1, 2048, nU + 1824, 1848, 24, 1.f);
    CMP(fQL + r0 * 1792, 1, 1792, nRC, 768, 768, 1.f / (0.10206207261596577f * 1.4426950408889634f)); CMP(fXN + r0 * 768, 1, 768, nRA, 768, 768, 1.f);
    CMP(fYC + r0 * 1024, 1, 1024, nH, 1024, 512, 1.f);
#elif DBG_STAGE == 4
    if ((DBG_LAYERS & 1) == 1) { CMP(fU + r0 * 2048 + 544, 1, 2048, nRD, 512, 512, 1.f / (0.125f * 1.4426950408889634f)); }
    else { CMP(fYC + r0 * 1024, 1, 1024, nU, 1024, 1024, 1.f); }
#elif DBG_STAGE == 6
    { const float* nSM = nws + nv::R_SMALL; const fx::bf16_t* fKC = (const fx::bf16_t*)(ws + fx::WS_MISC + 65536) + (size_t)DBG_B0 * 2 * 128 * 64; const fx::bf16_t* fVC = fKC + 16 * 128 * 64;
      CMP(fU + r0 * 2048 + 544, 1, 2048, nRD, 512, 512, 1.f / (0.125f * 1.4426950408889634f));
      CMPR(fKC, 1, 64, nSM, 64, 127, 64, 1.f); CMPR(fKC + 128 * 64, 1, 64, nSM + 128 * 64, 64, 127, 64, 1.f);
      CMPR(fVC, 1, 64, nSM + 16 * 128 * 64, 64, 127, 64, 1.f); CMPR(fVC + 128 * 64, 1, 64, nSM + 17 * 128 * 64, 64, 127, 64, 1.f);
      CMP(fU + r0 * 2048 + 1312, 1, 2048, nRA, 128, 128, 1.f); CMP(fU + r0 * 2048 + 1568, 1, 2048, nRA + 2 * NMi, 128, 128, 1.f); }
#elif DBG_STAGE == 8
    { const float* nb_ = NSA_ONLY == 0 ? nRC : NSA_ONLY == 1 ? nRA + 4 * NMi : nRB; CMP(fYC + r0 * 1024 + 512, 1, 1024, nb_, 512, 512, 1.f); }
#elif DBG_STAGE == 7
    CMP(fYC + r0 * 1024, 1, 1024, nH, 1024, 512, 1.f); CMP(fYC + r0 * 1024 + 512, 1, 1024, nH + 512, 1024, 512, 1.f);
#endif
    nv::forward(in, (float*)d_out, (float*)d_ws, stream, 4, 0, 8, 0);
    hipLaunchKernelGGL(dbg::k_finish, dim3(1024), dim3(256), 0, stream, (float*)d_out, errs, nchk, (long)16384 * 1024);
#endif
}
```
